# Optimizing an MI355X kernel written in HIP

```python
import jax
import jax.numpy as jnp
from jax import lax
import numpy as np


D_MODEL = 1024
BATCH = 4
SEQ = 8192
DEPTH = 1

GRID_W = 64
CTX_LEN = 256
CONV_CH = 512
CONV_ROW_CH = CONV_CH // 2
CONV_WIDTH = 31
LRU_WIDTH = 512
LRU_HEADS = 8
LRU_HEAD_DIM = LRU_WIDTH // LRU_HEADS
LRU_CONV_WIDTH = 4
LRU_C = 8.0
N_DIRS = 2
D_IN = 2 * CONV_CH + 2 * LRU_WIDTH
D_MIX = CONV_CH + LRU_WIDTH
N_EXPERTS = 16
EC_CAPACITY = 2
D_EXPERT = 2816
N_MOD = 6
RMS_EPS = 1e-6
LN_EPS = 1e-5

kernel_name = "hybrid_conformer_rglru_ecmoe_dit"


def rms_norm(x, g):
    xf = x.astype(jnp.float32)
    y = xf * lax.rsqrt(jnp.mean(xf * xf, axis=-1, keepdims=True) + RMS_EPS)
    return (y * g.astype(jnp.float32)).astype(x.dtype)


def layer_norm(x, g, b):
    xf = x.astype(jnp.float32)
    mu = jnp.mean(xf, axis=-1, keepdims=True)
    var = jnp.mean(jnp.square(xf - mu), axis=-1, keepdims=True)
    y = (xf - mu) * lax.rsqrt(var + LN_EPS) * g.astype(jnp.float32) + b.astype(jnp.float32)
    return y.astype(x.dtype)


def adaln(cond, w, b):
    return jnp.split(jax.nn.silu(cond) @ w + b, N_MOD, axis=-1)


def modulate(h, shift, scale):
    return h * (1.0 + scale[:, None, :]) + shift[:, None, :]


def depthwise_conv_seq(u, w, pad):
    return lax.conv_general_dilated(u, w[:, None, :].astype(u.dtype), window_strides=(1,), padding=[pad],
                                    dimension_numbers=('NWC', 'WIO', 'NWC'), feature_group_count=u.shape[-1])


def depthwise_conv_grid(u, w):
    bsz, n, ch = u.shape
    rows = n // GRID_W
    pad = (CONV_WIDTH - 1) // 2
    g = u.reshape(bsz, rows, GRID_W, ch)
    w = w.astype(u.dtype)
    dn = ('NHWC', 'HWIO', 'NHWC')
    n_col = ch - CONV_ROW_CH
    y_row = lax.conv_general_dilated(g[..., :CONV_ROW_CH], w[:, :CONV_ROW_CH].reshape(1, CONV_WIDTH, 1, CONV_ROW_CH),
                                     (1, 1), [(0, 0), (pad, pad)], dimension_numbers=dn, feature_group_count=CONV_ROW_CH)
    y_col = lax.conv_general_dilated(g[..., CONV_ROW_CH:], w[:, CONV_ROW_CH:].reshape(CONV_WIDTH, 1, 1, n_col),
                                     (1, 1), [(pad, pad), (0, 0)], dimension_numbers=dn, feature_group_count=n_col)
    return jnp.concatenate([y_row, y_col], axis=-1).reshape(bsz, n, ch)


def conformer_tail(y, g, b):
    return jax.nn.silu(layer_norm(y, g, b))


def mixer_inputs(h, norm_g, shift, scale, w_in, b_in):
    u = modulate(rms_norm(h, norm_g), shift, scale)
    p = u @ w_in + b_in
    cv, cg, lx, lg = jnp.split(p, [CONV_CH, 2 * CONV_CH, 2 * CONV_CH + LRU_WIDTH], axis=-1)
    return cv * jax.nn.sigmoid(cg), lx, lg


def _linear_combine(left, right):
    a1, b1 = left
    a2, b2 = right
    return a1 * a2, a2 * b1 + b2


def rg_lru_dir(xr, lru_p, d, h0):
    conv_w, conv_b, wa, ba, wi, bi, lam = lru_p
    bsz, n, ch = xr.shape
    xc = depthwise_conv_seq(xr, conv_w[d], (LRU_CONV_WIDTH - 1, 0)) + conv_b[d]
    xh = xc.reshape(bsz, n, LRU_HEADS, LRU_HEAD_DIM)
    r = jax.nn.sigmoid((jnp.einsum('bnhi,hij->bnhj', xh, wa[d]).reshape(bsz, n, ch) + ba[d]).astype(jnp.float32))
    i = jax.nn.sigmoid((jnp.einsum('bnhi,hij->bnhj', xh, wi[d]).reshape(bsz, n, ch) + bi[d]).astype(jnp.float32))
    log_a = -LRU_C * r * jax.nn.softplus(-lam[d].astype(jnp.float32))
    a = jnp.exp(log_a)
    u = jnp.sqrt(-jnp.expm1(2.0 * log_a)) * (i * xc.astype(jnp.float32))
    a_cum, u_cum = lax.associative_scan(_linear_combine, (a, u), axis=1)
    return a_cum * h0[:, None, :] + u_cum


def merge_heads(conv_y, h_sum, lg, w_out, b_out):
    y_lru = (h_sum * jax.nn.gelu(lg.astype(jnp.float32))).astype(conv_y.dtype)
    return jnp.concatenate([conv_y, y_lru], axis=-1) @ w_out + b_out


def ec_moe(v, router_w, wg, wu, wd):
    bsz, n, _ = v.shape
    cap = EC_CAPACITY * n // N_EXPERTS
    aff = jax.nn.softmax(jnp.einsum('bnd,de->bne', v, router_w).astype(jnp.float32), axis=-1)
    gate, idx = lax.top_k(jnp.swapaxes(aff, 1, 2), cap)
    bidx = jnp.arange(bsz)[:, None, None]
    xs = jnp.swapaxes(v[bidx, idx], 0, 1)

    def expert(args):
        xe, wge, wue, wde = args
        return (jax.nn.silu(xe @ wge) * (xe @ wue)) @ wde

    ys = jnp.swapaxes(lax.map(expert, (xs, wg, wu, wd)), 0, 1)
    ys = ys * gate[..., None].astype(v.dtype)
    return jnp.zeros_like(v).at[bidx, idx].add(ys)


def hybrid_layer(x, ctx, c, c_ctx, norm1_g, norm2_g, ada_w, ada_b, w_in, b_in, conv_p, lru_p,
                 w_out, b_out, moe_p, update_ctx):
    conv_w, conv_b, ln_g, ln_b = conv_p
    mod = adaln(c, ada_w, ada_b)
    mod_c = adaln(c_ctx[None, :], ada_w, ada_b)

    c_glu, c_lx, c_lg = mixer_inputs(ctx, norm1_g, mod_c[0], mod_c[1], w_in, b_in)
    h0 = jnp.zeros((ctx.shape[0], LRU_WIDTH), jnp.float32)
    hf_c = rg_lru_dir(c_lx, lru_p, 0, h0)
    hb_c_rev = rg_lru_dir(c_lx[:, ::-1], lru_p, 1, h0)

    x_glu, x_lx, x_lg = mixer_inputs(x, norm1_g, mod[0], mod[1], w_in, b_in)
    conv_x = conformer_tail(depthwise_conv_grid(x_glu, conv_w) + conv_b, ln_g, ln_b)
    hf = rg_lru_dir(x_lx, lru_p, 0, hf_c[:, -1])
    hb = rg_lru_dir(x_lx[:, ::-1], lru_p, 1, hb_c_rev[:, -1])[:, ::-1]
    x = x + mod[2][:, None, :] * merge_heads(conv_x, hf + hb, x_lg, w_out, b_out)
    x = x + mod[5][:, None, :] * ec_moe(modulate(rms_norm(x, norm2_g), mod[3], mod[4]), *moe_p)

    if update_ctx:
        pad = (CONV_WIDTH - 1) // 2
        conv_c = conformer_tail(depthwise_conv_seq(c_glu, conv_w, (pad, pad)) + conv_b, ln_g, ln_b)
        ctx = ctx + mod_c[2][:, None, :] * merge_heads(conv_c, hf_c + hb_c_rev[:, ::-1], c_lg, w_out, b_out)
        ctx = ctx + mod_c[5][:, None, :] * ec_moe(modulate(rms_norm(ctx, norm2_g), mod_c[3], mod_c[4]), *moe_p)
    return x, ctx


def setup_inputs(seed: int = 0) -> dict:
    key = jax.random.key(seed)
    ks = jax.random.split(key, 28)
    f32 = jnp.float32

    def nrm(k, shape, scale):
        return scale * jax.random.normal(k, shape, f32)

    u = jax.random.uniform(ks[20], (DEPTH, N_DIRS, LRU_WIDTH), f32, 0.9, 0.999)
    a0 = u ** (1.0 / LRU_C)
    return {
        "x": nrm(ks[0], (BATCH, SEQ, D_MODEL), 1.0),
        "c": nrm(ks[1], (BATCH, D_MODEL), 1.0),
        "ctx": nrm(ks[2], (BATCH, CTX_LEN, D_MODEL), 1.0),
        "c_ctx": nrm(ks[3], (D_MODEL,), 1.0),
        "norm1_g": 1.0 + nrm(ks[4], (DEPTH, D_MODEL), 0.02),
        "norm2_g": 1.0 + nrm(ks[5], (DEPTH, D_MODEL), 0.02),
        "ada_w": nrm(ks[6], (DEPTH, D_MODEL, N_MOD * D_MODEL), D_MODEL ** -0.5),
        "ada_b": nrm(ks[7], (DEPTH, N_MOD * D_MODEL), 0.02),
        "w_in": nrm(ks[8], (DEPTH, D_MODEL, D_IN), D_MODEL ** -0.5),
        "b_in": nrm(ks[9], (DEPTH, D_IN), 0.02),
        "conv_dw_w": nrm(ks[10], (DEPTH, CONV_WIDTH, CONV_CH), CONV_WIDTH ** -0.5),
        "conv_dw_b": nrm(ks[11], (DEPTH, CONV_CH), 0.02),
        "conv_ln_g": 1.0 + nrm(ks[12], (DEPTH, CONV_CH), 0.02),
        "conv_ln_b": nrm(ks[13], (DEPTH, CONV_CH), 0.02),
        "lru_conv_w": nrm(ks[14], (DEPTH, N_DIRS, LRU_CONV_WIDTH, LRU_WIDTH), LRU_CONV_WIDTH ** -0.5),
        "lru_conv_b": nrm(ks[15], (DEPTH, N_DIRS, LRU_WIDTH), 0.02),
        "lru_wa": nrm(ks[16], (DEPTH, N_DIRS, LRU_HEADS, LRU_HEAD_DIM, LRU_HEAD_DIM), LRU_HEAD_DIM ** -0.5),
        "lru_ba": nrm(ks[17], (DEPTH, N_DIRS, LRU_WIDTH), 0.02),
        "lru_wi": nrm(ks[18], (DEPTH, N_DIRS, LRU_HEADS, LRU_HEAD_DIM, LRU_HEAD_DIM), LRU_HEAD_DIM ** -0.5),
        "lru_bi": nrm(ks[19], (DEPTH, N_DIRS, LRU_WIDTH), 0.02),
        "lru_lambda": jnp.log(a0) - jnp.log1p(-a0),
        "w_out": nrm(ks[21], (DEPTH, D_MIX, D_MODEL), D_MIX ** -0.5),
        "b_out": nrm(ks[22], (DEPTH, D_MODEL), 0.02),
        "router_w": nrm(ks[23], (DEPTH, D_MODEL, N_EXPERTS), D_MODEL ** -0.5),
        "exp_w_gate": nrm(ks[24], (DEPTH, N_EXPERTS, D_MODEL, D_EXPERT), D_MODEL ** -0.5),
        "exp_w_up": nrm(ks[25], (DEPTH, N_EXPERTS, D_MODEL, D_EXPERT), D_MODEL ** -0.5),
        "exp_w_down": nrm(ks[26], (DEPTH, N_EXPERTS, D_EXPERT, D_MODEL), D_EXPERT ** -0.5),
        "final_norm_g": 1.0 + nrm(ks[27], (D_MODEL,), 0.02),
    }


def reference(x, c, ctx, c_ctx, norm1_g, norm2_g, ada_w, ada_b, w_in, b_in, conv_dw_w, conv_dw_b,
              conv_ln_g, conv_ln_b, lru_conv_w, lru_conv_b, lru_wa, lru_ba, lru_wi, lru_bi, lru_lambda,
              w_out, b_out, router_w, exp_w_gate, exp_w_up, exp_w_down, final_norm_g):
    for l in range(DEPTH):
        conv_p = (conv_dw_w[l], conv_dw_b[l], conv_ln_g[l], conv_ln_b[l])
        lru_p = (lru_conv_w[l], lru_conv_b[l], lru_wa[l], lru_ba[l], lru_wi[l], lru_bi[l], lru_lambda[l])
        moe_p = (router_w[l], exp_w_gate[l], exp_w_up[l], exp_w_down[l])
        x, ctx = hybrid_layer(x, ctx, c, c_ctx, norm1_g[l], norm2_g[l], ada_w[l], ada_b[l], w_in[l], b_in[l],
                              conv_p, lru_p, w_out[l], b_out[l], moe_p, l < DEPTH - 1)
    return rms_norm(x, final_norm_g)
```

```cpp
#include <hip/hip_runtime.h>
#include <hip/hip_cooperative_groups.h>
#include <cstdio>
#include <cstdint>

#define LAS __attribute__((address_space(3)))
typedef unsigned short bf16_t;
typedef short bf16x8 __attribute__((ext_vector_type(8)));
typedef float f32x4 __attribute__((ext_vector_type(4)));
typedef float f32x2 __attribute__((ext_vector_type(2)));
typedef unsigned u32x4 __attribute__((ext_vector_type(4)));
typedef unsigned u32x2 __attribute__((ext_vector_type(2)));
typedef int v4i_t __attribute__((ext_vector_type(4)));
typedef _Float16 h2_t __attribute__((ext_vector_type(2)));
typedef int v8i_t __attribute__((ext_vector_type(8)));

constexpr int D = 1024, NB = 4, SEQ = 8192, NTOK = NB * SEQ, CTXL = 256, NCTX = NB * CTXL, NROWS = NTOK + NCTX;
constexpr int DE = 2816, NE = 16, CAP = 1024, ROWS_E = NB * CAP;
constexpr int NQ = 132;
constexpr int NWAVES = 8, NTHREADS = 512;

constexpr size_t MiB = 1u << 20;
constexpr size_t WS_CTL = 0, CTL_BYTES = 1 * MiB;
constexpr size_t WS_CTXFLAG = WS_CTL + 40960;
constexpr size_t WS_ADACNT = WS_CTL + 45056;
constexpr size_t WS_BHCNT = WS_CTL + 49152;
constexpr size_t WS_MOD = 1 * MiB;
constexpr size_t WS_CARRY = 2 * MiB;
constexpr size_t WS_AFFT = 7 * MiB;
constexpr size_t WS_IDXE = 9 * MiB;
constexpr size_t WS_GATEE = WS_IDXE + 256 * 1024;
constexpr size_t WS_INV = WS_GATEE + 256 * 1024;
constexpr size_t WS_WINT = 12 * MiB;
constexpr size_t WS_WOUTT = 16 * MiB;
constexpr size_t WS_WGUT = 18 * MiB;
constexpr size_t WS_WDT = 146 * MiB;
constexpr size_t WS_V = 190 * MiB;
constexpr size_t WS_R1 = 222 * MiB;
constexpr size_t WS_U = WS_R1;
constexpr size_t WS_XGLU = WS_R1 + 66 * MiB;
constexpr size_t WS_XLX = WS_R1 + 98 * MiB;
constexpr size_t WS_GLG = WS_R1 + 131 * MiB;
constexpr size_t WS_MIX = WS_R1 + 163 * MiB;
constexpr size_t WS_M = WS_R1 + 227 * MiB;
constexpr size_t WS_X1B = WS_R1 + 291 * MiB;
constexpr size_t WS_AU = WS_R1 + 291 * MiB;
constexpr size_t WS_END = 641 * MiB;
constexpr int LDS_BYTES = 147456;

__device__ __forceinline__ unsigned f2bf(float f) { unsigned u = __builtin_bit_cast(unsigned, f); return (u + 0x7fffu + ((u >> 16) & 1u)) >> 16; }
__device__ __forceinline__ unsigned pk2(float lo, float hi) { return f2bf(lo) | (f2bf(hi) << 16); }
__device__ __forceinline__ unsigned pk2h(float lo, float hi) { h2_t p; p.x = (_Float16)lo; p.y = (_Float16)hi; return __builtin_bit_cast(unsigned, p); }
__device__ __forceinline__ void fma_mix_lo(float& acc, float w, unsigned xh) { asm("v_fma_mix_f32 %0, %1, %2, %0 op_sel_hi:[0,1,0]" : "+v"(acc) : "v"(w), "v"(xh)); }
__device__ __forceinline__ void fma_mix_hi(float& acc, float w, unsigned xh) { asm("v_fma_mix_f32 %0, %1, %2, %0 op_sel:[0,1,0] op_sel_hi:[0,1,0]" : "+v"(acc) : "v"(w), "v"(xh)); }
__device__ __forceinline__ float bf_lo(unsigned w) { return __builtin_bit_cast(float, w << 16); }
__device__ __forceinline__ float bf_hi(unsigned w) { return __builtin_bit_cast(float, w & 0xffff0000u); }
__device__ __forceinline__ unsigned pk4_fp8(float a, float b, float c, float d) {
    a = __builtin_amdgcn_fmed3f(a, -448.f, 448.f); b = __builtin_amdgcn_fmed3f(b, -448.f, 448.f); c = __builtin_amdgcn_fmed3f(c, -448.f, 448.f); d = __builtin_amdgcn_fmed3f(d, -448.f, 448.f);
    int w = 0; w = __builtin_amdgcn_cvt_pk_fp8_f32(a, b, w, false); w = __builtin_amdgcn_cvt_pk_fp8_f32(c, d, w, true); return (unsigned)w; }
__device__ __forceinline__ float wave_sum(float v) {
#pragma unroll
    for (int o = 32; o >= 1; o >>= 1) v += __shfl_xor(v, o);
    return v;
}
__device__ __forceinline__ float wave_max(float v) {
#pragma unroll
    for (int o = 32; o >= 1; o >>= 1) v = fmaxf(v, __shfl_xor(v, o));
    return v;
}
__device__ __forceinline__ float sigm(float x) { return __builtin_amdgcn_rcpf(1.0f + __expf(-x)); }
__device__ __forceinline__ float silu_f(float x) { return x * sigm(x); }
__device__ __forceinline__ float gelu_tanh(float x) { const float z = 0.7978845608028654f * (x + 0.044715f * x * x * x); return x * sigm(2.0f * z); }

namespace pg8 {
constexpr int BM = 256, BK = 64, HALF = 128, HTB = HALF * BK * 2, STAGE_BYTES = 8 * HTB, NXCD = 8, WGM = 8;
__device__ __forceinline__ int lds_byte(int r, int c) { const int st = (r >> 4) * 2 + (c >> 5), rr = r & 15, cc = c & 31, ob = rr * 64 + cc * 2; return st * 1024 + (ob ^ (((ob >> 9) & 1) << 5)); }
__device__ __forceinline__ void stage_rc(int b, int& R, int& C) { const int st = b / 1024, sb = b % 1024, swz = sb ^ (((sb >> 9) & 1) << 5); R = (st >> 1) * 16 + swz / 64; C = (st & 1) * 32 + (swz % 64) / 2; }
__device__ __forceinline__ int perm32(int rho) { const int n = rho >> 4, i = rho & 15; return 8 * (i >> 2) + 4 * n + (i & 3); }
struct Unit { int pm, pn; };
struct Lay { unsigned rowA, rowB; size_t kstepA, kstepB, hstepB, tstepA, tstepB; };
__device__ __forceinline__ Lay lay_rowmajor(int K) { Lay l; l.rowA = l.rowB = (unsigned)K * 2u; l.kstepA = l.kstepB = 128; l.hstepB = (size_t)128 * K * 2; l.tstepA = l.tstepB = (size_t)256 * K * 2; return l; }
__device__ __forceinline__ Lay lay_blocked(int nkt) { Lay l; l.rowA = l.rowB = 128u; l.kstepA = l.kstepB = 32768; l.hstepB = 16384; l.tstepA = l.tstepB = (size_t)nkt * 32768; return l; }

__device__ __forceinline__ void tile_order(int w, int nM, int nN, int& pm, int& pn) {
    const int nwg = nM * nN;
    int wgid = w; { const int q = nwg / NXCD, r = nwg % NXCD, xcd = wgid % NXCD, off = wgid / NXCD; wgid = (xcd < r ? xcd * (q + 1) : r * (q + 1) + (xcd - r) * q) + off; }
    const int nig = WGM * nN, gid = wgid / nig, fm = gid * WGM, gsz = (nM - fm) < WGM ? (nM - fm) : WGM;
    pm = fm + ((wgid % nig) % gsz); pn = (wgid % nig) / gsz;
}
struct Sched {
    int nM, nN, ngroups, G, c;
    __device__ __forceinline__ bool next(int i, Unit& u) const {
        const int per = nM * nN; const long L = (long)i * G + c; if (L >= (long)per * ngroups) return false;
        const int e = (int)(L / per), w = (int)(L % per); int pm, pn; tile_order(w, nM, nN, pm, pn);
        u.pm = e * nM + pm; u.pn = e * nN + pn; return true;
    }
};
struct SchedInProj {
    int G, c;
    __device__ __forceinline__ bool next(int i, Unit& u) const {
        const long L = (long)i * G + c; if (L >= 1024) return false;
        int pm, pn; tile_order((int)L, 128, 8, pm, pn); u.pm = pm; u.pn = pn; return true;
    }
};
struct SchedCtx {
    int c;
    __device__ __forceinline__ bool next(int i, Unit& u) const {
        if (i != 0 || (c & 7) != 7 || (c >> 3) >= 8) return false;
        const int k = c >> 3; u.pm = 128 + (k >> 1); u.pn = 4 + (k & 1); return true;
    }
};
struct SchedDown {
    int G, c;
    __device__ __forceinline__ bool next(int i, Unit& u) const {
        if (G != 256) { const long L = (long)i * G + c; if (L >= 1024) return false; const int e = (int)(L >> 6), w = (int)(L & 63); u.pm = e * 16 + (w >> 2); u.pn = e * 4 + (w & 3); return true; }
        if (i >= 4) return false;
        const int x = c & 7, j = c >> 3, e = 4 * i + (x >> 1);
        u.pm = e * 16 + 8 * (x & 1) + (j & 7); u.pn = e * 4 + (j >> 3); return true;
    }
};
template <class Epi, class SchedT, bool GATHER, bool FP8 = false, bool SP2 = true, bool ALIGN_EPI = true>
__device__ __forceinline__ void gemm_phase(LAS unsigned char* lds, const bf16_t* Ag, const bf16_t* Btg, const int K, const SchedT& S, const Epi& E, const int* gidx, const int TID, const int BID, const int GD, const int scaleB, const Lay L) {
    const int tid = TID, wid = __builtin_amdgcn_readfirstlane(tid >> 6), lane = tid & 63, wr = wid >> 2, wc = wid & 3, fr = lane & 15, fq = lane >> 4;
    const int nt = K / BK;
    int Rr[2], Cc[2]; unsigned voffB[2];
#pragma unroll
    for (int i = 0; i < 2; ++i) { stage_rc(tid * 16 + i * 8192, Rr[i], Cc[i]); const int Rb = Epi::PERM ? ((Rr[i] & ~31) + perm32(Rr[i] & 31)) : Rr[i]; voffB[i] = (unsigned)Rb * L.rowB + (unsigned)Cc[i] * 2u; }
    const size_t kstepA = L.kstepA, kstepB = L.kstepB, hstep = L.hstepB, tstepA = L.tstepA, tstepB = L.tstepB;
    const unsigned ldsw = (unsigned)wid * 1024u;
    const int aoff = lds_byte(wr * 64 + fr, fq * 8), boff = lds_byte(wc * 32 + fr, fq * 8);
    const int aoff8_0 = aoff, aoff8_1 = aoff + 1024, boff8_0 = boff, boff8_1 = boff + 1024;
#define PG8_SA(b, h) (((b) * 2 + (h)) * HTB)
#define PG8_SB(b, h) ((4 + (b) * 2 + (h)) * HTB)
#define PG8_STAGE(bufoff, gbase, voff) do { _Pragma("unroll") for (int _i = 0; _i < 2; ++_i) \
        __builtin_amdgcn_global_load_lds((const unsigned*)((const char*)(gbase) + (voff)[_i]), (LAS unsigned*)(lds + (bufoff) + ldsw + _i * 8192), 16, 0, 0); } while (0)
#define PG8_LD8(p0, p1) __builtin_shufflevector(*(const LAS v4i_t*)(p0), *(const LAS v4i_t*)(p1), 0, 1, 2, 3, 4, 5, 6, 7)
#define PG8_LDA(dst, b, h) do { _Pragma("unroll") for (int m = 0; m < 4; ++m) { if constexpr (FP8) { \
        dst##8[m] = PG8_LD8(lds + PG8_SA(b, h) + aoff8_0 + m * 2048, lds + PG8_SA(b, h) + aoff8_1 + m * 2048); } else { \
        _Pragma("unroll") for (int k = 0; k < 2; ++k) dst[m][k] = *(const LAS bf16x8*)(lds + PG8_SA(b, h) + aoff + m * 2048 + k * 1024); } } } while (0)
#define PG8_LDB(dst, b, h) do { _Pragma("unroll") for (int n = 0; n < 2; ++n) { if constexpr (FP8) { \
        dst##8[n] = PG8_LD8(lds + PG8_SB(b, h) + boff8_0 + n * 2048, lds + PG8_SB(b, h) + boff8_1 + n * 2048); } else { \
        _Pragma("unroll") for (int k = 0; k < 2; ++k) dst[n][k] = *(const LAS bf16x8*)(lds + PG8_SB(b, h) + boff + n * 2048 + k * 1024); } } } while (0)
#define PG8_MMA(ai, bj, At, Bt) do { if constexpr (FP8) __builtin_amdgcn_sched_barrier(0); __builtin_amdgcn_s_setprio(1); _Pragma("unroll") for (int m = 0; m < 4; ++m) _Pragma("unroll") for (int n = 0; n < 2; ++n) { if constexpr (FP8) { \
        acc[ai][bj][m][n] = __builtin_amdgcn_mfma_scale_f32_16x16x128_f8f6f4(Bt##8[n], At##8[m], acc[ai][bj][m][n], 0, 0, 0, scaleB, 0, 0x7F7F7F7F); } else { \
        _Pragma("unroll") for (int k = 0; k < 2; ++k) acc[ai][bj][m][n] = __builtin_amdgcn_mfma_f32_16x16x32_bf16(Bt[n][k], At[m][k], acc[ai][bj][m][n], 0, 0, 0); } } \
        if constexpr (FP8) { _Pragma("unroll") for (int m = 0; m < 4; ++m) _Pragma("unroll") for (int n = 0; n < 2; ++n) asm volatile("" : "+v"(acc[ai][bj][m][n])); } \
        __builtin_amdgcn_s_setprio(0); if constexpr (FP8) __builtin_amdgcn_sched_barrier(0); } while (0)
#define PG8_WAIT_V(n) asm volatile("s_waitcnt vmcnt(" #n ")" ::: "memory")
#define PG8_WAIT_L(n) asm volatile("s_waitcnt lgkmcnt(" #n ")" ::: "memory")
#define PG8_BAR __builtin_amdgcn_s_barrier()
#define PG8_SCHED __builtin_amdgcn_sched_barrier(0)
#define PG8_LOADV(dst, u) do { _Pragma("unroll") for (int _h = 0; _h < 2; ++_h) _Pragma("unroll") for (int _i = 0; _i < 2; ++_i) \
        dst[_h][_i] = GATHER ? ((unsigned)gidx[(u).pm * BM + _h * HALF + Rr[_i]] * L.rowA + (unsigned)Cc[_i] * 2u) : ((unsigned)(_h * HALF + Rr[_i]) * L.rowA + (unsigned)Cc[_i] * 2u); } while (0)
    Unit cur, nxt; int ui = 0;
    if (!S.next(0, cur)) return;
    f32x4 acc[2][2][4][2];
#pragma unroll
    for (int a = 0; a < 2; ++a)
#pragma unroll
        for (int b = 0; b < 2; ++b)
#pragma unroll
            for (int m = 0; m < 4; ++m)
#pragma unroll
                for (int n = 0; n < 2; ++n) acc[a][b][m][n] = (f32x4){0.f, 0.f, 0.f, 0.f};
    bf16x8 At[4][2], B0[2][2], B1[2][2];
    v8i_t At8[4], B08[2], B18[2];
    unsigned vc[2][2], vn[2][2];
    PG8_LOADV(vc, cur);
    const char* cA = GATHER ? (const char*)Ag : (const char*)Ag + (size_t)cur.pm * tstepA;
    const char* cB = (const char*)Btg + (size_t)cur.pn * tstepB;
    if constexpr (SP2) {
        PG8_STAGE(PG8_SB(0, 0), cB, voffB); PG8_STAGE(PG8_SB(0, 1), cB + hstep, voffB); PG8_STAGE(PG8_SA(0, 0), cA, vc[0]); PG8_STAGE(PG8_SA(0, 1), cA, vc[1]);
        if (wr == 1) PG8_BAR;
        PG8_WAIT_V(2); PG8_BAR;
        PG8_STAGE(PG8_SB(1, 0), cB + kstepB, voffB); PG8_STAGE(PG8_SA(1, 0), cA + kstepA, vc[0]); PG8_STAGE(PG8_SB(1, 1), cB + hstep + kstepB, voffB);
        PG8_WAIT_V(6); PG8_BAR;
    } else {
    PG8_STAGE(PG8_SB(0, 0), cB, voffB); PG8_STAGE(PG8_SA(0, 0), cA, vc[0]); PG8_STAGE(PG8_SB(0, 1), cB + hstep, voffB); PG8_STAGE(PG8_SA(0, 1), cA, vc[1]);
    if (wr == 1) PG8_BAR;
    PG8_WAIT_V(4); PG8_BAR;
    PG8_STAGE(PG8_SB(1, 0), cB + kstepB, voffB); PG8_STAGE(PG8_SA(1, 0), cA + kstepA, vc[0]); PG8_STAGE(PG8_SB(1, 1), cB + hstep + kstepB, voffB);
    PG8_WAIT_V(6); PG8_BAR;
    }
    for (;;) {
        const bool has_next = S.next(ui + 1, nxt);
        const char* nA = cA; const char* nB = cB;
        if (has_next) { nA = GATHER ? (const char*)Ag : (const char*)Ag + (size_t)nxt.pm * tstepA; nB = (const char*)Btg + (size_t)nxt.pn * tstepB; PG8_LOADV(vn, nxt); }
        else {
#pragma unroll
            for (int h = 0; h < 2; ++h)
#pragma unroll
                for (int i = 0; i < 2; ++i) vn[h][i] = vc[h][i];
        }
        for (int t = 0; t < nt; t += 2) {
            const bool last = (t == nt - 2);
            const char* a1 = cA + (size_t)(t + 1) * kstepA;
            const char* a2 = last ? nA : cA + (size_t)(t + 2) * kstepA; const char* b2 = last ? nB : cB + (size_t)(t + 2) * kstepB;
            const char* a3 = a2 + kstepA; const char* b3 = b2 + kstepB;
#pragma unroll
            for (int i = 0; i < 2; ++i) vc[0][i] = last ? vn[0][i] : vc[0][i];
            if constexpr (SP2) {
            PG8_LDB(B0, 0, 0); PG8_LDB(B1, 0, 1); PG8_SCHED; PG8_LDA(At, 0, 0); PG8_STAGE(PG8_SA(1, 1), a1, vc[1]);
            _Pragma("unroll") for (int i = 0; i < 2; ++i) vc[1][i] = last ? vn[1][i] : vc[1][i];
            PG8_WAIT_V(8); PG8_WAIT_L(0); PG8_BAR; PG8_MMA(0, 0, At, B0); PG8_MMA(0, 1, At, B1); PG8_BAR; PG8_SCHED;
            PG8_LDA(At, 0, 1); PG8_STAGE(PG8_SB(0, 0), b2, voffB); PG8_STAGE(PG8_SB(0, 1), b2 + hstep, voffB); PG8_STAGE(PG8_SA(0, 0), a2, vc[0]);
            PG8_WAIT_V(8); PG8_WAIT_L(0); PG8_BAR; PG8_MMA(1, 0, At, B0); PG8_MMA(1, 1, At, B1); PG8_BAR; PG8_SCHED;
            PG8_LDB(B0, 1, 0); PG8_LDB(B1, 1, 1); PG8_SCHED; PG8_LDA(At, 1, 0); PG8_STAGE(PG8_SA(0, 1), a2, vc[1]);
            PG8_WAIT_V(8); PG8_WAIT_L(0); PG8_BAR; PG8_MMA(0, 0, At, B0); PG8_MMA(0, 1, At, B1); PG8_BAR; PG8_SCHED;
            PG8_LDA(At, 1, 1); PG8_STAGE(PG8_SB(1, 0), b3, voffB); PG8_STAGE(PG8_SB(1, 1), b3 + hstep, voffB); PG8_STAGE(PG8_SA(1, 0), a3, vc[0]);
            PG8_WAIT_V(8); PG8_WAIT_L(0); PG8_BAR; PG8_MMA(1, 0, At, B0); PG8_MMA(1, 1, At, B1); PG8_BAR; PG8_SCHED;
            } else {
            PG8_LDB(B0, 0, 0); PG8_SCHED; PG8_LDA(At, 0, 0); PG8_STAGE(PG8_SA(1, 1), a1, vc[1]);
            _Pragma("unroll") for (int i = 0; i < 2; ++i) vc[1][i] = last ? vn[1][i] : vc[1][i];
            PG8_WAIT_L(8); PG8_BAR; PG8_WAIT_L(0); PG8_MMA(0, 0, At, B0); PG8_BAR; PG8_SCHED;
            PG8_LDB(B1, 0, 1); PG8_STAGE(PG8_SB(0, 0), b2, voffB);
            PG8_BAR; PG8_WAIT_L(0); PG8_MMA(0, 1, At, B1); PG8_BAR;
            PG8_LDA(At, 0, 1); PG8_STAGE(PG8_SA(0, 0), a2, vc[0]);
            PG8_BAR; PG8_WAIT_L(0); PG8_MMA(1, 0, At, B0); PG8_BAR; PG8_SCHED;
            PG8_STAGE(PG8_SB(0, 1), b2 + hstep, voffB);
            PG8_WAIT_V(6); PG8_BAR; PG8_MMA(1, 1, At, B1); PG8_BAR;
            PG8_LDB(B0, 1, 0); PG8_SCHED; PG8_LDA(At, 1, 0); PG8_STAGE(PG8_SA(0, 1), a2, vc[1]);
            PG8_WAIT_L(8); PG8_BAR; PG8_WAIT_L(0); PG8_MMA(0, 0, At, B0); PG8_BAR; PG8_SCHED;
            PG8_LDB(B1, 1, 1); PG8_STAGE(PG8_SB(1, 0), b3, voffB);
            PG8_BAR; PG8_WAIT_L(0); PG8_MMA(0, 1, At, B1); PG8_BAR;
            PG8_LDA(At, 1, 1); PG8_STAGE(PG8_SA(1, 0), a3, vc[0]);
            PG8_BAR; PG8_WAIT_L(0); PG8_MMA(1, 0, At, B0); PG8_BAR; PG8_SCHED;
            PG8_STAGE(PG8_SB(1, 1), b3 + hstep, voffB);
            PG8_WAIT_V(6); PG8_BAR; PG8_MMA(1, 1, At, B1); PG8_BAR;
            }
        }
        if constexpr (ALIGN_EPI) { if (wr == 0) PG8_BAR; }
        E(acc, cur, wr, wc, fr, fq);
        if (!has_next) break;
#pragma unroll
        for (int a = 0; a < 2; ++a)
#pragma unroll
            for (int b = 0; b < 2; ++b)
#pragma unroll
                for (int m = 0; m < 4; ++m)
#pragma unroll
                    for (int n = 0; n < 2; ++n) acc[a][b][m][n] = (f32x4){0.f, 0.f, 0.f, 0.f};
        cur = nxt; cA = nA; cB = nB; ++ui;
#pragma unroll
        for (int h = 0; h < 2; ++h)
#pragma unroll
            for (int i = 0; i < 2; ++i) vc[h][i] = vn[h][i];
        if constexpr (ALIGN_EPI) { if (wr == 1) PG8_BAR; }
    }
    PG8_WAIT_V(0);
    if constexpr (!ALIGN_EPI) { if (wr == 0) PG8_BAR; }
    PG8_BAR;
#undef PG8_SA
#undef PG8_SB
#undef PG8_STAGE
#undef PG8_LDA
#undef PG8_LDB
#undef PG8_MMA
#undef PG8_LD8
#undef PG8_WAIT_V
#undef PG8_WAIT_L
#undef PG8_BAR
#undef PG8_SCHED
#undef PG8_LOADV
}
}

struct EpiInProj {
    static constexpr bool PERM = true;
    bf16_t* xglu; bf16_t* xlx; bf16_t* glg; const float* b_in;
    __device__ __forceinline__ void operator()(const f32x4 (&acc)[2][2][4][2], const pg8::Unit& u, int wr, int wc, int fr, int fq) const {
        const int row0 = u.pm * 256 + wr * 64 + fr, cl = wc * 32 + 8 * fq;
        if (u.pn < 4) {
            const int col = 128 * u.pn + cl;
            f32x4 bv[2][2];
#pragma unroll
            for (int n = 0; n < 2; ++n) { bv[0][n] = *(const f32x4*)(b_in + col + 4 * n); bv[1][n] = *(const f32x4*)(b_in + 512 + col + 4 * n); }
#pragma unroll
            for (int ai = 0; ai < 2; ++ai)
#pragma unroll
                for (int m = 0; m < 4; ++m) {
                    const size_t row = (size_t)(row0 + ai * 128 + m * 16);
                    float o[8];
#pragma unroll
                    for (int n = 0; n < 2; ++n) { const f32x4 v = acc[ai][0][m][n] + bv[0][n], g = acc[ai][1][m][n] + bv[1][n];
#pragma unroll
                        for (int j = 0; j < 4; ++j) o[4 * n + j] = v[j] * sigm(g[j]); }
                    u32x4 w; w.x = pk2h(o[0], o[1]); w.y = pk2h(o[2], o[3]); w.z = pk2h(o[4], o[5]); w.w = pk2h(o[6], o[7]);
                    *(u32x4*)(xglu + row * 512 + col) = w;
                }
        } else {
            const bool isg = u.pn >= 6;
            const int cbase = 256 * (u.pn - (isg ? 6 : 4));
            const float* bias = b_in + (isg ? 1536 : 1024) + cbase;
            bf16_t* outp = isg ? glg : xlx;
#pragma unroll
            for (int bj = 0; bj < 2; ++bj) {
                const int col = 128 * bj + cl;
                const f32x4 b0 = *(const f32x4*)(bias + col), b1 = *(const f32x4*)(bias + col + 4);
#pragma unroll
                for (int ai = 0; ai < 2; ++ai)
#pragma unroll
                    for (int m = 0; m < 4; ++m) {
                        const size_t row = (size_t)(row0 + ai * 128 + m * 16);
                        f32x4 v0 = acc[ai][bj][m][0] + b0, v1 = acc[ai][bj][m][1] + b1;
                        if (isg) {
#pragma unroll
                            for (int j = 0; j < 4; ++j) { v0[j] = gelu_tanh(v0[j]); v1[j] = gelu_tanh(v1[j]); }
                        }
                        u32x4 w; w.x = pk2(v0[0], v0[1]); w.y = pk2(v0[2], v0[3]); w.z = pk2(v1[0], v1[1]); w.w = pk2(v1[2], v1[3]);
                        *(u32x4*)(outp + row * 512 + cbase + col) = w;
                    }
            }
        }
    }
};
struct EpiOutProj {
    static constexpr bool PERM = true;
    bf16_t* M; const float* mod; const float* b_out;
    __device__ __forceinline__ void operator()(const f32x4 (&acc)[2][2][4][2], const pg8::Unit& u, int wr, int wc, int fr, int fq) const {
        const int row0 = u.pm * 256 + wr * 64 + fr, col0 = u.pn * 256 + wc * 32 + 8 * fq;
        const int b = u.pm >> 5;
        const float* g1 = mod + b * 6144 + 2048;
#pragma unroll
        for (int bj = 0; bj < 2; ++bj) {
            const int col = col0 + bj * 128;
            const f32x4 bo0 = *(const f32x4*)(b_out + col), bo1 = *(const f32x4*)(b_out + col + 4), gg0 = *(const f32x4*)(g1 + col), gg1 = *(const f32x4*)(g1 + col + 4);
#pragma unroll
            for (int ai = 0; ai < 2; ++ai)
#pragma unroll
                for (int m = 0; m < 4; ++m) {
                    const f32x4 v0 = gg0 * (acc[ai][bj][m][0] + bo0), v1 = gg1 * (acc[ai][bj][m][1] + bo1);
                    u32x4 w; w.x = pk2(v0[0], v0[1]); w.y = pk2(v0[2], v0[3]); w.z = pk2(v1[0], v1[1]); w.w = pk2(v1[2], v1[3]);
                    *(u32x4*)(M + (size_t)(row0 + ai * 128 + m * 16) * D + col) = w;
                }
        }
    }
};
struct EpiExpUp {
    static constexpr bool PERM = true;
    unsigned char* H;
    __device__ __forceinline__ void operator()(const f32x4 (&acc)[2][2][4][2], const pg8::Unit& u, int wr, int wc, int fr, int fq) const {
        const int e = u.pm >> 4, t = u.pn - e * 22;
        const int row0 = u.pm * 256 + wr * 64 + fr, col = 128 * t + wc * 32 + 8 * fq;
#pragma unroll
        for (int ai = 0; ai < 2; ++ai)
#pragma unroll
            for (int m = 0; m < 4; ++m) {
                const size_t row = (size_t)(row0 + ai * 128 + m * 16);
                float o[8];
#pragma unroll
                for (int n = 0; n < 2; ++n)
#pragma unroll
                    for (int j = 0; j < 4; j += 2) {
                        const f32x2 g2 = (f32x2){acc[ai][0][m][n][j], acc[ai][0][m][n][j + 1]}, u2 = (f32x2){acc[ai][1][m][n][j], acc[ai][1][m][n][j + 1]};
                        const f32x2 tt = g2 * (-1.4426950408889634f);
                        f32x2 ee; ee.x = __builtin_amdgcn_exp2f(tt.x); ee.y = __builtin_amdgcn_exp2f(tt.y);
                        const f32x2 dd = ee + 1.0f;
                        f32x2 rr; rr.x = __builtin_amdgcn_rcpf(dd.x); rr.y = __builtin_amdgcn_rcpf(dd.y);
                        const f32x2 hh = (g2 * u2) * rr;
                        o[4 * n + j] = hh.x; o[4 * n + j + 1] = hh.y; }
                u32x2 w; w.x = pk4_fp8(o[0], o[1], o[2], o[3]); w.y = pk4_fp8(o[4], o[5], o[6], o[7]);
                *(u32x2*)(H + ((size_t)u.pm * 22 + t) * 32768 + (size_t)(row - (size_t)u.pm * 256) * 128 + (col - 128 * t)) = w;
            }
    }
};
struct EpiExpDown {
    static constexpr bool PERM = true;
    unsigned char* Y; const float* gateE;
    __device__ __forceinline__ void operator()(const f32x4 (&acc)[2][2][4][2], const pg8::Unit& u, int wr, int wc, int fr, int fq) const {
        const int e = u.pm >> 4, c4 = u.pn - e * 4;
        const int row0 = u.pm * 256 + wr * 64 + fr, col0 = 256 * c4 + wc * 32 + 8 * fq;
#pragma unroll
        for (int ai = 0; ai < 2; ++ai)
#pragma unroll
            for (int m = 0; m < 4; ++m) {
                const size_t row = (size_t)(row0 + ai * 128 + m * 16);
                const float g = gateE[row] * 32.0f;
#pragma unroll
                for (int bj = 0; bj < 2; ++bj) {
                    const f32x4 v0 = acc[ai][bj][m][0] * g, v1 = acc[ai][bj][m][1] * g;
                    u32x2 w; w.x = pk4_fp8(v0[0], v0[1], v0[2], v0[3]); w.y = pk4_fp8(v1[0], v1[1], v1[2], v1[3]);
                    *(u32x2*)(Y + row * D + col0 + 128 * bj) = w;
                }
            }
    }
};

__device__ __forceinline__ void wg_publish(unsigned* cnt, int tid) {
    asm volatile("s_waitcnt vmcnt(0)" ::: "memory");
    __syncthreads();
    if (tid == 0) { __builtin_amdgcn_fence(__ATOMIC_RELEASE, "agent"); asm volatile("s_waitcnt vmcnt(0)" ::: "memory");
        (void)__hip_atomic_fetch_add(cnt, 1u, __ATOMIC_RELAXED, __HIP_MEMORY_SCOPE_AGENT); }
}
__device__ __forceinline__ void wg_wait(unsigned* cnt, unsigned target, int tid) {
    if (tid == 0) { unsigned sp = 0;
        while (__hip_atomic_load(cnt, __ATOMIC_RELAXED, __HIP_MEMORY_SCOPE_AGENT) < target && ++sp < (1u << 22)) __builtin_amdgcn_s_sleep(2);
        __builtin_amdgcn_fence(__ATOMIC_ACQUIRE, "agent"); asm volatile("s_waitcnt vmcnt(0)" ::: "memory"); }
    __syncthreads();
}

__device__ __forceinline__ void transpose_item(const float* W, int K, int N, bf16_t* WT, int k0, int n0, size_t drow0, LAS float* scr, int lane) {
    float tv[32];
#pragma unroll
    for (int i = 0; i < 32; ++i) { const int kk = 2 * i + (lane >> 5); tv[i] = __builtin_nontemporal_load(W + (size_t)(k0 + kk) * N + n0 + (lane & 31)); }
#pragma unroll
    for (int i = 0; i < 32; ++i) { const int kk = 2 * i + (lane >> 5); scr[kk * 33 + (lane & 31)] = tv[i]; }
    asm volatile("s_waitcnt lgkmcnt(0)" ::: "memory");
    const int c = lane & 7;
#pragma unroll
    for (int j = 0; j < 4; ++j) { const int n = (lane >> 3) + 8 * j; const LAS float* s = scr + (8 * c) * 33 + n;
        u32x4 o; o.x = pk2(s[0 * 33], s[1 * 33]); o.y = pk2(s[2 * 33], s[3 * 33]); o.z = pk2(s[4 * 33], s[5 * 33]); o.w = pk2(s[6 * 33], s[7 * 33]);
        *(u32x4*)(WT + (drow0 + n) * (size_t)K + k0 + 8 * c) = o; }
    asm volatile("s_waitcnt lgkmcnt(0)" ::: "memory");
}

__device__ __forceinline__ void transpose_item8(const float* W, int K, int N, unsigned char* WT, int k0, int n0, size_t drow0, float scale, LAS float* scr, int lane) {
    float tv[32];
#pragma unroll
    for (int i = 0; i < 32; ++i) { const int kk = 2 * i + (lane >> 5); tv[i] = __builtin_nontemporal_load(W + (size_t)(k0 + kk) * N + n0 + (lane & 31)); }
#pragma unroll
    for (int i = 0; i < 32; ++i) { const int kk = 2 * i + (lane >> 5); scr[kk * 33 + (lane & 31)] = tv[i] * scale; }
    asm volatile("s_waitcnt lgkmcnt(0)" ::: "memory");
    const int c = lane & 7;
#pragma unroll
    for (int j = 0; j < 4; ++j) { const int n = (lane >> 3) + 8 * j; const LAS float* s = scr + (8 * c) * 33 + n;
        u32x2 o; o.x = pk4_fp8(s[0 * 33], s[1 * 33], s[2 * 33], s[3 * 33]); o.y = pk4_fp8(s[4 * 33], s[5 * 33], s[6 * 33], s[7 * 33]);
        *(u32x2*)(WT + (drow0 + n) * (size_t)K + k0 + 8 * c) = o; }
    asm volatile("s_waitcnt lgkmcnt(0)" ::: "memory");
}

__device__ __forceinline__ void transpose_item8b(const float* W, int N, unsigned char* WTblk, int k0, int n0, int drow0, int kc0, float scale, LAS float* scr, int lane) {
    float tv[32];
#pragma unroll
    for (int i = 0; i < 32; ++i) { const int kk = 2 * i + (lane >> 5); tv[i] = __builtin_nontemporal_load(W + (size_t)(k0 + kk) * N + n0 + (lane & 31)); }
#pragma unroll
    for (int i = 0; i < 32; ++i) { const int kk = 2 * i + (lane >> 5); scr[kk * 33 + (lane & 31)] = tv[i] * scale; }
    asm volatile("s_waitcnt lgkmcnt(0)" ::: "memory");
    const int c = lane & 7;
#pragma unroll
    for (int j = 0; j < 4; ++j) { const int n = (lane >> 3) + 8 * j; const LAS float* s = scr + (8 * c) * 33 + n;
        u32x2 o; o.x = pk4_fp8(s[0 * 33], s[1 * 33], s[2 * 33], s[3 * 33]); o.y = pk4_fp8(s[4 * 33], s[5 * 33], s[6 * 33], s[7 * 33]);
        *(u32x2*)(WTblk + (size_t)(drow0 + n) * 128 + kc0 + 8 * c) = o; }
    asm volatile("s_waitcnt lgkmcnt(0)" ::: "memory");
}

#ifndef PROBE_MASK
#define PROBE_MASK 0
#endif
struct Args { const float* in[28]; float* out; unsigned char* ws; int ph_lo, ph_hi, dbg, pad; };

__device__ __forceinline__ void phase0(LAS unsigned char* lds, const Args& a, const int TID, const int BID, const int GD) {
    const int tid = TID, lane = tid & 63, wave = tid >> 6, G = GD;
    unsigned char* ws = a.ws;
    __syncthreads();
    {
        const float* c = a.in[1]; const float* cctx = a.in[3]; const float* ada_w = a.in[6]; const float* ada_b = a.in[7];
        float* mod = (float*)(ws + WS_MOD); float* modc = mod + 4 * 6144;
        LAS float* sc = (LAS float*)lds;
        LAS float* red = (LAS float*)(lds + 20480);
        for (int grp = BID; grp < 96; grp += G) {
            for (int i = tid; i < 5 * 1024; i += NTHREADS) { const float v = (i < 4096) ? c[i] : cctx[i - 4096]; sc[i] = silu_f(v); }
            __syncthreads();
            const int col = grp * 64 + lane;
            float acc[5] = {0.f, 0.f, 0.f, 0.f, 0.f};
            const int k0 = wave * 128;
#pragma unroll 8
            for (int k = k0; k < k0 + 128; ++k) { const float w = ada_w[(size_t)k * 6144 + col];
#pragma unroll
                for (int v = 0; v < 5; ++v) acc[v] += sc[v * 1024 + k] * w; }
#pragma unroll
            for (int v = 0; v < 5; ++v) red[(wave * 5 + v) * 64 + lane] = acc[v];
            __syncthreads();
            if (tid < 320) { const int v = tid >> 6, l = tid & 63; float s = 0.f;
#pragma unroll
                for (int w = 0; w < 8; ++w) s += red[(w * 5 + v) * 64 + l];
                const int cc = grp * 64 + l; s += ada_b[cc];
                if (v < 4) mod[v * 6144 + cc] = s; else if (cc < 2048) modc[cc] = s; }
            wg_publish((unsigned*)(ws + WS_ADACNT), tid);
            __syncthreads();
        }
    }
    {
        LAS float* scr = (LAS float*)(lds + wave * 8704);
        const int gw = BID * NWAVES + wave, NGW = G * NWAVES;
        const float* w_in = a.in[8]; const float* w_out = a.in[21]; const float* wg = a.in[24]; const float* wu = a.in[25]; const float* wd = a.in[26];
        bf16_t* WinT = (bf16_t*)(ws + WS_WINT); bf16_t* WoutT = (bf16_t*)(ws + WS_WOUTT); unsigned char* WguT = ws + WS_WGUT; unsigned char* WdT = ws + WS_WDT;
        constexpr int I_IN = 16 * 64, I_OUT = 16 * 32, I_GE = 16 * 88, I_G = 16 * I_GE, I_DE = 44 * 32, I_D = 16 * I_DE;
        const int nitems = a.dbg == 1 ? (I_IN + I_OUT) : (I_IN + I_OUT + 2 * I_G + I_D);
        const bool bal = (G == 256) && (nitems == 69120);
        const int nv = (BID - 96) * NWAVES + wave;
        const int nloop = bal ? (BID < 96 ? 30 : 36) : (nitems - gw + NGW - 1) / NGW;
        for (int jj = 0; jj < nloop; ++jj) {
            const int it = bal ? (jj < 30 ? gw + jj * NGW : 61440 + nv + (jj - 30) * 1280) : gw + jj * NGW;
            int r = it;
            if (r < I_IN) { const int kb = r / 64, nb = r % 64, n0 = 32 * nb;
                int drow; if (n0 < 512) drow = (n0 >> 7) * 256 + (n0 & 127); else if (n0 < 1024) drow = ((n0 - 512) >> 7) * 256 + 128 + ((n0 - 512) & 127); else drow = n0;
                transpose_item(w_in, 1024, 2048, WinT, 64 * kb, n0, (size_t)drow, scr, lane); continue; }
            r -= I_IN;
            if (r < I_OUT) { const int kb = r / 32, nb = r % 32; transpose_item(w_out, 1024, 1024, WoutT, 64 * kb, 32 * nb, (size_t)(32 * nb), scr, lane); continue; }
            r -= I_OUT;
            if (r < 2 * I_G) { const int up = r >= I_G; if (up) r -= I_G; const int e = r / I_GE, q = r % I_GE, kb = q / 88, nb = q % 88, n0 = 32 * nb;
                const size_t drow = (size_t)e * 5632 + (size_t)(n0 >> 7) * 256 + (up ? 128 : 0) + (n0 & 127);
                transpose_item8((up ? wu : wg) + (size_t)e * 1024 * DE, 1024, DE, WguT, 64 * kb, n0, drow, 32.0f, scr, lane); continue; }
            r -= 2 * I_G;
            { const int e = r / I_DE, q = r % I_DE, kb = q / 32, nb = q % 32;
                const int n0 = 32 * nb, k0 = 64 * kb;
                transpose_item8b(wd + (size_t)e * DE * 1024, 1024, WdT + ((size_t)((e * 4 + (n0 >> 8)) * 22 + (k0 >> 7))) * 32768, k0, n0, n0 & 255, k0 & 127, 64.0f, scr, lane); }
        }
    }
}

__device__ __forceinline__ void phase1(const Args& a, const int TID, const int BID, const int GD) {
    const int lane = TID & 63, wave = TID >> 6, G = GD;
    const float* x = a.in[0]; const float* ctx = a.in[2]; const float* g1 = a.in[4];
    const float* mod = (const float*)(a.ws + WS_MOD); const float* modc = mod + 4 * 6144;
    bf16_t* U = (bf16_t*)(a.ws + WS_U);
    f32x4 gg[4];
#pragma unroll
    for (int i = 0; i < 4; ++i) gg[i] = *(const f32x4*)(g1 + 4 * (lane + 64 * i));
    for (int row = BID * NWAVES + wave; row < NROWS; row += G * NWAVES) {
        const float* xr; const float* sh; const float* scl;
        if (row < NTOK) { xr = x + (size_t)row * D; const int b = row >> 13; sh = mod + b * 6144; scl = sh + 1024; }
        else { xr = ctx + (size_t)(row - NTOK) * D; sh = modc; scl = modc + 1024; }
        f32x4 v[4]; float ss = 0.f;
#pragma unroll
        for (int i = 0; i < 4; ++i) { v[i] = *(const f32x4*)(xr + 4 * (lane + 64 * i)); ss += v[i].x * v[i].x + v[i].y * v[i].y + v[i].z * v[i].z + v[i].w * v[i].w; }
        ss = wave_sum(ss);
        const float r = rsqrtf(ss * (1.0f / D) + 1e-6f);
#pragma unroll
        for (int i = 0; i < 4; ++i) {
            const f32x4 s1 = *(const f32x4*)(sh + 4 * (lane + 64 * i)), c1 = *(const f32x4*)(scl + 4 * (lane + 64 * i));
            const f32x4 o = (v[i] * r) * gg[i] * (c1 + 1.0f) + s1;
            u32x2 w; w.x = pk2(o.x, o.y); w.y = pk2(o.z, o.w);
            *(u32x2*)(U + (size_t)row * D + 4 * (lane + 64 * i)) = w;
        }
    }
}

__device__ __forceinline__ void conv_units(LAS unsigned char* lds, const Args& a, int ubeg, int ustride, const int TID, const int BID, const int GD) {
    const int tid = TID, lane = tid & 63, wave = tid >> 6;
    const float* cw = a.in[10]; const float* cb = a.in[11]; const float* lg = a.in[12]; const float* lb = a.in[13];
    const bf16_t* xglu = (const bf16_t*)(a.ws + WS_XGLU); bf16_t* mix = (bf16_t*)(a.ws + WS_MIX);
    LAS float* wts = (LAS float*)lds;
    for (int i = tid; i < 31 * 512; i += NTHREADS) { const int k = i >> 9, ch = i & 511; wts[((k * 2 + ((ch >> 2) & 1)) * 64 + (ch >> 3)) * 4 + (ch & 3)] = cw[i]; }
    __syncthreads();
    const int ch0 = 8 * lane;
    float bias[8], lng[8], lnb[8];
#pragma unroll
    for (int j = 0; j < 8; ++j) { bias[j] = cb[ch0 + j]; lng[j] = lg[ch0 + j]; lnb[j] = lb[ch0 + j]; }
    const bool rowc = lane < 32;
    for (int unit = ubeg; unit < NB * 128; unit += ustride) {
        const int b = unit >> 7, r = unit & 127;
        const bf16_t* xb = xglu + (size_t)b * SEQ * 512;
#pragma unroll 1
        for (int p = 0; p < 4; ++p) {
            const int c = p * 16 + 2 * wave;
            float acc[2][8];
#pragma unroll
            for (int j = 0; j < 8; ++j) { acc[0][j] = bias[j]; acc[1][j] = bias[j]; }
#pragma unroll 1
            for (int kb = 0; kb < 31; kb += 16) {
                u32x4 xv[2][16];
#pragma unroll
                for (int kk = 0; kk < 16; ++kk) { const int k = kb + kk;
#pragma unroll
                    for (int tt = 0; tt < 2; ++tt) { xv[tt][kk] = (u32x4){0u, 0u, 0u, 0u};
                        if (k < 31) { int tok; bool valid;
                            if (rowc) { const int cc = c + tt + k - 15; valid = (cc >= 0) && (cc < 64); tok = r * 64 + cc; }
                            else { const int rr = r + k - 15; valid = (rr >= 0) && (rr < 128); tok = rr * 64 + c + tt; }
                            if (valid) xv[tt][kk] = *(const u32x4*)(xb + (size_t)tok * 512 + ch0); } } }
#pragma unroll
                for (int kk = 0; kk < 16; ++kk) { const int k = kb + kk;
                    if (k < 31) {
                        const f32x4 w0 = *(const LAS f32x4*)(wts + ((k * 2 + 0) * 64 + lane) * 4), w1 = *(const LAS f32x4*)(wts + ((k * 2 + 1) * 64 + lane) * 4);
#pragma unroll
                        for (int tt = 0; tt < 2; ++tt) { const u32x4 x4 = xv[tt][kk];
                            fma_mix_lo(acc[tt][0], w0.x, x4.x); fma_mix_hi(acc[tt][1], w0.y, x4.x); fma_mix_lo(acc[tt][2], w0.z, x4.y); fma_mix_hi(acc[tt][3], w0.w, x4.y);
                            fma_mix_lo(acc[tt][4], w1.x, x4.z); fma_mix_hi(acc[tt][5], w1.y, x4.z); fma_mix_lo(acc[tt][6], w1.z, x4.w); fma_mix_hi(acc[tt][7], w1.w, x4.w); } } }
            }
#pragma unroll
            for (int tt = 0; tt < 2; ++tt) {
                float s = 0.f;
#pragma unroll
                for (int j = 0; j < 8; ++j) s += acc[tt][j];
                const float mean = wave_sum(s) * (1.0f / 512.0f);
                float q = 0.f;
#pragma unroll
                for (int j = 0; j < 8; ++j) { acc[tt][j] -= mean; q += acc[tt][j] * acc[tt][j]; }
                const float rstd = rsqrtf(wave_sum(q) * (1.0f / 512.0f) + 1e-5f);
                float o[8];
#pragma unroll
                for (int j = 0; j < 8; ++j) { const float y = acc[tt][j] * rstd * lng[j] + lnb[j]; o[j] = silu_f(y); }
                u32x4 w; w.x = pk2(o[0], o[1]); w.y = pk2(o[2], o[3]); w.z = pk2(o[4], o[5]); w.w = pk2(o[6], o[7]);
                *(u32x4*)(mix + (size_t)(b * SEQ + r * 64 + c + tt) * D + ch0) = w;
            }
        }
    }
    __syncthreads();
}

constexpr int L_XT = 0;
constexpr int L_XC = 9216;
constexpr int L_A = L_XC + 2 * 17408;
constexpr int L_U = L_A + 2 * 16384;
constexpr int L_SUB = L_U + 2 * 16384;
constexpr int L_PRE = L_SUB + 8192;
constexpr int L_CIN = L_PRE + 4096;
static_assert(L_CIN + 2 * 17 * 64 * 4 <= 131072, "lru lds");

__device__ __forceinline__ int lru_seq(int d, int i) { return d == 0 ? i : (i < 4 ? 3 - i : NQ - 1 - (i - 4)); }
__device__ __forceinline__ u32x4 lru_load_xt(const bf16_t* xlx, int b, int h, int q, int i) {
    int rowbase, L, chunk;
    if (q < 4) { rowbase = NTOK + b * CTXL; L = CTXL; chunk = q; } else { rowbase = b * SEQ; L = SEQ; chunk = q - 4; }
    const int rr = i >> 3, seg = i & 7, t = chunk * 64 - 3 + rr;
    u32x4 v = (u32x4){0u, 0u, 0u, 0u};
    if (t >= 0 && t < L) v = *(const u32x4*)(xlx + (size_t)(rowbase + t) * 512 + 64 * h + 8 * seg);
    return v;
}
template <int MODE>
__device__ __forceinline__ void lru_phase(LAS unsigned char* lds, const Args& a, const int TID, const int BID, const int GD) {
    const int tid = TID, lane = tid & 63, wave = tid >> 6;
    const float* wa = a.in[16]; const float* wi = a.in[18];
    const bf16_t* xlx = (const bf16_t*)(a.ws + WS_XLX); const bf16_t* glg = (const bf16_t*)(a.ws + WS_GLG); bf16_t* mix = (bf16_t*)(a.ws + WS_MIX);
    f32x2* carry = (f32x2*)(a.ws + WS_CARRY); unsigned* au = (unsigned*)(a.ws + WS_AU);
    const float* conv_w = a.in[14]; const float* conv_b = a.in[15]; const float* ba = a.in[17]; const float* bi = a.in[19]; const float* lam = a.in[20];
    LAS bf16_t* XT = (LAS bf16_t*)(lds + L_XT); LAS float* XC = (LAS float*)(lds + L_XC); LAS float* Aa = (LAS float*)(lds + L_A); LAS float* Uu = (LAS float*)(lds + L_U);
    LAS f32x2* SUB = (LAS f32x2*)(lds + L_SUB); LAS float* PRE = (LAS float*)(lds + L_PRE); LAS float* CIN = (LAS float*)(lds + L_CIN);
    const int l15 = lane & 15, l4 = lane >> 4;
    for (int vb = BID; vb < 256; vb += GD) {
        const int bh = vb >> 3, grp = vb & 7, b = bh >> 3, h = bh & 7;
        int q0, nq;
        if (MODE == 1) { q0 = grp * 17; nq = (NQ - q0) < 17 ? (NQ - q0) : 17; } else { q0 = 4 + grp * 16; nq = 16; }
        const int wd = wave >> 2, mtp = (wave >> 1) & 1, ntp = wave & 1;
        bf16x8 wf[2][2][2];
#pragma unroll
        for (int nn = 0; nn < 2; ++nn)
#pragma unroll
            for (int g = 0; g < 2; ++g)
#pragma unroll
                for (int ks = 0; ks < 2; ++ks) { const float* wp = (g ? wi : wa) + (size_t)((wd * 8 + h) * 64 + 32 * ks + 8 * l4) * 64 + 16 * (ntp * 2 + nn) + l15;
                    u32x4 w; w.x = pk2(wp[0], wp[64]); w.y = pk2(wp[128], wp[192]); w.z = pk2(wp[256], wp[320]); w.w = pk2(wp[384], wp[448]); wf[nn][g][ks] = __builtin_bit_cast(bf16x8, w); }
        float cw[2][4], cbv[2];
        { const int gc = 64 * h + (tid & 63);
#pragma unroll
            for (int d = 0; d < 2; ++d) { cbv[d] = conv_b[d * 512 + gc];
#pragma unroll
                for (int k = 0; k < 4; ++k) cw[d][k] = conv_w[(d * 4 + k) * 512 + gc]; } }
        float bav[2], biv[2], spv[2];
#pragma unroll
        for (int nn = 0; nn < 2; ++nn) { const int gc = 64 * h + 16 * (ntp * 2 + nn) + l15;
            bav[nn] = ba[wd * 512 + gc]; biv[nn] = bi[wd * 512 + gc]; spv[nn] = log1pf(__expf(-lam[wd * 512 + gc])); }
        if (MODE == 2 && tid < 128) {
            const int d = tid >> 6, ch = tid & 63;
            const f32x2* cp = carry + (size_t)((d * NB + b) * NQ) * 512 + 64 * h + ch;
            const int cnt = d == 0 ? q0 : (NQ + 4 - (q0 + nq));
            float s = 0.f;
            for (int i0 = 0; i0 < cnt; i0 += 8) {
                f32x2 c[8];
#pragma unroll
                for (int j = 0; j < 8; ++j) { const int ii = (i0 + j) < cnt ? (i0 + j) : (cnt - 1); c[j] = cp[(size_t)lru_seq(d, ii) * 512]; }
#pragma unroll
                for (int j = 0; j < 8; ++j) if (i0 + j < cnt) s = c[j].x * s + c[j].y;
            }
            f32x2 c[16];
#pragma unroll
            for (int j = 0; j < 16; ++j) c[j] = cp[(size_t)(q0 + j) * 512];
            if (d == 0) {
#pragma unroll
                for (int j = 0; j < 16; ++j) { CIN[(0 * 17 + j) * 64 + ch] = s; s = c[j].x * s + c[j].y; }
            } else {
#pragma unroll
                for (int j = 15; j >= 0; --j) { CIN[(1 * 17 + j) * 64 + ch] = s; s = c[j].x * s + c[j].y; }
            }
        }
        if (MODE == 1 && q0 < 4) {
            if (tid == 0) { unsigned* fl = (unsigned*)(a.ws + WS_CTXFLAG) + 64 * (b * 2 + (h >> 2)); unsigned sp = 0;
                while (__hip_atomic_load(fl, __ATOMIC_RELAXED, __HIP_MEMORY_SCOPE_AGENT) == 0u && ++sp < (1u << 22)) __builtin_amdgcn_s_sleep(2);
                __builtin_amdgcn_fence(__ATOMIC_ACQUIRE, "agent"); asm volatile("s_waitcnt vmcnt(0)" ::: "memory"); }
            __syncthreads();
        }
        u32x4 xr0 = lru_load_xt(xlx, b, h, q0, tid), xr1 = (u32x4){0u, 0u, 0u, 0u};
        if (tid < 48) xr1 = lru_load_xt(xlx, b, h, q0, tid + 512);
#pragma unroll 1
        for (int jc = 0; jc < nq; ++jc) {
            const int q = q0 + jc;
            const size_t rowbase0 = (q < 4) ? (size_t)(NTOK + b * CTXL + q * 64) : (size_t)(b * SEQ + (q - 4) * 64);
            *(LAS u32x4*)(XT + tid * 8) = xr0;
            if (tid < 48) *(LAS u32x4*)(XT + (tid + 512) * 8) = xr1;
            __syncthreads();
            if (jc + 1 < nq) { xr0 = lru_load_xt(xlx, b, h, q + 1, tid); if (tid < 48) xr1 = lru_load_xt(xlx, b, h, q + 1, tid + 512); }
            u32x4 gl = (u32x4){0u, 0u, 0u, 0u};
            if (MODE == 2) gl = *(const u32x4*)(glg + (rowbase0 + (tid >> 3)) * 512 + 64 * h + (tid & 7) * 8);
            { const int ch = tid & 63, tb = tid >> 6;
#pragma unroll
                for (int i = 0; i < 8; ++i) { const int t = tb + 8 * i;
                    const float x0 = bf_lo(XT[(t + 0) * 64 + ch]), x1 = bf_lo(XT[(t + 1) * 64 + ch]), x2 = bf_lo(XT[(t + 2) * 64 + ch]), x3 = bf_lo(XT[(t + 3) * 64 + ch]), x4 = bf_lo(XT[(t + 4) * 64 + ch]), x5 = bf_lo(XT[(t + 5) * 64 + ch]), x6 = bf_lo(XT[(t + 6) * 64 + ch]);
                    XC[t * 68 + ch] = cbv[0] + cw[0][0] * x0 + cw[0][1] * x1 + cw[0][2] * x2 + cw[0][3] * x3;
                    XC[64 * 68 + t * 68 + ch] = cbv[1] + cw[1][3] * x3 + cw[1][2] * x4 + cw[1][1] * x5 + cw[1][0] * x6; } }
            __syncthreads();
#pragma unroll
            for (int mm = 0; mm < 2; ++mm) {
                const int mtl = 2 * mtp + mm;
                bf16x8 af[2];
#pragma unroll
                for (int ks = 0; ks < 2; ++ks) { const LAS float* p = XC + wd * (64 * 68) + (16 * mtl + l15) * 68 + 32 * ks + 8 * l4; const f32x4 p0 = *(const LAS f32x4*)p, p1 = *(const LAS f32x4*)(p + 4);
                    u32x4 w; w.x = pk2(p0.x, p0.y); w.y = pk2(p0.z, p0.w); w.z = pk2(p1.x, p1.y); w.w = pk2(p1.z, p1.w); af[ks] = __builtin_bit_cast(bf16x8, w); }
#pragma unroll
                for (int nn = 0; nn < 2; ++nn) { const int n = 16 * (ntp * 2 + nn) + l15;
                    f32x4 accR = (f32x4){0.f, 0.f, 0.f, 0.f}, accI = (f32x4){0.f, 0.f, 0.f, 0.f};
#pragma unroll
                    for (int ks = 0; ks < 2; ++ks) {
                        accR = __builtin_amdgcn_mfma_f32_16x16x32_bf16(af[ks], wf[nn][0][ks], accR, 0, 0, 0);
                        accI = __builtin_amdgcn_mfma_f32_16x16x32_bf16(af[ks], wf[nn][1][ks], accI, 0, 0, 0);
                    }
#pragma unroll
                    for (int rg = 0; rg < 4; rg += 2) { const int t = 16 * mtl + 4 * l4 + rg;
                        const f32x2 zr = (f32x2){accR[rg], accR[rg + 1]} + bav[nn], zi = (f32x2){accI[rg], accI[rg + 1]} + biv[nn];
                        const f32x2 tr = zr * (-1.4426950408889634f), ti = zi * (-1.4426950408889634f);
                        f32x2 er, ei; er.x = __builtin_amdgcn_exp2f(tr.x); er.y = __builtin_amdgcn_exp2f(tr.y); ei.x = __builtin_amdgcn_exp2f(ti.x); ei.y = __builtin_amdgcn_exp2f(ti.y);
                        const f32x2 dr = er + 1.0f, di = ei + 1.0f;
                        f32x2 rr, ii; rr.x = __builtin_amdgcn_rcpf(dr.x); rr.y = __builtin_amdgcn_rcpf(dr.y); ii.x = __builtin_amdgcn_rcpf(di.x); ii.y = __builtin_amdgcn_rcpf(di.y);
                        const f32x2 la = rr * (-8.0f * spv[nn]);
                        f32x2 oma = -la * (1.0f + 0.5f * la * (1.0f + 0.33333334f * la * (1.0f + 0.25f * la * (1.0f + 0.2f * la))));
                        if (__any(la.x < -0.25f || la.y < -0.25f)) {
                            oma.x = la.x < -0.25f ? 1.0f - __expf(la.x) : oma.x; oma.y = la.y < -0.25f ? 1.0f - __expf(la.y) : oma.y; }
                        const f32x2 om2 = oma * (2.0f - oma);
                        f32x2 mult; mult.x = __builtin_amdgcn_sqrtf(om2.x); mult.y = __builtin_amdgcn_sqrtf(om2.y);
                        const f32x2 xc2 = (f32x2){XC[wd * (64 * 68) + t * 68 + n], XC[wd * (64 * 68) + (t + 1) * 68 + n]};
                        const f32x2 uu = mult * ii * xc2;
                        Aa[wd * 4096 + t * 64 + n] = oma.x; Aa[wd * 4096 + (t + 1) * 64 + n] = oma.y; Uu[wd * 4096 + t * 64 + n] = uu.x; Uu[wd * 4096 + (t + 1) * 64 + n] = uu.y; }
                }
            }
            __syncthreads();
            if (MODE == 1 && q >= 4) {
                const int t = tid >> 3, c8 = (tid & 7) * 8;
#pragma unroll
                for (int d = 0; d < 2; ++d) {
                    const LAS float* ap = Aa + d * 4096 + t * 64 + c8; const LAS float* up = Uu + d * 4096 + t * 64 + c8;
                    const f32x4 a0 = *(const LAS f32x4*)ap, a1 = *(const LAS f32x4*)(ap + 4), u0 = *(const LAS f32x4*)up, u1 = *(const LAS f32x4*)(up + 4);
                    u32x4 w0, w1; w0.x = pk2h(a0.x, u0.x); w0.y = pk2h(a0.y, u0.y); w0.z = pk2h(a0.z, u0.z); w0.w = pk2h(a0.w, u0.w); w1.x = pk2h(a1.x, u1.x); w1.y = pk2h(a1.y, u1.y); w1.z = pk2h(a1.z, u1.z); w1.w = pk2h(a1.w, u1.w);
                    unsigned* dst = au + ((size_t)d * NTOK + rowbase0 + t) * 512 + 64 * h + c8;
                    *(u32x4*)dst = w0; *(u32x4*)(dst + 4) = w1; }
            }
            { float A0 = 1.f, h0 = 0.f, A1 = 1.f, h1 = 0.f;
#pragma unroll
                for (int s2 = 0; s2 < 8; ++s2) { const int p = 8 * wave + s2, t0 = p, t1 = 63 - p;
                    const float a0 = 1.0f - Aa[t0 * 64 + lane], u0 = Uu[t0 * 64 + lane], a1 = 1.0f - Aa[4096 + t1 * 64 + lane], u1 = Uu[4096 + t1 * 64 + lane];
                    h0 = a0 * h0 + u0; A0 *= a0; h1 = a1 * h1 + u1; A1 *= a1; }
                SUB[wave * 64 + lane] = (f32x2){A0, h0}; SUB[512 + wave * 64 + lane] = (f32x2){A1, h1}; }
            __syncthreads();
            if (MODE == 1) {
                if (tid < 128) { const int d = tid >> 6, ch = tid & 63; float Ac = 1.f, hc = 0.f;
#pragma unroll
                    for (int s2 = 0; s2 < 8; ++s2) { const f32x2 c = SUB[d * 512 + s2 * 64 + ch]; hc = c.x * hc + c.y; Ac *= c.x; }
                    carry[(size_t)((d * NB + b) * NQ + q) * 512 + 64 * h + ch] = (f32x2){Ac, hc}; }
            } else {
                if (tid < 128) { const int d = tid >> 6, ch = tid & 63; float s2 = CIN[(d * 17 + jc) * 64 + ch];
#pragma unroll
                    for (int sb = 0; sb < 8; ++sb) { PRE[d * 512 + sb * 64 + ch] = s2; const f32x2 c = SUB[d * 512 + sb * 64 + ch]; s2 = c.x * s2 + c.y; } }
                __syncthreads();
                { float h0 = PRE[wave * 64 + lane], h1 = PRE[512 + wave * 64 + lane];
#pragma unroll
                    for (int s2 = 0; s2 < 8; ++s2) { const int p = 8 * wave + s2, t0 = p, t1 = 63 - p;
                        h0 = (1.0f - Aa[t0 * 64 + lane]) * h0 + Uu[t0 * 64 + lane]; Uu[t0 * 64 + lane] = h0;
                        h1 = (1.0f - Aa[4096 + t1 * 64 + lane]) * h1 + Uu[4096 + t1 * 64 + lane]; Uu[4096 + t1 * 64 + lane] = h1; } }
                __syncthreads();
                { const int t = tid >> 3, c8 = (tid & 7) * 8;
                    const LAS float* u1 = Uu + t * 64 + c8; const LAS float* u2 = Uu + 4096 + t * 64 + c8;
                    const f32x4 f0 = *(const LAS f32x4*)u1, f1 = *(const LAS f32x4*)(u1 + 4), b0 = *(const LAS f32x4*)u2, b1 = *(const LAS f32x4*)(u2 + 4);
                    u32x4 w;
                    w.x = pk2((f0.x + b0.x) * bf_lo(gl.x), (f0.y + b0.y) * bf_hi(gl.x)); w.y = pk2((f0.z + b0.z) * bf_lo(gl.y), (f0.w + b0.w) * bf_hi(gl.y));
                    w.z = pk2((f1.x + b1.x) * bf_lo(gl.z), (f1.y + b1.y) * bf_hi(gl.z)); w.w = pk2((f1.z + b1.z) * bf_lo(gl.w), (f1.w + b1.w) * bf_hi(gl.w));
                    *(u32x4*)(mix + (rowbase0 + t) * D + 512 + 64 * h + c8) = w; }
            }
        }
        if (MODE == 1) wg_publish((unsigned*)(a.ws + WS_BHCNT) + 64 * bh, tid);
        __syncthreads();
    }
}

__device__ __forceinline__ void lru_rescan(LAS unsigned char* lds, const Args& a, const int TID, const int BID, const int GD) {
    const int tid = TID, lane = tid & 63, wave = tid >> 6;
    const unsigned* au = (const unsigned*)(a.ws + WS_AU); const bf16_t* glg = (const bf16_t*)(a.ws + WS_GLG); bf16_t* mix = (bf16_t*)(a.ws + WS_MIX);
    const f32x2* carry = (const f32x2*)(a.ws + WS_CARRY);
    LAS f32x2* SUB = (LAS f32x2*)(lds + L_SUB); LAS float* PRE = (LAS float*)(lds + L_PRE); LAS float* CIN = (LAS float*)(lds + L_CIN);
    for (int vb = BID; vb < 256; vb += GD) {
        const int bh = vb >> 3, grp = vb & 7, b = bh >> 3, h = bh & 7;
        const int q0 = 4 + grp * 16, nq = 16;
        wg_wait((unsigned*)(a.ws + WS_BHCNT) + 64 * bh, 8u * (unsigned)(1 + ((a.dbg >> 11) & 1)), tid);
        if (tid < 128) {
            const int d = tid >> 6, ch = tid & 63;
            const f32x2* cp = carry + (size_t)((d * NB + b) * NQ) * 512 + 64 * h + ch;
            const int cnt = d == 0 ? q0 : (NQ + 4 - (q0 + nq));
            float s = 0.f;
            for (int i0 = 0; i0 < cnt; i0 += 8) {
                f32x2 c[8];
#pragma unroll
                for (int j = 0; j < 8; ++j) { const int ii = (i0 + j) < cnt ? (i0 + j) : (cnt - 1); c[j] = cp[(size_t)lru_seq(d, ii) * 512]; }
#pragma unroll
                for (int j = 0; j < 8; ++j) if (i0 + j < cnt) s = c[j].x * s + c[j].y;
            }
            f32x2 c[16];
#pragma unroll
            for (int j = 0; j < 16; ++j) c[j] = cp[(size_t)(q0 + j) * 512];
            if (d == 0) {
#pragma unroll
                for (int j = 0; j < 16; ++j) { CIN[(0 * 17 + j) * 64 + ch] = s; s = c[j].x * s + c[j].y; }
            } else {
#pragma unroll
                for (int j = 15; j >= 0; --j) { CIN[(1 * 17 + j) * 64 + ch] = s; s = c[j].x * s + c[j].y; }
            }
        }
        __syncthreads();
        const size_t cbase = (size_t)64 * h + lane;
#pragma unroll 1
        for (int jc = 0; jc < nq; ++jc) {
            const size_t row0 = (size_t)b * SEQ + (size_t)(q0 - 4 + jc) * 64 + 8 * wave;
            unsigned pf[8], pb[8]; bf16_t gg[8];
#pragma unroll
            for (int s2 = 0; s2 < 8; ++s2) { pf[s2] = au[(row0 + s2) * 512 + cbase]; pb[s2] = au[((size_t)NTOK + row0 + s2) * 512 + cbase]; gg[s2] = glg[(row0 + s2) * 512 + cbase]; }
            float af[8], uf[8], ab[8], ub[8];
#pragma unroll
            for (int s2 = 0; s2 < 8; ++s2) { const h2_t x = __builtin_bit_cast(h2_t, pf[s2]), y = __builtin_bit_cast(h2_t, pb[s2]);
                af[s2] = 1.0f - (float)x.x; uf[s2] = (float)x.y; ab[s2] = 1.0f - (float)y.x; ub[s2] = (float)y.y; }
            float A0 = 1.f, h0 = 0.f, A1 = 1.f, h1 = 0.f;
#pragma unroll
            for (int s2 = 0; s2 < 8; ++s2) { h0 = af[s2] * h0 + uf[s2]; A0 *= af[s2]; h1 = ab[7 - s2] * h1 + ub[7 - s2]; A1 *= ab[7 - s2]; }
            SUB[wave * 64 + lane] = (f32x2){A0, h0}; SUB[512 + (7 - wave) * 64 + lane] = (f32x2){A1, h1};
            __syncthreads();
            if (tid < 128) { const int d = tid >> 6, ch = tid & 63; float s2 = CIN[(d * 17 + jc) * 64 + ch];
#pragma unroll
                for (int sb = 0; sb < 8; ++sb) { PRE[d * 512 + sb * 64 + ch] = s2; const f32x2 c = SUB[d * 512 + sb * 64 + ch]; s2 = c.x * s2 + c.y; } }
            __syncthreads();
            float hf[8], hb[8];
            { float hc = PRE[wave * 64 + lane];
#pragma unroll
                for (int s2 = 0; s2 < 8; ++s2) { hc = af[s2] * hc + uf[s2]; hf[s2] = hc; }
                hc = PRE[512 + (7 - wave) * 64 + lane];
#pragma unroll
                for (int s2 = 7; s2 >= 0; --s2) { hc = ab[s2] * hc + ub[s2]; hb[s2] = hc; } }
#pragma unroll
            for (int s2 = 0; s2 < 8; ++s2) mix[(row0 + s2) * D + 512 + cbase] = (bf16_t)f2bf((hf[s2] + hb[s2]) * bf_lo(gg[s2]));
        }
        __syncthreads();
    }
}

__device__ __forceinline__ void phase6(LAS unsigned char* lds, const Args& a, const int TID, const int BID, const int GD) {
    const int tid = TID, lane = tid & 63, wave = tid >> 6, G = GD;
    const float* x = a.in[0]; const bf16_t* Mb = (const bf16_t*)(a.ws + WS_M); const float* g2 = a.in[5]; const float* rw = a.in[23];
    const float* mod = (const float*)(a.ws + WS_MOD);
    unsigned char* V = a.ws + WS_V; float* affT = (float*)(a.ws + WS_AFFT); bf16_t* X1b = (bf16_t*)(a.ws + WS_X1B);
    LAS float* rwT = (LAS float*)lds;
    for (int idx = tid; idx < 16384; idx += NTHREADS) rwT[(idx & 15) * 1024 + (idx >> 4)] = rw[idx];
    __syncthreads();
    f32x4 gg[4];
#pragma unroll
    for (int i = 0; i < 4; ++i) gg[i] = *(const f32x4*)(g2 + 4 * (lane + 64 * i));
    for (int row = BID * NWAVES + wave; row < NTOK; row += G * NWAVES) {
        const int b = row >> 13, t = row & (SEQ - 1);
        const float* sh = mod + b * 6144 + 3072; const float* scl = mod + b * 6144 + 4096;
        f32x4 v[4]; float ss = 0.f;
#pragma unroll
        for (int i = 0; i < 4; ++i) { v[i] = *(const f32x4*)(x + (size_t)row * D + 4 * (lane + 64 * i)); const u32x2 mw = *(const u32x2*)(Mb + (size_t)row * D + 4 * (lane + 64 * i));
            v[i].x += bf_lo(mw.x); v[i].y += bf_hi(mw.x); v[i].z += bf_lo(mw.y); v[i].w += bf_hi(mw.y);
            { u32x2 xw; xw.x = pk2(v[i].x, v[i].y); xw.y = pk2(v[i].z, v[i].w); *(u32x2*)(X1b + (size_t)row * D + 4 * (lane + 64 * i)) = xw; }
            ss += v[i].x * v[i].x + v[i].y * v[i].y + v[i].z * v[i].z + v[i].w * v[i].w; }
        ss = wave_sum(ss);
        const float r = rsqrtf(ss * (1.0f / D) + 1e-6f);
#pragma unroll
        for (int i = 0; i < 4; ++i) {
            const f32x4 s1 = *(const f32x4*)(sh + 4 * (lane + 64 * i)), c1 = *(const f32x4*)(scl + 4 * (lane + 64 * i));
            v[i] = (v[i] * r) * gg[i] * (c1 + 1.0f) + s1;
            *(unsigned*)(V + (size_t)row * D + 4 * (lane + 64 * i)) = pk4_fp8(v[i].x, v[i].y, v[i].z, v[i].w);
        }
        float p[16];
#pragma unroll
        for (int e = 0; e < 16; ++e) p[e] = 0.f;
#pragma unroll
        for (int i = 0; i < 4; ++i) {
#pragma unroll
            for (int e = 0; e < 16; ++e) { const f32x4 w = *(const LAS f32x4*)(rwT + e * 1024 + 4 * (lane + 64 * i)); p[e] += v[i].x * w.x + v[i].y * w.y + v[i].z * w.z + v[i].w * w.w; }
            asm volatile("" ::: "memory");
        }
        const bool b5 = (lane & 32) != 0, b4 = (lane & 16) != 0, b3 = (lane & 8) != 0, b2 = (lane & 4) != 0;
        float q8[8], q4[4], q2[2];
#pragma unroll
        for (int j = 0; j < 8; ++j) { const float send = b5 ? p[j] : p[j + 8], keep = b5 ? p[j + 8] : p[j]; q8[j] = keep + __shfl_xor(send, 32); }
#pragma unroll
        for (int j = 0; j < 4; ++j) { const float send = b4 ? q8[j] : q8[j + 4], keep = b4 ? q8[j + 4] : q8[j]; q4[j] = keep + __shfl_xor(send, 16); }
#pragma unroll
        for (int j = 0; j < 2; ++j) { const float send = b3 ? q4[j] : q4[j + 2], keep = b3 ? q4[j + 2] : q4[j]; q2[j] = keep + __shfl_xor(send, 8); }
        float lgt = (b2 ? q2[1] : q2[0]) + __shfl_xor(b2 ? q2[0] : q2[1], 4);
        lgt += __shfl_xor(lgt, 2); lgt += __shfl_xor(lgt, 1);
        float mx = lgt;
        mx = fmaxf(mx, __shfl_xor(mx, 4)); mx = fmaxf(mx, __shfl_xor(mx, 8)); mx = fmaxf(mx, __shfl_xor(mx, 16)); mx = fmaxf(mx, __shfl_xor(mx, 32));
        const float ex = __expf(lgt - mx);
        float den = ex;
        den += __shfl_xor(den, 4); den += __shfl_xor(den, 8); den += __shfl_xor(den, 16); den += __shfl_xor(den, 32);
        if ((lane & 3) == 0) affT[(size_t)(b * 16 + ((lane >> 2) & 15)) * SEQ + t] = ex / den;
    }
    __syncthreads();
}

__device__ __forceinline__ int block_excl_scan(int v, LAS int* wsum, int tid, int& total) {
    const int lane = tid & 63, wave = tid >> 6;
    int inc = v;
#pragma unroll
    for (int o = 1; o < 64; o <<= 1) { const int t = __shfl_up(inc, o); if (lane >= o) inc += t; }
    __syncthreads();
    if (lane == 63) wsum[wave] = inc;
    __syncthreads();
    int base = 0, tot = 0;
#pragma unroll
    for (int w = 0; w < 8; ++w) { const int s = wsum[w]; if (w < wave) base += s; tot += s; }
    total = tot;
    return base + inc - v;
}
__device__ __forceinline__ void phase7(LAS unsigned char* lds, const Args& a, const int TID, const int BID, const int GD) {
    const int tid = TID, lane = tid & 63, wave = tid >> 6, G = GD;
    const float* affT = (const float*)(a.ws + WS_AFFT);
    int* idxE = (int*)(a.ws + WS_IDXE); float* gateE = (float*)(a.ws + WS_GATEE); int* inv = (int*)(a.ws + WS_INV);
    LAS unsigned* hist = (LAS unsigned*)lds;
    LAS unsigned* selw = hist + 256;
    LAS int* wsum = (LAS int*)(hist + 264);
    for (int unit = BID; unit < NB * NE; unit += G) {
        const int b = unit >> 4, e = unit & 15;
        const float* src = affT + (size_t)unit * SEQ + 16 * tid;
        unsigned key[16];
#pragma unroll
        for (int i = 0; i < 4; ++i) { const f32x4 v = *(const f32x4*)(src + 4 * i); const float f0 = v[0], f1 = v[1], f2 = v[2], f3 = v[3]; key[4 * i + 0] = __float_as_uint(f0); key[4 * i + 1] = __float_as_uint(f1); key[4 * i + 2] = __float_as_uint(f2); key[4 * i + 3] = __float_as_uint(f3); }
        unsigned prefix = 0u, mask = 0u, rem = CAP;
#pragma unroll 1
        for (int pass = 0; pass < 4; ++pass) {
            const int shift = 24 - 8 * pass;
            if (tid < 256) hist[tid] = 0u;
            __syncthreads();
#pragma unroll
            for (int j = 0; j < 16; ++j) if ((key[j] & mask) == prefix) __hip_atomic_fetch_add(&hist[(key[j] >> shift) & 255u], 1u, __ATOMIC_RELAXED, __HIP_MEMORY_SCOPE_WORKGROUP);
            __syncthreads();
            if (wave == 0) {
                const unsigned c0 = hist[4 * lane], c1 = hist[4 * lane + 1], c2 = hist[4 * lane + 2], c3 = hist[4 * lane + 3];
                const unsigned s = c0 + c1 + c2 + c3; unsigned v = s;
#pragma unroll
                for (int o = 1; o < 64; o <<= 1) { const unsigned t = __shfl_down(v, o); if (lane + o < 64) v += t; }
                const unsigned above = v - s;
                if (above < rem && rem <= above + s) {
                    unsigned cum = above, bin, nr;
                    if (cum + c3 >= rem) { bin = 4 * lane + 3; nr = rem - cum; }
                    else { cum += c3; if (cum + c2 >= rem) { bin = 4 * lane + 2; nr = rem - cum; }
                        else { cum += c2; if (cum + c1 >= rem) { bin = 4 * lane + 1; nr = rem - cum; } else { cum += c1; bin = 4 * lane; nr = rem - cum; } } }
                    selw[0] = bin; selw[1] = nr;
                }
            }
            __syncthreads();
            prefix |= selw[0] << shift; mask |= 255u << shift; rem = selw[1];
            __syncthreads();
        }
        const unsigned thr = prefix;
        int ceq = 0;
#pragma unroll
        for (int j = 0; j < 16; ++j) ceq += (key[j] == thr) ? 1 : 0;
        int tot; const int eqbase = block_excl_scan(ceq, wsum, tid, tot);
        unsigned selm = 0u; int er = eqbase, cs = 0;
#pragma unroll
        for (int j = 0; j < 16; ++j) { bool s = key[j] > thr; if (key[j] == thr) { s = (unsigned)er < rem; ++er; } if (s) { selm |= 1u << j; ++cs; } }
        int slot = block_excl_scan(cs, wsum, tid, tot);
#pragma unroll
        for (int j = 0; j < 16; ++j) { const int t = 16 * tid + j; const bool s = (selm >> j) & 1u;
            inv[(size_t)(b * SEQ + t) * 16 + e] = s ? slot : -1;
            if (s) { const int ro = e * ROWS_E + b * CAP + slot; idxE[ro] = b * SEQ + t; gateE[ro] = __uint_as_float(key[j]); ++slot; } }
        __syncthreads();
    }
}


__device__ __forceinline__ void phase10(const Args& a, const int TID, const int BID, const int GD) {
    const int lane = TID & 63, wave = TID >> 6;
    float* xo = a.out; const float* fg = a.in[27];
    const float* mod = (const float*)(a.ws + WS_MOD);
    const bf16_t* X1b = (const bf16_t*)(a.ws + WS_X1B);
    const unsigned char* Y = a.ws + WS_WGUT; const int* inv = (const int*)(a.ws + WS_INV);
    f32x4 gg[4];
#pragma unroll
    for (int i = 0; i < 4; ++i) gg[i] = *(const f32x4*)(fg + 4 * (lane + 64 * i));
    const int row0 = BID * NWAVES + wave, rstride = GD * NWAVES;
    int myslot = (row0 < NTOK) ? inv[(size_t)row0 * 16 + (lane & 15)] : -1;
#pragma unroll 1
    for (int row = row0; row < NTOK; row += rstride) {
        const int b = row >> 13;
        const int slot_cur = myslot;
        if (row + rstride < NTOK) myslot = inv[(size_t)(row + rstride) * 16 + (lane & 15)];
        u32x2 xw[4];
#pragma unroll
        for (int i = 0; i < 4; ++i) xw[i] = *(const u32x2*)(X1b + (size_t)row * D + 4 * (lane + 64 * i));
        f32x4 mo[4];
#pragma unroll
        for (int i = 0; i < 4; ++i) mo[i] = (f32x4){0.f, 0.f, 0.f, 0.f};
        unsigned long long bal = __ballot(lane < 16 && slot_cur >= 0);
        while (bal) {
            int ee[4]; const unsigned char* yr[4];
#pragma unroll
            for (int q = 0; q < 4; ++q) { ee[q] = -1; if (bal) { ee[q] = (int)__builtin_ctzll(bal); bal &= bal - 1; } }
#pragma unroll
            for (int q = 0; q < 4; ++q) { const int e = ee[q] < 0 ? 0 : ee[q]; const int sl = __shfl(slot_cur, e); yr[q] = Y + (size_t)(e * ROWS_E + b * CAP + (sl < 0 ? 0 : sl)) * D; }
            unsigned yw[4][4];
#pragma unroll
            for (int q = 0; q < 4; ++q)
#pragma unroll
                for (int i = 0; i < 4; ++i) { yw[q][i] = 0u; if (ee[q] >= 0) yw[q][i] = *(const unsigned*)(yr[q] + 4 * (lane + 64 * i)); }
#pragma unroll
            for (int q = 0; q < 4; ++q)
#pragma unroll
                for (int i = 0; i < 4; ++i) { const f32x2 lo = __builtin_amdgcn_cvt_pk_f32_fp8((int)yw[q][i], false), hi = __builtin_amdgcn_cvt_pk_f32_fp8((int)yw[q][i], true);
                    mo[i].x += lo.x; mo[i].y += lo.y; mo[i].z += hi.x; mo[i].w += hi.y; }
        }
        const float* g5 = mod + b * 6144 + 5120;
        f32x4 v[4]; float ss = 0.f;
#pragma unroll
        for (int i = 0; i < 4; ++i) { const f32x4 g = *(const f32x4*)(g5 + 4 * (lane + 64 * i)) * (1.0f / 32.0f);
            v[i] = (f32x4){bf_lo(xw[i].x), bf_hi(xw[i].x), bf_lo(xw[i].y), bf_hi(xw[i].y)};
            v[i] = v[i] + g * mo[i];
            ss += v[i].x * v[i].x + v[i].y * v[i].y + v[i].z * v[i].z + v[i].w * v[i].w; }
        ss = wave_sum(ss);
        const float r = rsqrtf(ss * (1.0f / D) + 1e-6f);
#pragma unroll
        for (int i = 0; i < 4; ++i) *(f32x4*)(xo + (size_t)row * D + 4 * (lane + 64 * i)) = (v[i] * r) * gg[i];
    }
}

#define XB_TMO      128
#define XB_XCNT(j)  (256  + 64 * (j))
#define XB_XSUB(j)  (1280 + 64 * (j))
#define XB_XGEN(j)  (2304 + 64 * (j))
#define XB_TOP      3328
#define XB_TOPGEN   3392
#define XCD_BAR_WORDS 3456
#define XB_SPIN_CAP (1u << 18)
__device__ __forceinline__ unsigned xb_ld(unsigned* p)              { return __hip_atomic_load(p, __ATOMIC_RELAXED, __HIP_MEMORY_SCOPE_AGENT); }
__device__ __forceinline__ unsigned xb_add(unsigned* p, unsigned v) { return __hip_atomic_fetch_add(p, v, __ATOMIC_RELAXED, __HIP_MEMORY_SCOPE_AGENT); }
__device__ __forceinline__ unsigned xb_xcc_id() { return (unsigned)__builtin_amdgcn_s_getreg((3 << 11) | 20) & 0xFu; }
#define XB_SPIN(cond, bar) do { unsigned _sp = 0; while (cond) { __builtin_amdgcn_s_sleep(1); \
    if ((++_sp & 255u) == 0u) { if (xb_ld(&(bar)[XB_TMO])) break; if (_sp > XB_SPIN_CAP) { atomicAdd(&(bar)[XB_TMO], 1u); break; } } } } while (0)
struct XcdBarrier { unsigned* bar; unsigned x; volatile LAS unsigned* st; };

__device__ __forceinline__ int lane_id_opaque() { unsigned m = ~0u; asm volatile("" : "+s"(m)); return (int)__builtin_amdgcn_mbcnt_hi(m, __builtin_amdgcn_mbcnt_lo(m, 0u)); }
__device__ __forceinline__ XcdBarrier xcd_barrier_post(unsigned* bar, volatile LAS unsigned* st, int tid) {
    XcdBarrier b; b.bar = bar; b.x = xb_xcc_id(); b.st = st;
    if (tid == 0) (void)xb_add(&bar[XB_XCNT(b.x)], 1u);
    return b;
}
__device__ __forceinline__ void xcd_barrier_complete(unsigned* bar, unsigned x, unsigned G, unsigned& nloc, unsigned& nx) {
    unsigned sum, cnt, mine, sp = 0u;
    for (;;) {
        sum = 0u; cnt = 0u; mine = 0u;
#pragma unroll
        for (unsigned j = 0; j < 16; ++j) { const unsigned c = xb_ld(&bar[XB_XCNT(j)]); sum += c; cnt += (c > 0u) ? 1u : 0u; mine = (j == x) ? c : mine; }
        if (sum == G) break;
        __builtin_amdgcn_s_sleep(1);
        if ((++sp & 255u) == 0u) { if (xb_ld(&bar[XB_TMO])) break; if (sp > XB_SPIN_CAP) { atomicAdd(&bar[XB_TMO], 1u); break; } }
    }
    nloc = mine > 0u ? mine : 1u; nx = cnt > 0u ? cnt : 1u;
}
__device__ __forceinline__ void xcd_barrier(const XcdBarrier& b, int tid, unsigned G) {
    asm volatile("s_waitcnt vmcnt(0)" ::: "memory");
    __syncthreads();
    if (tid == 0) {
        unsigned* bar = b.bar;
        __builtin_amdgcn_s_waitcnt(0);
        unsigned nloc = b.st[0], nx = b.st[1];
        if (nloc == 0u) { xcd_barrier_complete(bar, b.x, G, nloc, nx); b.st[0] = nloc; b.st[1] = nx; }
        const unsigned old = xb_add(&bar[XB_XSUB(b.x)], 1u);
        const unsigned gen = old / nloc;
        if (old + 1u == (gen + 1u) * nloc) {
            __builtin_amdgcn_fence(__ATOMIC_RELEASE, "agent");
            asm volatile("s_waitcnt vmcnt(0)" ::: "memory");
            const unsigned og = xb_add(&bar[XB_TOP], 1u);
            const unsigned tg = og / nx;
            if (og + 1u == (tg + 1u) * nx) xb_add(&bar[XB_TOPGEN], 1u);
            else XB_SPIN(xb_ld(&bar[XB_TOPGEN]) == tg, bar);
            __builtin_amdgcn_fence(__ATOMIC_ACQUIRE, "agent");
            xb_add(&bar[XB_XGEN(b.x)], 1u);
            asm volatile("s_waitcnt vmcnt(0)" ::: "memory");
        } else {
            XB_SPIN(xb_ld(&bar[XB_XGEN(b.x)]) == gen, bar);
            __builtin_amdgcn_fence(__ATOMIC_ACQUIRE, "agent");
            asm volatile("s_waitcnt vmcnt(0)" ::: "memory");
        }
    }
    __syncthreads();
}
constexpr int BAR_LDS_OFF = LDS_BYTES - 64;
constexpr size_t WS_BAR = WS_CTL + 16384;

typedef const __attribute__((address_space(4))) Args* ArgsP;
template <int PH>
__device__ __forceinline__ void do_phase(LAS unsigned char* lds, const Args& a_in, const int wave_id_s) {
#if defined(__HIP_DEVICE_COMPILE__)
    ArgsP ap = (ArgsP)__builtin_amdgcn_kernarg_segment_ptr();
    asm volatile("" : "+s"(ap));
    const Args a = *ap;
#else
    const Args a = a_in;
#endif
    const int nrep = 1 + ((a.dbg >> (8 + PH)) & 1);
#pragma unroll 1
    for (int rep = 0; rep < nrep; ++rep) {
        int WID = wave_id_s, BID = blockIdx.x, GD = gridDim.x;
        asm volatile("" : "+s"(WID), "+s"(BID), "+s"(GD));
        const int TID = WID * 64 + lane_id_opaque();
        const int G = GD;
        unsigned char* ws = a.ws;
        if constexpr (PH == 0) { phase0(lds, a, TID, BID, GD); if (rep == nrep - 1) { wg_wait((unsigned*)(ws + WS_ADACNT), 96u * (unsigned)nrep, TID); phase1(a, TID, BID, GD); } }
        else if constexpr (PH == 1) { }
        else if constexpr (PH == 2) {
            pg8::SchedInProj S{G, BID};
            EpiInProj E{(bf16_t*)(ws + WS_XGLU), (bf16_t*)(ws + WS_XLX), (bf16_t*)(ws + WS_GLG), a.in[9]};
            pg8::gemm_phase<EpiInProj, pg8::SchedInProj, false>(lds, (const bf16_t*)(ws + WS_U), (const bf16_t*)(ws + WS_WINT), 1024, S, E, nullptr, TID, BID, GD, 0x7F7F7F7F, pg8::lay_rowmajor(1024));
        } else if constexpr (PH == 3) {
            {
                pg8::SchedCtx S{BID};
                EpiInProj E{(bf16_t*)(ws + WS_XGLU), (bf16_t*)(ws + WS_XLX), (bf16_t*)(ws + WS_GLG), a.in[9]};
                pg8::gemm_phase<EpiInProj, pg8::SchedCtx, false>(lds, (const bf16_t*)(ws + WS_U), (const bf16_t*)(ws + WS_WINT), 1024, S, E, nullptr, TID, BID, GD, 0x7F7F7F7F, pg8::lay_rowmajor(1024));
                if ((BID & 7) == 7 && (BID >> 3) < 8) {
                    asm volatile("s_waitcnt vmcnt(0)" ::: "memory");
                    __syncthreads();
                    if (TID == 0) { __builtin_amdgcn_fence(__ATOMIC_RELEASE, "agent"); asm volatile("s_waitcnt vmcnt(0)" ::: "memory");
                        __hip_atomic_store((unsigned*)(ws + WS_CTXFLAG) + 64 * (BID >> 3), 1u, __ATOMIC_RELAXED, __HIP_MEMORY_SCOPE_AGENT); }
                }
            }
            conv_units(lds, a, BID, G, TID, BID, GD);
            lru_phase<1>(lds, a, TID, BID, GD);
            if (rep == nrep - 1) { __syncthreads(); lru_rescan(lds, a, TID, BID, GD); }
        } else if constexpr (PH == 4) {
        } else if constexpr (PH == 5) {
            pg8::Sched S{128, 4, 1, G, BID};
            EpiOutProj E{(bf16_t*)(ws + WS_M), (const float*)(ws + WS_MOD), a.in[22]};
            pg8::gemm_phase<EpiOutProj, pg8::Sched, false>(lds, (const bf16_t*)(ws + WS_MIX), (const bf16_t*)(ws + WS_WOUTT), 1024, S, E, nullptr, TID, BID, GD, 0x7F7F7F7F, pg8::lay_rowmajor(1024));
        } else if constexpr (PH == 6) phase6(lds, a, TID, BID, GD);
        else if constexpr (PH == 7) phase7(lds, a, TID, BID, GD);
        else if constexpr (PH == 8) {
            pg8::Sched S{16, 22, 16, G, BID};
            EpiExpUp E{ws + WS_R1};
            pg8::gemm_phase<EpiExpUp, pg8::Sched, true, true>(lds, (const bf16_t*)(ws + WS_V), (const bf16_t*)(ws + WS_WGUT), 512, S, E, (const int*)(ws + WS_IDXE), TID, BID, GD, 0x7A7A7A7A, pg8::lay_rowmajor(512));
        } else if constexpr (PH == 9) {
            pg8::SchedDown S{G, BID};
            EpiExpDown E{ws + WS_WGUT, (const float*)(ws + WS_GATEE)};
            pg8::gemm_phase<EpiExpDown, pg8::SchedDown, false, true>(lds, (const bf16_t*)(ws + WS_R1), (const bf16_t*)(ws + WS_WDT), DE / 2, S, E, nullptr, TID, BID, GD, 0x79797979, pg8::lay_blocked(22));
        } else if constexpr (PH == 10) phase10(a, TID, BID, GD);
    }
}
template <int PH, int PH0, int PH1>
__device__ __forceinline__ void run_phases(LAS unsigned char* lds, const Args& a_in, const int wave_id_s) {
    if constexpr (PH < PH1) {
        if constexpr (PH > PH0 && PH != 1 && PH != 4) {
#if defined(__HIP_DEVICE_COMPILE__)
            ArgsP apb = (ArgsP)__builtin_amdgcn_kernarg_segment_ptr(); asm volatile("" : "+s"(apb));
            XcdBarrier xb2; xb2.bar = (unsigned*)(apb->ws + WS_BAR); xb2.x = xb_xcc_id(); xb2.st = (volatile LAS unsigned*)(lds + BAR_LDS_OFF);
            int wv = wave_id_s; asm volatile("" : "+s"(wv));
            xcd_barrier(xb2, wv * 64 + lane_id_opaque(), gridDim.x);
#endif
        }
        do_phase<PH>(lds, a_in, wave_id_s);
        run_phases<PH + 1, PH0, PH1>(lds, a_in, wave_id_s);
    }
}
template <int PH0, int PH1>
__global__ void __launch_bounds__(NTHREADS, 2) hybrid_fwd(Args a_in) {
    extern __shared__ __attribute__((aligned(16))) unsigned char lds_raw[];
    LAS unsigned char* lds = (LAS unsigned char*)lds_raw;
    const int wave_id_s = __builtin_amdgcn_readfirstlane((int)threadIdx.x >> 6);
    {
        volatile LAS unsigned* st = (volatile LAS unsigned*)(lds + BAR_LDS_OFF);
        if (threadIdx.x == 0) { st[0] = 0u; st[1] = 0u; }
        __syncthreads();
        (void)xcd_barrier_post((unsigned*)(a_in.ws + WS_BAR), st, (int)threadIdx.x);
    }
    run_phases<PH0, PH0, PH1>(lds, a_in, wave_id_s);
}

extern "C" void kernel_launch(void* const* d_in, const int* in_sizes, int n_in, void* d_out, int out_size, void* d_ws, size_t ws_size, hipStream_t stream) {
    if (n_in != 28 || out_size != NTOK * D || ws_size < WS_END) { fprintf(stderr, "kernel_launch: unexpected shapes (n_in %d out %d ws %zu)\n", n_in, out_size, ws_size); return; }
    Args a{};
    for (int i = 0; i < 28; ++i) a.in[i] = (const float*)d_in[i];
    a.out = (float*)d_out; a.ws = (unsigned char*)d_ws; a.dbg = PROBE_MASK; a.pad = 0;
    static int grid = 0;
    if (!grid) {
        (void)hipFuncSetAttribute((const void*)hybrid_fwd<0, 11>, hipFuncAttributeMaxDynamicSharedMemorySize, LDS_BYTES);
        int dev = 0, cus = 0, per_cu = 0;
        (void)hipGetDevice(&dev); (void)hipDeviceGetAttribute(&cus, hipDeviceAttributeMultiprocessorCount, dev);
        (void)hipOccupancyMaxActiveBlocksPerMultiprocessor(&per_cu, (const void*)hybrid_fwd<0, 11>, NTHREADS, LDS_BYTES);
        grid = (per_cu >= 1 ? 1 : 0) * cus;
        if (grid != 256) fprintf(stderr, "kernel_launch: grid %d (cus %d per_cu %d)\n", grid, cus, per_cu);
    }
    if (grid <= 0) return;
    a.ph_lo = 0; a.ph_hi = 11;
    (void)hipMemsetAsync((char*)d_ws + WS_CTL, 0, 65536, stream);
    void* kargs[] = {&a};
    hipError_t e = hipLaunchCooperativeKernel((const void*)hybrid_fwd<0, 11>, dim3(grid), dim3(NTHREADS), kargs, LDS_BYTES, stream);
    if (e != hipSuccess) fprintf(stderr, "cooperative launch failed: %s (grid %d)\n", hipGetErrorString(e), grid);
}
```

```cpp
#include <hip/hip_runtime.h>
#include <hip/hip_cooperative_groups.h>
#include <cstdio>
#include <cstdint>

#define LAS __attribute__((address_space(3)))
typedef unsigned short bf16_t;
typedef short bf16x8 __attribute__((ext_vector_type(8)));
typedef float f32x4 __attribute__((ext_vector_type(4)));
typedef float f32x2 __attribute__((ext_vector_type(2)));
typedef unsigned u32x4 __attribute__((ext_vector_type(4)));
typedef unsigned u32x2 __attribute__((ext_vector_type(2)));
typedef int v4i_t __attribute__((ext_vector_type(4)));
typedef _Float16 h2_t __attribute__((ext_vector_type(2)));
typedef int v8i_t __attribute__((ext_vector_type(8)));

constexpr int D = 1024, NB = 4, SEQ = 8192, NTOK = NB * SEQ, CTXL = 256, NCTX = NB * CTXL, NROWS = NTOK + NCTX;
constexpr int DE = 2816, NE = 16, CAP = 1024, ROWS_E = NB * CAP;
constexpr int NQ = 132;
constexpr int NWAVES = 8, NTHREADS = 512;

constexpr size_t MiB = 1u << 20;
constexpr size_t WS_CTL = 0, CTL_BYTES = 1 * MiB;
constexpr size_t WS_CTXFLAG = WS_CTL + 40960;
constexpr size_t WS_ADACNT = WS_CTL + 45056;
constexpr size_t WS_BHCNT = WS_CTL + 49152;
constexpr size_t WS_MOD = 1 * MiB;
constexpr size_t WS_CARRY = 2 * MiB;
constexpr size_t WS_AFFT = 7 * MiB;
constexpr size_t WS_IDXE = 9 * MiB;
constexpr size_t WS_GATEE = WS_IDXE + 256 * 1024;
constexpr size_t WS_INV = WS_GATEE + 256 * 1024;
constexpr size_t WS_WINT = 12 * MiB;
constexpr size_t WS_WOUTT = 16 * MiB;
constexpr size_t WS_WGUT = 18 * MiB;
constexpr size_t WS_WDT = 146 * MiB;
constexpr size_t WS_V = 190 * MiB;
constexpr size_t WS_R1 = 222 * MiB;
constexpr size_t WS_U = WS_R1;
constexpr size_t WS_XGLU = WS_R1 + 66 * MiB;
constexpr size_t WS_XLX = WS_R1 + 98 * MiB;
constexpr size_t WS_GLG = WS_R1 + 131 * MiB;
constexpr size_t WS_MIX = WS_R1 + 163 * MiB;
constexpr size_t WS_M = WS_R1 + 227 * MiB;
constexpr size_t WS_X1B = WS_R1 + 291 * MiB;
constexpr size_t WS_AU = WS_R1 + 291 * MiB;
constexpr size_t WS_END = 641 * MiB;
constexpr int LDS_BYTES = 147456;

__device__ __forceinline__ unsigned f2bf(float f) { unsigned u = __builtin_bit_cast(unsigned, f); return (u + 0x7fffu + ((u >> 16) & 1u)) >> 16; }
__device__ __forceinline__ unsigned pk2(float lo, float hi) { return f2bf(lo) | (f2bf(hi) << 16); }
__device__ __forceinline__ unsigned pk2h(float lo, float hi) { h2_t p; p.x = (_Float16)lo; p.y = (_Float16)hi; return __builtin_bit_cast(unsigned, p); }
__device__ __forceinline__ void fma_mix_lo(float& acc, float w, unsigned xh) { asm("v_fma_mix_f32 %0, %1, %2, %0 op_sel_hi:[0,1,0]" : "+v"(acc) : "v"(w), "v"(xh)); }
__device__ __forceinline__ void fma_mix_hi(float& acc, float w, unsigned xh) { asm("v_fma_mix_f32 %0, %1, %2, %0 op_sel:[0,1,0] op_sel_hi:[0,1,0]" : "+v"(acc) : "v"(w), "v"(xh)); }
__device__ __forceinline__ float bf_lo(unsigned w) { return __builtin_bit_cast(float, w << 16); }
__device__ __forceinline__ float bf_hi(unsigned w) { return __builtin_bit_cast(float, w & 0xffff0000u); }
__device__ __forceinline__ unsigned pk4_fp8(float a, float b, float c, float d) {
    a = __builtin_amdgcn_fmed3f(a, -448.f, 448.f); b = __builtin_amdgcn_fmed3f(b, -448.f, 448.f); c = __builtin_amdgcn_fmed3f(c, -448.f, 448.f); d = __builtin_amdgcn_fmed3f(d, -448.f, 448.f);
    int w = 0; w = __builtin_amdgcn_cvt_pk_fp8_f32(a, b, w, false); w = __builtin_amdgcn_cvt_pk_fp8_f32(c, d, w, true); return (unsigned)w; }
__device__ __forceinline__ float wave_sum(float v) {
#pragma unroll
    for (int o = 32; o >= 1; o >>= 1) v += __shfl_xor(v, o);
    return v;
}
__device__ __forceinline__ float wave_max(float v) {
#pragma unroll
    for (int o = 32; o >= 1; o >>= 1) v = fmaxf(v, __shfl_xor(v, o));
    return v;
}
__device__ __forceinline__ float sigm(float x) { return __builtin_amdgcn_rcpf(1.0f + __expf(-x)); }
__device__ __forceinline__ float silu_f(float x) { return x * sigm(x); }
__device__ __forceinline__ float gelu_tanh(float x) { const float z = 0.7978845608028654f * (x + 0.044715f * x * x * x); return x * sigm(2.0f * z); }

namespace pg8 {
constexpr int BM = 256, BK = 64, HALF = 128, HTB = HALF * BK * 2, STAGE_BYTES = 8 * HTB, NXCD = 8, WGM = 8;
__device__ __forceinline__ int lds_byte(int r, int c) { const int st = (r >> 4) * 2 + (c >> 5), rr = r & 15, cc = c & 31, ob = rr * 64 + cc * 2; return st * 1024 + (ob ^ (((ob >> 9) & 1) << 5)); }
__device__ __forceinline__ void stage_rc(int b, int& R, int& C) { const int st = b / 1024, sb = b % 1024, swz = sb ^ (((sb >> 9) & 1) << 5); R = (st >> 1) * 16 + swz / 64; C = (st & 1) * 32 + (swz % 64) / 2; }
__device__ __forceinline__ int perm32(int rho) { const int n = rho >> 4, i = rho & 15; return 8 * (i >> 2) + 4 * n + (i & 3); }
struct Unit { int pm, pn; };
struct Lay { unsigned rowA, rowB; size_t kstepA, kstepB, hstepB, tstepA, tstepB; };
__device__ __forceinline__ Lay lay_rowmajor(int K) { Lay l; l.rowA = l.rowB = (unsigned)K * 2u; l.kstepA = l.kstepB = 128; l.hstepB = (size_t)128 * K * 2; l.tstepA = l.tstepB = (size_t)256 * K * 2; return l; }
__device__ __forceinline__ Lay lay_blocked(int nkt) { Lay l; l.rowA = l.rowB = 128u; l.kstepA = l.kstepB = 32768; l.hstepB = 16384; l.tstepA = l.tstepB = (size_t)nkt * 32768; return l; }

__device__ __forceinline__ void tile_order(int w, int nM, int nN, int& pm, int& pn) {
    const int nwg = nM * nN;
    int wgid = w; { const int q = nwg / NXCD, r = nwg % NXCD, xcd = wgid % NXCD, off = wgid / NXCD; wgid = (xcd < r ? xcd * (q + 1) : r * (q + 1) + (xcd - r) * q) + off; }
    const int nig = WGM * nN, gid = wgid / nig, fm = gid * WGM, gsz = (nM - fm) < WGM ? (nM - fm) : WGM;
    pm = fm + ((wgid % nig) % gsz); pn = (wgid % nig) / gsz;
}
struct Sched {
    int nM, nN, ngroups, G, c;
    __device__ __forceinline__ bool next(int i, Unit& u) const {
        const int per = nM * nN; const long L = (long)i * G + c; if (L >= (long)per * ngroups) return false;
        const int e = (int)(L / per), w = (int)(L % per); int pm, pn; tile_order(w, nM, nN, pm, pn);
        u.pm = e * nM + pm; u.pn = e * nN + pn; return true;
    }
};
struct SchedInProj {
    int G, c;
    __device__ __forceinline__ bool next(int i, Unit& u) const {
        const long L = (long)i * G + c; if (L >= 1024) return false;
        int pm, pn; tile_order((int)L, 128, 8, pm, pn); u.pm = pm; u.pn = pn; return true;
    }
};
struct SchedCtx {
    int c;
    __device__ __forceinline__ bool next(int i, Unit& u) const {
        if (i != 0 || (c & 7) != 7 || (c >> 3) >= 8) return false;
        const int k = c >> 3; u.pm = 128 + (k >> 1); u.pn = 4 + (k & 1); return true;
    }
};
struct SchedDown {
    int G, c;
    __device__ __forceinline__ bool next(int i, Unit& u) const {
        if (G != 256) { const long L = (long)i * G + c; if (L >= 1024) return false; const int e = (int)(L >> 6), w = (int)(L & 63); u.pm = e * 16 + (w >> 2); u.pn = e * 4 + (w & 3); return true; }
        if (i >= 4) return false;
        const int x = c & 7, j = c >> 3, e = 4 * i + (x >> 1);
        u.pm = e * 16 + 8 * (x & 1) + (j & 7); u.pn = e * 4 + (j >> 3); return true;
    }
};
template <class Epi, class SchedT, bool GATHER, bool FP8 = false, bool SP2 = true, bool ALIGN_EPI = true>
__device__ __forceinline__ void gemm_phase(LAS unsigned char* lds, const bf16_t* Ag, const bf16_t* Btg, const int K, const SchedT& S, const Epi& E, const int* gidx, const int TID, const int BID, const int GD, const int scaleB, const Lay L) {
    const int tid = TID, wid = __builtin_amdgcn_readfirstlane(tid >> 6), lane = tid & 63, wr = wid >> 2, wc = wid & 3, fr = lane & 15, fq = lane >> 4;
    const int nt = K / BK;
    int Rr[2], Cc[2]; unsigned voffB[2];
#pragma unroll
    for (int i = 0; i < 2; ++i) { stage_rc(tid * 16 + i * 8192, Rr[i], Cc[i]); const int Rb = Epi::PERM ? ((Rr[i] & ~31) + perm32(Rr[i] & 31)) : Rr[i]; voffB[i] = (unsigned)Rb * L.rowB + (unsigned)Cc[i] * 2u; }
    const size_t kstepA = L.kstepA, kstepB = L.kstepB, hstep = L.hstepB, tstepA = L.tstepA, tstepB = L.tstepB;
    const unsigned ldsw = (unsigned)wid * 1024u;
    const int aoff = lds_byte(wr * 64 + fr, fq * 8), boff = lds_byte(wc * 32 + fr, fq * 8);
    const int aoff8_0 = aoff, aoff8_1 = aoff + 1024, boff8_0 = boff, boff8_1 = boff + 1024;
#define PG8_SA(b, h) (((b) * 2 + (h)) * HTB)
#define PG8_SB(b, h) ((4 + (b) * 2 + (h)) * HTB)
#define PG8_STAGE(bufoff, gbase, voff) do { _Pragma("unroll") for (int _i = 0; _i < 2; ++_i) \
        __builtin_amdgcn_global_load_lds((const unsigned*)((const char*)(gbase) + (voff)[_i]), (LAS unsigned*)(lds + (bufoff) + ldsw + _i * 8192), 16, 0, 0); } while (0)
#define PG8_LD8(p0, p1) __builtin_shufflevector(*(const LAS v4i_t*)(p0), *(const LAS v4i_t*)(p1), 0, 1, 2, 3, 4, 5, 6, 7)
#define PG8_LDA(dst, b, h) do { _Pragma("unroll") for (int m = 0; m < 4; ++m) { if constexpr (FP8) { \
        dst##8[m] = PG8_LD8(lds + PG8_SA(b, h) + aoff8_0 + m * 2048, lds + PG8_SA(b, h) + aoff8_1 + m * 2048); } else { \
        _Pragma("unroll") for (int k = 0; k < 2; ++k) dst[m][k] = *(const LAS bf16x8*)(lds + PG8_SA(b, h) + aoff + m * 2048 + k * 1024); } } } while (0)
#define PG8_LDB(dst, b, h) do { _Pragma("unroll") for (int n = 0; n < 2; ++n) { if constexpr (FP8) { \
        dst##8[n] = PG8_LD8(lds + PG8_SB(b, h) + boff8_0 + n * 2048, lds + PG8_SB(b, h) + boff8_1 + n * 2048); } else { \
        _Pragma("unroll") for (int k = 0; k < 2; ++k) dst[n][k] = *(const LAS bf16x8*)(lds + PG8_SB(b, h) + boff + n * 2048 + k * 1024); } } } while (0)
#define PG8_MMA(ai, bj, At, Bt) do { if constexpr (FP8) __builtin_amdgcn_sched_barrier(0); __builtin_amdgcn_s_setprio(1); _Pragma("unroll") for (int m = 0; m < 4; ++m) _Pragma("unroll") for (int n = 0; n < 2; ++n) { if constexpr (FP8) { \
        acc[ai][bj][m][n] = __builtin_amdgcn_mfma_scale_f32_16x16x128_f8f6f4(Bt##8[n], At##8[m], acc[ai][bj][m][n], 0, 0, 0, scaleB, 0, 0x7F7F7F7F); } else { \
        _Pragma("unroll") for (int k = 0; k < 2; ++k) acc[ai][bj][m][n] = __builtin_amdgcn_mfma_f32_16x16x32_bf16(Bt[n][k], At[m][k], acc[ai][bj][m][n], 0, 0, 0); } } \
        if constexpr (FP8) { _Pragma("unroll") for (int m = 0; m < 4; ++m) _Pragma("unroll") for (int n = 0; n < 2; ++n) asm volatile("" : "+v"(acc[ai][bj][m][n])); } \
        __builtin_amdgcn_s_setprio(0); if constexpr (FP8) __builtin_amdgcn_sched_barrier(0); } while (0)
#define PG8_WAIT_V(n) asm volatile("s_waitcnt vmcnt(" #n ")" ::: "memory")
#define PG8_WAIT_L(n) asm volatile("s_waitcnt lgkmcnt(" #n ")" ::: "memory")
#define PG8_BAR __builtin_amdgcn_s_barrier()
#define PG8_SCHED __builtin_amdgcn_sched_barrier(0)
#define PG8_LOADV(dst, u) do { _Pragma("unroll") for (int _h = 0; _h < 2; ++_h) _Pragma("unroll") for (int _i = 0; _i < 2; ++_i) \
        dst[_h][_i] = GATHER ? ((unsigned)gidx[(u).pm * BM + _h * HALF + Rr[_i]] * L.rowA + (unsigned)Cc[_i] * 2u) : ((unsigned)(_h * HALF + Rr[_i]) * L.rowA + (unsigned)Cc[_i] * 2u); } while (0)
    Unit cur, nxt; int ui = 0;
    if (!S.next(0, cur)) return;
    f32x4 acc[2][2][4][2];
#pragma unroll
    for (int a = 0; a < 2; ++a)
#pragma unroll
        for (int b = 0; b < 2; ++b)
#pragma unroll
            for (int m = 0; m < 4; ++m)
#pragma unroll
                for (int n = 0; n < 2; ++n) acc[a][b][m][n] = (f32x4){0.f, 0.f, 0.f, 0.f};
    bf16x8 At[4][2], B0[2][2], B1[2][2];
    v8i_t At8[4], B08[2], B18[2];
    unsigned vc[2][2], vn[2][2];
    PG8_LOADV(vc, cur);
    const char* cA = GATHER ? (const char*)Ag : (const char*)Ag + (size_t)cur.pm * tstepA;
    const char* cB = (const char*)Btg + (size_t)cur.pn * tstepB;
    if constexpr (SP2) {
        PG8_STAGE(PG8_SB(0, 0), cB, voffB); PG8_STAGE(PG8_SB(0, 1), cB + hstep, voffB); PG8_STAGE(PG8_SA(0, 0), cA, vc[0]); PG8_STAGE(PG8_SA(0, 1), cA, vc[1]);
        if (wr == 1) PG8_BAR;
        PG8_WAIT_V(2); PG8_BAR;
        PG8_STAGE(PG8_SB(1, 0), cB + kstepB, voffB); PG8_STAGE(PG8_SA(1, 0), cA + kstepA, vc[0]); PG8_STAGE(PG8_SB(1, 1), cB + hstep + kstepB, voffB);
        PG8_WAIT_V(6); PG8_BAR;
    } else {
    PG8_STAGE(PG8_SB(0, 0), cB, voffB); PG8_STAGE(PG8_SA(0, 0), cA, vc[0]); PG8_STAGE(PG8_SB(0, 1), cB + hstep, voffB); PG8_STAGE(PG8_SA(0, 1), cA, vc[1]);
    if (wr == 1) PG8_BAR;
    PG8_WAIT_V(4); PG8_BAR;
    PG8_STAGE(PG8_SB(1, 0), cB + kstepB, voffB); PG8_STAGE(PG8_SA(1, 0), cA + kstepA, vc[0]); PG8_STAGE(PG8_SB(1, 1), cB + hstep + kstepB, voffB);
    PG8_WAIT_V(6); PG8_BAR;
    }
    for (;;) {
        const bool has_next = S.next(ui + 1, nxt);
        const char* nA = cA; const char* nB = cB;
        if (has_next) { nA = GATHER ? (const char*)Ag : (const char*)Ag + (size_t)nxt.pm * tstepA; nB = (const char*)Btg + (size_t)nxt.pn * tstepB; PG8_LOADV(vn, nxt); }
        else {
#pragma unroll
            for (int h = 0; h < 2; ++h)
#pragma unroll
                for (int i = 0; i < 2; ++i) vn[h][i] = vc[h][i];
        }
        for (int t = 0; t < nt; t += 2) {
            const bool last = (t == nt - 2);
            const char* a1 = cA + (size_t)(t + 1) * kstepA;
            const char* a2 = last ? nA : cA + (size_t)(t + 2) * kstepA; const char* b2 = last ? nB : cB + (size_t)(t + 2) * kstepB;
            const char* a3 = a2 + kstepA; const char* b3 = b2 + kstepB;
#pragma unroll
            for (int i = 0; i < 2; ++i) vc[0][i] = last ? vn[0][i] : vc[0][i];
            if constexpr (SP2) {
            PG8_LDB(B0, 0, 0); PG8_LDB(B1, 0, 1); PG8_SCHED; PG8_LDA(At, 0, 0); PG8_STAGE(PG8_SA(1, 1), a1, vc[1]);
            _Pragma("unroll") for (int i = 0; i < 2; ++i) vc[1][i] = last ? vn[1][i] : vc[1][i];
            PG8_WAIT_V(8); PG8_WAIT_L(0); PG8_BAR; PG8_MMA(0, 0, At, B0); PG8_MMA(0, 1, At, B1); PG8_BAR; PG8_SCHED;
            PG8_LDA(At, 0, 1); PG8_STAGE(PG8_SB(0, 0), b2, voffB); PG8_STAGE(PG8_SB(0, 1), b2 + hstep, voffB); PG8_STAGE(PG8_SA(0, 0), a2, vc[0]);
            PG8_WAIT_V(8); PG8_WAIT_L(0); PG8_BAR; PG8_MMA(1, 0, At, B0); PG8_MMA(1, 1, At, B1); PG8_BAR; PG8_SCHED;
            PG8_LDB(B0, 1, 0); PG8_LDB(B1, 1, 1); PG8_SCHED; PG8_LDA(At, 1, 0); PG8_STAGE(PG8_SA(0, 1), a2, vc[1]);
            PG8_WAIT_V(8); PG8_WAIT_L(0); PG8_BAR; PG8_MMA(0, 0, At, B0); PG8_MMA(0, 1, At, B1); PG8_BAR; PG8_SCHED;
            PG8_LDA(At, 1, 1); PG8_STAGE(PG8_SB(1, 0), b3, voffB); PG8_STAGE(PG8_SB(1, 1), b3 + hstep, voffB); PG8_STAGE(PG8_SA(1, 0), a3, vc[0]);
            PG8_WAIT_V(8); PG8_WAIT_L(0); PG8_BAR; PG8_MMA(1, 0, At, B0); PG8_MMA(1, 1, At, B1); PG8_BAR; PG8_SCHED;
            } else {
            PG8_LDB(B0, 0, 0); PG8_SCHED; PG8_LDA(At, 0, 0); PG8_STAGE(PG8_SA(1, 1), a1, vc[1]);
            _Pragma("unroll") for (int i = 0; i < 2; ++i) vc[1][i] = last ? vn[1][i] : vc[1][i];
            PG8_WAIT_L(8); PG8_BAR; PG8_WAIT_L(0); PG8_MMA(0, 0, At, B0); PG8_BAR; PG8_SCHED;
            PG8_LDB(B1, 0, 1); PG8_STAGE(PG8_SB(0, 0), b2, voffB);
            PG8_BAR; PG8_WAIT_L(0); PG8_MMA(0, 1, At, B1); PG8_BAR;
            PG8_LDA(At, 0, 1); PG8_STAGE(PG8_SA(0, 0), a2, vc[0]);
            PG8_BAR; PG8_WAIT_L(0); PG8_MMA(1, 0, At, B0); PG8_BAR; PG8_SCHED;
            PG8_STAGE(PG8_SB(0, 1), b2 + hstep, voffB);
            PG8_WAIT_V(6); PG8_BAR; PG8_MMA(1, 1, At, B1); PG8_BAR;
            PG8_LDB(B0, 1, 0); PG8_SCHED; PG8_LDA(At, 1, 0); PG8_STAGE(PG8_SA(0, 1), a2, vc[1]);
            PG8_WAIT_L(8); PG8_BAR; PG8_WAIT_L(0); PG8_MMA(0, 0, At, B0); PG8_BAR; PG8_SCHED;
            PG8_LDB(B1, 1, 1); PG8_STAGE(PG8_SB(1, 0), b3, voffB);
            PG8_BAR; PG8_WAIT_L(0); PG8_MMA(0, 1, At, B1); PG8_BAR;
            PG8_LDA(At, 1, 1); PG8_STAGE(PG8_SA(1, 0), a3, vc[0]);
            PG8_BAR; PG8_WAIT_L(0); PG8_MMA(1, 0, At, B0); PG8_BAR; PG8_SCHED;
            PG8_STAGE(PG8_SB(1, 1), b3 + hstep, voffB);
            PG8_WAIT_V(6); PG8_BAR; PG8_MMA(1, 1, At, B1); PG8_BAR;
            }
        }
        if constexpr (ALIGN_EPI) { if (wr == 0) PG8_BAR; }
        E(acc, cur, wr, wc, fr, fq);
        if (!has_next) break;
#pragma unroll
        for (int a = 0; a < 2; ++a)
#pragma unroll
            for (int b = 0; b < 2; ++b)
#pragma unroll
                for (int m = 0; m < 4; ++m)
#pragma unroll
                    for (int n = 0; n < 2; ++n) acc[a][b][m][n] = (f32x4){0.f, 0.f, 0.f, 0.f};
        cur = nxt; cA = nA; cB = nB; ++ui;
#pragma unroll
        for (int h = 0; h < 2; ++h)
#pragma unroll
            for (int i = 0; i < 2; ++i) vc[h][i] = vn[h][i];
        if constexpr (ALIGN_EPI) { if (wr == 1) PG8_BAR; }
    }
    PG8_WAIT_V(0);
    if constexpr (!ALIGN_EPI) { if (wr == 0) PG8_BAR; }
    PG8_BAR;
#undef PG8_SA
#undef PG8_SB
#undef PG8_STAGE
#undef PG8_LDA
#undef PG8_LDB
#undef PG8_MMA
#undef PG8_LD8
#undef PG8_WAIT_V
#undef PG8_WAIT_L
#undef PG8_BAR
#undef PG8_SCHED
#undef PG8_LOADV
}
}

struct EpiInProj {
    static constexpr bool PERM = true;
    bf16_t* xglu; bf16_t* xlx; bf16_t* glg; const float* b_in;
    __device__ __forceinline__ void operator()(const f32x4 (&acc)[2][2][4][2], const pg8::Unit& u, int wr, int wc, int fr, int fq) const {
        const int row0 = u.pm * 256 + wr * 64 + fr, cl = wc * 32 + 8 * fq;
        if (u.pn < 4) {
            const int col = 128 * u.pn + cl;
            f32x4 bv[2][2];
#pragma unroll
            for (int n = 0; n < 2; ++n) { bv[0][n] = *(const f32x4*)(b_in + col + 4 * n); bv[1][n] = *(const f32x4*)(b_in + 512 + col + 4 * n); }
#pragma unroll
            for (int ai = 0; ai < 2; ++ai)
#pragma unroll
                for (int m = 0; m < 4; ++m) {
                    const size_t row = (size_t)(row0 + ai * 128 + m * 16);
                    float o[8];
#pragma unroll
                    for (int n = 0; n < 2; ++n) { const f32x4 v = acc[ai][0][m][n] + bv[0][n], g = acc[ai][1][m][n] + bv[1][n];
#pragma unroll
                        for (int j = 0; j < 4; ++j) o[4 * n + j] = v[j] * sigm(g[j]); }
                    u32x4 w; w.x = pk2h(o[0], o[1]); w.y = pk2h(o[2], o[3]); w.z = pk2h(o[4], o[5]); w.w = pk2h(o[6], o[7]);
                    *(u32x4*)(xglu + row * 512 + col) = w;
                }
        } else {
            const bool isg = u.pn >= 6;
            const int cbase = 256 * (u.pn - (isg ? 6 : 4));
            const float* bias = b_in + (isg ? 1536 : 1024) + cbase;
            bf16_t* outp = isg ? glg : xlx;
#pragma unroll
            for (int bj = 0; bj < 2; ++bj) {
                const int col = 128 * bj + cl;
                const f32x4 b0 = *(const f32x4*)(bias + col), b1 = *(const f32x4*)(bias + col + 4);
#pragma unroll
                for (int ai = 0; ai < 2; ++ai)
#pragma unroll
                    for (int m = 0; m < 4; ++m) {
                        const size_t row = (size_t)(row0 + ai * 128 + m * 16);
                        f32x4 v0 = acc[ai][bj][m][0] + b0, v1 = acc[ai][bj][m][1] + b1;
                        if (isg) {
#pragma unroll
                            for (int j = 0; j < 4; ++j) { v0[j] = gelu_tanh(v0[j]); v1[j] = gelu_tanh(v1[j]); }
                        }
                        u32x4 w; w.x = pk2(v0[0], v0[1]); w.y = pk2(v0[2], v0[3]); w.z = pk2(v1[0], v1[1]); w.w = pk2(v1[2], v1[3]);
                        *(u32x4*)(outp + row * 512 + cbase + col) = w;
                    }
            }
        }
    }
};
struct EpiOutProj {
    static constexpr bool PERM = true;
    bf16_t* M; const float* mod; const float* b_out;
    __device__ __forceinline__ void operator()(const f32x4 (&acc)[2][2][4][2], const pg8::Unit& u, int wr, int wc, int fr, int fq) const {
        const int row0 = u.pm * 256 + wr * 64 + fr, col0 = u.pn * 256 + wc * 32 + 8 * fq;
        const int b = u.pm >> 5;
        const float* g1 = mod + b * 6144 + 2048;
#pragma unroll
        for (int bj = 0; bj < 2; ++bj) {
            const int col = col0 + bj * 128;
            const f32x4 bo0 = *(const f32x4*)(b_out + col), bo1 = *(const f32x4*)(b_out + col + 4), gg0 = *(const f32x4*)(g1 + col), gg1 = *(const f32x4*)(g1 + col + 4);
#pragma unroll
            for (int ai = 0; ai < 2; ++ai)
#pragma unroll
                for (int m = 0; m < 4; ++m) {
                    const f32x4 v0 = gg0 * (acc[ai][bj][m][0] + bo0), v1 = gg1 * (acc[ai][bj][m][1] + bo1);
                    u32x4 w; w.x = pk2(v0[0], v0[1]); w.y = pk2(v0[2], v0[3]); w.z = pk2(v1[0], v1[1]); w.w = pk2(v1[2], v1[3]);
                    *(u32x4*)(M + (size_t)(row0 + ai * 128 + m * 16) * D + col) = w;
                }
        }
    }
};
struct EpiExpUp {
    static constexpr bool PERM = true;
    unsigned char* H;
    __device__ __forceinline__ void operator()(const f32x4 (&acc)[2][2][4][2], const pg8::Unit& u, int wr, int wc, int fr, int fq) const {
        const int e = u.pm >> 4, t = u.pn - e * 22;
        const int row0 = u.pm * 256 + wr * 64 + fr, col = 128 * t + wc * 32 + 8 * fq;
#pragma unroll
        for (int ai = 0; ai < 2; ++ai)
#pragma unroll
            for (int m = 0; m < 4; ++m) {
                const size_t row = (size_t)(row0 + ai * 128 + m * 16);
                float o[8];
#pragma unroll
                for (int n = 0; n < 2; ++n)
#pragma unroll
                    for (int j = 0; j < 4; j += 2) {
                        const f32x2 g2 = (f32x2){acc[ai][0][m][n][j], acc[ai][0][m][n][j + 1]}, u2 = (f32x2){acc[ai][1][m][n][j], acc[ai][1][m][n][j + 1]};
                        const f32x2 tt = g2 * (-1.4426950408889634f);
                        f32x2 ee; ee.x = __builtin_amdgcn_exp2f(tt.x); ee.y = __builtin_amdgcn_exp2f(tt.y);
                        const f32x2 dd = ee + 1.0f;
                        f32x2 rr; rr.x = __builtin_amdgcn_rcpf(dd.x); rr.y = __builtin_amdgcn_rcpf(dd.y);
                        const f32x2 hh = (g2 * u2) * rr;
                        o[4 * n + j] = hh.x; o[4 * n + j + 1] = hh.y; }
                u32x2 w; w.x = pk4_fp8(o[0], o[1], o[2], o[3]); w.y = pk4_fp8(o[4], o[5], o[6], o[7]);
                *(u32x2*)(H + ((size_t)u.pm * 22 + t) * 32768 + (size_t)(row - (size_t)u.pm * 256) * 128 + (col - 128 * t)) = w;
            }
    }
};
struct EpiExpDown {
    static constexpr bool PERM = true;
    unsigned char* Y; const float* gateE;
    __device__ __forceinline__ void operator()(const f32x4 (&acc)[2][2][4][2], const pg8::Unit& u, int wr, int wc, int fr, int fq) const {
        const int e = u.pm >> 4, c4 = u.pn - e * 4;
        const int row0 = u.pm * 256 + wr * 64 + fr, col0 = 256 * c4 + wc * 32 + 8 * fq;
#pragma unroll
        for (int ai = 0; ai < 2; ++ai)
#pragma unroll
            for (int m = 0; m < 4; ++m) {
                const size_t row = (size_t)(row0 + ai * 128 + m * 16);
                const float g = gateE[row] * 32.0f;
#pragma unroll
                for (int bj = 0; bj < 2; ++bj) {
                    const f32x4 v0 = acc[ai][bj][m][0] * g, v1 = acc[ai][bj][m][1] * g;
                    u32x2 w; w.x = pk4_fp8(v0[0], v0[1], v0[2], v0[3]); w.y = pk4_fp8(v1[0], v1[1], v1[2], v1[3]);
                    *(u32x2*)(Y + row * D + col0 + 128 * bj) = w;
                }
            }
    }
};

__device__ __forceinline__ void wg_publish(unsigned* cnt, int tid) {
    asm volatile("s_waitcnt vmcnt(0)" ::: "memory");
    __syncthreads();
    if (tid == 0) { __builtin_amdgcn_fence(__ATOMIC_RELEASE, "agent"); asm volatile("s_waitcnt vmcnt(0)" ::: "memory");
        (void)__hip_atomic_fetch_add(cnt, 1u, __ATOMIC_RELAXED, __HIP_MEMORY_SCOPE_AGENT); }
}
__device__ __forceinline__ void wg_wait(unsigned* cnt, unsigned target, int tid) {
    if (tid == 0) { unsigned sp = 0;
        while (__hip_atomic_load(cnt, __ATOMIC_RELAXED, __HIP_MEMORY_SCOPE_AGENT) < target && ++sp < (1u << 22)) __builtin_amdgcn_s_sleep(2);
        __builtin_amdgcn_fence(__ATOMIC_ACQUIRE, "agent"); asm volatile("s_waitcnt vmcnt(0)" ::: "memory"); }
    __syncthreads();
}

__device__ __forceinline__ void transpose_item(const float* W, int K, int N, bf16_t* WT, int k0, int n0, size_t drow0, LAS float* scr, int lane) {
    float tv[32];
#pragma unroll
    for (int i = 0; i < 32; ++i) { const int kk = 2 * i + (lane >> 5); tv[i] = __builtin_nontemporal_load(W + (size_t)(k0 + kk) * N + n0 + (lane & 31)); }
#pragma unroll
    for (int i = 0; i < 32; ++i) { const int kk = 2 * i + (lane >> 5); scr[kk * 33 + (lane & 31)] = tv[i]; }
    asm volatile("s_waitcnt lgkmcnt(0)" ::: "memory");
    const int c = lane & 7;
#pragma unroll
    for (int j = 0; j < 4; ++j) { const int n = (lane >> 3) + 8 * j; const LAS float* s = scr + (8 * c) * 33 + n;
        u32x4 o; o.x = pk2(s[0 * 33], s[1 * 33]); o.y = pk2(s[2 * 33], s[3 * 33]); o.z = pk2(s[4 * 33], s[5 * 33]); o.w = pk2(s[6 * 33], s[7 * 33]);
        *(u32x4*)(WT + (drow0 + n) * (size_t)K + k0 + 8 * c) = o; }
    asm volatile("s_waitcnt lgkmcnt(0)" ::: "memory");
}

__device__ __forceinline__ void transpose_item8(const float* W, int K, int N, unsigned char* WT, int k0, int n0, size_t drow0, float scale, LAS float* scr, int lane) {
    float tv[32];
#pragma unroll
    for (int i = 0; i < 32; ++i) { const int kk = 2 * i + (lane >> 5); tv[i] = __builtin_nontemporal_load(W + (size_t)(k0 + kk) * N + n0 + (lane & 31)); }
#pragma unroll
    for (int i = 0; i < 32; ++i) { const int kk = 2 * i + (lane >> 5); scr[kk * 33 + (lane & 31)] = tv[i] * scale; }
    asm volatile("s_waitcnt lgkmcnt(0)" ::: "memory");
    const int c = lane & 7;
#pragma unroll
    for (int j = 0; j < 4; ++j) { const int n = (lane >> 3) + 8 * j; const LAS float* s = scr + (8 * c) * 33 + n;
        u32x2 o; o.x = pk4_fp8(s[0 * 33], s[1 * 33], s[2 * 33], s[3 * 33]); o.y = pk4_fp8(s[4 * 33], s[5 * 33], s[6 * 33], s[7 * 33]);
        *(u32x2*)(WT + (drow0 + n) * (size_t)K + k0 + 8 * c) = o; }
    asm volatile("s_waitcnt lgkmcnt(0)" ::: "memory");
}

__device__ __forceinline__ void transpose_item8b(const float* W, int N, unsigned char* WTblk, int k0, int n0, int drow0, int kc0, float scale, LAS float* scr, int lane) {
    float tv[32];
#pragma unroll
    for (int i = 0; i < 32; ++i) { const int kk = 2 * i + (lane >> 5); tv[i] = __builtin_nontemporal_load(W + (size_t)(k0 + kk) * N + n0 + (lane & 31)); }
#pragma unroll
    for (int i = 0; i < 32; ++i) { const int kk = 2 * i + (lane >> 5); scr[kk * 33 + (lane & 31)] = tv[i] * scale; }
    asm volatile("s_waitcnt lgkmcnt(0)" ::: "memory");
    const int c = lane & 7;
#pragma unroll
    for (int j = 0; j < 4; ++j) { const int n = (lane >> 3) + 8 * j; const LAS float* s = scr + (8 * c) * 33 + n;
        u32x2 o; o.x = pk4_fp8(s[0 * 33], s[1 * 33], s[2 * 33], s[3 * 33]); o.y = pk4_fp8(s[4 * 33], s[5 * 33], s[6 * 33], s[7 * 33]);
        *(u32x2*)(WTblk + (size_t)(drow0 + n) * 128 + kc0 + 8 * c) = o; }
    asm volatile("s_waitcnt lgkmcnt(0)" ::: "memory");
}

#ifndef PROBE_MASK
#define PROBE_MASK 0
#endif
struct Args { const float* in[28]; float* out; unsigned char* ws; int ph_lo, ph_hi, dbg, pad; };

__device__ __forceinline__ void convert_items(LAS unsigned char* lds, const Args& a, const int kind, const int TID, const int BID, const int GD) {
    const int lane = TID & 63, wave = TID >> 6;
    unsigned char* ws = a.ws;
    LAS float* scr = (LAS float*)(lds + wave * 8704);
    const int gw = BID * NWAVES + wave, NGW = GD * NWAVES;
    const float* w_in = a.in[8]; const float* w_out = a.in[21]; const float* wg = a.in[24]; const float* wu = a.in[25]; const float* wd = a.in[26];
    bf16_t* WinT = (bf16_t*)(ws + WS_WINT); bf16_t* WoutT = (bf16_t*)(ws + WS_WOUTT); unsigned char* WguT = ws + WS_WGUT; unsigned char* WdT = ws + WS_WDT;
    constexpr int I_IN = 16 * 64, I_OUT = 16 * 32, I_GE = 16 * 88, I_G = 16 * I_GE, I_DE = 44 * 32, I_D = 16 * I_DE;
    const int nitems = kind == 0 ? (I_IN + I_OUT) : (kind == 1 ? 2 * I_G : I_D);
    for (int it = gw; it < nitems; it += NGW) {
        int r = it;
        if (kind == 0) {
            if (r < I_IN) { const int kb = r / 64, nb = r % 64, n0 = 32 * nb;
                int drow; if (n0 < 512) drow = (n0 >> 7) * 256 + (n0 & 127); else if (n0 < 1024) drow = ((n0 - 512) >> 7) * 256 + 128 + ((n0 - 512) & 127); else drow = n0;
                transpose_item(w_in, 1024, 2048, WinT, 64 * kb, n0, (size_t)drow, scr, lane); continue; }
            r -= I_IN;
            { const int kb = r / 32, nb = r % 32; transpose_item(w_out, 1024, 1024, WoutT, 64 * kb, 32 * nb, (size_t)(32 * nb), scr, lane); }
        } else if (kind == 1) {
            const int up = r >= I_G; if (up) r -= I_G; const int e = r / I_GE, q = r % I_GE, kb = q / 88, nb = q % 88, n0 = 32 * nb;
            const size_t drow = (size_t)e * 5632 + (size_t)(n0 >> 7) * 256 + (up ? 128 : 0) + (n0 & 127);
            transpose_item8((up ? wu : wg) + (size_t)e * 1024 * DE, 1024, DE, WguT, 64 * kb, n0, drow, 32.0f, scr, lane);
        } else {
            const int e = r / I_DE, q = r % I_DE, kb = q / 32, nb = q % 32;
            const int n0 = 32 * nb, k0 = 64 * kb;
            transpose_item8b(wd + (size_t)e * DE * 1024, 1024, WdT + ((size_t)((e * 4 + (n0 >> 8)) * 22 + (k0 >> 7))) * 32768, k0, n0, n0 & 255, k0 & 127, 64.0f, scr, lane);
        }
    }
}

__device__ __forceinline__ void phase0(LAS unsigned char* lds, const Args& a, const int TID, const int BID, const int GD) {
    const int tid = TID, lane = tid & 63, wave = tid >> 6, G = GD;
    unsigned char* ws = a.ws;
    __syncthreads();
    {
        const float* c = a.in[1]; const float* cctx = a.in[3]; const float* ada_w = a.in[6]; const float* ada_b = a.in[7];
        float* mod = (float*)(ws + WS_MOD); float* modc = mod + 4 * 6144;
        LAS float* sc = (LAS float*)lds;
        LAS float* red = (LAS float*)(lds + 20480);
        for (int grp = BID; grp < 96; grp += G) {
            for (int i = tid; i < 5 * 1024; i += NTHREADS) { const float v = (i < 4096) ? c[i] : cctx[i - 4096]; sc[i] = silu_f(v); }
            __syncthreads();
            const int col = grp * 64 + lane;
            float acc[5] = {0.f, 0.f, 0.f, 0.f, 0.f};
            const int k0 = wave * 128;
#pragma unroll 8
            for (int k = k0; k < k0 + 128; ++k) { const float w = ada_w[(size_t)k * 6144 + col];
#pragma unroll
                for (int v = 0; v < 5; ++v) acc[v] += sc[v * 1024 + k] * w; }
#pragma unroll
            for (int v = 0; v < 5; ++v) red[(wave * 5 + v) * 64 + lane] = acc[v];
            __syncthreads();
            if (tid < 320) { const int v = tid >> 6, l = tid & 63; float s = 0.f;
#pragma unroll
                for (int w = 0; w < 8; ++w) s += red[(w * 5 + v) * 64 + l];
                const int cc = grp * 64 + l; s += ada_b[cc];
                if (v < 4) mod[v * 6144 + cc] = s; else if (cc < 2048) modc[cc] = s; }
            wg_publish((unsigned*)(ws + WS_ADACNT), tid);
            __syncthreads();
        }
    }
    convert_items(lds, a, 0, TID, BID, GD);
}

__device__ __forceinline__ void phase1(const Args& a, const int TID, const int BID, const int GD) {
    const int lane = TID & 63, wave = TID >> 6, G = GD;
    const float* x = a.in[0]; const float* ctx = a.in[2]; const float* g1 = a.in[4];
    const float* mod = (const float*)(a.ws + WS_MOD); const float* modc = mod + 4 * 6144;
    bf16_t* U = (bf16_t*)(a.ws + WS_U);
    f32x4 gg[4];
#pragma unroll
    for (int i = 0; i < 4; ++i) gg[i] = *(const f32x4*)(g1 + 4 * (lane + 64 * i));
    for (int row = BID * NWAVES + wave; row < NROWS; row += G * NWAVES) {
        const float* xr; const float* sh; const float* scl;
        if (row < NTOK) { xr = x + (size_t)row * D; const int b = row >> 13; sh = mod + b * 6144; scl = sh + 1024; }
        else { xr = ctx + (size_t)(row - NTOK) * D; sh = modc; scl = modc + 1024; }
        f32x4 v[4]; float ss = 0.f;
#pragma unroll
        for (int i = 0; i < 4; ++i) { v[i] = *(const f32x4*)(xr + 4 * (lane + 64 * i)); ss += v[i].x * v[i].x + v[i].y * v[i].y + v[i].z * v[i].z + v[i].w * v[i].w; }
        ss = wave_sum(ss);
        const float r = rsqrtf(ss * (1.0f / D) + 1e-6f);
#pragma unroll
        for (int i = 0; i < 4; ++i) {
            const f32x4 s1 = *(const f32x4*)(sh + 4 * (lane + 64 * i)), c1 = *(const f32x4*)(scl + 4 * (lane + 64 * i));
            const f32x4 o = (v[i] * r) * gg[i] * (c1 + 1.0f) + s1;
            u32x2 w; w.x = pk2(o.x, o.y); w.y = pk2(o.z, o.w);
            *(u32x2*)(U + (size_t)row * D + 4 * (lane + 64 * i)) = w;
        }
    }
}

__device__ __forceinline__ void conv_units(LAS unsigned char* lds, const Args& a, int ubeg, int ustride, const int TID, const int BID, const int GD) {
    const int tid = TID, lane = tid & 63, wave = tid >> 6;
    const float* cw = a.in[10]; const float* cb = a.in[11]; const float* lg = a.in[12]; const float* lb = a.in[13];
    const bf16_t* xglu = (const bf16_t*)(a.ws + WS_XGLU); bf16_t* mix = (bf16_t*)(a.ws + WS_MIX);
    LAS float* wts = (LAS float*)lds;
    for (int i = tid; i < 31 * 512; i += NTHREADS) { const int k = i >> 9, ch = i & 511; wts[((k * 2 + ((ch >> 2) & 1)) * 64 + (ch >> 3)) * 4 + (ch & 3)] = cw[i]; }
    __syncthreads();
    const int ch0 = 8 * lane;
    float bias[8], lng[8], lnb[8];
#pragma unroll
    for (int j = 0; j < 8; ++j) { bias[j] = cb[ch0 + j]; lng[j] = lg[ch0 + j]; lnb[j] = lb[ch0 + j]; }
    const bool rowc = lane < 32;
    for (int unit = ubeg; unit < NB * 128; unit += ustride) {
        const int b = unit >> 7, r = unit & 127;
        const bf16_t* xb = xglu + (size_t)b * SEQ * 512;
#pragma unroll 1
        for (int p = 0; p < 4; ++p) {
            const int c = p * 16 + 2 * wave;
            float acc[2][8];
#pragma unroll
            for (int j = 0; j < 8; ++j) { acc[0][j] = bias[j]; acc[1][j] = bias[j]; }
#pragma unroll 1
            for (int kb = 0; kb < 31; kb += 16) {
                u32x4 xv[2][16];
#pragma unroll
                for (int kk = 0; kk < 16; ++kk) { const int k = kb + kk;
#pragma unroll
                    for (int tt = 0; tt < 2; ++tt) { xv[tt][kk] = (u32x4){0u, 0u, 0u, 0u};
                        if (k < 31) { int tok; bool valid;
                            if (rowc) { const int cc = c + tt + k - 15; valid = (cc >= 0) && (cc < 64); tok = r * 64 + cc; }
                            else { const int rr = r + k - 15; valid = (rr >= 0) && (rr < 128); tok = rr * 64 + c + tt; }
                            if (valid) xv[tt][kk] = *(const u32x4*)(xb + (size_t)tok * 512 + ch0); } } }
#pragma unroll
                for (int kk = 0; kk < 16; ++kk) { const int k = kb + kk;
                    if (k < 31) {
                        const f32x4 w0 = *(const LAS f32x4*)(wts + ((k * 2 + 0) * 64 + lane) * 4), w1 = *(const LAS f32x4*)(wts + ((k * 2 + 1) * 64 + lane) * 4);
#pragma unroll
                        for (int tt = 0; tt < 2; ++tt) { const u32x4 x4 = xv[tt][kk];
                            fma_mix_lo(acc[tt][0], w0.x, x4.x); fma_mix_hi(acc[tt][1], w0.y, x4.x); fma_mix_lo(acc[tt][2], w0.z, x4.y); fma_mix_hi(acc[tt][3], w0.w, x4.y);
                            fma_mix_lo(acc[tt][4], w1.x, x4.z); fma_mix_hi(acc[tt][5], w1.y, x4.z); fma_mix_lo(acc[tt][6], w1.z, x4.w); fma_mix_hi(acc[tt][7], w1.w, x4.w); } } }
            }
#pragma unroll
            for (int tt = 0; tt < 2; ++tt) {
                float s = 0.f;
#pragma unroll
                for (int j = 0; j < 8; ++j) s += acc[tt][j];
                const float mean = wave_sum(s) * (1.0f / 512.0f);
                float q = 0.f;
#pragma unroll
                for (int j = 0; j < 8; ++j) { acc[tt][j] -= mean; q += acc[tt][j] * acc[tt][j]; }
                const float rstd = rsqrtf(wave_sum(q) * (1.0f / 512.0f) + 1e-5f);
                float o[8];
#pragma unroll
                for (int j = 0; j < 8; ++j) { const float y = acc[tt][j] * rstd * lng[j] + lnb[j]; o[j] = silu_f(y); }
                u32x4 w; w.x = pk2(o[0], o[1]); w.y = pk2(o[2], o[3]); w.z = pk2(o[4], o[5]); w.w = pk2(o[6], o[7]);
                *(u32x4*)(mix + (size_t)(b * SEQ + r * 64 + c + tt) * D + ch0) = w;
            }
        }
    }
    __syncthreads();
}

constexpr int L_XT = 0;
constexpr int L_XC = 9216;
constexpr int L_A = L_XC + 2 * 17408;
constexpr int L_U = L_A + 2 * 16384;
constexpr int L_SUB = L_U + 2 * 16384;
constexpr int L_PRE = L_SUB + 8192;
constexpr int L_CIN = L_PRE + 4096;
static_assert(L_CIN + 2 * 17 * 64 * 4 <= 131072, "lru lds");

__device__ __forceinline__ int lru_seq(int d, int i) { return d == 0 ? i : (i < 4 ? 3 - i : NQ - 1 - (i - 4)); }
__device__ __forceinline__ u32x4 lru_load_xt(const bf16_t* xlx, int b, int h, int q, int i) {
    int rowbase, L, chunk;
    if (q < 4) { rowbase = NTOK + b * CTXL; L = CTXL; chunk = q; } else { rowbase = b * SEQ; L = SEQ; chunk = q - 4; }
    const int rr = i >> 3, seg = i & 7, t = chunk * 64 - 3 + rr;
    u32x4 v = (u32x4){0u, 0u, 0u, 0u};
    if (t >= 0 && t < L) v = *(const u32x4*)(xlx + (size_t)(rowbase + t) * 512 + 64 * h + 8 * seg);
    return v;
}
template <int MODE>
__device__ __forceinline__ void lru_phase(LAS unsigned char* lds, const Args& a, const int TID, const int BID, const int GD) {
    const int tid = TID, lane = tid & 63, wave = tid >> 6;
    const float* wa = a.in[16]; const float* wi = a.in[18];
    const bf16_t* xlx = (const bf16_t*)(a.ws + WS_XLX); const bf16_t* glg = (const bf16_t*)(a.ws + WS_GLG); bf16_t* mix = (bf16_t*)(a.ws + WS_MIX);
    f32x2* carry = (f32x2*)(a.ws + WS_CARRY); unsigned* au = (unsigned*)(a.ws + WS_AU);
    const float* conv_w = a.in[14]; const float* conv_b = a.in[15]; const float* ba = a.in[17]; const float* bi = a.in[19]; const float* lam = a.in[20];
    LAS bf16_t* XT = (LAS bf16_t*)(lds + L_XT); LAS float* XC = (LAS float*)(lds + L_XC); LAS float* Aa = (LAS float*)(lds + L_A); LAS float* Uu = (LAS float*)(lds + L_U);
    LAS f32x2* SUB = (LAS f32x2*)(lds + L_SUB); LAS float* PRE = (LAS float*)(lds + L_PRE); LAS float* CIN = (LAS float*)(lds + L_CIN);
    const int l15 = lane & 15, l4 = lane >> 4;
    for (int vb = BID; vb < 256; vb += GD) {
        const int bh = vb >> 3, grp = vb & 7, b = bh >> 3, h = bh & 7;
        int q0, nq;
        if (MODE == 1) { q0 = grp * 17; nq = (NQ - q0) < 17 ? (NQ - q0) : 17; } else { q0 = 4 + grp * 16; nq = 16; }
        const int wd = wave >> 2, mtp = (wave >> 1) & 1, ntp = wave & 1;
        bf16x8 wf[2][2][2];
#pragma unroll
        for (int nn = 0; nn < 2; ++nn)
#pragma unroll
            for (int g = 0; g < 2; ++g)
#pragma unroll
                for (int ks = 0; ks < 2; ++ks) { const float* wp = (g ? wi : wa) + (size_t)((wd * 8 + h) * 64 + 32 * ks + 8 * l4) * 64 + 16 * (ntp * 2 + nn) + l15;
                    u32x4 w; w.x = pk2(wp[0], wp[64]); w.y = pk2(wp[128], wp[192]); w.z = pk2(wp[256], wp[320]); w.w = pk2(wp[384], wp[448]); wf[nn][g][ks] = __builtin_bit_cast(bf16x8, w); }
        float cw[2][4], cbv[2];
        { const int gc = 64 * h + (tid & 63);
#pragma unroll
            for (int d = 0; d < 2; ++d) { cbv[d] = conv_b[d * 512 + gc];
#pragma unroll
                for (int k = 0; k < 4; ++k) cw[d][k] = conv_w[(d * 4 + k) * 512 + gc]; } }
        float bav[2], biv[2], spv[2];
#pragma unroll
        for (int nn = 0; nn < 2; ++nn) { const int gc = 64 * h + 16 * (ntp * 2 + nn) + l15;
            bav[nn] = ba[wd * 512 + gc]; biv[nn] = bi[wd * 512 + gc]; spv[nn] = log1pf(__expf(-lam[wd * 512 + gc])); }
        if (MODE == 2 && tid < 128) {
            const int d = tid >> 6, ch = tid & 63;
            const f32x2* cp = carry + (size_t)((d * NB + b) * NQ) * 512 + 64 * h + ch;
            const int cnt = d == 0 ? q0 : (NQ + 4 - (q0 + nq));
            float s = 0.f;
            for (int i0 = 0; i0 < cnt; i0 += 8) {
                f32x2 c[8];
#pragma unroll
                for (int j = 0; j < 8; ++j) { const int ii = (i0 + j) < cnt ? (i0 + j) : (cnt - 1); c[j] = cp[(size_t)lru_seq(d, ii) * 512]; }
#pragma unroll
                for (int j = 0; j < 8; ++j) if (i0 + j < cnt) s = c[j].x * s + c[j].y;
            }
            f32x2 c[16];
#pragma unroll
            for (int j = 0; j < 16; ++j) c[j] = cp[(size_t)(q0 + j) * 512];
            if (d == 0) {
#pragma unroll
                for (int j = 0; j < 16; ++j) { CIN[(0 * 17 + j) * 64 + ch] = s; s = c[j].x * s + c[j].y; }
            } else {
#pragma unroll
                for (int j = 15; j >= 0; --j) { CIN[(1 * 17 + j) * 64 + ch] = s; s = c[j].x * s + c[j].y; }
            }
        }
        if (MODE == 1 && q0 < 4) {
            if (tid == 0) { unsigned* fl = (unsigned*)(a.ws + WS_CTXFLAG) + 64 * (b * 2 + (h >> 2)); unsigned sp = 0;
                while (__hip_atomic_load(fl, __ATOMIC_RELAXED, __HIP_MEMORY_SCOPE_AGENT) == 0u && ++sp < (1u << 22)) __builtin_amdgcn_s_sleep(2);
                __builtin_amdgcn_fence(__ATOMIC_ACQUIRE, "agent"); asm volatile("s_waitcnt vmcnt(0)" ::: "memory"); }
            __syncthreads();
        }
        u32x4 xr0 = lru_load_xt(xlx, b, h, q0, tid), xr1 = (u32x4){0u, 0u, 0u, 0u};
        if (tid < 48) xr1 = lru_load_xt(xlx, b, h, q0, tid + 512);
#pragma unroll 1
        for (int jc = 0; jc < nq; ++jc) {
            const int q = q0 + jc;
            const size_t rowbase0 = (q < 4) ? (size_t)(NTOK + b * CTXL + q * 64) : (size_t)(b * SEQ + (q - 4) * 64);
            *(LAS u32x4*)(XT + tid * 8) = xr0;
            if (tid < 48) *(LAS u32x4*)(XT + (tid + 512) * 8) = xr1;
            __syncthreads();
            if (jc + 1 < nq) { xr0 = lru_load_xt(xlx, b, h, q + 1, tid); if (tid < 48) xr1 = lru_load_xt(xlx, b, h, q + 1, tid + 512); }
            u32x4 gl = (u32x4){0u, 0u, 0u, 0u};
            if (MODE == 2) gl = *(const u32x4*)(glg + (rowbase0 + (tid >> 3)) * 512 + 64 * h + (tid & 7) * 8);
            { const int ch = tid & 63, tb = tid >> 6;
#pragma unroll
                for (int i = 0; i < 8; ++i) { const int t = tb + 8 * i;
                    const float x0 = bf_lo(XT[(t + 0) * 64 + ch]), x1 = bf_lo(XT[(t + 1) * 64 + ch]), x2 = bf_lo(XT[(t + 2) * 64 + ch]), x3 = bf_lo(XT[(t + 3) * 64 + ch]), x4 = bf_lo(XT[(t + 4) * 64 + ch]), x5 = bf_lo(XT[(t + 5) * 64 + ch]), x6 = bf_lo(XT[(t + 6) * 64 + ch]);
                    XC[t * 68 + ch] = cbv[0] + cw[0][0] * x0 + cw[0][1] * x1 + cw[0][2] * x2 + cw[0][3] * x3;
                    XC[64 * 68 + t * 68 + ch] = cbv[1] + cw[1][3] * x3 + cw[1][2] * x4 + cw[1][1] * x5 + cw[1][0] * x6; } }
            __syncthreads();
#pragma unroll
            for (int mm = 0; mm < 2; ++mm) {
                const int mtl = 2 * mtp + mm;
                bf16x8 af[2];
#pragma unroll
                for (int ks = 0; ks < 2; ++ks) { const LAS float* p = XC + wd * (64 * 68) + (16 * mtl + l15) * 68 + 32 * ks + 8 * l4; const f32x4 p0 = *(const LAS f32x4*)p, p1 = *(const LAS f32x4*)(p + 4);
                    u32x4 w; w.x = pk2(p0.x, p0.y); w.y = pk2(p0.z, p0.w); w.z = pk2(p1.x, p1.y); w.w = pk2(p1.z, p1.w); af[ks] = __builtin_bit_cast(bf16x8, w); }
#pragma unroll
                for (int nn = 0; nn < 2; ++nn) { const int n = 16 * (ntp * 2 + nn) + l15;
                    f32x4 accR = (f32x4){0.f, 0.f, 0.f, 0.f}, accI = (f32x4){0.f, 0.f, 0.f, 0.f};
#pragma unroll
                    for (int ks = 0; ks < 2; ++ks) {
                        accR = __builtin_amdgcn_mfma_f32_16x16x32_bf16(af[ks], wf[nn][0][ks], accR, 0, 0, 0);
                        accI = __builtin_amdgcn_mfma_f32_16x16x32_bf16(af[ks], wf[nn][1][ks], accI, 0, 0, 0);
                    }
#pragma unroll
                    for (int rg = 0; rg < 4; rg += 2) { const int t = 16 * mtl + 4 * l4 + rg;
                        const f32x2 zr = (f32x2){accR[rg], accR[rg + 1]} + bav[nn], zi = (f32x2){accI[rg], accI[rg + 1]} + biv[nn];
                        const f32x2 tr = zr * (-1.4426950408889634f), ti = zi * (-1.4426950408889634f);
                        f32x2 er, ei; er.x = __builtin_amdgcn_exp2f(tr.x); er.y = __builtin_amdgcn_exp2f(tr.y); ei.x = __builtin_amdgcn_exp2f(ti.x); ei.y = __builtin_amdgcn_exp2f(ti.y);
                        const f32x2 dr = er + 1.0f, di = ei + 1.0f;
                        f32x2 rr, ii; rr.x = __builtin_amdgcn_rcpf(dr.x); rr.y = __builtin_amdgcn_rcpf(dr.y); ii.x = __builtin_amdgcn_rcpf(di.x); ii.y = __builtin_amdgcn_rcpf(di.y);
                        const f32x2 la = rr * (-8.0f * spv[nn]);
                        f32x2 oma = -la * (1.0f + 0.5f * la * (1.0f + 0.33333334f * la * (1.0f + 0.25f * la * (1.0f + 0.2f * la))));
                        if (__any(la.x < -0.25f || la.y < -0.25f)) {
                            oma.x = la.x < -0.25f ? 1.0f - __expf(la.x) : oma.x; oma.y = la.y < -0.25f ? 1.0f - __expf(la.y) : oma.y; }
                        const f32x2 om2 = oma * (2.0f - oma);
                        f32x2 mult; mult.x = __builtin_amdgcn_sqrtf(om2.x); mult.y = __builtin_amdgcn_sqrtf(om2.y);
                        const f32x2 xc2 = (f32x2){XC[wd * (64 * 68) + t * 68 + n], XC[wd * (64 * 68) + (t + 1) * 68 + n]};
                        const f32x2 uu = mult * ii * xc2;
                        Aa[wd * 4096 + t * 64 + n] = oma.x; Aa[wd * 4096 + (t + 1) * 64 + n] = oma.y; Uu[wd * 4096 + t * 64 + n] = uu.x; Uu[wd * 4096 + (t + 1) * 64 + n] = uu.y; }
                }
            }
            __syncthreads();
            if (MODE == 1 && q >= 4) {
                const int t = tid >> 3, c8 = (tid & 7) * 8;
#pragma unroll
                for (int d = 0; d < 2; ++d) {
                    const LAS float* ap = Aa + d * 4096 + t * 64 + c8; const LAS float* up = Uu + d * 4096 + t * 64 + c8;
                    const f32x4 a0 = *(const LAS f32x4*)ap, a1 = *(const LAS f32x4*)(ap + 4), u0 = *(const LAS f32x4*)up, u1 = *(const LAS f32x4*)(up + 4);
                    u32x4 w0, w1; w0.x = pk2h(a0.x, u0.x); w0.y = pk2h(a0.y, u0.y); w0.z = pk2h(a0.z, u0.z); w0.w = pk2h(a0.w, u0.w); w1.x = pk2h(a1.x, u1.x); w1.y = pk2h(a1.y, u1.y); w1.z = pk2h(a1.z, u1.z); w1.w = pk2h(a1.w, u1.w);
                    unsigned* dst = au + ((size_t)d * NTOK + rowbase0 + t) * 512 + 64 * h + c8;
                    *(u32x4*)dst = w0; *(u32x4*)(dst + 4) = w1; }
            }
            { float A0 = 1.f, h0 = 0.f, A1 = 1.f, h1 = 0.f;
#pragma unroll
                for (int s2 = 0; s2 < 8; ++s2) { const int p = 8 * wave + s2, t0 = p, t1 = 63 - p;
                    const float a0 = 1.0f - Aa[t0 * 64 + lane], u0 = Uu[t0 * 64 + lane], a1 = 1.0f - Aa[4096 + t1 * 64 + lane], u1 = Uu[4096 + t1 * 64 + lane];
                    h0 = a0 * h0 + u0; A0 *= a0; h1 = a1 * h1 + u1; A1 *= a1; }
                SUB[wave * 64 + lane] = (f32x2){A0, h0}; SUB[512 + wave * 64 + lane] = (f32x2){A1, h1}; }
            __syncthreads();
            if (MODE == 1) {
                if (tid < 128) { const int d = tid >> 6, ch = tid & 63; float Ac = 1.f, hc = 0.f;
#pragma unroll
                    for (int s2 = 0; s2 < 8; ++s2) { const f32x2 c = SUB[d * 512 + s2 * 64 + ch]; hc = c.x * hc + c.y; Ac *= c.x; }
                    carry[(size_t)((d * NB + b) * NQ + q) * 512 + 64 * h + ch] = (f32x2){Ac, hc}; }
            } else {
                if (tid < 128) { const int d = tid >> 6, ch = tid & 63; float s2 = CIN[(d * 17 + jc) * 64 + ch];
#pragma unroll
                    for (int sb = 0; sb < 8; ++sb) { PRE[d * 512 + sb * 64 + ch] = s2; const f32x2 c = SUB[d * 512 + sb * 64 + ch]; s2 = c.x * s2 + c.y; } }
                __syncthreads();
                { float h0 = PRE[wave * 64 + lane], h1 = PRE[512 + wave * 64 + lane];
#pragma unroll
                    for (int s2 = 0; s2 < 8; ++s2) { const int p = 8 * wave + s2, t0 = p, t1 = 63 - p;
                        h0 = (1.0f - Aa[t0 * 64 + lane]) * h0 + Uu[t0 * 64 + lane]; Uu[t0 * 64 + lane] = h0;
                        h1 = (1.0f - Aa[4096 + t1 * 64 + lane]) * h1 + Uu[4096 + t1 * 64 + lane]; Uu[4096 + t1 * 64 + lane] = h1; } }
                __syncthreads();
                { const int t = tid >> 3, c8 = (tid & 7) * 8;
                    const LAS float* u1 = Uu + t * 64 + c8; const LAS float* u2 = Uu + 4096 + t * 64 + c8;
                    const f32x4 f0 = *(const LAS f32x4*)u1, f1 = *(const LAS f32x4*)(u1 + 4), b0 = *(const LAS f32x4*)u2, b1 = *(const LAS f32x4*)(u2 + 4);
                    u32x4 w;
                    w.x = pk2((f0.x + b0.x) * bf_lo(gl.x), (f0.y + b0.y) * bf_hi(gl.x)); w.y = pk2((f0.z + b0.z) * bf_lo(gl.y), (f0.w + b0.w) * bf_hi(gl.y));
                    w.z = pk2((f1.x + b1.x) * bf_lo(gl.z), (f1.y + b1.y) * bf_hi(gl.z)); w.w = pk2((f1.z + b1.z) * bf_lo(gl.w), (f1.w + b1.w) * bf_hi(gl.w));
                    *(u32x4*)(mix + (rowbase0 + t) * D + 512 + 64 * h + c8) = w; }
            }
        }
        if (MODE == 1) wg_publish((unsigned*)(a.ws + WS_BHCNT) + 64 * bh, tid);
        __syncthreads();
    }
}

__device__ __forceinline__ void lru_rescan(LAS unsigned char* lds, const Args& a, const int TID, const int BID, const int GD) {
    const int tid = TID, lane = tid & 63, wave = tid >> 6;
    const unsigned* au = (const unsigned*)(a.ws + WS_AU); const bf16_t* glg = (const bf16_t*)(a.ws + WS_GLG); bf16_t* mix = (bf16_t*)(a.ws + WS_MIX);
    const f32x2* carry = (const f32x2*)(a.ws + WS_CARRY);
    LAS f32x2* SUB = (LAS f32x2*)(lds + L_SUB); LAS float* PRE = (LAS float*)(lds + L_PRE); LAS float* CIN = (LAS float*)(lds + L_CIN);
    for (int vb = BID; vb < 256; vb += GD) {
        const int bh = vb >> 3, grp = vb & 7, b = bh >> 3, h = bh & 7;
        const int q0 = 4 + grp * 16, nq = 16;
        wg_wait((unsigned*)(a.ws + WS_BHCNT) + 64 * bh, 8u * (unsigned)(1 + ((a.dbg >> 11) & 1)), tid);
        if (tid < 128) {
            const int d = tid >> 6, ch = tid & 63;
            const f32x2* cp = carry + (size_t)((d * NB + b) * NQ) * 512 + 64 * h + ch;
            const int cnt = d == 0 ? q0 : (NQ + 4 - (q0 + nq));
            float s = 0.f;
            for (int i0 = 0; i0 < cnt; i0 += 8) {
                f32x2 c[8];
#pragma unroll
                for (int j = 0; j < 8; ++j) { const int ii = (i0 + j) < cnt ? (i0 + j) : (cnt - 1); c[j] = cp[(size_t)lru_seq(d, ii) * 512]; }
#pragma unroll
                for (int j = 0; j < 8; ++j) if (i0 + j < cnt) s = c[j].x * s + c[j].y;
            }
            f32x2 c[16];
#pragma unroll
            for (int j = 0; j < 16; ++j) c[j] = cp[(size_t)(q0 + j) * 512];
            if (d == 0) {
#pragma unroll
                for (int j = 0; j < 16; ++j) { CIN[(0 * 17 + j) * 64 + ch] = s; s = c[j].x * s + c[j].y; }
            } else {
#pragma unroll
                for (int j = 15; j >= 0; --j) { CIN[(1 * 17 + j) * 64 + ch] = s; s = c[j].x * s + c[j].y; }
            }
        }
        __syncthreads();
        const size_t cbase = (size_t)64 * h + lane;
#pragma unroll 1
        for (int jc = 0; jc < nq; ++jc) {
            const size_t row0 = (size_t)b * SEQ + (size_t)(q0 - 4 + jc) * 64 + 8 * wave;
            unsigned pf[8], pb[8]; bf16_t gg[8];
#pragma unroll
            for (int s2 = 0; s2 < 8; ++s2) { pf[s2] = au[(row0 + s2) * 512 + cbase]; pb[s2] = au[((size_t)NTOK + row0 + s2) * 512 + cbase]; gg[s2] = glg[(row0 + s2) * 512 + cbase]; }
            float af[8], uf[8], ab[8], ub[8];
#pragma unroll
            for (int s2 = 0; s2 < 8; ++s2) { const h2_t x = __builtin_bit_cast(h2_t, pf[s2]), y = __builtin_bit_cast(h2_t, pb[s2]);
                af[s2] = 1.0f - (float)x.x; uf[s2] = (float)x.y; ab[s2] = 1.0f - (float)y.x; ub[s2] = (float)y.y; }
            float A0 = 1.f, h0 = 0.f, A1 = 1.f, h1 = 0.f;
#pragma unroll
            for (int s2 = 0; s2 < 8; ++s2) { h0 = af[s2] * h0 + uf[s2]; A0 *= af[s2]; h1 = ab[7 - s2] * h1 + ub[7 - s2]; A1 *= ab[7 - s2]; }
            SUB[wave * 64 + lane] = (f32x2){A0, h0}; SUB[512 + (7 - wave) * 64 + lane] = (f32x2){A1, h1};
            __syncthreads();
            if (tid < 128) { const int d = tid >> 6, ch = tid & 63; float s2 = CIN[(d * 17 + jc) * 64 + ch];
#pragma unroll
                for (int sb = 0; sb < 8; ++sb) { PRE[d * 512 + sb * 64 + ch] = s2; const f32x2 c = SUB[d * 512 + sb * 64 + ch]; s2 = c.x * s2 + c.y; } }
            __syncthreads();
            float hf[8], hb[8];
            { float hc = PRE[wave * 64 + lane];
#pragma unroll
                for (int s2 = 0; s2 < 8; ++s2) { hc = af[s2] * hc + uf[s2]; hf[s2] = hc; }
                hc = PRE[512 + (7 - wave) * 64 + lane];
#pragma unroll
                for (int s2 = 7; s2 >= 0; --s2) { hc = ab[s2] * hc + ub[s2]; hb[s2] = hc; } }
#pragma unroll
            for (int s2 = 0; s2 < 8; ++s2) mix[(row0 + s2) * D + 512 + cbase] = (bf16_t)f2bf((hf[s2] + hb[s2]) * bf_lo(gg[s2]));
        }
        __syncthreads();
    }
}

__device__ __forceinline__ void phase6(LAS unsigned char* lds, const Args& a, const int TID, const int BID, const int GD) {
    const int tid = TID, lane = tid & 63, wave = tid >> 6, G = GD;
    const float* x = a.in[0]; const bf16_t* Mb = (const bf16_t*)(a.ws + WS_M); const float* g2 = a.in[5]; const float* rw = a.in[23];
    const float* mod = (const float*)(a.ws + WS_MOD);
    unsigned char* V = a.ws + WS_V; float* affT = (float*)(a.ws + WS_AFFT); bf16_t* X1b = (bf16_t*)(a.ws + WS_X1B);
    LAS float* rwT = (LAS float*)lds;
    for (int idx = tid; idx < 16384; idx += NTHREADS) rwT[(idx & 15) * 1024 + (idx >> 4)] = rw[idx];
    __syncthreads();
    f32x4 gg[4];
#pragma unroll
    for (int i = 0; i < 4; ++i) gg[i] = *(const f32x4*)(g2 + 4 * (lane + 64 * i));
    for (int row = BID * NWAVES + wave; row < NTOK; row += G * NWAVES) {
        const int b = row >> 13, t = row & (SEQ - 1);
        const float* sh = mod + b * 6144 + 3072; const float* scl = mod + b * 6144 + 4096;
        f32x4 v[4]; float ss = 0.f;
#pragma unroll
        for (int i = 0; i < 4; ++i) { v[i] = *(const f32x4*)(x + (size_t)row * D + 4 * (lane + 64 * i)); const u32x2 mw = *(const u32x2*)(Mb + (size_t)row * D + 4 * (lane + 64 * i));
            v[i].x += bf_lo(mw.x); v[i].y += bf_hi(mw.x); v[i].z += bf_lo(mw.y); v[i].w += bf_hi(mw.y);
            { u32x2 xw; xw.x = pk2(v[i].x, v[i].y); xw.y = pk2(v[i].z, v[i].w); *(u32x2*)(X1b + (size_t)row * D + 4 * (lane + 64 * i)) = xw; }
            ss += v[i].x * v[i].x + v[i].y * v[i].y + v[i].z * v[i].z + v[i].w * v[i].w; }
        ss = wave_sum(ss);
        const float r = rsqrtf(ss * (1.0f / D) + 1e-6f);
#pragma unroll
        for (int i = 0; i < 4; ++i) {
            const f32x4 s1 = *(const f32x4*)(sh + 4 * (lane + 64 * i)), c1 = *(const f32x4*)(scl + 4 * (lane + 64 * i));
            v[i] = (v[i] * r) * gg[i] * (c1 + 1.0f) + s1;
            *(unsigned*)(V + (size_t)row * D + 4 * (lane + 64 * i)) = pk4_fp8(v[i].x, v[i].y, v[i].z, v[i].w);
        }
        float p[16];
#pragma unroll
        for (int e = 0; e < 16; ++e) p[e] = 0.f;
#pragma unroll
        for (int i = 0; i < 4; ++i) {
#pragma unroll
            for (int e = 0; e < 16; ++e) { const f32x4 w = *(const LAS f32x4*)(rwT + e * 1024 + 4 * (lane + 64 * i)); p[e] += v[i].x * w.x + v[i].y * w.y + v[i].z * w.z + v[i].w * w.w; }
            asm volatile("" ::: "memory");
        }
        const bool b5 = (lane & 32) != 0, b4 = (lane & 16) != 0, b3 = (lane & 8) != 0, b2 = (lane & 4) != 0;
        float q8[8], q4[4], q2[2];
#pragma unroll
        for (int j = 0; j < 8; ++j) { const float send = b5 ? p[j] : p[j + 8], keep = b5 ? p[j + 8] : p[j]; q8[j] = keep + __shfl_xor(send, 32); }
#pragma unroll
        for (int j = 0; j < 4; ++j) { const float send = b4 ? q8[j] : q8[j + 4], keep = b4 ? q8[j + 4] : q8[j]; q4[j] = keep + __shfl_xor(send, 16); }
#pragma unroll
        for (int j = 0; j < 2; ++j) { const float send = b3 ? q4[j] : q4[j + 2], keep = b3 ? q4[j + 2] : q4[j]; q2[j] = keep + __shfl_xor(send, 8); }
        float lgt = (b2 ? q2[1] : q2[0]) + __shfl_xor(b2 ? q2[0] : q2[1], 4);
        lgt += __shfl_xor(lgt, 2); lgt += __shfl_xor(lgt, 1);
        float mx = lgt;
        mx = fmaxf(mx, __shfl_xor(mx, 4)); mx = fmaxf(mx, __shfl_xor(mx, 8)); mx = fmaxf(mx, __shfl_xor(mx, 16)); mx = fmaxf(mx, __shfl_xor(mx, 32));
        const float ex = __expf(lgt - mx);
        float den = ex;
        den += __shfl_xor(den, 4); den += __shfl_xor(den, 8); den += __shfl_xor(den, 16); den += __shfl_xor(den, 32);
        if ((lane & 3) == 0) affT[(size_t)(b * 16 + ((lane >> 2) & 15)) * SEQ + t] = ex / den;
    }
    __syncthreads();
}

__device__ __forceinline__ int block_excl_scan(int v, LAS int* wsum, int tid, int& total) {
    const int lane = tid & 63, wave = tid >> 6;
    int inc = v;
#pragma unroll
    for (int o = 1; o < 64; o <<= 1) { const int t = __shfl_up(inc, o); if (lane >= o) inc += t; }
    __syncthreads();
    if (lane == 63) wsum[wave] = inc;
    __syncthreads();
    int base = 0, tot = 0;
#pragma unroll
    for (int w = 0; w < 8; ++w) { const int s = wsum[w]; if (w < wave) base += s; tot += s; }
    total = tot;
    return base + inc - v;
}
__device__ __forceinline__ void phase7(LAS unsigned char* lds, const Args& a, const int TID, const int BID, const int GD) {
    const int tid = TID, lane = tid & 63, wave = tid >> 6, G = GD;
    const float* affT = (const float*)(a.ws + WS_AFFT);
    int* idxE = (int*)(a.ws + WS_IDXE); float* gateE = (float*)(a.ws + WS_GATEE); int* inv = (int*)(a.ws + WS_INV);
    LAS unsigned* hist = (LAS unsigned*)lds;
    LAS unsigned* selw = hist + 256;
    LAS int* wsum = (LAS int*)(hist + 264);
    for (int unit = BID; unit < NB * NE; unit += G) {
        const int b = unit >> 4, e = unit & 15;
        const float* src = affT + (size_t)unit * SEQ + 16 * tid;
        unsigned key[16];
#pragma unroll
        for (int i = 0; i < 4; ++i) { const f32x4 v = *(const f32x4*)(src + 4 * i); const float f0 = v[0], f1 = v[1], f2 = v[2], f3 = v[3]; key[4 * i + 0] = __float_as_uint(f0); key[4 * i + 1] = __float_as_uint(f1); key[4 * i + 2] = __float_as_uint(f2); key[4 * i + 3] = __float_as_uint(f3); }
        unsigned prefix = 0u, mask = 0u, rem = CAP;
#pragma unroll 1
        for (int pass = 0; pass < 4; ++pass) {
            const int shift = 24 - 8 * pass;
            if (tid < 256) hist[tid] = 0u;
            __syncthreads();
#pragma unroll
            for (int j = 0; j < 16; ++j) if ((key[j] & mask) == prefix) __hip_atomic_fetch_add(&hist[(key[j] >> shift) & 255u], 1u, __ATOMIC_RELAXED, __HIP_MEMORY_SCOPE_WORKGROUP);
            __syncthreads();
            if (wave == 0) {
                const unsigned c0 = hist[4 * lane], c1 = hist[4 * lane + 1], c2 = hist[4 * lane + 2], c3 = hist[4 * lane + 3];
                const unsigned s = c0 + c1 + c2 + c3; unsigned v = s;
#pragma unroll
                for (int o = 1; o < 64; o <<= 1) { const unsigned t = __shfl_down(v, o); if (lane + o < 64) v += t; }
                const unsigned above = v - s;
                if (above < rem && rem <= above + s) {
                    unsigned cum = above, bin, nr;
                    if (cum + c3 >= rem) { bin = 4 * lane + 3; nr = rem - cum; }
                    else { cum += c3; if (cum + c2 >= rem) { bin = 4 * lane + 2; nr = rem - cum; }
                        else { cum += c2; if (cum + c1 >= rem) { bin = 4 * lane + 1; nr = rem - cum; } else { cum += c1; bin = 4 * lane; nr = rem - cum; } } }
                    selw[0] = bin; selw[1] = nr;
                }
            }
            __syncthreads();
            prefix |= selw[0] << shift; mask |= 255u << shift; rem = selw[1];
            __syncthreads();
        }
        const unsigned thr = prefix;
        int ceq = 0;
#pragma unroll
        for (int j = 0; j < 16; ++j) ceq += (key[j] == thr) ? 1 : 0;
        int tot; const int eqbase = block_excl_scan(ceq, wsum, tid, tot);
        unsigned selm = 0u; int er = eqbase, cs = 0;
#pragma unroll
        for (int j = 0; j < 16; ++j) { bool s = key[j] > thr; if (key[j] == thr) { s = (unsigned)er < rem; ++er; } if (s) { selm |= 1u << j; ++cs; } }
        int slot = block_excl_scan(cs, wsum, tid, tot);
#pragma unroll
        for (int j = 0; j < 16; ++j) { const int t = 16 * tid + j; const bool s = (selm >> j) & 1u;
            inv[(size_t)(b * SEQ + t) * 16 + e] = s ? slot : -1;
            if (s) { const int ro = e * ROWS_E + b * CAP + slot; idxE[ro] = b * SEQ + t; gateE[ro] = __uint_as_float(key[j]); ++slot; } }
        __syncthreads();
    }
}


__device__ __forceinline__ void phase10(const Args& a, const int TID, const int BID, const int GD) {
    const int lane = TID & 63, wave = TID >> 6;
    float* xo = a.out; const float* fg = a.in[27];
    const float* mod = (const float*)(a.ws + WS_MOD);
    const bf16_t* X1b = (const bf16_t*)(a.ws + WS_X1B);
    const unsigned char* Y = a.ws + WS_WGUT; const int* inv = (const int*)(a.ws + WS_INV);
    f32x4 gg[4];
#pragma unroll
    for (int i = 0; i < 4; ++i) gg[i] = *(const f32x4*)(fg + 4 * (lane + 64 * i));
    const int row0 = BID * NWAVES + wave, rstride = GD * NWAVES;
    int myslot = (row0 < NTOK) ? inv[(size_t)row0 * 16 + (lane & 15)] : -1;
#pragma unroll 1
    for (int row = row0; row < NTOK; row += rstride) {
        const int b = row >> 13;
        const int slot_cur = myslot;
        if (row + rstride < NTOK) myslot = inv[(size_t)(row + rstride) * 16 + (lane & 15)];
        u32x2 xw[4];
#pragma unroll
        for (int i = 0; i < 4; ++i) xw[i] = *(const u32x2*)(X1b + (size_t)row * D + 4 * (lane + 64 * i));
        f32x4 mo[4];
#pragma unroll
        for (int i = 0; i < 4; ++i) mo[i] = (f32x4){0.f, 0.f, 0.f, 0.f};
        unsigned long long bal = __ballot(lane < 16 && slot_cur >= 0);
        while (bal) {
            int ee[4]; const unsigned char* yr[4];
#pragma unroll
            for (int q = 0; q < 4; ++q) { ee[q] = -1; if (bal) { ee[q] = (int)__builtin_ctzll(bal); bal &= bal - 1; } }
#pragma unroll
            for (int q = 0; q < 4; ++q) { const int e = ee[q] < 0 ? 0 : ee[q]; const int sl = __shfl(slot_cur, e); yr[q] = Y + (size_t)(e * ROWS_E + b * CAP + (sl < 0 ? 0 : sl)) * D; }
            unsigned yw[4][4];
#pragma unroll
            for (int q = 0; q < 4; ++q)
#pragma unroll
                for (int i = 0; i < 4; ++i) { yw[q][i] = 0u; if (ee[q] >= 0) yw[q][i] = *(const unsigned*)(yr[q] + 4 * (lane + 64 * i)); }
#pragma unroll
            for (int q = 0; q < 4; ++q)
#pragma unroll
                for (int i = 0; i < 4; ++i) { const f32x2 lo = __builtin_amdgcn_cvt_pk_f32_fp8((int)yw[q][i], false), hi = __builtin_amdgcn_cvt_pk_f32_fp8((int)yw[q][i], true);
                    mo[i].x += lo.x; mo[i].y += lo.y; mo[i].z += hi.x; mo[i].w += hi.y; }
        }
        const float* g5 = mod + b * 6144 + 5120;
        f32x4 v[4]; float ss = 0.f;
#pragma unroll
        for (int i = 0; i < 4; ++i) { const f32x4 g = *(const f32x4*)(g5 + 4 * (lane + 64 * i)) * (1.0f / 32.0f);
            v[i] = (f32x4){bf_lo(xw[i].x), bf_hi(xw[i].x), bf_lo(xw[i].y), bf_hi(xw[i].y)};
            v[i] = v[i] + g * mo[i];
            ss += v[i].x * v[i].x + v[i].y * v[i].y + v[i].z * v[i].z + v[i].w * v[i].w; }
        ss = wave_sum(ss);
        const float r = rsqrtf(ss * (1.0f / D) + 1e-6f);
#pragma unroll
        for (int i = 0; i < 4; ++i) *(f32x4*)(xo + (size_t)row * D + 4 * (lane + 64 * i)) = (v[i] * r) * gg[i];
    }
}

#define XB_TMO      128
#define XB_XCNT(j)  (256  + 64 * (j))
#define XB_XSUB(j)  (1280 + 64 * (j))
#define XB_XGEN(j)  (2304 + 64 * (j))
#define XB_TOP      3328
#define XB_TOPGEN   3392
#define XCD_BAR_WORDS 3456
#define XB_SPIN_CAP (1u << 18)
__device__ __forceinline__ unsigned xb_ld(unsigned* p)              { return __hip_atomic_load(p, __ATOMIC_RELAXED, __HIP_MEMORY_SCOPE_AGENT); }
__device__ __forceinline__ unsigned xb_add(unsigned* p, unsigned v) { return __hip_atomic_fetch_add(p, v, __ATOMIC_RELAXED, __HIP_MEMORY_SCOPE_AGENT); }
__device__ __forceinline__ unsigned xb_xcc_id() { return (unsigned)__builtin_amdgcn_s_getreg((3 << 11) | 20) & 0xFu; }
#define XB_SPIN(cond, bar) do { unsigned _sp = 0; while (cond) { __builtin_amdgcn_s_sleep(1); \
    if ((++_sp & 255u) == 0u) { if (xb_ld(&(bar)[XB_TMO])) break; if (_sp > XB_SPIN_CAP) { atomicAdd(&(bar)[XB_TMO], 1u); break; } } } } while (0)
struct XcdBarrier { unsigned* bar; unsigned x; volatile LAS unsigned* st; };

__device__ __forceinline__ int lane_id_opaque() { unsigned m = ~0u; asm volatile("" : "+s"(m)); return (int)__builtin_amdgcn_mbcnt_hi(m, __builtin_amdgcn_mbcnt_lo(m, 0u)); }
__device__ __forceinline__ XcdBarrier xcd_barrier_post(unsigned* bar, volatile LAS unsigned* st, int tid) {
    XcdBarrier b; b.bar = bar; b.x = xb_xcc_id(); b.st = st;
    if (tid == 0) (void)xb_add(&bar[XB_XCNT(b.x)], 1u);
    return b;
}
__device__ __forceinline__ void xcd_barrier_complete(unsigned* bar, unsigned x, unsigned G, unsigned& nloc, unsigned& nx) {
    unsigned sum, cnt, mine, sp = 0u;
    for (;;) {
        sum = 0u; cnt = 0u; mine = 0u;
#pragma unroll
        for (unsigned j = 0; j < 16; ++j) { const unsigned c = xb_ld(&bar[XB_XCNT(j)]); sum += c; cnt += (c > 0u) ? 1u : 0u; mine = (j == x) ? c : mine; }
        if (sum == G) break;
        __builtin_amdgcn_s_sleep(1);
        if ((++sp & 255u) == 0u) { if (xb_ld(&bar[XB_TMO])) break; if (sp > XB_SPIN_CAP) { atomicAdd(&bar[XB_TMO], 1u); break; } }
    }
    nloc = mine > 0u ? mine : 1u; nx = cnt > 0u ? cnt : 1u;
}
__device__ __forceinline__ void xcd_barrier(const XcdBarrier& b, int tid, unsigned G) {
    asm volatile("s_waitcnt vmcnt(0)" ::: "memory");
    __syncthreads();
    if (tid == 0) {
        unsigned* bar = b.bar;
        __builtin_amdgcn_s_waitcnt(0);
        unsigned nloc = b.st[0], nx = b.st[1];
        if (nloc == 0u) { xcd_barrier_complete(bar, b.x, G, nloc, nx); b.st[0] = nloc; b.st[1] = nx; }
        const unsigned old = xb_add(&bar[XB_XSUB(b.x)], 1u);
        const unsigned gen = old / nloc;
        if (old + 1u == (gen + 1u) * nloc) {
            __builtin_amdgcn_fence(__ATOMIC_RELEASE, "agent");
            asm volatile("s_waitcnt vmcnt(0)" ::: "memory");
            const unsigned og = xb_add(&bar[XB_TOP], 1u);
            const unsigned tg = og / nx;
            if (og + 1u == (tg + 1u) * nx) xb_add(&bar[XB_TOPGEN], 1u);
            else XB_SPIN(xb_ld(&bar[XB_TOPGEN]) == tg, bar);
            __builtin_amdgcn_fence(__ATOMIC_ACQUIRE, "agent");
            xb_add(&bar[XB_XGEN(b.x)], 1u);
            asm volatile("s_waitcnt vmcnt(0)" ::: "memory");
        } else {
            XB_SPIN(xb_ld(&bar[XB_XGEN(b.x)]) == gen, bar);
            __builtin_amdgcn_fence(__ATOMIC_ACQUIRE, "agent");
            asm volatile("s_waitcnt vmcnt(0)" ::: "memory");
        }
    }
    __syncthreads();
}
constexpr int BAR_LDS_OFF = LDS_BYTES - 64;
constexpr size_t WS_BAR = WS_CTL + 16384;

typedef const __attribute__((address_space(4))) Args* ArgsP;
template <int PH>
__device__ __forceinline__ void do_phase(LAS unsigned char* lds, const Args& a_in, const int wave_id_s) {
#if defined(__HIP_DEVICE_COMPILE__)
    ArgsP ap = (ArgsP)__builtin_amdgcn_kernarg_segment_ptr();
    asm volatile("" : "+s"(ap));
    const Args a = *ap;
#else
    const Args a = a_in;
#endif
    const int nrep = 1 + ((a.dbg >> (8 + PH)) & 1);
#pragma unroll 1
    for (int rep = 0; rep < nrep; ++rep) {
        int WID = wave_id_s, BID = blockIdx.x, GD = gridDim.x;
        asm volatile("" : "+s"(WID), "+s"(BID), "+s"(GD));
        const int TID = WID * 64 + lane_id_opaque();
        const int G = GD;
        unsigned char* ws = a.ws;
        if constexpr (PH == 0) { phase0(lds, a, TID, BID, GD); if (rep == nrep - 1) { wg_wait((unsigned*)(ws + WS_ADACNT), 96u * (unsigned)nrep, TID); phase1(a, TID, BID, GD); } }
        else if constexpr (PH == 1) { }
        else if constexpr (PH == 2) {
            if (BID & 1) { convert_items(lds, a, 1, TID, BID, GD); __syncthreads(); }
            pg8::SchedInProj S{G, BID};
            EpiInProj E{(bf16_t*)(ws + WS_XGLU), (bf16_t*)(ws + WS_XLX), (bf16_t*)(ws + WS_GLG), a.in[9]};
            pg8::gemm_phase<EpiInProj, pg8::SchedInProj, false>(lds, (const bf16_t*)(ws + WS_U), (const bf16_t*)(ws + WS_WINT), 1024, S, E, nullptr, TID, BID, GD, 0x7F7F7F7F, pg8::lay_rowmajor(1024));
            if (!(BID & 1)) { __syncthreads(); convert_items(lds, a, 1, TID, BID, GD); }
        } else if constexpr (PH == 3) {
            {
                pg8::SchedCtx S{BID};
                EpiInProj E{(bf16_t*)(ws + WS_XGLU), (bf16_t*)(ws + WS_XLX), (bf16_t*)(ws + WS_GLG), a.in[9]};
                pg8::gemm_phase<EpiInProj, pg8::SchedCtx, false>(lds, (const bf16_t*)(ws + WS_U), (const bf16_t*)(ws + WS_WINT), 1024, S, E, nullptr, TID, BID, GD, 0x7F7F7F7F, pg8::lay_rowmajor(1024));
                if ((BID & 7) == 7 && (BID >> 3) < 8) {
                    asm volatile("s_waitcnt vmcnt(0)" ::: "memory");
                    __syncthreads();
                    if (TID == 0) { __builtin_amdgcn_fence(__ATOMIC_RELEASE, "agent"); asm volatile("s_waitcnt vmcnt(0)" ::: "memory");
                        __hip_atomic_store((unsigned*)(ws + WS_CTXFLAG) + 64 * (BID >> 3), 1u, __ATOMIC_RELAXED, __HIP_MEMORY_SCOPE_AGENT); }
                }
            }
            conv_units(lds, a, BID, G, TID, BID, GD);
            lru_phase<1>(lds, a, TID, BID, GD);
            if (rep == nrep - 1) { __syncthreads(); lru_rescan(lds, a, TID, BID, GD); }
        } else if constexpr (PH == 4) {
        } else if constexpr (PH == 5) {
            pg8::Sched S{128, 4, 1, G, BID};
            EpiOutProj E{(bf16_t*)(ws + WS_M), (const float*)(ws + WS_MOD), a.in[22]};
            pg8::gemm_phase<EpiOutProj, pg8::Sched, false>(lds, (const bf16_t*)(ws + WS_MIX), (const bf16_t*)(ws + WS_WOUTT), 1024, S, E, nullptr, TID, BID, GD, 0x7F7F7F7F, pg8::lay_rowmajor(1024));
        } else if constexpr (PH == 6) phase6(lds, a, TID, BID, GD);
        else if constexpr (PH == 7) phase7(lds, a, TID, BID, GD);
        else if constexpr (PH == 8) {
            if (BID & 1) { convert_items(lds, a, 2, TID, BID, GD); __syncthreads(); }
            pg8::Sched S{16, 22, 16, G, BID};
            EpiExpUp E{ws + WS_R1};
            pg8::gemm_phase<EpiExpUp, pg8::Sched, true, true>(lds, (const bf16_t*)(ws + WS_V), (const bf16_t*)(ws + WS_WGUT), 512, S, E, (const int*)(ws + WS_IDXE), TID, BID, GD, 0x7A7A7A7A, pg8::lay_rowmajor(512));
            if (!(BID & 1)) { __syncthreads(); convert_items(lds, a, 2, TID, BID, GD); }
        } else if constexpr (PH == 9) {
            pg8::SchedDown S{G, BID};
            EpiExpDown E{ws + WS_WGUT, (const float*)(ws + WS_GATEE)};
            pg8::gemm_phase<EpiExpDown, pg8::SchedDown, false, true>(lds, (const bf16_t*)(ws + WS_R1), (const bf16_t*)(ws + WS_WDT), DE / 2, S, E, nullptr, TID, BID, GD, 0x79797979, pg8::lay_blocked(22));
        } else if constexpr (PH == 10) phase10(a, TID, BID, GD);
    }
}
template <int PH, int PH0, int PH1>
__device__ __forceinline__ void run_phases(LAS unsigned char* lds, const Args& a_in, const int wave_id_s) {
    if constexpr (PH < PH1) {
        if constexpr (PH > PH0 && PH != 1 && PH != 4) {
#if defined(__HIP_DEVICE_COMPILE__)
            ArgsP apb = (ArgsP)__builtin_amdgcn_kernarg_segment_ptr(); asm volatile("" : "+s"(apb));
            XcdBarrier xb2; xb2.bar = (unsigned*)(apb->ws + WS_BAR); xb2.x = xb_xcc_id(); xb2.st = (volatile LAS unsigned*)(lds + BAR_LDS_OFF);
            int wv = wave_id_s; asm volatile("" : "+s"(wv));
            xcd_barrier(xb2, wv * 64 + lane_id_opaque(), gridDim.x);
#endif
        }
        do_phase<PH>(lds, a_in, wave_id_s);
        run_phases<PH + 1, PH0, PH1>(lds, a_in, wave_id_s);
    }
}
template <int PH0, int PH1>
__global__ void __launch_bounds__(NTHREADS, 2) hybrid_fwd(Args a_in) {
    extern __shared__ __attribute__((aligned(16))) unsigned char lds_raw[];
    LAS unsigned char* lds = (LAS unsigned char*)lds_raw;
    const int wave_id_s = __builtin_amdgcn_readfirstlane((int)threadIdx.x >> 6);
    {
        volatile LAS unsigned* st = (volatile LAS unsigned*)(lds + BAR_LDS_OFF);
        if (threadIdx.x == 0) { st[0] = 0u; st[1] = 0u; }
        __syncthreads();
        (void)xcd_barrier_post((unsigned*)(a_in.ws + WS_BAR), st, (int)threadIdx.x);
    }
    run_phases<PH0, PH0, PH1>(lds, a_in, wave_id_s);
}

extern "C" void kernel_launch(void* const* d_in, const int* in_sizes, int n_in, void* d_out, int out_size, void* d_ws, size_t ws_size, hipStream_t stream) {
    if (n_in != 28 || out_size != NTOK * D || ws_size < WS_END) { fprintf(stderr, "kernel_launch: unexpected shapes (n_in %d out %d ws %zu)\n", n_in, out_size, ws_size); return; }
    Args a{};
    for (int i = 0; i < 28; ++i) a.in[i] = (const float*)d_in[i];
    a.out = (float*)d_out; a.ws = (unsigned char*)d_ws; a.dbg = PROBE_MASK; a.pad = 0;
    static int grid = 0;
    if (!grid) {
        (void)hipFuncSetAttribute((const void*)hybrid_fwd<0, 11>, hipFuncAttributeMaxDynamicSharedMemorySize, LDS_BYTES);
        int dev = 0, cus = 0, per_cu = 0;
        (void)hipGetDevice(&dev); (void)hipDeviceGetAttribute(&cus, hipDeviceAttributeMultiprocessorCount, dev);
        (void)hipOccupancyMaxActiveBlocksPerMultiprocessor(&per_cu, (const void*)hybrid_fwd<0, 11>, NTHREADS, LDS_BYTES);
        grid = (per_cu >= 1 ? 1 : 0) * cus;
        if (grid != 256) fprintf(stderr, "kernel_launch: grid %d (cus %d per_cu %d)\n", grid, cus, per_cu);
    }
    if (grid <= 0) return;
    a.ph_lo = 0; a.ph_hi = 11;
    (void)hipMemsetAsync((char*)d_ws + WS_CTL, 0, 65536, stream);
    void* kargs[] = {&a};
    hipError_t e = hipLaunchCooperativeKernel((const void*)hybrid_fwd<0, 11>, dim3(grid), dim3(NTHREADS), kargs, LDS_BYTES, stream);
    if (e != hipSuccess) fprintf(stderr, "cooperative launch failed: %s (grid %d)\n", hipGetErrorString(e), grid);
}
```

```cpp
#include <hip/hip_runtime.h>
#include <hip/hip_cooperative_groups.h>
#include <cstdio>
#include <cstdint>

#define LAS __attribute__((address_space(3)))
typedef unsigned short bf16_t;
typedef short bf16x8 __attribute__((ext_vector_type(8)));
typedef float f32x4 __attribute__((ext_vector_type(4)));
typedef float f32x2 __attribute__((ext_vector_type(2)));
typedef unsigned u32x4 __attribute__((ext_vector_type(4)));
typedef unsigned u32x2 __attribute__((ext_vector_type(2)));
typedef int v4i_t __attribute__((ext_vector_type(4)));
typedef _Float16 h2_t __attribute__((ext_vector_type(2)));
typedef int v8i_t __attribute__((ext_vector_type(8)));

constexpr int D = 1024, NB = 4, SEQ = 8192, NTOK = NB * SEQ, CTXL = 256, NCTX = NB * CTXL, NROWS = NTOK + NCTX;
constexpr int DE = 2816, NE = 16, CAP = 1024, ROWS_E = NB * CAP;
constexpr int NQ = 132;
constexpr int NWAVES = 8, NTHREADS = 512;

constexpr size_t MiB = 1u << 20;
constexpr size_t WS_CTL = 0, CTL_BYTES = 1 * MiB;
constexpr size_t WS_CTXFLAG = WS_CTL + 40960;
constexpr size_t WS_ADACNT = WS_CTL + 45056;
constexpr size_t WS_BHCNT = WS_CTL + 49152;
constexpr size_t WS_MOD = 1 * MiB;
constexpr size_t WS_CARRY = 2 * MiB;
constexpr size_t WS_AFFT = 7 * MiB;
constexpr size_t WS_IDXE = 9 * MiB;
constexpr size_t WS_GATEE = WS_IDXE + 256 * 1024;
constexpr size_t WS_INV = WS_GATEE + 256 * 1024;
constexpr size_t WS_WINT = 12 * MiB;
constexpr size_t WS_WOUTT = 16 * MiB;
constexpr size_t WS_WGUT = 18 * MiB;
constexpr size_t WS_WDT = 146 * MiB;
constexpr size_t WS_V = 190 * MiB;
constexpr size_t WS_R1 = 222 * MiB;
constexpr size_t WS_U = WS_R1;
constexpr size_t WS_XGLU = WS_R1 + 66 * MiB;
constexpr size_t WS_XLX = WS_R1 + 98 * MiB;
constexpr size_t WS_GLG = WS_R1 + 131 * MiB;
constexpr size_t WS_MIX = WS_R1 + 163 * MiB;
constexpr size_t WS_M = WS_R1 + 227 * MiB;
constexpr size_t WS_X1B = WS_R1 + 291 * MiB;
constexpr size_t WS_AU = WS_R1 + 291 * MiB;
constexpr size_t WS_END = 641 * MiB;
constexpr int LDS_BYTES = 147456;

__device__ __forceinline__ unsigned f2bf(float f) { unsigned u = __builtin_bit_cast(unsigned, f); return (u + 0x7fffu + ((u >> 16) & 1u)) >> 16; }
__device__ __forceinline__ unsigned pk2(float lo, float hi) { return f2bf(lo) | (f2bf(hi) << 16); }
__device__ __forceinline__ unsigned pk2h(float lo, float hi) { h2_t p; p.x = (_Float16)lo; p.y = (_Float16)hi; return __builtin_bit_cast(unsigned, p); }
__device__ __forceinline__ void fma_mix_lo(float& acc, float w, unsigned xh) { asm("v_fma_mix_f32 %0, %1, %2, %0 op_sel_hi:[0,1,0]" : "+v"(acc) : "v"(w), "v"(xh)); }
__device__ __forceinline__ void fma_mix_hi(float& acc, float w, unsigned xh) { asm("v_fma_mix_f32 %0, %1, %2, %0 op_sel:[0,1,0] op_sel_hi:[0,1,0]" : "+v"(acc) : "v"(w), "v"(xh)); }
__device__ __forceinline__ float bf_lo(unsigned w) { return __builtin_bit_cast(float, w << 16); }
__device__ __forceinline__ float bf_hi(unsigned w) { return __builtin_bit_cast(float, w & 0xffff0000u); }
__device__ __forceinline__ unsigned pk4_fp8(float a, float b, float c, float d) {
    a = __builtin_amdgcn_fmed3f(a, -448.f, 448.f); b = __builtin_amdgcn_fmed3f(b, -448.f, 448.f); c = __builtin_amdgcn_fmed3f(c, -448.f, 448.f); d = __builtin_amdgcn_fmed3f(d, -448.f, 448.f);
    int w = 0; w = __builtin_amdgcn_cvt_pk_fp8_f32(a, b, w, false); w = __builtin_amdgcn_cvt_pk_fp8_f32(c, d, w, true); return (unsigned)w; }
__device__ __forceinline__ float wave_sum(float v) {
#pragma unroll
    for (int o = 32; o >= 1; o >>= 1) v += __shfl_xor(v, o);
    return v;
}
__device__ __forceinline__ float wave_max(float v) {
#pragma unroll
    for (int o = 32; o >= 1; o >>= 1) v = fmaxf(v, __shfl_xor(v, o));
    return v;
}
__device__ __forceinline__ float sigm(float x) { return __builtin_amdgcn_rcpf(1.0f + __expf(-x)); }
__device__ __forceinline__ float silu_f(float x) { return x * sigm(x); }
__device__ __forceinline__ float gelu_tanh(float x) { const float z = 0.7978845608028654f * (x + 0.044715f * x * x * x); return x * sigm(2.0f * z); }

namespace pg8 {
constexpr int BM = 256, BK = 64, HALF = 128, HTB = HALF * BK * 2, STAGE_BYTES = 8 * HTB, NXCD = 8, WGM = 8;
__device__ __forceinline__ int lds_byte(int r, int c) { const int st = (r >> 4) * 2 + (c >> 5), rr = r & 15, cc = c & 31, ob = rr * 64 + cc * 2; return st * 1024 + (ob ^ (((ob >> 9) & 1) << 5)); }
__device__ __forceinline__ void stage_rc(int b, int& R, int& C) { const int st = b / 1024, sb = b % 1024, swz = sb ^ (((sb >> 9) & 1) << 5); R = (st >> 1) * 16 + swz / 64; C = (st & 1) * 32 + (swz % 64) / 2; }
__device__ __forceinline__ int perm32(int rho) { const int n = rho >> 4, i = rho & 15; return 8 * (i >> 2) + 4 * n + (i & 3); }
struct Unit { int pm, pn; };
struct Lay { unsigned rowA, rowB; size_t kstepA, kstepB, hstepB, tstepA, tstepB; };
__device__ __forceinline__ Lay lay_rowmajor(int K) { Lay l; l.rowA = l.rowB = (unsigned)K * 2u; l.kstepA = l.kstepB = 128; l.hstepB = (size_t)128 * K * 2; l.tstepA = l.tstepB = (size_t)256 * K * 2; return l; }
__device__ __forceinline__ Lay lay_blocked(int nkt) { Lay l; l.rowA = l.rowB = 128u; l.kstepA = l.kstepB = 32768; l.hstepB = 16384; l.tstepA = l.tstepB = (size_t)nkt * 32768; return l; }

__device__ __forceinline__ void tile_order(int w, int nM, int nN, int& pm, int& pn) {
    const int nwg = nM * nN;
    int wgid = w; { const int q = nwg / NXCD, r = nwg % NXCD, xcd = wgid % NXCD, off = wgid / NXCD; wgid = (xcd < r ? xcd * (q + 1) : r * (q + 1) + (xcd - r) * q) + off; }
    const int nig = WGM * nN, gid = wgid / nig, fm = gid * WGM, gsz = (nM - fm) < WGM ? (nM - fm) : WGM;
    pm = fm + ((wgid % nig) % gsz); pn = (wgid % nig) / gsz;
}
struct Sched {
    int nM, nN, ngroups, G, c;
    __device__ __forceinline__ bool next(int i, Unit& u) const {
        const int per = nM * nN; const long L = (long)i * G + c; if (L >= (long)per * ngroups) return false;
        const int e = (int)(L / per), w = (int)(L % per); int pm, pn; tile_order(w, nM, nN, pm, pn);
        u.pm = e * nM + pm; u.pn = e * nN + pn; return true;
    }
};
struct SchedInProj {
    int G, c;
    __device__ __forceinline__ bool next(int i, Unit& u) const {
        const long L = (long)i * G + c; if (L >= 1024) return false;
        int pm, pn; tile_order((int)L, 128, 8, pm, pn); u.pm = pm; u.pn = pn; return true;
    }
};
struct SchedCtx {
    int c;
    __device__ __forceinline__ bool next(int i, Unit& u) const {
        if (i != 0 || (c & 7) != 7 || (c >> 3) >= 8) return false;
        const int k = c >> 3; u.pm = 128 + (k >> 1); u.pn = 4 + (k & 1); return true;
    }
};
struct SchedDown {
    int G, c;
    __device__ __forceinline__ bool next(int i, Unit& u) const {
        if (G != 256) { const long L = (long)i * G + c; if (L >= 1024) return false; const int e = (int)(L >> 6), w = (int)(L & 63); u.pm = e * 16 + (w >> 2); u.pn = e * 4 + (w & 3); return true; }
        if (i >= 4) return false;
        const int x = c & 7, j = c >> 3, e = 4 * i + (x >> 1);
        u.pm = e * 16 + 8 * (x & 1) + (j & 7); u.pn = e * 4 + (j >> 3); return true;
    }
};
template <class Epi, class SchedT, bool GATHER, bool FP8 = false, bool SP2 = true, bool ALIGN_EPI = true>
__device__ __forceinline__ void gemm_phase(LAS unsigned char* lds, const bf16_t* Ag, const bf16_t* Btg, const int K, const SchedT& S, const Epi& E, const int* gidx, const int TID, const int BID, const int GD, const int scaleB, const Lay L) {
    const int tid = TID, wid = __builtin_amdgcn_readfirstlane(tid >> 6), lane = tid & 63, wr = wid >> 2, wc = wid & 3, fr = lane & 15, fq = lane >> 4;
    const int nt = K / BK;
    int Rr[2], Cc[2]; unsigned voffB[2];
#pragma unroll
    for (int i = 0; i < 2; ++i) { stage_rc(tid * 16 + i * 8192, Rr[i], Cc[i]); const int Rb = Epi::PERM ? ((Rr[i] & ~31) + perm32(Rr[i] & 31)) : Rr[i]; voffB[i] = (unsigned)Rb * L.rowB + (unsigned)Cc[i] * 2u; }
    const size_t kstepA = L.kstepA, kstepB = L.kstepB, hstep = L.hstepB, tstepA = L.tstepA, tstepB = L.tstepB;
    const unsigned ldsw = (unsigned)wid * 1024u;
    const int aoff = lds_byte(wr * 64 + fr, fq * 8), boff = lds_byte(wc * 32 + fr, fq * 8);
    const int aoff8_0 = aoff, aoff8_1 = aoff + 1024, boff8_0 = boff, boff8_1 = boff + 1024;
#define PG8_SA(b, h) (((b) * 2 + (h)) * HTB)
#define PG8_SB(b, h) ((4 + (b) * 2 + (h)) * HTB)
#define PG8_STAGE(bufoff, gbase, voff) do { _Pragma("unroll") for (int _i = 0; _i < 2; ++_i) \
        __builtin_amdgcn_global_load_lds((const unsigned*)((const char*)(gbase) + (voff)[_i]), (LAS unsigned*)(lds + (bufoff) + ldsw + _i * 8192), 16, 0, 0); } while (0)
#define PG8_LD8(p0, p1) __builtin_shufflevector(*(const LAS v4i_t*)(p0), *(const LAS v4i_t*)(p1), 0, 1, 2, 3, 4, 5, 6, 7)
#define PG8_LDA(dst, b, h) do { _Pragma("unroll") for (int m = 0; m < 4; ++m) { if constexpr (FP8) { \
        dst##8[m] = PG8_LD8(lds + PG8_SA(b, h) + aoff8_0 + m * 2048, lds + PG8_SA(b, h) + aoff8_1 + m * 2048); } else { \
        _Pragma("unroll") for (int k = 0; k < 2; ++k) dst[m][k] = *(const LAS bf16x8*)(lds + PG8_SA(b, h) + aoff + m * 2048 + k * 1024); } } } while (0)
#define PG8_LDB(dst, b, h) do { _Pragma("unroll") for (int n = 0; n < 2; ++n) { if constexpr (FP8) { \
        dst##8[n] = PG8_LD8(lds + PG8_SB(b, h) + boff8_0 + n * 2048, lds + PG8_SB(b, h) + boff8_1 + n * 2048); } else { \
        _Pragma("unroll") for (int k = 0; k < 2; ++k) dst[n][k] = *(const LAS bf16x8*)(lds + PG8_SB(b, h) + boff + n * 2048 + k * 1024); } } } while (0)
#define PG8_MMA(ai, bj, At, Bt) do { if constexpr (FP8) __builtin_amdgcn_sched_barrier(0); __builtin_amdgcn_s_setprio(1); _Pragma("unroll") for (int m = 0; m < 4; ++m) _Pragma("unroll") for (int n = 0; n < 2; ++n) { if constexpr (FP8) { \
        acc[ai][bj][m][n] = __builtin_amdgcn_mfma_scale_f32_16x16x128_f8f6f4(Bt##8[n], At##8[m], acc[ai][bj][m][n], 0, 0, 0, scaleB, 0, 0x7F7F7F7F); } else { \
        _Pragma("unroll") for (int k = 0; k < 2; ++k) acc[ai][bj][m][n] = __builtin_amdgcn_mfma_f32_16x16x32_bf16(Bt[n][k], At[m][k], acc[ai][bj][m][n], 0, 0, 0); } } \
        if constexpr (FP8) { _Pragma("unroll") for (int m = 0; m < 4; ++m) _Pragma("unroll") for (int n = 0; n < 2; ++n) asm volatile("" : "+v"(acc[ai][bj][m][n])); } \
        __builtin_amdgcn_s_setprio(0); if constexpr (FP8) __builtin_amdgcn_sched_barrier(0); } while (0)
#define PG8_WAIT_V(n) asm volatile("s_waitcnt vmcnt(" #n ")" ::: "memory")
#define PG8_WAIT_L(n) asm volatile("s_waitcnt lgkmcnt(" #n ")" ::: "memory")
#define PG8_BAR __builtin_amdgcn_s_barrier()
#define PG8_SCHED __builtin_amdgcn_sched_barrier(0)
#define PG8_LOADV(dst, u) do { _Pragma("unroll") for (int _h = 0; _h < 2; ++_h) _Pragma("unroll") for (int _i = 0; _i < 2; ++_i) \
        dst[_h][_i] = GATHER ? ((unsigned)gidx[(u).pm * BM + _h * HALF + Rr[_i]] * L.rowA + (unsigned)Cc[_i] * 2u) : ((unsigned)(_h * HALF + Rr[_i]) * L.rowA + (unsigned)Cc[_i] * 2u); } while (0)
    Unit cur, nxt; int ui = 0;
    if (!S.next(0, cur)) return;
    f32x4 acc[2][2][4][2];
#pragma unroll
    for (int a = 0; a < 2; ++a)
#pragma unroll
        for (int b = 0; b < 2; ++b)
#pragma unroll
            for (int m = 0; m < 4; ++m)
#pragma unroll
                for (int n = 0; n < 2; ++n) acc[a][b][m][n] = (f32x4){0.f, 0.f, 0.f, 0.f};
    bf16x8 At[4][2], B0[2][2], B1[2][2];
    v8i_t At8[4], B08[2], B18[2];
    unsigned vc[2][2], vn[2][2];
    PG8_LOADV(vc, cur);
    const char* cA = GATHER ? (const char*)Ag : (const char*)Ag + (size_t)cur.pm * tstepA;
    const char* cB = (const char*)Btg + (size_t)cur.pn * tstepB;
    if constexpr (SP2) {
        PG8_STAGE(PG8_SB(0, 0), cB, voffB); PG8_STAGE(PG8_SB(0, 1), cB + hstep, voffB); PG8_STAGE(PG8_SA(0, 0), cA, vc[0]); PG8_STAGE(PG8_SA(0, 1), cA, vc[1]);
        if (wr == 1) PG8_BAR;
        PG8_WAIT_V(2); PG8_BAR;
        PG8_STAGE(PG8_SB(1, 0), cB + kstepB, voffB); PG8_STAGE(PG8_SA(1, 0), cA + kstepA, vc[0]); PG8_STAGE(PG8_SB(1, 1), cB + hstep + kstepB, voffB);
        PG8_WAIT_V(6); PG8_BAR;
    } else {
    PG8_STAGE(PG8_SB(0, 0), cB, voffB); PG8_STAGE(PG8_SA(0, 0), cA, vc[0]); PG8_STAGE(PG8_SB(0, 1), cB + hstep, voffB); PG8_STAGE(PG8_SA(0, 1), cA, vc[1]);
    if (wr == 1) PG8_BAR;
    PG8_WAIT_V(4); PG8_BAR;
    PG8_STAGE(PG8_SB(1, 0), cB + kstepB, voffB); PG8_STAGE(PG8_SA(1, 0), cA + kstepA, vc[0]); PG8_STAGE(PG8_SB(1, 1), cB + hstep + kstepB, voffB);
    PG8_WAIT_V(6); PG8_BAR;
    }
    for (;;) {
        const bool has_next = S.next(ui + 1, nxt);
        const char* nA = cA; const char* nB = cB;
        if (has_next) { nA = GATHER ? (const char*)Ag : (const char*)Ag + (size_t)nxt.pm * tstepA; nB = (const char*)Btg + (size_t)nxt.pn * tstepB; PG8_LOADV(vn, nxt); }
        else {
#pragma unroll
            for (int h = 0; h < 2; ++h)
#pragma unroll
                for (int i = 0; i < 2; ++i) vn[h][i] = vc[h][i];
        }
        for (int t = 0; t < nt; t += 2) {
            const bool last = (t == nt - 2);
            const char* a1 = cA + (size_t)(t + 1) * kstepA;
            const char* a2 = last ? nA : cA + (size_t)(t + 2) * kstepA; const char* b2 = last ? nB : cB + (size_t)(t + 2) * kstepB;
            const char* a3 = a2 + kstepA; const char* b3 = b2 + kstepB;
#pragma unroll
            for (int i = 0; i < 2; ++i) vc[0][i] = last ? vn[0][i] : vc[0][i];
            if constexpr (SP2) {
            PG8_LDB(B0, 0, 0); PG8_LDB(B1, 0, 1); PG8_SCHED; PG8_LDA(At, 0, 0); PG8_STAGE(PG8_SA(1, 1), a1, vc[1]);
            _Pragma("unroll") for (int i = 0; i < 2; ++i) vc[1][i] = last ? vn[1][i] : vc[1][i];
            PG8_WAIT_V(8); PG8_WAIT_L(0); PG8_BAR; PG8_MMA(0, 0, At, B0); PG8_MMA(0, 1, At, B1); PG8_BAR; PG8_SCHED;
            PG8_LDA(At, 0, 1); PG8_STAGE(PG8_SB(0, 0), b2, voffB); PG8_STAGE(PG8_SB(0, 1), b2 + hstep, voffB); PG8_STAGE(PG8_SA(0, 0), a2, vc[0]);
            PG8_WAIT_V(8); PG8_WAIT_L(0); PG8_BAR; PG8_MMA(1, 0, At, B0); PG8_MMA(1, 1, At, B1); PG8_BAR; PG8_SCHED;
            PG8_LDB(B0, 1, 0); PG8_LDB(B1, 1, 1); PG8_SCHED; PG8_LDA(At, 1, 0); PG8_STAGE(PG8_SA(0, 1), a2, vc[1]);
            PG8_WAIT_V(8); PG8_WAIT_L(0); PG8_BAR; PG8_MMA(0, 0, At, B0); PG8_MMA(0, 1, At, B1); PG8_BAR; PG8_SCHED;
            PG8_LDA(At, 1, 1); PG8_STAGE(PG8_SB(1, 0), b3, voffB); PG8_STAGE(PG8_SB(1, 1), b3 + hstep, voffB); PG8_STAGE(PG8_SA(1, 0), a3, vc[0]);
            PG8_WAIT_V(8); PG8_WAIT_L(0); PG8_BAR; PG8_MMA(1, 0, At, B0); PG8_MMA(1, 1, At, B1); PG8_BAR; PG8_SCHED;
            } else {
            PG8_LDB(B0, 0, 0); PG8_SCHED; PG8_LDA(At, 0, 0); PG8_STAGE(PG8_SA(1, 1), a1, vc[1]);
            _Pragma("unroll") for (int i = 0; i < 2; ++i) vc[1][i] = last ? vn[1][i] : vc[1][i];
            PG8_WAIT_L(8); PG8_BAR; PG8_WAIT_L(0); PG8_MMA(0, 0, At, B0); PG8_BAR; PG8_SCHED;
            PG8_LDB(B1, 0, 1); PG8_STAGE(PG8_SB(0, 0), b2, voffB);
            PG8_BAR; PG8_WAIT_L(0); PG8_MMA(0, 1, At, B1); PG8_BAR;
            PG8_LDA(At, 0, 1); PG8_STAGE(PG8_SA(0, 0), a2, vc[0]);
            PG8_BAR; PG8_WAIT_L(0); PG8_MMA(1, 0, At, B0); PG8_BAR; PG8_SCHED;
            PG8_STAGE(PG8_SB(0, 1), b2 + hstep, voffB);
            PG8_WAIT_V(6); PG8_BAR; PG8_MMA(1, 1, At, B1); PG8_BAR;
            PG8_LDB(B0, 1, 0); PG8_SCHED; PG8_LDA(At, 1, 0); PG8_STAGE(PG8_SA(0, 1), a2, vc[1]);
            PG8_WAIT_L(8); PG8_BAR; PG8_WAIT_L(0); PG8_MMA(0, 0, At, B0); PG8_BAR; PG8_SCHED;
            PG8_LDB(B1, 1, 1); PG8_STAGE(PG8_SB(1, 0), b3, voffB);
            PG8_BAR; PG8_WAIT_L(0); PG8_MMA(0, 1, At, B1); PG8_BAR;
            PG8_LDA(At, 1, 1); PG8_STAGE(PG8_SA(1, 0), a3, vc[0]);
            PG8_BAR; PG8_WAIT_L(0); PG8_MMA(1, 0, At, B0); PG8_BAR; PG8_SCHED;
            PG8_STAGE(PG8_SB(1, 1), b3 + hstep, voffB);
            PG8_WAIT_V(6); PG8_BAR; PG8_MMA(1, 1, At, B1); PG8_BAR;
            }
        }
        if constexpr (ALIGN_EPI) { if (wr == 0) PG8_BAR; }
        E(acc, cur, wr, wc, fr, fq);
        if (!has_next) break;
#pragma unroll
        for (int a = 0; a < 2; ++a)
#pragma unroll
            for (int b = 0; b < 2; ++b)
#pragma unroll
                for (int m = 0; m < 4; ++m)
#pragma unroll
                    for (int n = 0; n < 2; ++n) acc[a][b][m][n] = (f32x4){0.f, 0.f, 0.f, 0.f};
        cur = nxt; cA = nA; cB = nB; ++ui;
#pragma unroll
        for (int h = 0; h < 2; ++h)
#pragma unroll
            for (int i = 0; i < 2; ++i) vc[h][i] = vn[h][i];
        if constexpr (ALIGN_EPI) { if (wr == 1) PG8_BAR; }
    }
    PG8_WAIT_V(0);
    if constexpr (!ALIGN_EPI) { if (wr == 0) PG8_BAR; }
    PG8_BAR;
#undef PG8_SA
#undef PG8_SB
#undef PG8_STAGE
#undef PG8_LDA
#undef PG8_LDB
#undef PG8_MMA
#undef PG8_LD8
#undef PG8_WAIT_V
#undef PG8_WAIT_L
#undef PG8_BAR
#undef PG8_SCHED
#undef PG8_LOADV
}
}

struct EpiInProj {
    static constexpr bool PERM = true;
    bf16_t* xglu; bf16_t* xlx; bf16_t* glg; const float* b_in;
    __device__ __forceinline__ void operator()(const f32x4 (&acc)[2][2][4][2], const pg8::Unit& u, int wr, int wc, int fr, int fq) const {
        const int row0 = u.pm * 256 + wr * 64 + fr, cl = wc * 32 + 8 * fq;
        if (u.pn < 4) {
            const int col = 128 * u.pn + cl;
            f32x4 bv[2][2];
#pragma unroll
            for (int n = 0; n < 2; ++n) { bv[0][n] = *(const f32x4*)(b_in + col + 4 * n); bv[1][n] = *(const f32x4*)(b_in + 512 + col + 4 * n); }
#pragma unroll
            for (int ai = 0; ai < 2; ++ai)
#pragma unroll
                for (int m = 0; m < 4; ++m) {
                    const size_t row = (size_t)(row0 + ai * 128 + m * 16);
                    float o[8];
#pragma unroll
                    for (int n = 0; n < 2; ++n) { const f32x4 v = acc[ai][0][m][n] + bv[0][n], g = acc[ai][1][m][n] + bv[1][n];
#pragma unroll
                        for (int j = 0; j < 4; ++j) o[4 * n + j] = v[j] * sigm(g[j]); }
                    u32x4 w; w.x = pk2h(o[0], o[1]); w.y = pk2h(o[2], o[3]); w.z = pk2h(o[4], o[5]); w.w = pk2h(o[6], o[7]);
                    *(u32x4*)(xglu + row * 512 + col) = w;
                }
        } else {
            const bool isg = u.pn >= 6;
            const int cbase = 256 * (u.pn - (isg ? 6 : 4));
            const float* bias = b_in + (isg ? 1536 : 1024) + cbase;
            bf16_t* outp = isg ? glg : xlx;
#pragma unroll
            for (int bj = 0; bj < 2; ++bj) {
                const int col = 128 * bj + cl;
                const f32x4 b0 = *(const f32x4*)(bias + col), b1 = *(const f32x4*)(bias + col + 4);
#pragma unroll
                for (int ai = 0; ai < 2; ++ai)
#pragma unroll
                    for (int m = 0; m < 4; ++m) {
                        const size_t row = (size_t)(row0 + ai * 128 + m * 16);
                        f32x4 v0 = acc[ai][bj][m][0] + b0, v1 = acc[ai][bj][m][1] + b1;
                        if (isg) {
#pragma unroll
                            for (int j = 0; j < 4; ++j) { v0[j] = gelu_tanh(v0[j]); v1[j] = gelu_tanh(v1[j]); }
                        }
                        u32x4 w; w.x = pk2(v0[0], v0[1]); w.y = pk2(v0[2], v0[3]); w.z = pk2(v1[0], v1[1]); w.w = pk2(v1[2], v1[3]);
                        *(u32x4*)(outp + row * 512 + cbase + col) = w;
                    }
            }
        }
    }
};
struct EpiOutProj {
    static constexpr bool PERM = true;
    bf16_t* M; const float* mod; const float* b_out;
    __device__ __forceinline__ void operator()(const f32x4 (&acc)[2][2][4][2], const pg8::Unit& u, int wr, int wc, int fr, int fq) const {
        const int row0 = u.pm * 256 + wr * 64 + fr, col0 = u.pn * 256 + wc * 32 + 8 * fq;
        const int b = u.pm >> 5;
        const float* g1 = mod + b * 6144 + 2048;
#pragma unroll
        for (int bj = 0; bj < 2; ++bj) {
            const int col = col0 + bj * 128;
            const f32x4 bo0 = *(const f32x4*)(b_out + col), bo1 = *(const f32x4*)(b_out + col + 4), gg0 = *(const f32x4*)(g1 + col), gg1 = *(const f32x4*)(g1 + col + 4);
#pragma unroll
            for (int ai = 0; ai < 2; ++ai)
#pragma unroll
                for (int m = 0; m < 4; ++m) {
                    const f32x4 v0 = gg0 * (acc[ai][bj][m][0] + bo0), v1 = gg1 * (acc[ai][bj][m][1] + bo1);
                    u32x4 w; w.x = pk2(v0[0], v0[1]); w.y = pk2(v0[2], v0[3]); w.z = pk2(v1[0], v1[1]); w.w = pk2(v1[2], v1[3]);
                    *(u32x4*)(M + (size_t)(row0 + ai * 128 + m * 16) * D + col) = w;
                }
        }
    }
};
struct EpiExpUp {
    static constexpr bool PERM = true;
    unsigned char* H;
    __device__ __forceinline__ void operator()(const f32x4 (&acc)[2][2][4][2], const pg8::Unit& u, int wr, int wc, int fr, int fq) const {
        const int e = u.pm >> 4, t = u.pn - e * 22;
        const int row0 = u.pm * 256 + wr * 64 + fr, col = 128 * t + wc * 32 + 8 * fq;
#pragma unroll
        for (int ai = 0; ai < 2; ++ai)
#pragma unroll
            for (int m = 0; m < 4; ++m) {
                const size_t row = (size_t)(row0 + ai * 128 + m * 16);
                float o[8];
#pragma unroll
                for (int n = 0; n < 2; ++n)
#pragma unroll
                    for (int j = 0; j < 4; j += 2) {
                        const f32x2 g2 = (f32x2){acc[ai][0][m][n][j], acc[ai][0][m][n][j + 1]}, u2 = (f32x2){acc[ai][1][m][n][j], acc[ai][1][m][n][j + 1]};
                        const f32x2 tt = g2 * (-1.4426950408889634f);
                        f32x2 ee; ee.x = __builtin_amdgcn_exp2f(tt.x); ee.y = __builtin_amdgcn_exp2f(tt.y);
                        const f32x2 dd = ee + 1.0f;
                        f32x2 rr; rr.x = __builtin_amdgcn_rcpf(dd.x); rr.y = __builtin_amdgcn_rcpf(dd.y);
                        const f32x2 hh = (g2 * u2) * rr;
                        o[4 * n + j] = hh.x; o[4 * n + j + 1] = hh.y; }
                u32x2 w; w.x = pk4_fp8(o[0], o[1], o[2], o[3]); w.y = pk4_fp8(o[4], o[5], o[6], o[7]);
                *(u32x2*)(H + ((size_t)u.pm * 22 + t) * 32768 + (size_t)(row - (size_t)u.pm * 256) * 128 + (col - 128 * t)) = w;
            }
    }
};
struct EpiExpDown {
    static constexpr bool PERM = true;
    unsigned char* Y; const float* gateE;
    __device__ __forceinline__ void operator()(const f32x4 (&acc)[2][2][4][2], const pg8::Unit& u, int wr, int wc, int fr, int fq) const {
        const int e = u.pm >> 4, c4 = u.pn - e * 4;
        const int row0 = u.pm * 256 + wr * 64 + fr, col0 = 256 * c4 + wc * 32 + 8 * fq;
#pragma unroll
        for (int ai = 0; ai < 2; ++ai)
#pragma unroll
            for (int m = 0; m < 4; ++m) {
                const size_t row = (size_t)(row0 + ai * 128 + m * 16);
                const float g = gateE[row] * 32.0f;
#pragma unroll
                for (int bj = 0; bj < 2; ++bj) {
                    const f32x4 v0 = acc[ai][bj][m][0] * g, v1 = acc[ai][bj][m][1] * g;
                    u32x2 w; w.x = pk4_fp8(v0[0], v0[1], v0[2], v0[3]); w.y = pk4_fp8(v1[0], v1[1], v1[2], v1[3]);
                    *(u32x2*)(Y + row * D + col0 + 128 * bj) = w;
                }
            }
    }
};

__device__ __forceinline__ void wg_publish(unsigned* cnt, int tid) {
    asm volatile("s_waitcnt vmcnt(0)" ::: "memory");
    __syncthreads();
    if (tid == 0) { __builtin_amdgcn_fence(__ATOMIC_RELEASE, "agent"); asm volatile("s_waitcnt vmcnt(0)" ::: "memory");
        (void)__hip_atomic_fetch_add(cnt, 1u, __ATOMIC_RELAXED, __HIP_MEMORY_SCOPE_AGENT); }
}
__device__ __forceinline__ void wg_wait(unsigned* cnt, unsigned target, int tid) {
    if (tid == 0) { unsigned sp = 0;
        while (__hip_atomic_load(cnt, __ATOMIC_RELAXED, __HIP_MEMORY_SCOPE_AGENT) < target && ++sp < (1u << 22)) __builtin_amdgcn_s_sleep(2);
        __builtin_amdgcn_fence(__ATOMIC_ACQUIRE, "agent"); asm volatile("s_waitcnt vmcnt(0)" ::: "memory"); }
    __syncthreads();
}

__device__ __forceinline__ void transpose_item(const float* W, int K, int N, bf16_t* WT, int k0, int n0, size_t drow0, LAS float* scr, int lane) {
    float tv[32];
#pragma unroll
    for (int i = 0; i < 32; ++i) { const int kk = 2 * i + (lane >> 5); tv[i] = __builtin_nontemporal_load(W + (size_t)(k0 + kk) * N + n0 + (lane & 31)); }
#pragma unroll
    for (int i = 0; i < 32; ++i) { const int kk = 2 * i + (lane >> 5); scr[kk * 33 + (lane & 31)] = tv[i]; }
    asm volatile("s_waitcnt lgkmcnt(0)" ::: "memory");
    const int c = lane & 7;
#pragma unroll
    for (int j = 0; j < 4; ++j) { const int n = (lane >> 3) + 8 * j; const LAS float* s = scr + (8 * c) * 33 + n;
        u32x4 o; o.x = pk2(s[0 * 33], s[1 * 33]); o.y = pk2(s[2 * 33], s[3 * 33]); o.z = pk2(s[4 * 33], s[5 * 33]); o.w = pk2(s[6 * 33], s[7 * 33]);
        *(u32x4*)(WT + (drow0 + n) * (size_t)K + k0 + 8 * c) = o; }
    asm volatile("s_waitcnt lgkmcnt(0)" ::: "memory");
}

__device__ __forceinline__ void transpose_item8(const float* W, int K, int N, unsigned char* WT, int k0, int n0, size_t drow0, float scale, LAS float* scr, int lane) {
    float tv[32];
#pragma unroll
    for (int i = 0; i < 32; ++i) { const int kk = 2 * i + (lane >> 5); tv[i] = __builtin_nontemporal_load(W + (size_t)(k0 + kk) * N + n0 + (lane & 31)); }
#pragma unroll
    for (int i = 0; i < 32; ++i) { const int kk = 2 * i + (lane >> 5); scr[kk * 33 + (lane & 31)] = tv[i] * scale; }
    asm volatile("s_waitcnt lgkmcnt(0)" ::: "memory");
    const int c = lane & 7;
#pragma unroll
    for (int j = 0; j < 4; ++j) { const int n = (lane >> 3) + 8 * j; const LAS float* s = scr + (8 * c) * 33 + n;
        u32x2 o; o.x = pk4_fp8(s[0 * 33], s[1 * 33], s[2 * 33], s[3 * 33]); o.y = pk4_fp8(s[4 * 33], s[5 * 33], s[6 * 33], s[7 * 33]);
        *(u32x2*)(WT + (drow0 + n) * (size_t)K + k0 + 8 * c) = o; }
    asm volatile("s_waitcnt lgkmcnt(0)" ::: "memory");
}

__device__ __forceinline__ void transpose_item8b(const float* W, int N, unsigned char* WTblk, int k0, int n0, int drow0, int kc0, float scale, LAS float* scr, int lane) {
    float tv[32];
#pragma unroll
    for (int i = 0; i < 32; ++i) { const int kk = 2 * i + (lane >> 5); tv[i] = __builtin_nontemporal_load(W + (size_t)(k0 + kk) * N + n0 + (lane & 31)); }
#pragma unroll
    for (int i = 0; i < 32; ++i) { const int kk = 2 * i + (lane >> 5); scr[kk * 33 + (lane & 31)] = tv[i] * scale; }
    asm volatile("s_waitcnt lgkmcnt(0)" ::: "memory");
    const int c = lane & 7;
#pragma unroll
    for (int j = 0; j < 4; ++j) { const int n = (lane >> 3) + 8 * j; const LAS float* s = scr + (8 * c) * 33 + n;
        u32x2 o; o.x = pk4_fp8(s[0 * 33], s[1 * 33], s[2 * 33], s[3 * 33]); o.y = pk4_fp8(s[4 * 33], s[5 * 33], s[6 * 33], s[7 * 33]);
        *(u32x2*)(WTblk + (size_t)(drow0 + n) * 128 + kc0 + 8 * c) = o; }
    asm volatile("s_waitcnt lgkmcnt(0)" ::: "memory");
}

#ifndef PROBE_MASK
#define PROBE_MASK 0
#endif
struct Args { const float* in[28]; float* out; unsigned char* ws; int ph_lo, ph_hi, dbg, pad; };

__device__ __forceinline__ void convert_items(LAS unsigned char* lds, const Args& a, const int kind, const int TID, const int BID, const int GD) {
    const int lane = TID & 63, wave = TID >> 6;
    unsigned char* ws = a.ws;
    LAS float* scr = (LAS float*)(lds + wave * 8704);
    const int gw = BID * NWAVES + wave, NGW = GD * NWAVES;
    const float* w_in = a.in[8]; const float* w_out = a.in[21]; const float* wg = a.in[24]; const float* wu = a.in[25]; const float* wd = a.in[26];
    bf16_t* WinT = (bf16_t*)(ws + WS_WINT); bf16_t* WoutT = (bf16_t*)(ws + WS_WOUTT); unsigned char* WguT = ws + WS_WGUT; unsigned char* WdT = ws + WS_WDT;
    constexpr int I_IN = 16 * 64, I_OUT = 16 * 32, I_GE = 16 * 88, I_G = 16 * I_GE, I_DE = 44 * 32, I_D = 16 * I_DE;
    const int nitems = kind == 0 ? (I_IN + I_OUT) : (kind == 1 ? 2 * I_G : I_D);
    for (int it = gw; it < nitems; it += NGW) {
        int r = it;
        if (kind == 0) {
            if (r < I_IN) { const int kb = r / 64, nb = r % 64, n0 = 32 * nb;
                int drow; if (n0 < 512) drow = (n0 >> 7) * 256 + (n0 & 127); else if (n0 < 1024) drow = ((n0 - 512) >> 7) * 256 + 128 + ((n0 - 512) & 127); else drow = n0;
                transpose_item(w_in, 1024, 2048, WinT, 64 * kb, n0, (size_t)drow, scr, lane); continue; }
            r -= I_IN;
            { const int kb = r / 32, nb = r % 32; transpose_item(w_out, 1024, 1024, WoutT, 64 * kb, 32 * nb, (size_t)(32 * nb), scr, lane); }
        } else if (kind == 1) {
            const int up = r >= I_G; if (up) r -= I_G; const int e = r / I_GE, q = r % I_GE, kb = q / 88, nb = q % 88, n0 = 32 * nb;
            const size_t drow = (size_t)e * 5632 + (size_t)(n0 >> 7) * 256 + (up ? 128 : 0) + (n0 & 127);
            transpose_item8((up ? wu : wg) + (size_t)e * 1024 * DE, 1024, DE, WguT, 64 * kb, n0, drow, 32.0f, scr, lane);
        } else {
            const int e = r / I_DE, q = r % I_DE, kb = q / 32, nb = q % 32;
            const int n0 = 32 * nb, k0 = 64 * kb;
            transpose_item8b(wd + (size_t)e * DE * 1024, 1024, WdT + ((size_t)((e * 4 + (n0 >> 8)) * 22 + (k0 >> 7))) * 32768, k0, n0, n0 & 255, k0 & 127, 64.0f, scr, lane);
        }
    }
}

__device__ __forceinline__ void phase0(LAS unsigned char* lds, const Args& a, const int TID, const int BID, const int GD) {
    const int tid = TID, lane = tid & 63, wave = tid >> 6, G = GD;
    unsigned char* ws = a.ws;
    __syncthreads();
    {
        const float* c = a.in[1]; const float* cctx = a.in[3]; const float* ada_w = a.in[6]; const float* ada_b = a.in[7];
        float* mod = (float*)(ws + WS_MOD); float* modc = mod + 4 * 6144;
        LAS float* sc = (LAS float*)lds;
        LAS float* red = (LAS float*)(lds + 20480);
        for (int grp = BID; grp < 96; grp += G) {
            for (int i = tid; i < 5 * 1024; i += NTHREADS) { const float v = (i < 4096) ? c[i] : cctx[i - 4096]; sc[i] = silu_f(v); }
            __syncthreads();
            const int col = grp * 64 + lane;
            float acc[5] = {0.f, 0.f, 0.f, 0.f, 0.f};
            const int k0 = wave * 128;
#pragma unroll 8
            for (int k = k0; k < k0 + 128; ++k) { const float w = ada_w[(size_t)k * 6144 + col];
#pragma unroll
                for (int v = 0; v < 5; ++v) acc[v] += sc[v * 1024 + k] * w; }
#pragma unroll
            for (int v = 0; v < 5; ++v) red[(wave * 5 + v) * 64 + lane] = acc[v];
            __syncthreads();
            if (tid < 320) { const int v = tid >> 6, l = tid & 63; float s = 0.f;
#pragma unroll
                for (int w = 0; w < 8; ++w) s += red[(w * 5 + v) * 64 + l];
                const int cc = grp * 64 + l; s += ada_b[cc];
                if (v < 4) mod[v * 6144 + cc] = s; else if (cc < 2048) modc[cc] = s; }
            wg_publish((unsigned*)(ws + WS_ADACNT), tid);
            __syncthreads();
        }
    }
    convert_items(lds, a, 0, TID, BID, GD);
}

__device__ __forceinline__ void phase1(const Args& a, const int TID, const int BID, const int GD) {
    const int lane = TID & 63, wave = TID >> 6, G = GD;
    const float* x = a.in[0]; const float* ctx = a.in[2]; const float* g1 = a.in[4];
    const float* mod = (const float*)(a.ws + WS_MOD); const float* modc = mod + 4 * 6144;
    bf16_t* U = (bf16_t*)(a.ws + WS_U);
    f32x4 gg[4];
#pragma unroll
    for (int i = 0; i < 4; ++i) gg[i] = *(const f32x4*)(g1 + 4 * (lane + 64 * i));
    for (int row = BID * NWAVES + wave; row < NROWS; row += G * NWAVES) {
        const float* xr; const float* sh; const float* scl;
        if (row < NTOK) { xr = x + (size_t)row * D; const int b = row >> 13; sh = mod + b * 6144; scl = sh + 1024; }
        else { xr = ctx + (size_t)(row - NTOK) * D; sh = modc; scl = modc + 1024; }
        f32x4 v[4]; float ss = 0.f;
#pragma unroll
        for (int i = 0; i < 4; ++i) { v[i] = *(const f32x4*)(xr + 4 * (lane + 64 * i)); ss += v[i].x * v[i].x + v[i].y * v[i].y + v[i].z * v[i].z + v[i].w * v[i].w; }
        ss = wave_sum(ss);
        const float r = rsqrtf(ss * (1.0f / D) + 1e-6f);
#pragma unroll
        for (int i = 0; i < 4; ++i) {
            const f32x4 s1 = *(const f32x4*)(sh + 4 * (lane + 64 * i)), c1 = *(const f32x4*)(scl + 4 * (lane + 64 * i));
            const f32x4 o = (v[i] * r) * gg[i] * (c1 + 1.0f) + s1;
            u32x2 w; w.x = pk2(o.x, o.y); w.y = pk2(o.z, o.w);
            *(u32x2*)(U + (size_t)row * D + 4 * (lane + 64 * i)) = w;
        }
    }
}

__device__ __forceinline__ void conv_units(LAS unsigned char* lds, const Args& a, int ubeg, int ustride, const int TID, const int BID, const int GD) {
    const int tid = TID, lane = tid & 63, wave = tid >> 6;
    const float* cw = a.in[10]; const float* cb = a.in[11]; const float* lg = a.in[12]; const float* lb = a.in[13];
    const bf16_t* xglu = (const bf16_t*)(a.ws + WS_XGLU); bf16_t* mix = (bf16_t*)(a.ws + WS_MIX);
    LAS float* wts = (LAS float*)lds;
    for (int i = tid; i < 31 * 512; i += NTHREADS) { const int k = i >> 9, ch = i & 511; wts[((k * 2 + ((ch >> 2) & 1)) * 64 + (ch >> 3)) * 4 + (ch & 3)] = cw[i]; }
    __syncthreads();
    const int ch0 = 8 * lane;
    const bool rowc = lane < 32;
    for (int unit = ubeg; unit < NB * 128; unit += ustride) {
        const int b = unit >> 7, r = unit & 127;
        const bf16_t* xb = xglu + (size_t)b * SEQ * 512;
#pragma unroll 1
        for (int p = 0; p < 4; ++p) {
            const int c = p * 16 + 2 * wave;
            float acc[2][8];
#pragma unroll
            for (int j = 0; j < 8; ++j) { const float bj_ = cb[ch0 + j]; acc[0][j] = bj_; acc[1][j] = bj_; }
            u32x4 xv[2][2][8];
#define CONV_LOADS(buf, kb) do { _Pragma("unroll") for (int kk = 0; kk < 8; ++kk) { const int k = (kb) + kk; _Pragma("unroll") for (int tt = 0; tt < 2; ++tt) { xv[buf][tt][kk] = (u32x4){0u, 0u, 0u, 0u}; \
                if (k < 31) { int tok; bool valid; \
                    if (rowc) { const int cc = c + tt + k - 15; valid = (cc >= 0) && (cc < 64); tok = r * 64 + cc; } \
                    else { const int rr = r + k - 15; valid = (rr >= 0) && (rr < 128); tok = rr * 64 + c + tt; } \
                    if (valid) xv[buf][tt][kk] = *(const u32x4*)(xb + (size_t)tok * 512 + ch0); } } } } while (0)
#define CONV_FMAS(buf, kb) do { _Pragma("unroll") for (int kk = 0; kk < 8; ++kk) { const int k = (kb) + kk; if (k < 31) { \
                const f32x4 w0 = *(const LAS f32x4*)(wts + ((k * 2 + 0) * 64 + lane) * 4), w1 = *(const LAS f32x4*)(wts + ((k * 2 + 1) * 64 + lane) * 4); \
                _Pragma("unroll") for (int tt = 0; tt < 2; ++tt) { const u32x4 x4 = xv[buf][tt][kk]; \
                    fma_mix_lo(acc[tt][0], w0.x, x4.x); fma_mix_hi(acc[tt][1], w0.y, x4.x); fma_mix_lo(acc[tt][2], w0.z, x4.y); fma_mix_hi(acc[tt][3], w0.w, x4.y); \
                    fma_mix_lo(acc[tt][4], w1.x, x4.z); fma_mix_hi(acc[tt][5], w1.y, x4.z); fma_mix_lo(acc[tt][6], w1.z, x4.w); fma_mix_hi(acc[tt][7], w1.w, x4.w); } } } } while (0)
            CONV_LOADS(0, 0);
            CONV_LOADS(1, 8);  CONV_FMAS(0, 0);
            CONV_LOADS(0, 16); CONV_FMAS(1, 8);
            CONV_LOADS(1, 24); CONV_FMAS(0, 16);
            CONV_FMAS(1, 24);
#undef CONV_LOADS
#undef CONV_FMAS
#pragma unroll
            for (int tt = 0; tt < 2; ++tt) {
                float s = 0.f;
#pragma unroll
                for (int j = 0; j < 8; ++j) s += acc[tt][j];
                const float mean = wave_sum(s) * (1.0f / 512.0f);
                float q = 0.f;
#pragma unroll
                for (int j = 0; j < 8; ++j) { acc[tt][j] -= mean; q += acc[tt][j] * acc[tt][j]; }
                const float rstd = rsqrtf(wave_sum(q) * (1.0f / 512.0f) + 1e-5f);
                float o[8];
#pragma unroll
                for (int j = 0; j < 8; ++j) { const float y = acc[tt][j] * rstd * lg[ch0 + j] + lb[ch0 + j]; o[j] = silu_f(y); }
                u32x4 w; w.x = pk2(o[0], o[1]); w.y = pk2(o[2], o[3]); w.z = pk2(o[4], o[5]); w.w = pk2(o[6], o[7]);
                *(u32x4*)(mix + (size_t)(b * SEQ + r * 64 + c + tt) * D + ch0) = w;
            }
        }
    }
    __syncthreads();
}

constexpr int L_XT = 0;
constexpr int L_XC = 9216;
constexpr int L_A = L_XC + 2 * 17408;
constexpr int L_U = L_A + 2 * 16384;
constexpr int L_SUB = L_U + 2 * 16384;
constexpr int L_PRE = L_SUB + 8192;
constexpr int L_CIN = L_PRE + 4096;
static_assert(L_CIN + 2 * 17 * 64 * 4 <= 131072, "lru lds");

__device__ __forceinline__ int lru_seq(int d, int i) { return d == 0 ? i : (i < 4 ? 3 - i : NQ - 1 - (i - 4)); }
__device__ __forceinline__ u32x4 lru_load_xt(const bf16_t* xlx, int b, int h, int q, int i) {
    int rowbase, L, chunk;
    if (q < 4) { rowbase = NTOK + b * CTXL; L = CTXL; chunk = q; } else { rowbase = b * SEQ; L = SEQ; chunk = q - 4; }
    const int rr = i >> 3, seg = i & 7, t = chunk * 64 - 3 + rr;
    u32x4 v = (u32x4){0u, 0u, 0u, 0u};
    if (t >= 0 && t < L) v = *(const u32x4*)(xlx + (size_t)(rowbase + t) * 512 + 64 * h + 8 * seg);
    return v;
}
template <int MODE>
__device__ __forceinline__ void lru_phase(LAS unsigned char* lds, const Args& a, const int TID, const int BID, const int GD) {
    const int tid = TID, lane = tid & 63, wave = tid >> 6;
    const float* wa = a.in[16]; const float* wi = a.in[18];
    const bf16_t* xlx = (const bf16_t*)(a.ws + WS_XLX); const bf16_t* glg = (const bf16_t*)(a.ws + WS_GLG); bf16_t* mix = (bf16_t*)(a.ws + WS_MIX);
    f32x2* carry = (f32x2*)(a.ws + WS_CARRY); unsigned* au = (unsigned*)(a.ws + WS_AU);
    const float* conv_w = a.in[14]; const float* conv_b = a.in[15]; const float* ba = a.in[17]; const float* bi = a.in[19]; const float* lam = a.in[20];
    LAS bf16_t* XT = (LAS bf16_t*)(lds + L_XT); LAS float* XC = (LAS float*)(lds + L_XC); LAS float* Aa = (LAS float*)(lds + L_A); LAS float* Uu = (LAS float*)(lds + L_U);
    LAS f32x2* SUB = (LAS f32x2*)(lds + L_SUB); LAS float* PRE = (LAS float*)(lds + L_PRE); LAS float* CIN = (LAS float*)(lds + L_CIN);
    const int l15 = lane & 15, l4 = lane >> 4;
    for (int vb = BID; vb < 256; vb += GD) {
        const int bh = vb >> 3, grp = vb & 7, b = bh >> 3, h = bh & 7;
        int q0, nq;
        if (MODE == 1) { q0 = grp * 17; nq = (NQ - q0) < 17 ? (NQ - q0) : 17; } else { q0 = 4 + grp * 16; nq = 16; }
        const int wd = wave >> 2, mtp = (wave >> 1) & 1, ntp = wave & 1;
        bf16x8 wf[2][2][2];
#pragma unroll
        for (int nn = 0; nn < 2; ++nn)
#pragma unroll
            for (int g = 0; g < 2; ++g)
#pragma unroll
                for (int ks = 0; ks < 2; ++ks) { const float* wp = (g ? wi : wa) + (size_t)((wd * 8 + h) * 64 + 32 * ks + 8 * l4) * 64 + 16 * (ntp * 2 + nn) + l15;
                    u32x4 w; w.x = pk2(wp[0], wp[64]); w.y = pk2(wp[128], wp[192]); w.z = pk2(wp[256], wp[320]); w.w = pk2(wp[384], wp[448]); wf[nn][g][ks] = __builtin_bit_cast(bf16x8, w); }
        float cw[2][4], cbv[2];
        { const int gc = 64 * h + (tid & 63);
#pragma unroll
            for (int d = 0; d < 2; ++d) { cbv[d] = conv_b[d * 512 + gc];
#pragma unroll
                for (int k = 0; k < 4; ++k) cw[d][k] = conv_w[(d * 4 + k) * 512 + gc]; } }
        float bav[2], biv[2], spv[2];
#pragma unroll
        for (int nn = 0; nn < 2; ++nn) { const int gc = 64 * h + 16 * (ntp * 2 + nn) + l15;
            bav[nn] = ba[wd * 512 + gc]; biv[nn] = bi[wd * 512 + gc]; spv[nn] = log1pf(__expf(-lam[wd * 512 + gc])); }
        if (MODE == 2 && tid < 128) {
            const int d = tid >> 6, ch = tid & 63;
            const f32x2* cp = carry + (size_t)((d * NB + b) * NQ) * 512 + 64 * h + ch;
            const int cnt = d == 0 ? q0 : (NQ + 4 - (q0 + nq));
            float s = 0.f;
            for (int i0 = 0; i0 < cnt; i0 += 8) {
                f32x2 c[8];
#pragma unroll
                for (int j = 0; j < 8; ++j) { const int ii = (i0 + j) < cnt ? (i0 + j) : (cnt - 1); c[j] = cp[(size_t)lru_seq(d, ii) * 512]; }
#pragma unroll
                for (int j = 0; j < 8; ++j) if (i0 + j < cnt) s = c[j].x * s + c[j].y;
            }
            f32x2 c[16];
#pragma unroll
            for (int j = 0; j < 16; ++j) c[j] = cp[(size_t)(q0 + j) * 512];
            if (d == 0) {
#pragma unroll
                for (int j = 0; j < 16; ++j) { CIN[(0 * 17 + j) * 64 + ch] = s; s = c[j].x * s + c[j].y; }
            } else {
#pragma unroll
                for (int j = 15; j >= 0; --j) { CIN[(1 * 17 + j) * 64 + ch] = s; s = c[j].x * s + c[j].y; }
            }
        }
        if (MODE == 1 && q0 < 4) {
            if (tid == 0) { unsigned* fl = (unsigned*)(a.ws + WS_CTXFLAG) + 64 * (b * 2 + (h >> 2)); unsigned sp = 0;
                while (__hip_atomic_load(fl, __ATOMIC_RELAXED, __HIP_MEMORY_SCOPE_AGENT) == 0u && ++sp < (1u << 22)) __builtin_amdgcn_s_sleep(2);
                __builtin_amdgcn_fence(__ATOMIC_ACQUIRE, "agent"); asm volatile("s_waitcnt vmcnt(0)" ::: "memory"); }
            __syncthreads();
        }
        u32x4 xr0 = lru_load_xt(xlx, b, h, q0, tid), xr1 = (u32x4){0u, 0u, 0u, 0u};
        if (tid < 48) xr1 = lru_load_xt(xlx, b, h, q0, tid + 512);
#pragma unroll 1
        for (int jc = 0; jc < nq; ++jc) {
            const int q = q0 + jc;
            const size_t rowbase0 = (q < 4) ? (size_t)(NTOK + b * CTXL + q * 64) : (size_t)(b * SEQ + (q - 4) * 64);
            *(LAS u32x4*)(XT + tid * 8) = xr0;
            if (tid < 48) *(LAS u32x4*)(XT + (tid + 512) * 8) = xr1;
            __syncthreads();
            if (jc + 1 < nq) { xr0 = lru_load_xt(xlx, b, h, q + 1, tid); if (tid < 48) xr1 = lru_load_xt(xlx, b, h, q + 1, tid + 512); }
            u32x4 gl = (u32x4){0u, 0u, 0u, 0u};
            if (MODE == 2) gl = *(const u32x4*)(glg + (rowbase0 + (tid >> 3)) * 512 + 64 * h + (tid & 7) * 8);
            { const int ch = tid & 63, tb = tid >> 6;
#pragma unroll
                for (int i = 0; i < 8; ++i) { const int t = tb + 8 * i;
                    const float x0 = bf_lo(XT[(t + 0) * 64 + ch]), x1 = bf_lo(XT[(t + 1) * 64 + ch]), x2 = bf_lo(XT[(t + 2) * 64 + ch]), x3 = bf_lo(XT[(t + 3) * 64 + ch]), x4 = bf_lo(XT[(t + 4) * 64 + ch]), x5 = bf_lo(XT[(t + 5) * 64 + ch]), x6 = bf_lo(XT[(t + 6) * 64 + ch]);
                    XC[t * 68 + ch] = cbv[0] + cw[0][0] * x0 + cw[0][1] * x1 + cw[0][2] * x2 + cw[0][3] * x3;
                    XC[64 * 68 + t * 68 + ch] = cbv[1] + cw[1][3] * x3 + cw[1][2] * x4 + cw[1][1] * x5 + cw[1][0] * x6; } }
            __syncthreads();
#pragma unroll
            for (int mm = 0; mm < 2; ++mm) {
                const int mtl = 2 * mtp + mm;
                bf16x8 af[2];
#pragma unroll
                for (int ks = 0; ks < 2; ++ks) { const LAS float* p = XC + wd * (64 * 68) + (16 * mtl + l15) * 68 + 32 * ks + 8 * l4; const f32x4 p0 = *(const LAS f32x4*)p, p1 = *(const LAS f32x4*)(p + 4);
                    u32x4 w; w.x = pk2(p0.x, p0.y); w.y = pk2(p0.z, p0.w); w.z = pk2(p1.x, p1.y); w.w = pk2(p1.z, p1.w); af[ks] = __builtin_bit_cast(bf16x8, w); }
#pragma unroll
                for (int nn = 0; nn < 2; ++nn) { const int n = 16 * (ntp * 2 + nn) + l15;
                    f32x4 accR = (f32x4){0.f, 0.f, 0.f, 0.f}, accI = (f32x4){0.f, 0.f, 0.f, 0.f};
#pragma unroll
                    for (int ks = 0; ks < 2; ++ks) {
                        accR = __builtin_amdgcn_mfma_f32_16x16x32_bf16(af[ks], wf[nn][0][ks], accR, 0, 0, 0);
                        accI = __builtin_amdgcn_mfma_f32_16x16x32_bf16(af[ks], wf[nn][1][ks], accI, 0, 0, 0);
                    }
#pragma unroll
                    for (int rg = 0; rg < 4; rg += 2) { const int t = 16 * mtl + 4 * l4 + rg;
                        const f32x2 zr = (f32x2){accR[rg], accR[rg + 1]} + bav[nn], zi = (f32x2){accI[rg], accI[rg + 1]} + biv[nn];
                        const f32x2 tr = zr * (-1.4426950408889634f), ti = zi * (-1.4426950408889634f);
                        f32x2 er, ei; er.x = __builtin_amdgcn_exp2f(tr.x); er.y = __builtin_amdgcn_exp2f(tr.y); ei.x = __builtin_amdgcn_exp2f(ti.x); ei.y = __builtin_amdgcn_exp2f(ti.y);
                        const f32x2 dr = er + 1.0f, di = ei + 1.0f;
                        f32x2 rr, ii; rr.x = __builtin_amdgcn_rcpf(dr.x); rr.y = __builtin_amdgcn_rcpf(dr.y); ii.x = __builtin_amdgcn_rcpf(di.x); ii.y = __builtin_amdgcn_rcpf(di.y);
                        const f32x2 la = rr * (-8.0f * spv[nn]);
                        f32x2 oma = -la * (1.0f + 0.5f * la * (1.0f + 0.33333334f * la * (1.0f + 0.25f * la * (1.0f + 0.2f * la))));
                        if (__any(la.x < -0.25f || la.y < -0.25f)) {
                            oma.x = la.x < -0.25f ? 1.0f - __expf(la.x) : oma.x; oma.y = la.y < -0.25f ? 1.0f - __expf(la.y) : oma.y; }
                        const f32x2 om2 = oma * (2.0f - oma);
                        f32x2 mult; mult.x = __builtin_amdgcn_sqrtf(om2.x); mult.y = __builtin_amdgcn_sqrtf(om2.y);
                        const f32x2 xc2 = (f32x2){XC[wd * (64 * 68) + t * 68 + n], XC[wd * (64 * 68) + (t + 1) * 68 + n]};
                        const f32x2 uu = mult * ii * xc2;
                        Aa[wd * 4096 + t * 64 + n] = oma.x; Aa[wd * 4096 + (t + 1) * 64 + n] = oma.y; Uu[wd * 4096 + t * 64 + n] = uu.x; Uu[wd * 4096 + (t + 1) * 64 + n] = uu.y; }
                }
            }
            __syncthreads();
            if (MODE == 1 && q >= 4) {
                const int t = tid >> 3, c8 = (tid & 7) * 8;
#pragma unroll
                for (int d = 0; d < 2; ++d) {
                    const LAS float* ap = Aa + d * 4096 + t * 64 + c8; const LAS float* up = Uu + d * 4096 + t * 64 + c8;
                    const f32x4 a0 = *(const LAS f32x4*)ap, a1 = *(const LAS f32x4*)(ap + 4), u0 = *(const LAS f32x4*)up, u1 = *(const LAS f32x4*)(up + 4);
                    u32x4 w0, w1; w0.x = pk2h(a0.x, u0.x); w0.y = pk2h(a0.y, u0.y); w0.z = pk2h(a0.z, u0.z); w0.w = pk2h(a0.w, u0.w); w1.x = pk2h(a1.x, u1.x); w1.y = pk2h(a1.y, u1.y); w1.z = pk2h(a1.z, u1.z); w1.w = pk2h(a1.w, u1.w);
                    unsigned* dst = au + ((size_t)d * NTOK + rowbase0 + t) * 512 + 64 * h + c8;
                    *(u32x4*)dst = w0; *(u32x4*)(dst + 4) = w1; }
            }
            { float A0 = 1.f, h0 = 0.f, A1 = 1.f, h1 = 0.f;
#pragma unroll
                for (int s2 = 0; s2 < 8; ++s2) { const int p = 8 * wave + s2, t0 = p, t1 = 63 - p;
                    const float a0 = 1.0f - Aa[t0 * 64 + lane], u0 = Uu[t0 * 64 + lane], a1 = 1.0f - Aa[4096 + t1 * 64 + lane], u1 = Uu[4096 + t1 * 64 + lane];
                    h0 = a0 * h0 + u0; A0 *= a0; h1 = a1 * h1 + u1; A1 *= a1; }
                SUB[wave * 64 + lane] = (f32x2){A0, h0}; SUB[512 + wave * 64 + lane] = (f32x2){A1, h1}; }
            __syncthreads();
            if (MODE == 1) {
                if (tid < 128) { const int d = tid >> 6, ch = tid & 63; float Ac = 1.f, hc = 0.f;
#pragma unroll
                    for (int s2 = 0; s2 < 8; ++s2) { const f32x2 c = SUB[d * 512 + s2 * 64 + ch]; hc = c.x * hc + c.y; Ac *= c.x; }
                    carry[(size_t)((d * NB + b) * NQ + q) * 512 + 64 * h + ch] = (f32x2){Ac, hc}; }
            } else {
                if (tid < 128) { const int d = tid >> 6, ch = tid & 63; float s2 = CIN[(d * 17 + jc) * 64 + ch];
#pragma unroll
                    for (int sb = 0; sb < 8; ++sb) { PRE[d * 512 + sb * 64 + ch] = s2; const f32x2 c = SUB[d * 512 + sb * 64 + ch]; s2 = c.x * s2 + c.y; } }
                __syncthreads();
                { float h0 = PRE[wave * 64 + lane], h1 = PRE[512 + wave * 64 + lane];
#pragma unroll
                    for (int s2 = 0; s2 < 8; ++s2) { const int p = 8 * wave + s2, t0 = p, t1 = 63 - p;
                        h0 = (1.0f - Aa[t0 * 64 + lane]) * h0 + Uu[t0 * 64 + lane]; Uu[t0 * 64 + lane] = h0;
                        h1 = (1.0f - Aa[4096 + t1 * 64 + lane]) * h1 + Uu[4096 + t1 * 64 + lane]; Uu[4096 + t1 * 64 + lane] = h1; } }
                __syncthreads();
                { const int t = tid >> 3, c8 = (tid & 7) * 8;
                    const LAS float* u1 = Uu + t * 64 + c8; const LAS float* u2 = Uu + 4096 + t * 64 + c8;
                    const f32x4 f0 = *(const LAS f32x4*)u1, f1 = *(const LAS f32x4*)(u1 + 4), b0 = *(const LAS f32x4*)u2, b1 = *(const LAS f32x4*)(u2 + 4);
                    u32x4 w;
                    w.x = pk2((f0.x + b0.x) * bf_lo(gl.x), (f0.y + b0.y) * bf_hi(gl.x)); w.y = pk2((f0.z + b0.z) * bf_lo(gl.y), (f0.w + b0.w) * bf_hi(gl.y));
                    w.z = pk2((f1.x + b1.x) * bf_lo(gl.z), (f1.y + b1.y) * bf_hi(gl.z)); w.w = pk2((f1.z + b1.z) * bf_lo(gl.w), (f1.w + b1.w) * bf_hi(gl.w));
                    *(u32x4*)(mix + (rowbase0 + t) * D + 512 + 64 * h + c8) = w; }
            }
        }
        if (MODE == 1) wg_publish((unsigned*)(a.ws + WS_BHCNT) + 64 * bh, tid);
        __syncthreads();
    }
}

__device__ __forceinline__ void lru_rescan(LAS unsigned char* lds, const Args& a, const int TID, const int BID, const int GD) {
    const int tid = TID, lane = tid & 63, wave = tid >> 6;
    const unsigned* au = (const unsigned*)(a.ws + WS_AU); const bf16_t* glg = (const bf16_t*)(a.ws + WS_GLG); bf16_t* mix = (bf16_t*)(a.ws + WS_MIX);
    const f32x2* carry = (const f32x2*)(a.ws + WS_CARRY);
    LAS f32x2* SUB = (LAS f32x2*)(lds + L_SUB); LAS float* PRE = (LAS float*)(lds + L_PRE); LAS float* CIN = (LAS float*)(lds + L_CIN);
    for (int vb = BID; vb < 256; vb += GD) {
        const int bh = vb >> 3, grp = vb & 7, b = bh >> 3, h = bh & 7;
        const int q0 = 4 + grp * 16, nq = 16;
        wg_wait((unsigned*)(a.ws + WS_BHCNT) + 64 * bh, 8u * (unsigned)(1 + ((a.dbg >> 11) & 1)), tid);
        if (tid < 128) {
            const int d = tid >> 6, ch = tid & 63;
            const f32x2* cp = carry + (size_t)((d * NB + b) * NQ) * 512 + 64 * h + ch;
            const int cnt = d == 0 ? q0 : (NQ + 4 - (q0 + nq));
            float s = 0.f;
            for (int i0 = 0; i0 < cnt; i0 += 8) {
                f32x2 c[8];
#pragma unroll
                for (int j = 0; j < 8; ++j) { const int ii = (i0 + j) < cnt ? (i0 + j) : (cnt - 1); c[j] = cp[(size_t)lru_seq(d, ii) * 512]; }
#pragma unroll
                for (int j = 0; j < 8; ++j) if (i0 + j < cnt) s = c[j].x * s + c[j].y;
            }
            f32x2 c[16];
#pragma unroll
            for (int j = 0; j < 16; ++j) c[j] = cp[(size_t)(q0 + j) * 512];
            if (d == 0) {
#pragma unroll
                for (int j = 0; j < 16; ++j) { CIN[(0 * 17 + j) * 64 + ch] = s; s = c[j].x * s + c[j].y; }
            } else {
#pragma unroll
                for (int j = 15; j >= 0; --j) { CIN[(1 * 17 + j) * 64 + ch] = s; s = c[j].x * s + c[j].y; }
            }
        }
        __syncthreads();
        const size_t cbase = (size_t)64 * h + lane;
#pragma unroll 1
        for (int jc = 0; jc < nq; ++jc) {
            const size_t row0 = (size_t)b * SEQ + (size_t)(q0 - 4 + jc) * 64 + 8 * wave;
            unsigned pf[8], pb[8]; bf16_t gg[8];
#pragma unroll
            for (int s2 = 0; s2 < 8; ++s2) { pf[s2] = au[(row0 + s2) * 512 + cbase]; pb[s2] = au[((size_t)NTOK + row0 + s2) * 512 + cbase]; gg[s2] = glg[(row0 + s2) * 512 + cbase]; }
            float af[8], uf[8], ab[8], ub[8];
#pragma unroll
            for (int s2 = 0; s2 < 8; ++s2) { const h2_t x = __builtin_bit_cast(h2_t, pf[s2]), y = __builtin_bit_cast(h2_t, pb[s2]);
                af[s2] = 1.0f - (float)x.x; uf[s2] = (float)x.y; ab[s2] = 1.0f - (float)y.x; ub[s2] = (float)y.y; }
            float A0 = 1.f, h0 = 0.f, A1 = 1.f, h1 = 0.f;
#pragma unroll
            for (int s2 = 0; s2 < 8; ++s2) { h0 = af[s2] * h0 + uf[s2]; A0 *= af[s2]; h1 = ab[7 - s2] * h1 + ub[7 - s2]; A1 *= ab[7 - s2]; }
            SUB[wave * 64 + lane] = (f32x2){A0, h0}; SUB[512 + (7 - wave) * 64 + lane] = (f32x2){A1, h1};
            __syncthreads();
            if (tid < 128) { const int d = tid >> 6, ch = tid & 63; float s2 = CIN[(d * 17 + jc) * 64 + ch];
#pragma unroll
                for (int sb = 0; sb < 8; ++sb) { PRE[d * 512 + sb * 64 + ch] = s2; const f32x2 c = SUB[d * 512 + sb * 64 + ch]; s2 = c.x * s2 + c.y; } }
            __syncthreads();
            float hf[8], hb[8];
            { float hc = PRE[wave * 64 + lane];
#pragma unroll
                for (int s2 = 0; s2 < 8; ++s2) { hc = af[s2] * hc + uf[s2]; hf[s2] = hc; }
                hc = PRE[512 + (7 - wave) * 64 + lane];
#pragma unroll
                for (int s2 = 7; s2 >= 0; --s2) { hc = ab[s2] * hc + ub[s2]; hb[s2] = hc; } }
#pragma unroll
            for (int s2 = 0; s2 < 8; ++s2) mix[(row0 + s2) * D + 512 + cbase] = (bf16_t)f2bf((hf[s2] + hb[s2]) * bf_lo(gg[s2]));
        }
        __syncthreads();
    }
}

__device__ __forceinline__ void phase6(LAS unsigned char* lds, const Args& a, const int TID, const int BID, const int GD) {
    const int tid = TID, lane = tid & 63, wave = tid >> 6, G = GD;
    const float* x = a.in[0]; const bf16_t* Mb = (const bf16_t*)(a.ws + WS_M); const float* g2 = a.in[5]; const float* rw = a.in[23];
    const float* mod = (const float*)(a.ws + WS_MOD);
    unsigned char* V = a.ws + WS_V; float* affT = (float*)(a.ws + WS_AFFT); bf16_t* X1b = (bf16_t*)(a.ws + WS_X1B);
    LAS float* rwT = (LAS float*)lds;
    for (int idx = tid; idx < 16384; idx += NTHREADS) rwT[(idx & 15) * 1024 + (idx >> 4)] = rw[idx];
    __syncthreads();
    f32x4 gg[4];
#pragma unroll
    for (int i = 0; i < 4; ++i) gg[i] = *(const f32x4*)(g2 + 4 * (lane + 64 * i));
    for (int row = BID * NWAVES + wave; row < NTOK; row += G * NWAVES) {
        const int b = row >> 13, t = row & (SEQ - 1);
        const float* sh = mod + b * 6144 + 3072; const float* scl = mod + b * 6144 + 4096;
        f32x4 v[4]; float ss = 0.f;
#pragma unroll
        for (int i = 0; i < 4; ++i) { v[i] = *(const f32x4*)(x + (size_t)row * D + 4 * (lane + 64 * i)); const u32x2 mw = *(const u32x2*)(Mb + (size_t)row * D + 4 * (lane + 64 * i));
            v[i].x += bf_lo(mw.x); v[i].y += bf_hi(mw.x); v[i].z += bf_lo(mw.y); v[i].w += bf_hi(mw.y);
            { u32x2 xw; xw.x = pk2(v[i].x, v[i].y); xw.y = pk2(v[i].z, v[i].w); *(u32x2*)(X1b + (size_t)row * D + 4 * (lane + 64 * i)) = xw; }
            ss += v[i].x * v[i].x + v[i].y * v[i].y + v[i].z * v[i].z + v[i].w * v[i].w; }
        ss = wave_sum(ss);
        const float r = rsqrtf(ss * (1.0f / D) + 1e-6f);
#pragma unroll
        for (int i = 0; i < 4; ++i) {
            const f32x4 s1 = *(const f32x4*)(sh + 4 * (lane + 64 * i)), c1 = *(const f32x4*)(scl + 4 * (lane + 64 * i));
            v[i] = (v[i] * r) * gg[i] * (c1 + 1.0f) + s1;
            *(unsigned*)(V + (size_t)row * D + 4 * (lane + 64 * i)) = pk4_fp8(v[i].x, v[i].y, v[i].z, v[i].w);
        }
        float p[16];
#pragma unroll
        for (int e = 0; e < 16; ++e) p[e] = 0.f;
#pragma unroll
        for (int i = 0; i < 4; ++i) {
#pragma unroll
            for (int e = 0; e < 16; ++e) { const f32x4 w = *(const LAS f32x4*)(rwT + e * 1024 + 4 * (lane + 64 * i)); p[e] += v[i].x * w.x + v[i].y * w.y + v[i].z * w.z + v[i].w * w.w; }
            asm volatile("" ::: "memory");
        }
        const bool b5 = (lane & 32) != 0, b4 = (lane & 16) != 0, b3 = (lane & 8) != 0, b2 = (lane & 4) != 0;
        float q8[8], q4[4], q2[2];
#pragma unroll
        for (int j = 0; j < 8; ++j) { const float send = b5 ? p[j] : p[j + 8], keep = b5 ? p[j + 8] : p[j]; q8[j] = keep + __shfl_xor(send, 32); }
#pragma unroll
        for (int j = 0; j < 4; ++j) { const float send = b4 ? q8[j] : q8[j + 4], keep = b4 ? q8[j + 4] : q8[j]; q4[j] = keep + __shfl_xor(send, 16); }
#pragma unroll
        for (int j = 0; j < 2; ++j) { const float send = b3 ? q4[j] : q4[j + 2], keep = b3 ? q4[j + 2] : q4[j]; q2[j] = keep + __shfl_xor(send, 8); }
        float lgt = (b2 ? q2[1] : q2[0]) + __shfl_xor(b2 ? q2[0] : q2[1], 4);
        lgt += __shfl_xor(lgt, 2); lgt += __shfl_xor(lgt, 1);
        float mx = lgt;
        mx = fmaxf(mx, __shfl_xor(mx, 4)); mx = fmaxf(mx, __shfl_xor(mx, 8)); mx = fmaxf(mx, __shfl_xor(mx, 16)); mx = fmaxf(mx, __shfl_xor(mx, 32));
        const float ex = __expf(lgt - mx);
        float den = ex;
        den += __shfl_xor(den, 4); den += __shfl_xor(den, 8); den += __shfl_xor(den, 16); den += __shfl_xor(den, 32);
        if ((lane & 3) == 0) affT[(size_t)(b * 16 + ((lane >> 2) & 15)) * SEQ + t] = ex / den;
    }
    __syncthreads();
}

__device__ __forceinline__ int block_excl_scan(int v, LAS int* wsum, int tid, int& total) {
    const int lane = tid & 63, wave = tid >> 6;
    int inc = v;
#pragma unroll
    for (int o = 1; o < 64; o <<= 1) { const int t = __shfl_up(inc, o); if (lane >= o) inc += t; }
    __syncthreads();
    if (lane == 63) wsum[wave] = inc;
    __syncthreads();
    int base = 0, tot = 0;
#pragma unroll
    for (int w = 0; w < 8; ++w) { const int s = wsum[w]; if (w < wave) base += s; tot += s; }
    total = tot;
    return base + inc - v;
}
__device__ __forceinline__ void phase7(LAS unsigned char* lds, const Args& a, const int TID, const int BID, const int GD) {
    const int tid = TID, lane = tid & 63, wave = tid >> 6, G = GD;
    const float* affT = (const float*)(a.ws + WS_AFFT);
    int* idxE = (int*)(a.ws + WS_IDXE); float* gateE = (float*)(a.ws + WS_GATEE); int* inv = (int*)(a.ws + WS_INV);
    LAS unsigned* hist = (LAS unsigned*)lds;
    LAS unsigned* selw = hist + 256;
    LAS int* wsum = (LAS int*)(hist + 264);
    for (int unit = BID; unit < NB * NE; unit += G) {
        const int b = unit >> 4, e = unit & 15;
        const float* src = affT + (size_t)unit * SEQ + 16 * tid;
        unsigned key[16];
#pragma unroll
        for (int i = 0; i < 4; ++i) { const f32x4 v = *(const f32x4*)(src + 4 * i); const float f0 = v[0], f1 = v[1], f2 = v[2], f3 = v[3]; key[4 * i + 0] = __float_as_uint(f0); key[4 * i + 1] = __float_as_uint(f1); key[4 * i + 2] = __float_as_uint(f2); key[4 * i + 3] = __float_as_uint(f3); }
        unsigned prefix = 0u, mask = 0u, rem = CAP;
#pragma unroll 1
        for (int pass = 0; pass < 4; ++pass) {
            const int shift = 24 - 8 * pass;
            if (tid < 256) hist[tid] = 0u;
            __syncthreads();
#pragma unroll
            for (int j = 0; j < 16; ++j) if ((key[j] & mask) == prefix) __hip_atomic_fetch_add(&hist[(key[j] >> shift) & 255u], 1u, __ATOMIC_RELAXED, __HIP_MEMORY_SCOPE_WORKGROUP);
            __syncthreads();
            if (wave == 0) {
                const unsigned c0 = hist[4 * lane], c1 = hist[4 * lane + 1], c2 = hist[4 * lane + 2], c3 = hist[4 * lane + 3];
                const unsigned s = c0 + c1 + c2 + c3; unsigned v = s;
#pragma unroll
                for (int o = 1; o < 64; o <<= 1) { const unsigned t = __shfl_down(v, o); if (lane + o < 64) v += t; }
                const unsigned above = v - s;
                if (above < rem && rem <= above + s) {
                    unsigned cum = above, bin, nr;
                    if (cum + c3 >= rem) { bin = 4 * lane + 3; nr = rem - cum; }
                    else { cum += c3; if (cum + c2 >= rem) { bin = 4 * lane + 2; nr = rem - cum; }
                        else { cum += c2; if (cum + c1 >= rem) { bin = 4 * lane + 1; nr = rem - cum; } else { cum += c1; bin = 4 * lane; nr = rem - cum; } } }
                    selw[0] = bin; selw[1] = nr;
                }
            }
            __syncthreads();
            prefix |= selw[0] << shift; mask |= 255u << shift; rem = selw[1];
            __syncthreads();
        }
        const unsigned thr = prefix;
        int ceq = 0;
#pragma unroll
        for (int j = 0; j < 16; ++j) ceq += (key[j] == thr) ? 1 : 0;
        int tot; const int eqbase = block_excl_scan(ceq, wsum, tid, tot);
        unsigned selm = 0u; int er = eqbase, cs = 0;
#pragma unroll
        for (int j = 0; j < 16; ++j) { bool s = key[j] > thr; if (key[j] == thr) { s = (unsigned)er < rem; ++er; } if (s) { selm |= 1u << j; ++cs; } }
        int slot = block_excl_scan(cs, wsum, tid, tot);
#pragma unroll
        for (int j = 0; j < 16; ++j) { const int t = 16 * tid + j; const bool s = (selm >> j) & 1u;
            inv[(size_t)(b * SEQ + t) * 16 + e] = s ? slot : -1;
            if (s) { const int ro = e * ROWS_E + b * CAP + slot; idxE[ro] = b * SEQ + t; gateE[ro] = __uint_as_float(key[j]); ++slot; } }
        __syncthreads();
    }
}


__device__ __forceinline__ void phase10(const Args& a, const int TID, const int BID, const int GD) {
    const int lane = TID & 63, wave = TID >> 6;
    float* xo = a.out; const float* fg = a.in[27];
    const float* mod = (const float*)(a.ws + WS_MOD);
    const bf16_t* X1b = (const bf16_t*)(a.ws + WS_X1B);
    const unsigned char* Y = a.ws + WS_WGUT; const int* inv = (const int*)(a.ws + WS_INV);
    f32x4 gg[4];
#pragma unroll
    for (int i = 0; i < 4; ++i) gg[i] = *(const f32x4*)(fg + 4 * (lane + 64 * i));
    const int row0 = BID * NWAVES + wave, rstride = GD * NWAVES;
    int myslot = (row0 < NTOK) ? inv[(size_t)row0 * 16 + (lane & 15)] : -1;
#pragma unroll 1
    for (int row = row0; row < NTOK; row += rstride) {
        const int b = row >> 13;
        const int slot_cur = myslot;
        if (row + rstride < NTOK) myslot = inv[(size_t)(row + rstride) * 16 + (lane & 15)];
        u32x2 xw[4];
#pragma unroll
        for (int i = 0; i < 4; ++i) xw[i] = *(const u32x2*)(X1b + (size_t)row * D + 4 * (lane + 64 * i));
        f32x4 mo[4];
#pragma unroll
        for (int i = 0; i < 4; ++i) mo[i] = (f32x4){0.f, 0.f, 0.f, 0.f};
        unsigned long long bal = __ballot(lane < 16 && slot_cur >= 0);
        while (bal) {
            int ee[4]; const unsigned char* yr[4];
#pragma unroll
            for (int q = 0; q < 4; ++q) { ee[q] = -1; if (bal) { ee[q] = (int)__builtin_ctzll(bal); bal &= bal - 1; } }
#pragma unroll
            for (int q = 0; q < 4; ++q) { const int e = ee[q] < 0 ? 0 : ee[q]; const int sl = __shfl(slot_cur, e); yr[q] = Y + (size_t)(e * ROWS_E + b * CAP + (sl < 0 ? 0 : sl)) * D; }
            unsigned yw[4][4];
#pragma unroll
            for (int q = 0; q < 4; ++q)
#pragma unroll
                for (int i = 0; i < 4; ++i) { yw[q][i] = 0u; if (ee[q] >= 0) yw[q][i] = *(const unsigned*)(yr[q] + 4 * (lane + 64 * i)); }
#pragma unroll
            for (int q = 0; q < 4; ++q)
#pragma unroll
                for (int i = 0; i < 4; ++i) { const f32x2 lo = __builtin_amdgcn_cvt_pk_f32_fp8((int)yw[q][i], false), hi = __builtin_amdgcn_cvt_pk_f32_fp8((int)yw[q][i], true);
                    mo[i].x += lo.x; mo[i].y += lo.y; mo[i].z += hi.x; mo[i].w += hi.y; }
        }
        const float* g5 = mod + b * 6144 + 5120;
        f32x4 v[4]; float ss = 0.f;
#pragma unroll
        for (int i = 0; i < 4; ++i) { const f32x4 g = *(const f32x4*)(g5 + 4 * (lane + 64 * i)) * (1.0f / 32.0f);
            v[i] = (f32x4){bf_lo(xw[i].x), bf_hi(xw[i].x), bf_lo(xw[i].y), bf_hi(xw[i].y)};
            v[i] = v[i] + g * mo[i];
            ss += v[i].x * v[i].x + v[i].y * v[i].y + v[i].z * v[i].z + v[i].w * v[i].w; }
        ss = wave_sum(ss);
        const float r = rsqrtf(ss * (1.0f / D) + 1e-6f);
#pragma unroll
        for (int i = 0; i < 4; ++i) *(f32x4*)(xo + (size_t)row * D + 4 * (lane + 64 * i)) = (v[i] * r) * gg[i];
    }
}

#define XB_TMO      128
#define XB_XCNT(j)  (256  + 64 * (j))
#define XB_XSUB(j)  (1280 + 64 * (j))
#define XB_XGEN(j)  (2304 + 64 * (j))
#define XB_TOP      3328
#define XB_TOPGEN   3392
#define XCD_BAR_WORDS 3456
#define XB_SPIN_CAP (1u << 18)
__device__ __forceinline__ unsigned xb_ld(unsigned* p)              { return __hip_atomic_load(p, __ATOMIC_RELAXED, __HIP_MEMORY_SCOPE_AGENT); }
__device__ __forceinline__ unsigned xb_add(unsigned* p, unsigned v) { return __hip_atomic_fetch_add(p, v, __ATOMIC_RELAXED, __HIP_MEMORY_SCOPE_AGENT); }
__device__ __forceinline__ unsigned xb_xcc_id() { return (unsigned)__builtin_amdgcn_s_getreg((3 << 11) | 20) & 0xFu; }
#define XB_SPIN(cond, bar) do { unsigned _sp = 0; while (cond) { __builtin_amdgcn_s_sleep(1); \
    if ((++_sp & 255u) == 0u) { if (xb_ld(&(bar)[XB_TMO])) break; if (_sp > XB_SPIN_CAP) { atomicAdd(&(bar)[XB_TMO], 1u); break; } } } } while (0)
struct XcdBarrier { unsigned* bar; unsigned x; volatile LAS unsigned* st; };

__device__ __forceinline__ int lane_id_opaque() { unsigned m = ~0u; asm volatile("" : "+s"(m)); return (int)__builtin_amdgcn_mbcnt_hi(m, __builtin_amdgcn_mbcnt_lo(m, 0u)); }
__device__ __forceinline__ XcdBarrier xcd_barrier_post(unsigned* bar, volatile LAS unsigned* st, int tid) {
    XcdBarrier b; b.bar = bar; b.x = xb_xcc_id(); b.st = st;
    if (tid == 0) (void)xb_add(&bar[XB_XCNT(b.x)], 1u);
    return b;
}
__device__ __forceinline__ void xcd_barrier_complete(unsigned* bar, unsigned x, unsigned G, unsigned& nloc, unsigned& nx) {
    unsigned sum, cnt, mine, sp = 0u;
    for (;;) {
        sum = 0u; cnt = 0u; mine = 0u;
#pragma unroll
        for (unsigned j = 0; j < 16; ++j) { const unsigned c = xb_ld(&bar[XB_XCNT(j)]); sum += c; cnt += (c > 0u) ? 1u : 0u; mine = (j == x) ? c : mine; }
        if (sum == G) break;
        __builtin_amdgcn_s_sleep(1);
        if ((++sp & 255u) == 0u) { if (xb_ld(&bar[XB_TMO])) break; if (sp > XB_SPIN_CAP) { atomicAdd(&bar[XB_TMO], 1u); break; } }
    }
    nloc = mine > 0u ? mine : 1u; nx = cnt > 0u ? cnt : 1u;
}
__device__ __forceinline__ void xcd_barrier(const XcdBarrier& b, int tid, unsigned G) {
    asm volatile("s_waitcnt vmcnt(0)" ::: "memory");
    __syncthreads();
    if (tid == 0) {
        unsigned* bar = b.bar;
        __builtin_amdgcn_s_waitcnt(0);
        unsigned nloc = b.st[0], nx = b.st[1];
        if (nloc == 0u) { xcd_barrier_complete(bar, b.x, G, nloc, nx); b.st[0] = nloc; b.st[1] = nx; }
        const unsigned old = xb_add(&bar[XB_XSUB(b.x)], 1u);
        const unsigned gen = old / nloc;
        if (old + 1u == (gen + 1u) * nloc) {
            __builtin_amdgcn_fence(__ATOMIC_RELEASE, "agent");
            asm volatile("s_waitcnt vmcnt(0)" ::: "memory");
            const unsigned og = xb_add(&bar[XB_TOP], 1u);
            const unsigned tg = og / nx;
            if (og + 1u == (tg + 1u) * nx) xb_add(&bar[XB_TOPGEN], 1u);
            else XB_SPIN(xb_ld(&bar[XB_TOPGEN]) == tg, bar);
            __builtin_amdgcn_fence(__ATOMIC_ACQUIRE, "agent");
            xb_add(&bar[XB_XGEN(b.x)], 1u);
            asm volatile("s_waitcnt vmcnt(0)" ::: "memory");
        } else {
            XB_SPIN(xb_ld(&bar[XB_XGEN(b.x)]) == gen, bar);
            __builtin_amdgcn_fence(__ATOMIC_ACQUIRE, "agent");
            asm volatile("s_waitcnt vmcnt(0)" ::: "memory");
        }
    }
    __syncthreads();
}
constexpr int BAR_LDS_OFF = LDS_BYTES - 64;
constexpr size_t WS_BAR = WS_CTL + 16384;

typedef const __attribute__((address_space(4))) Args* ArgsP;
template <int PH>
__device__ __forceinline__ void do_phase(LAS unsigned char* lds, const Args& a_in, const int wave_id_s) {
#if defined(__HIP_DEVICE_COMPILE__)
    ArgsP ap = (ArgsP)__builtin_amdgcn_kernarg_segment_ptr();
    asm volatile("" : "+s"(ap));
    const Args a = *ap;
#else
    const Args a = a_in;
#endif
    const int nrep = 1 + ((a.dbg >> (8 + PH)) & 1);
#pragma unroll 1
    for (int rep = 0; rep < nrep; ++rep) {
        int WID = wave_id_s, BID = blockIdx.x, GD = gridDim.x;
        asm volatile("" : "+s"(WID), "+s"(BID), "+s"(GD));
        const int TID = WID * 64 + lane_id_opaque();
        const int G = GD;
        unsigned char* ws = a.ws;
        if constexpr (PH == 0) { phase0(lds, a, TID, BID, GD); if (rep == nrep - 1) { wg_wait((unsigned*)(ws + WS_ADACNT), 96u * (unsigned)nrep, TID); phase1(a, TID, BID, GD); } }
        else if constexpr (PH == 1) { }
        else if constexpr (PH == 2) {
            if (BID & 1) { convert_items(lds, a, 1, TID, BID, GD); __syncthreads(); }
            pg8::SchedInProj S{G, BID};
            EpiInProj E{(bf16_t*)(ws + WS_XGLU), (bf16_t*)(ws + WS_XLX), (bf16_t*)(ws + WS_GLG), a.in[9]};
            pg8::gemm_phase<EpiInProj, pg8::SchedInProj, false>(lds, (const bf16_t*)(ws + WS_U), (const bf16_t*)(ws + WS_WINT), 1024, S, E, nullptr, TID, BID, GD, 0x7F7F7F7F, pg8::lay_rowmajor(1024));
            if (!(BID & 1)) { __syncthreads(); convert_items(lds, a, 1, TID, BID, GD); }
        } else if constexpr (PH == 3) {
            {
                pg8::SchedCtx S{BID};
                EpiInProj E{(bf16_t*)(ws + WS_XGLU), (bf16_t*)(ws + WS_XLX), (bf16_t*)(ws + WS_GLG), a.in[9]};
                pg8::gemm_phase<EpiInProj, pg8::SchedCtx, false>(lds, (const bf16_t*)(ws + WS_U), (const bf16_t*)(ws + WS_WINT), 1024, S, E, nullptr, TID, BID, GD, 0x7F7F7F7F, pg8::lay_rowmajor(1024));
                if ((BID & 7) == 7 && (BID >> 3) < 8) {
                    asm volatile("s_waitcnt vmcnt(0)" ::: "memory");
                    __syncthreads();
                    if (TID == 0) { __builtin_amdgcn_fence(__ATOMIC_RELEASE, "agent"); asm volatile("s_waitcnt vmcnt(0)" ::: "memory");
                        __hip_atomic_store((unsigned*)(ws + WS_CTXFLAG) + 64 * (BID >> 3), 1u, __ATOMIC_RELAXED, __HIP_MEMORY_SCOPE_AGENT); }
                }
            }
            conv_units(lds, a, BID, G, TID, BID, GD);
            lru_phase<1>(lds, a, TID, BID, GD);
            if (rep == nrep - 1) { __syncthreads(); lru_rescan(lds, a, TID, BID, GD); }
        } else if constexpr (PH == 4) {
        } else if constexpr (PH == 5) {
            pg8::Sched S{128, 4, 1, G, BID};
            EpiOutProj E{(bf16_t*)(ws + WS_M), (const float*)(ws + WS_MOD), a.in[22]};
            pg8::gemm_phase<EpiOutProj, pg8::Sched, false>(lds, (const bf16_t*)(ws + WS_MIX), (const bf16_t*)(ws + WS_WOUTT), 1024, S, E, nullptr, TID, BID, GD, 0x7F7F7F7F, pg8::lay_rowmajor(1024));
        } else if constexpr (PH == 6) phase6(lds, a, TID, BID, GD);
        else if constexpr (PH == 7) phase7(lds, a, TID, BID, GD);
        else if constexpr (PH == 8) {
            if (BID & 1) { convert_items(lds, a, 2, TID, BID, GD); __syncthreads(); }
            pg8::Sched S{16, 22, 16, G, BID};
            EpiExpUp E{ws + WS_R1};
            pg8::gemm_phase<EpiExpUp, pg8::Sched, true, true>(lds, (const bf16_t*)(ws + WS_V), (const bf16_t*)(ws + WS_WGUT), 512, S, E, (const int*)(ws + WS_IDXE), TID, BID, GD, 0x7A7A7A7A, pg8::lay_rowmajor(512));
            if (!(BID & 1)) { __syncthreads(); convert_items(lds, a, 2, TID, BID, GD); }
        } else if constexpr (PH == 9) {
            pg8::SchedDown S{G, BID};
            EpiExpDown E{ws + WS_WGUT, (const float*)(ws + WS_GATEE)};
            pg8::gemm_phase<EpiExpDown, pg8::SchedDown, false, true>(lds, (const bf16_t*)(ws + WS_R1), (const bf16_t*)(ws + WS_WDT), DE / 2, S, E, nullptr, TID, BID, GD, 0x79797979, pg8::lay_blocked(22));
        } else if constexpr (PH == 10) phase10(a, TID, BID, GD);
    }
}
template <int PH, int PH0, int PH1>
__device__ __forceinline__ void run_phases(LAS unsigned char* lds, const Args& a_in, const int wave_id_s) {
    if constexpr (PH < PH1) {
        if constexpr (PH > PH0 && PH != 1 && PH != 4) {
#if defined(__HIP_DEVICE_COMPILE__)
            ArgsP apb = (ArgsP)__builtin_amdgcn_kernarg_segment_ptr(); asm volatile("" : "+s"(apb));
            XcdBarrier xb2; xb2.bar = (unsigned*)(apb->ws + WS_BAR); xb2.x = xb_xcc_id(); xb2.st = (volatile LAS unsigned*)(lds + BAR_LDS_OFF);
            int wv = wave_id_s; asm volatile("" : "+s"(wv));
            xcd_barrier(xb2, wv * 64 + lane_id_opaque(), gridDim.x);
#endif
        }
        do_phase<PH>(lds, a_in, wave_id_s);
        run_phases<PH + 1, PH0, PH1>(lds, a_in, wave_id_s);
    }
}
template <int PH0, int PH1>
__global__ void __launch_bounds__(NTHREADS, 2) hybrid_fwd(Args a_in) {
    extern __shared__ __attribute__((aligned(16))) unsigned char lds_raw[];
    LAS unsigned char* lds = (LAS unsigned char*)lds_raw;
    const int wave_id_s = __builtin_amdgcn_readfirstlane((int)threadIdx.x >> 6);
    {
        volatile LAS unsigned* st = (volatile LAS unsigned*)(lds + BAR_LDS_OFF);
        if (threadIdx.x == 0) { st[0] = 0u; st[1] = 0u; }
        __syncthreads();
        (void)xcd_barrier_post((unsigned*)(a_in.ws + WS_BAR), st, (int)threadIdx.x);
    }
    run_phases<PH0, PH0, PH1>(lds, a_in, wave_id_s);
}

extern "C" void kernel_launch(void* const* d_in, const int* in_sizes, int n_in, void* d_out, int out_size, void* d_ws, size_t ws_size, hipStream_t stream) {
    if (n_in != 28 || out_size != NTOK * D || ws_size < WS_END) { fprintf(stderr, "kernel_launch: unexpected shapes (n_in %d out %d ws %zu)\n", n_in, out_size, ws_size); return; }
    Args a{};
    for (int i = 0; i < 28; ++i) a.in[i] = (const float*)d_in[i];
    a.out = (float*)d_out; a.ws = (unsigned char*)d_ws; a.dbg = PROBE_MASK; a.pad = 0;
    static int grid = 0;
    if (!grid) {
        (void)hipFuncSetAttribute((const void*)hybrid_fwd<0, 11>, hipFuncAttributeMaxDynamicSharedMemorySize, LDS_BYTES);
        int dev = 0, cus = 0, per_cu = 0;
        (void)hipGetDevice(&dev); (void)hipDeviceGetAttribute(&cus, hipDeviceAttributeMultiprocessorCount, dev);
        (void)hipOccupancyMaxActiveBlocksPerMultiprocessor(&per_cu, (const void*)hybrid_fwd<0, 11>, NTHREADS, LDS_BYTES);
        grid = (per_cu >= 1 ? 1 : 0) * cus;
        if (grid != 256) fprintf(stderr, "kernel_launch: grid %d (cus %d per_cu %d)\n", grid, cus, per_cu);
    }
    if (grid <= 0) return;
    a.ph_lo = 0; a.ph_hi = 11;
    (void)hipMemsetAsync((char*)d_ws + WS_CTL, 0, 65536, stream);
    void* kargs[] = {&a};
    hipError_t e = hipLaunchCooperativeKernel((const void*)hybrid_fwd<0, 11>, dim3(grid), dim3(NTHREADS), kargs, LDS_BYTES, stream);
    if (e != hipSuccess) fprintf(stderr, "cooperative launch failed: %s (grid %d)\n", hipGetErrorString(e), grid);
}
```

```cpp
#include <hip/hip_runtime.h>
#include <hip/hip_cooperative_groups.h>
#include <cstdio>
#include <cstdint>

#define LAS __attribute__((address_space(3)))
typedef unsigned short bf16_t;
typedef short bf16x8 __attribute__((ext_vector_type(8)));
typedef float f32x4 __attribute__((ext_vector_type(4)));
typedef float f32x2 __attribute__((ext_vector_type(2)));
typedef unsigned u32x4 __attribute__((ext_vector_type(4)));
typedef unsigned u32x2 __attribute__((ext_vector_type(2)));
typedef int v4i_t __attribute__((ext_vector_type(4)));
typedef _Float16 h2_t __attribute__((ext_vector_type(2)));
typedef int v8i_t __attribute__((ext_vector_type(8)));

constexpr int D = 1024, NB = 4, SEQ = 8192, NTOK = NB * SEQ, CTXL = 256, NCTX = NB * CTXL, NROWS = NTOK + NCTX;
constexpr int DE = 2816, NE = 16, CAP = 1024, ROWS_E = NB * CAP;
constexpr int NQ = 132;
constexpr int NWAVES = 8, NTHREADS = 512;

constexpr size_t MiB = 1u << 20;
constexpr size_t WS_CTL = 0, CTL_BYTES = 1 * MiB;
constexpr size_t WS_CTXFLAG = WS_CTL + 40960;
constexpr size_t WS_ADACNT = WS_CTL + 45056;
constexpr size_t WS_BHCNT = WS_CTL + 49152;
constexpr size_t WS_MOD = 1 * MiB;
constexpr size_t WS_CARRY = 2 * MiB;
constexpr size_t WS_AFFT = 7 * MiB;
constexpr size_t WS_IDXE = 9 * MiB;
constexpr size_t WS_GATEE = WS_IDXE + 256 * 1024;
constexpr size_t WS_INV = WS_GATEE + 256 * 1024;
constexpr size_t WS_WINT = 12 * MiB;
constexpr size_t WS_WOUTT = 16 * MiB;
constexpr size_t WS_WGUT = 18 * MiB;
constexpr size_t WS_WDT = 146 * MiB;
constexpr size_t WS_V = 190 * MiB;
constexpr size_t WS_R1 = 222 * MiB;
constexpr size_t WS_U = WS_R1;
constexpr size_t WS_XGLU = WS_R1 + 66 * MiB;
constexpr size_t WS_XLX = WS_R1 + 98 * MiB;
constexpr size_t WS_GLG = WS_R1 + 131 * MiB;
constexpr size_t WS_MIX = WS_R1 + 163 * MiB;
constexpr size_t WS_M = WS_R1 + 227 * MiB;
constexpr size_t WS_X1B = WS_R1 + 291 * MiB;
constexpr size_t WS_AU = WS_R1 + 291 * MiB;
constexpr size_t WS_END = 641 * MiB;
constexpr int LDS_BYTES = 147456;

__device__ __forceinline__ unsigned f2bf(float f) { unsigned u = __builtin_bit_cast(unsigned, f); return (u + 0x7fffu + ((u >> 16) & 1u)) >> 16; }
__device__ __forceinline__ unsigned pk2(float lo, float hi) { return f2bf(lo) | (f2bf(hi) << 16); }
__device__ __forceinline__ unsigned pk2h(float lo, float hi) { h2_t p; p.x = (_Float16)lo; p.y = (_Float16)hi; return __builtin_bit_cast(unsigned, p); }
__device__ __forceinline__ void fma_mix_lo(float& acc, float w, unsigned xh) { asm("v_fma_mix_f32 %0, %1, %2, %0 op_sel_hi:[0,1,0]" : "+v"(acc) : "v"(w), "v"(xh)); }
__device__ __forceinline__ void fma_mix_hi(float& acc, float w, unsigned xh) { asm("v_fma_mix_f32 %0, %1, %2, %0 op_sel:[0,1,0] op_sel_hi:[0,1,0]" : "+v"(acc) : "v"(w), "v"(xh)); }
__device__ __forceinline__ float bf_lo(unsigned w) { return __builtin_bit_cast(float, w << 16); }
__device__ __forceinline__ float bf_hi(unsigned w) { return __builtin_bit_cast(float, w & 0xffff0000u); }
__device__ __forceinline__ unsigned pk4_fp8(float a, float b, float c, float d) {
    a = __builtin_amdgcn_fmed3f(a, -448.f, 448.f); b = __builtin_amdgcn_fmed3f(b, -448.f, 448.f); c = __builtin_amdgcn_fmed3f(c, -448.f, 448.f); d = __builtin_amdgcn_fmed3f(d, -448.f, 448.f);
    int w = 0; w = __builtin_amdgcn_cvt_pk_fp8_f32(a, b, w, false); w = __builtin_amdgcn_cvt_pk_fp8_f32(c, d, w, true); return (unsigned)w; }
__device__ __forceinline__ float wave_sum(float v) {
#pragma unroll
    for (int o = 32; o >= 1; o >>= 1) v += __shfl_xor(v, o);
    return v;
}
__device__ __forceinline__ float wave_max(float v) {
#pragma unroll
    for (int o = 32; o >= 1; o >>= 1) v = fmaxf(v, __shfl_xor(v, o));
    return v;
}
__device__ __forceinline__ float sigm(float x) { return __builtin_amdgcn_rcpf(1.0f + __expf(-x)); }
__device__ __forceinline__ float silu_f(float x) { return x * sigm(x); }
__device__ __forceinline__ float gelu_tanh(float x) { const float z = 0.7978845608028654f * (x + 0.044715f * x * x * x); return x * sigm(2.0f * z); }

namespace pg8 {
constexpr int BM = 256, BK = 64, HALF = 128, HTB = HALF * BK * 2, STAGE_BYTES = 8 * HTB, NXCD = 8, WGM = 8;
__device__ __forceinline__ int lds_byte(int r, int c) { const int st = (r >> 4) * 2 + (c >> 5), rr = r & 15, cc = c & 31, ob = rr * 64 + cc * 2; return st * 1024 + (ob ^ (((ob >> 9) & 1) << 5)); }
__device__ __forceinline__ void stage_rc(int b, int& R, int& C) { const int st = b / 1024, sb = b % 1024, swz = sb ^ (((sb >> 9) & 1) << 5); R = (st >> 1) * 16 + swz / 64; C = (st & 1) * 32 + (swz % 64) / 2; }
__device__ __forceinline__ int perm32(int rho) { const int n = rho >> 4, i = rho & 15; return 8 * (i >> 2) + 4 * n + (i & 3); }
struct Unit { int pm, pn; };
struct Lay { unsigned rowA, rowB; size_t kstepA, kstepB, hstepB, tstepA, tstepB; };
__device__ __forceinline__ Lay lay_rowmajor(int K) { Lay l; l.rowA = l.rowB = (unsigned)K * 2u; l.kstepA = l.kstepB = 128; l.hstepB = (size_t)128 * K * 2; l.tstepA = l.tstepB = (size_t)256 * K * 2; return l; }
__device__ __forceinline__ Lay lay_blocked(int nkt) { Lay l; l.rowA = l.rowB = 128u; l.kstepA = l.kstepB = 32768; l.hstepB = 16384; l.tstepA = l.tstepB = (size_t)nkt * 32768; return l; }

__device__ __forceinline__ void tile_order(int w, int nM, int nN, int& pm, int& pn) {
    const int nwg = nM * nN;
    int wgid = w; { const int q = nwg / NXCD, r = nwg % NXCD, xcd = wgid % NXCD, off = wgid / NXCD; wgid = (xcd < r ? xcd * (q + 1) : r * (q + 1) + (xcd - r) * q) + off; }
    const int nig = WGM * nN, gid = wgid / nig, fm = gid * WGM, gsz = (nM - fm) < WGM ? (nM - fm) : WGM;
    pm = fm + ((wgid % nig) % gsz); pn = (wgid % nig) / gsz;
}
struct Sched {
    int nM, nN, ngroups, G, c;
    __device__ __forceinline__ bool next(int i, Unit& u) const {
        const int per = nM * nN; const long L = (long)i * G + c; if (L >= (long)per * ngroups) return false;
        const int e = (int)(L / per), w = (int)(L % per); int pm, pn; tile_order(w, nM, nN, pm, pn);
        u.pm = e * nM + pm; u.pn = e * nN + pn; return true;
    }
};
struct SchedInProj {
    int G, c;
    __device__ __forceinline__ bool next(int i, Unit& u) const {
        const long L = (long)i * G + c; if (L >= 1024) return false;
        int pm, pn; tile_order((int)L, 128, 8, pm, pn); u.pm = pm; u.pn = pn; return true;
    }
};
struct SchedCtx {
    int c;
    __device__ __forceinline__ bool next(int i, Unit& u) const {
        if (i != 0 || (c & 7) != 7 || (c >> 3) >= 8) return false;
        const int k = c >> 3; u.pm = 128 + (k >> 1); u.pn = 4 + (k & 1); return true;
    }
};
struct SchedDown {
    int G, c;
    __device__ __forceinline__ bool next(int i, Unit& u) const {
        if (G != 256) { const long L = (long)i * G + c; if (L >= 1024) return false; const int e = (int)(L >> 6), w = (int)(L & 63); u.pm = e * 16 + (w >> 2); u.pn = e * 4 + (w & 3); return true; }
        if (i >= 4) return false;
        const int x = c & 7, j = c >> 3, e = 4 * i + (x >> 1);
        u.pm = e * 16 + 8 * (x & 1) + (j & 7); u.pn = e * 4 + (j >> 3); return true;
    }
};
template <class Epi, class SchedT, bool GATHER, bool FP8 = false, bool SP2 = true, bool ALIGN_EPI = true>
__device__ __forceinline__ void gemm_phase(LAS unsigned char* lds, const bf16_t* Ag, const bf16_t* Btg, const int K, const SchedT& S, const Epi& E, const int* gidx, const int TID, const int BID, const int GD, const int scaleB, const Lay L) {
    const int tid = TID, wid = __builtin_amdgcn_readfirstlane(tid >> 6), lane = tid & 63, wr = wid >> 2, wc = wid & 3, fr = lane & 15, fq = lane >> 4;
    const int nt = K / BK;
    int Rr[2], Cc[2]; unsigned voffB[2];
#pragma unroll
    for (int i = 0; i < 2; ++i) { stage_rc(tid * 16 + i * 8192, Rr[i], Cc[i]); const int Rb = Epi::PERM ? ((Rr[i] & ~31) + perm32(Rr[i] & 31)) : Rr[i]; voffB[i] = (unsigned)Rb * L.rowB + (unsigned)Cc[i] * 2u; }
    const size_t kstepA = L.kstepA, kstepB = L.kstepB, hstep = L.hstepB, tstepA = L.tstepA, tstepB = L.tstepB;
    const unsigned ldsw = (unsigned)wid * 1024u;
    const int aoff = lds_byte(wr * 64 + fr, fq * 8), boff = lds_byte(wc * 32 + fr, fq * 8);
    const int aoff8_0 = aoff, aoff8_1 = aoff + 1024, boff8_0 = boff, boff8_1 = boff + 1024;
#define PG8_SA(b, h) (((b) * 2 + (h)) * HTB)
#define PG8_SB(b, h) ((4 + (b) * 2 + (h)) * HTB)
#define PG8_STAGE(bufoff, gbase, voff) do { _Pragma("unroll") for (int _i = 0; _i < 2; ++_i) \
        __builtin_amdgcn_global_load_lds((const unsigned*)((const char*)(gbase) + (voff)[_i]), (LAS unsigned*)(lds + (bufoff) + ldsw + _i * 8192), 16, 0, 0); } while (0)
#define PG8_LD8(p0, p1) __builtin_shufflevector(*(const LAS v4i_t*)(p0), *(const LAS v4i_t*)(p1), 0, 1, 2, 3, 4, 5, 6, 7)
#define PG8_LDA(dst, b, h) do { _Pragma("unroll") for (int m = 0; m < 4; ++m) { if constexpr (FP8) { \
        dst##8[m] = PG8_LD8(lds + PG8_SA(b, h) + aoff8_0 + m * 2048, lds + PG8_SA(b, h) + aoff8_1 + m * 2048); } else { \
        _Pragma("unroll") for (int k = 0; k < 2; ++k) dst[m][k] = *(const LAS bf16x8*)(lds + PG8_SA(b, h) + aoff + m * 2048 + k * 1024); } } } while (0)
#define PG8_LDB(dst, b, h) do { _Pragma("unroll") for (int n = 0; n < 2; ++n) { if constexpr (FP8) { \
        dst##8[n] = PG8_LD8(lds + PG8_SB(b, h) + boff8_0 + n * 2048, lds + PG8_SB(b, h) + boff8_1 + n * 2048); } else { \
        _Pragma("unroll") for (int k = 0; k < 2; ++k) dst[n][k] = *(const LAS bf16x8*)(lds + PG8_SB(b, h) + boff + n * 2048 + k * 1024); } } } while (0)
#define PG8_MMA(ai, bj, At, Bt) do { if constexpr (FP8) __builtin_amdgcn_sched_barrier(0); __builtin_amdgcn_s_setprio(1); _Pragma("unroll") for (int m = 0; m < 4; ++m) _Pragma("unroll") for (int n = 0; n < 2; ++n) { if constexpr (FP8) { \
        acc[ai][bj][m][n] = __builtin_amdgcn_mfma_scale_f32_16x16x128_f8f6f4(Bt##8[n], At##8[m], acc[ai][bj][m][n], 0, 0, 0, scaleB, 0, 0x7F7F7F7F); } else { \
        _Pragma("unroll") for (int k = 0; k < 2; ++k) acc[ai][bj][m][n] = __builtin_amdgcn_mfma_f32_16x16x32_bf16(Bt[n][k], At[m][k], acc[ai][bj][m][n], 0, 0, 0); } } \
        if constexpr (FP8) { _Pragma("unroll") for (int m = 0; m < 4; ++m) _Pragma("unroll") for (int n = 0; n < 2; ++n) asm volatile("" : "+v"(acc[ai][bj][m][n])); } \
        __builtin_amdgcn_s_setprio(0); if constexpr (FP8) __builtin_amdgcn_sched_barrier(0); } while (0)
#define PG8_WAIT_V(n) asm volatile("s_waitcnt vmcnt(" #n ")" ::: "memory")
#define PG8_WAIT_L(n) asm volatile("s_waitcnt lgkmcnt(" #n ")" ::: "memory")
#define PG8_BAR __builtin_amdgcn_s_barrier()
#define PG8_SCHED __builtin_amdgcn_sched_barrier(0)
#define PG8_LOADV(dst, u) do { _Pragma("unroll") for (int _h = 0; _h < 2; ++_h) _Pragma("unroll") for (int _i = 0; _i < 2; ++_i) \
        dst[_h][_i] = GATHER ? ((unsigned)gidx[(u).pm * BM + _h * HALF + Rr[_i]] * L.rowA + (unsigned)Cc[_i] * 2u) : ((unsigned)(_h * HALF + Rr[_i]) * L.rowA + (unsigned)Cc[_i] * 2u); } while (0)
    Unit cur, nxt; int ui = 0;
    if (!S.next(0, cur)) return;
    f32x4 acc[2][2][4][2];
#pragma unroll
    for (int a = 0; a < 2; ++a)
#pragma unroll
        for (int b = 0; b < 2; ++b)
#pragma unroll
            for (int m = 0; m < 4; ++m)
#pragma unroll
                for (int n = 0; n < 2; ++n) acc[a][b][m][n] = (f32x4){0.f, 0.f, 0.f, 0.f};
    bf16x8 At[4][2], B0[2][2], B1[2][2];
    v8i_t At8[4], B08[2], B18[2];
    unsigned vc[2][2], vn[2][2];
    PG8_LOADV(vc, cur);
    const char* cA = GATHER ? (const char*)Ag : (const char*)Ag + (size_t)cur.pm * tstepA;
    const char* cB = (const char*)Btg + (size_t)cur.pn * tstepB;
    if constexpr (SP2) {
        PG8_STAGE(PG8_SB(0, 0), cB, voffB); PG8_STAGE(PG8_SB(0, 1), cB + hstep, voffB); PG8_STAGE(PG8_SA(0, 0), cA, vc[0]); PG8_STAGE(PG8_SA(0, 1), cA, vc[1]);
        if (wr == 1) PG8_BAR;
        PG8_WAIT_V(2); PG8_BAR;
        PG8_STAGE(PG8_SB(1, 0), cB + kstepB, voffB); PG8_STAGE(PG8_SA(1, 0), cA + kstepA, vc[0]); PG8_STAGE(PG8_SB(1, 1), cB + hstep + kstepB, voffB);
        PG8_WAIT_V(6); PG8_BAR;
    } else {
    PG8_STAGE(PG8_SB(0, 0), cB, voffB); PG8_STAGE(PG8_SA(0, 0), cA, vc[0]); PG8_STAGE(PG8_SB(0, 1), cB + hstep, voffB); PG8_STAGE(PG8_SA(0, 1), cA, vc[1]);
    if (wr == 1) PG8_BAR;
    PG8_WAIT_V(4); PG8_BAR;
    PG8_STAGE(PG8_SB(1, 0), cB + kstepB, voffB); PG8_STAGE(PG8_SA(1, 0), cA + kstepA, vc[0]); PG8_STAGE(PG8_SB(1, 1), cB + hstep + kstepB, voffB);
    PG8_WAIT_V(6); PG8_BAR;
    }
    for (;;) {
        const bool has_next = S.next(ui + 1, nxt);
        const char* nA = cA; const char* nB = cB;
        if (has_next) { nA = GATHER ? (const char*)Ag : (const char*)Ag + (size_t)nxt.pm * tstepA; nB = (const char*)Btg + (size_t)nxt.pn * tstepB; PG8_LOADV(vn, nxt); }
        else {
#pragma unroll
            for (int h = 0; h < 2; ++h)
#pragma unroll
                for (int i = 0; i < 2; ++i) vn[h][i] = vc[h][i];
        }
        for (int t = 0; t < nt; t += 2) {
            const bool last = (t == nt - 2);
            const char* a1 = cA + (size_t)(t + 1) * kstepA;
            const char* a2 = last ? nA : cA + (size_t)(t + 2) * kstepA; const char* b2 = last ? nB : cB + (size_t)(t + 2) * kstepB;
            const char* a3 = a2 + kstepA; const char* b3 = b2 + kstepB;
#pragma unroll
            for (int i = 0; i < 2; ++i) vc[0][i] = last ? vn[0][i] : vc[0][i];
            if constexpr (SP2) {
            PG8_LDB(B0, 0, 0); PG8_LDB(B1, 0, 1); PG8_SCHED; PG8_LDA(At, 0, 0); PG8_STAGE(PG8_SA(1, 1), a1, vc[1]);
            _Pragma("unroll") for (int i = 0; i < 2; ++i) vc[1][i] = last ? vn[1][i] : vc[1][i];
            PG8_WAIT_V(8); PG8_WAIT_L(0); PG8_BAR; PG8_MMA(0, 0, At, B0); PG8_MMA(0, 1, At, B1); PG8_BAR; PG8_SCHED;
            PG8_LDA(At, 0, 1); PG8_STAGE(PG8_SB(0, 0), b2, voffB); PG8_STAGE(PG8_SB(0, 1), b2 + hstep, voffB); PG8_STAGE(PG8_SA(0, 0), a2, vc[0]);
            PG8_WAIT_V(8); PG8_WAIT_L(0); PG8_BAR; PG8_MMA(1, 0, At, B0); PG8_MMA(1, 1, At, B1); PG8_BAR; PG8_SCHED;
            PG8_LDB(B0, 1, 0); PG8_LDB(B1, 1, 1); PG8_SCHED; PG8_LDA(At, 1, 0); PG8_STAGE(PG8_SA(0, 1), a2, vc[1]);
            PG8_WAIT_V(8); PG8_WAIT_L(0); PG8_BAR; PG8_MMA(0, 0, At, B0); PG8_MMA(0, 1, At, B1); PG8_BAR; PG8_SCHED;
            PG8_LDA(At, 1, 1); PG8_STAGE(PG8_SB(1, 0), b3, voffB); PG8_STAGE(PG8_SB(1, 1), b3 + hstep, voffB); PG8_STAGE(PG8_SA(1, 0), a3, vc[0]);
            PG8_WAIT_V(8); PG8_WAIT_L(0); PG8_BAR; PG8_MMA(1, 0, At, B0); PG8_MMA(1, 1, At, B1); PG8_BAR; PG8_SCHED;
            } else {
            PG8_LDB(B0, 0, 0); PG8_SCHED; PG8_LDA(At, 0, 0); PG8_STAGE(PG8_SA(1, 1), a1, vc[1]);
            _Pragma("unroll") for (int i = 0; i < 2; ++i) vc[1][i] = last ? vn[1][i] : vc[1][i];
            PG8_WAIT_L(8); PG8_BAR; PG8_WAIT_L(0); PG8_MMA(0, 0, At, B0); PG8_BAR; PG8_SCHED;
            PG8_LDB(B1, 0, 1); PG8_STAGE(PG8_SB(0, 0), b2, voffB);
            PG8_BAR; PG8_WAIT_L(0); PG8_MMA(0, 1, At, B1); PG8_BAR;
            PG8_LDA(At, 0, 1); PG8_STAGE(PG8_SA(0, 0), a2, vc[0]);
            PG8_BAR; PG8_WAIT_L(0); PG8_MMA(1, 0, At, B0); PG8_BAR; PG8_SCHED;
            PG8_STAGE(PG8_SB(0, 1), b2 + hstep, voffB);
            PG8_WAIT_V(6); PG8_BAR; PG8_MMA(1, 1, At, B1); PG8_BAR;
            PG8_LDB(B0, 1, 0); PG8_SCHED; PG8_LDA(At, 1, 0); PG8_STAGE(PG8_SA(0, 1), a2, vc[1]);
            PG8_WAIT_L(8); PG8_BAR; PG8_WAIT_L(0); PG8_MMA(0, 0, At, B0); PG8_BAR; PG8_SCHED;
            PG8_LDB(B1, 1, 1); PG8_STAGE(PG8_SB(1, 0), b3, voffB);
            PG8_BAR; PG8_WAIT_L(0); PG8_MMA(0, 1, At, B1); PG8_BAR;
            PG8_LDA(At, 1, 1); PG8_STAGE(PG8_SA(1, 0), a3, vc[0]);
            PG8_BAR; PG8_WAIT_L(0); PG8_MMA(1, 0, At, B0); PG8_BAR; PG8_SCHED;
            PG8_STAGE(PG8_SB(1, 1), b3 + hstep, voffB);
            PG8_WAIT_V(6); PG8_BAR; PG8_MMA(1, 1, At, B1); PG8_BAR;
            }
        }
        if constexpr (ALIGN_EPI) { if (wr == 0) PG8_BAR; }
        E(acc, cur, wr, wc, fr, fq);
        if (!has_next) break;
#pragma unroll
        for (int a = 0; a < 2; ++a)
#pragma unroll
            for (int b = 0; b < 2; ++b)
#pragma unroll
                for (int m = 0; m < 4; ++m)
#pragma unroll
                    for (int n = 0; n < 2; ++n) acc[a][b][m][n] = (f32x4){0.f, 0.f, 0.f, 0.f};
        cur = nxt; cA = nA; cB = nB; ++ui;
#pragma unroll
        for (int h = 0; h < 2; ++h)
#pragma unroll
            for (int i = 0; i < 2; ++i) vc[h][i] = vn[h][i];
        if constexpr (ALIGN_EPI) { if (wr == 1) PG8_BAR; }
    }
    PG8_WAIT_V(0);
    if constexpr (!ALIGN_EPI) { if (wr == 0) PG8_BAR; }
    PG8_BAR;
#undef PG8_SA
#undef PG8_SB
#undef PG8_STAGE
#undef PG8_LDA
#undef PG8_LDB
#undef PG8_MMA
#undef PG8_LD8
#undef PG8_WAIT_V
#undef PG8_WAIT_L
#undef PG8_BAR
#undef PG8_SCHED
#undef PG8_LOADV
}
}

struct EpiInProj {
    static constexpr bool PERM = true;
    bf16_t* xglu; bf16_t* xlx; bf16_t* glg; const float* b_in;
    __device__ __forceinline__ void operator()(const f32x4 (&acc)[2][2][4][2], const pg8::Unit& u, int wr, int wc, int fr, int fq) const {
        const int row0 = u.pm * 256 + wr * 64 + fr, cl = wc * 32 + 8 * fq;
        if (u.pn < 4) {
            const int col = 128 * u.pn + cl;
            f32x4 bv[2][2];
#pragma unroll
            for (int n = 0; n < 2; ++n) { bv[0][n] = *(const f32x4*)(b_in + col + 4 * n); bv[1][n] = *(const f32x4*)(b_in + 512 + col + 4 * n); }
#pragma unroll
            for (int ai = 0; ai < 2; ++ai)
#pragma unroll
                for (int m = 0; m < 4; ++m) {
                    const size_t row = (size_t)(row0 + ai * 128 + m * 16);
                    float o[8];
#pragma unroll
                    for (int n = 0; n < 2; ++n) { const f32x4 v = acc[ai][0][m][n] + bv[0][n], g = acc[ai][1][m][n] + bv[1][n];
#pragma unroll
                        for (int j = 0; j < 4; ++j) o[4 * n + j] = v[j] * sigm(g[j]); }
                    u32x4 w; w.x = pk2h(o[0], o[1]); w.y = pk2h(o[2], o[3]); w.z = pk2h(o[4], o[5]); w.w = pk2h(o[6], o[7]);
                    *(u32x4*)(xglu + row * 512 + col) = w;
                }
        } else {
            const bool isg = u.pn >= 6;
            const int cbase = 256 * (u.pn - (isg ? 6 : 4));
            const float* bias = b_in + (isg ? 1536 : 1024) + cbase;
            bf16_t* outp = isg ? glg : xlx;
#pragma unroll
            for (int bj = 0; bj < 2; ++bj) {
                const int col = 128 * bj + cl;
                const f32x4 b0 = *(const f32x4*)(bias + col), b1 = *(const f32x4*)(bias + col + 4);
#pragma unroll
                for (int ai = 0; ai < 2; ++ai)
#pragma unroll
                    for (int m = 0; m < 4; ++m) {
                        const size_t row = (size_t)(row0 + ai * 128 + m * 16);
                        f32x4 v0 = acc[ai][bj][m][0] + b0, v1 = acc[ai][bj][m][1] + b1;
                        if (isg) {
#pragma unroll
                            for (int j = 0; j < 4; ++j) { v0[j] = gelu_tanh(v0[j]); v1[j] = gelu_tanh(v1[j]); }
                        }
                        u32x4 w; w.x = pk2(v0[0], v0[1]); w.y = pk2(v0[2], v0[3]); w.z = pk2(v1[0], v1[1]); w.w = pk2(v1[2], v1[3]);
                        *(u32x4*)(outp + row * 512 + cbase + col) = w;
                    }
            }
        }
    }
};
struct EpiOutProj {
    static constexpr bool PERM = true;
    bf16_t* M; const float* mod; const float* b_out;
    __device__ __forceinline__ void operator()(const f32x4 (&acc)[2][2][4][2], const pg8::Unit& u, int wr, int wc, int fr, int fq) const {
        const int row0 = u.pm * 256 + wr * 64 + fr, col0 = u.pn * 256 + wc * 32 + 8 * fq;
        const int b = u.pm >> 5;
        const float* g1 = mod + b * 6144 + 2048;
#pragma unroll
        for (int bj = 0; bj < 2; ++bj) {
            const int col = col0 + bj * 128;
            const f32x4 bo0 = *(const f32x4*)(b_out + col), bo1 = *(const f32x4*)(b_out + col + 4), gg0 = *(const f32x4*)(g1 + col), gg1 = *(const f32x4*)(g1 + col + 4);
#pragma unroll
            for (int ai = 0; ai < 2; ++ai)
#pragma unroll
                for (int m = 0; m < 4; ++m) {
                    const f32x4 v0 = gg0 * (acc[ai][bj][m][0] + bo0), v1 = gg1 * (acc[ai][bj][m][1] + bo1);
                    u32x4 w; w.x = pk2(v0[0], v0[1]); w.y = pk2(v0[2], v0[3]); w.z = pk2(v1[0], v1[1]); w.w = pk2(v1[2], v1[3]);
                    *(u32x4*)(M + (size_t)(row0 + ai * 128 + m * 16) * D + col) = w;
                }
        }
    }
};
struct EpiExpUp {
    static constexpr bool PERM = true;
    unsigned char* H;
    __device__ __forceinline__ void operator()(const f32x4 (&acc)[2][2][4][2], const pg8::Unit& u, int wr, int wc, int fr, int fq) const {
        const int e = u.pm >> 4, t = u.pn - e * 22;
        const int row0 = u.pm * 256 + wr * 64 + fr, col = 128 * t + wc * 32 + 8 * fq;
#pragma unroll
        for (int ai = 0; ai < 2; ++ai)
#pragma unroll
            for (int m = 0; m < 4; ++m) {
                const size_t row = (size_t)(row0 + ai * 128 + m * 16);
                float o[8];
#pragma unroll
                for (int n = 0; n < 2; ++n)
#pragma unroll
                    for (int j = 0; j < 4; j += 2) {
                        const f32x2 g2 = (f32x2){acc[ai][0][m][n][j], acc[ai][0][m][n][j + 1]}, u2 = (f32x2){acc[ai][1][m][n][j], acc[ai][1][m][n][j + 1]};
                        const f32x2 tt = g2 * (-1.4426950408889634f);
                        f32x2 ee; ee.x = __builtin_amdgcn_exp2f(tt.x); ee.y = __builtin_amdgcn_exp2f(tt.y);
                        const f32x2 dd = ee + 1.0f;
                        f32x2 rr; rr.x = __builtin_amdgcn_rcpf(dd.x); rr.y = __builtin_amdgcn_rcpf(dd.y);
                        const f32x2 hh = (g2 * u2) * rr;
                        o[4 * n + j] = hh.x; o[4 * n + j + 1] = hh.y; }
                u32x2 w; w.x = pk4_fp8(o[0], o[1], o[2], o[3]); w.y = pk4_fp8(o[4], o[5], o[6], o[7]);
                *(u32x2*)(H + ((size_t)u.pm * 22 + t) * 32768 + (size_t)(row - (size_t)u.pm * 256) * 128 + (col - 128 * t)) = w;
            }
    }
};
struct EpiExpDown {
    static constexpr bool PERM = true;
    unsigned char* Y; const float* gateE;
    __device__ __forceinline__ void operator()(const f32x4 (&acc)[2][2][4][2], const pg8::Unit& u, int wr, int wc, int fr, int fq) const {
        const int e = u.pm >> 4, c4 = u.pn - e * 4;
        const int row0 = u.pm * 256 + wr * 64 + fr, col0 = 256 * c4 + wc * 32 + 8 * fq;
#pragma unroll
        for (int ai = 0; ai < 2; ++ai)
#pragma unroll
            for (int m = 0; m < 4; ++m) {
                const size_t row = (size_t)(row0 + ai * 128 + m * 16);
                const float g = gateE[row] * 32.0f;
#pragma unroll
                for (int bj = 0; bj < 2; ++bj) {
                    const f32x4 v0 = acc[ai][bj][m][0] * g, v1 = acc[ai][bj][m][1] * g;
                    u32x2 w; w.x = pk4_fp8(v0[0], v0[1], v0[2], v0[3]); w.y = pk4_fp8(v1[0], v1[1], v1[2], v1[3]);
                    *(u32x2*)(Y + row * D + col0 + 128 * bj) = w;
                }
            }
    }
};

__device__ __forceinline__ void wg_publish(unsigned* cnt, int tid) {
    asm volatile("s_waitcnt vmcnt(0)" ::: "memory");
    __syncthreads();
    if (tid == 0) { __builtin_amdgcn_fence(__ATOMIC_RELEASE, "agent"); asm volatile("s_waitcnt vmcnt(0)" ::: "memory");
        (void)__hip_atomic_fetch_add(cnt, 1u, __ATOMIC_RELAXED, __HIP_MEMORY_SCOPE_AGENT); }
}
__device__ __forceinline__ void wg_wait(unsigned* cnt, unsigned target, int tid) {
    if (tid == 0) { unsigned sp = 0;
        while (__hip_atomic_load(cnt, __ATOMIC_RELAXED, __HIP_MEMORY_SCOPE_AGENT) < target && ++sp < (1u << 22)) __builtin_amdgcn_s_sleep(2);
        __builtin_amdgcn_fence(__ATOMIC_ACQUIRE, "agent"); asm volatile("s_waitcnt vmcnt(0)" ::: "memory"); }
    __syncthreads();
}

__device__ __forceinline__ void transpose_item(const float* W, int K, int N, bf16_t* WT, int k0, int n0, size_t drow0, LAS float* scr, int lane) {
    float tv[32];
#pragma unroll
    for (int i = 0; i < 32; ++i) { const int kk = 2 * i + (lane >> 5); tv[i] = __builtin_nontemporal_load(W + (size_t)(k0 + kk) * N + n0 + (lane & 31)); }
#pragma unroll
    for (int i = 0; i < 32; ++i) { const int kk = 2 * i + (lane >> 5); scr[kk * 33 + (lane & 31)] = tv[i]; }
    asm volatile("s_waitcnt lgkmcnt(0)" ::: "memory");
    const int c = lane & 7;
#pragma unroll
    for (int j = 0; j < 4; ++j) { const int n = (lane >> 3) + 8 * j; const LAS float* s = scr + (8 * c) * 33 + n;
        u32x4 o; o.x = pk2(s[0 * 33], s[1 * 33]); o.y = pk2(s[2 * 33], s[3 * 33]); o.z = pk2(s[4 * 33], s[5 * 33]); o.w = pk2(s[6 * 33], s[7 * 33]);
        *(u32x4*)(WT + (drow0 + n) * (size_t)K + k0 + 8 * c) = o; }
    asm volatile("s_waitcnt lgkmcnt(0)" ::: "memory");
}

__device__ __forceinline__ void transpose_item8(const float* W, int K, int N, unsigned char* WT, int k0, int n0, size_t drow0, float scale, LAS float* scr, int lane) {
    float tv[32];
#pragma unroll
    for (int i = 0; i < 32; ++i) { const int kk = 2 * i + (lane >> 5); tv[i] = __builtin_nontemporal_load(W + (size_t)(k0 + kk) * N + n0 + (lane & 31)); }
#pragma unroll
    for (int i = 0; i < 32; ++i) { const int kk = 2 * i + (lane >> 5); scr[kk * 33 + (lane & 31)] = tv[i] * scale; }
    asm volatile("s_waitcnt lgkmcnt(0)" ::: "memory");
    const int c = lane & 7;
#pragma unroll
    for (int j = 0; j < 4; ++j) { const int n = (lane >> 3) + 8 * j; const LAS float* s = scr + (8 * c) * 33 + n;
        u32x2 o; o.x = pk4_fp8(s[0 * 33], s[1 * 33], s[2 * 33], s[3 * 33]); o.y = pk4_fp8(s[4 * 33], s[5 * 33], s[6 * 33], s[7 * 33]);
        *(u32x2*)(WT + (drow0 + n) * (size_t)K + k0 + 8 * c) = o; }
    asm volatile("s_waitcnt lgkmcnt(0)" ::: "memory");
}

__device__ __forceinline__ void transpose_item8b(const float* W, int N, unsigned char* WTblk, int k0, int n0, int drow0, int kc0, float scale, LAS float* scr, int lane) {
    float tv[32];
#pragma unroll
    for (int i = 0; i < 32; ++i) { const int kk = 2 * i + (lane >> 5); tv[i] = __builtin_nontemporal_load(W + (size_t)(k0 + kk) * N + n0 + (lane & 31)); }
#pragma unroll
    for (int i = 0; i < 32; ++i) { const int kk = 2 * i + (lane >> 5); scr[kk * 33 + (lane & 31)] = tv[i] * scale; }
    asm volatile("s_waitcnt lgkmcnt(0)" ::: "memory");
    const int c = lane & 7;
#pragma unroll
    for (int j = 0; j < 4; ++j) { const int n = (lane >> 3) + 8 * j; const LAS float* s = scr + (8 * c) * 33 + n;
        u32x2 o; o.x = pk4_fp8(s[0 * 33], s[1 * 33], s[2 * 33], s[3 * 33]); o.y = pk4_fp8(s[4 * 33], s[5 * 33], s[6 * 33], s[7 * 33]);
        *(u32x2*)(WTblk + (size_t)(drow0 + n) * 128 + kc0 + 8 * c) = o; }
    asm volatile("s_waitcnt lgkmcnt(0)" ::: "memory");
}

#ifndef PROBE_MASK
#define PROBE_MASK 0
#endif
struct Args { const float* in[28]; float* out; unsigned char* ws; int ph_lo, ph_hi, dbg, pad; };

__device__ __forceinline__ void convert_items(LAS unsigned char* lds, const Args& a, const int kind, const int TID, const int BID, const int GD) {
    const int lane = TID & 63, wave = TID >> 6;
    unsigned char* ws = a.ws;
    LAS float* scr = (LAS float*)(lds + wave * 8704);
    const int gw = BID * NWAVES + wave, NGW = GD * NWAVES;
    const float* w_in = a.in[8]; const float* w_out = a.in[21]; const float* wg = a.in[24]; const float* wu = a.in[25]; const float* wd = a.in[26];
    bf16_t* WinT = (bf16_t*)(ws + WS_WINT); bf16_t* WoutT = (bf16_t*)(ws + WS_WOUTT); unsigned char* WguT = ws + WS_WGUT; unsigned char* WdT = ws + WS_WDT;
    constexpr int I_IN = 16 * 64, I_OUT = 16 * 32, I_GE = 16 * 88, I_G = 16 * I_GE, I_DE = 44 * 32, I_D = 16 * I_DE;
    const int nitems = kind == 0 ? (I_IN + I_OUT) : (kind == 1 ? 2 * I_G : I_D);
    for (int it = gw; it < nitems; it += NGW) {
        int r = it;
        if (kind == 0) {
            if (r < I_IN) { const int kb = r / 64, nb = r % 64, n0 = 32 * nb;
                int drow; if (n0 < 512) drow = (n0 >> 7) * 256 + (n0 & 127); else if (n0 < 1024) drow = ((n0 - 512) >> 7) * 256 + 128 + ((n0 - 512) & 127); else drow = n0;
                transpose_item(w_in, 1024, 2048, WinT, 64 * kb, n0, (size_t)drow, scr, lane); continue; }
            r -= I_IN;
            { const int kb = r / 32, nb = r % 32; transpose_item(w_out, 1024, 1024, WoutT, 64 * kb, 32 * nb, (size_t)(32 * nb), scr, lane); }
        } else if (kind == 1) {
            const int up = r >= I_G; if (up) r -= I_G; const int e = r / I_GE, q = r % I_GE, kb = q / 88, nb = q % 88, n0 = 32 * nb;
            const size_t drow = (size_t)e * 5632 + (size_t)(n0 >> 7) * 256 + (up ? 128 : 0) + (n0 & 127);
            transpose_item8((up ? wu : wg) + (size_t)e * 1024 * DE, 1024, DE, WguT, 64 * kb, n0, drow, 32.0f, scr, lane);
        } else {
            const int e = r / I_DE, q = r % I_DE, kb = q / 32, nb = q % 32;
            const int n0 = 32 * nb, k0 = 64 * kb;
            transpose_item8b(wd + (size_t)e * DE * 1024, 1024, WdT + ((size_t)((e * 4 + (n0 >> 8)) * 22 + (k0 >> 7))) * 32768, k0, n0, n0 & 255, k0 & 127, 64.0f, scr, lane);
        }
    }
}

__device__ __forceinline__ void phase0(LAS unsigned char* lds, const Args& a, const int TID, const int BID, const int GD) {
    const int tid = TID, lane = tid & 63, wave = tid >> 6, G = GD;
    unsigned char* ws = a.ws;
    __syncthreads();
    {
        const float* c = a.in[1]; const float* cctx = a.in[3]; const float* ada_w = a.in[6]; const float* ada_b = a.in[7];
        float* mod = (float*)(ws + WS_MOD); float* modc = mod + 4 * 6144;
        LAS float* sc = (LAS float*)lds;
        LAS float* red = (LAS float*)(lds + 20480);
        for (int grp = BID; grp < 96; grp += G) {
            for (int i = tid; i < 5 * 1024; i += NTHREADS) { const float v = (i < 4096) ? c[i] : cctx[i - 4096]; sc[i] = silu_f(v); }
            __syncthreads();
            const int col = grp * 64 + lane;
            float acc[5] = {0.f, 0.f, 0.f, 0.f, 0.f};
            const int k0 = wave * 128;
#pragma unroll 8
            for (int k = k0; k < k0 + 128; ++k) { const float w = ada_w[(size_t)k * 6144 + col];
#pragma unroll
                for (int v = 0; v < 5; ++v) acc[v] += sc[v * 1024 + k] * w; }
#pragma unroll
            for (int v = 0; v < 5; ++v) red[(wave * 5 + v) * 64 + lane] = acc[v];
            __syncthreads();
            if (tid < 320) { const int v = tid >> 6, l = tid & 63; float s = 0.f;
#pragma unroll
                for (int w = 0; w < 8; ++w) s += red[(w * 5 + v) * 64 + l];
                const int cc = grp * 64 + l; s += ada_b[cc];
                if (v < 4) mod[v * 6144 + cc] = s; else if (cc < 2048) modc[cc] = s; }
            wg_publish((unsigned*)(ws + WS_ADACNT), tid);
            __syncthreads();
        }
    }
    convert_items(lds, a, 0, TID, BID, GD);
}

__device__ __forceinline__ void phase1(const Args& a, const int TID, const int BID, const int GD) {
    const int lane = TID & 63, wave = TID >> 6, G = GD;
    const float* x = a.in[0]; const float* ctx = a.in[2]; const float* g1 = a.in[4];
    const float* mod = (const float*)(a.ws + WS_MOD); const float* modc = mod + 4 * 6144;
    bf16_t* U = (bf16_t*)(a.ws + WS_U);
    f32x4 gg[4];
#pragma unroll
    for (int i = 0; i < 4; ++i) gg[i] = *(const f32x4*)(g1 + 4 * (lane + 64 * i));
    for (int row = BID * NWAVES + wave; row < NROWS; row += G * NWAVES) {
        const float* xr; const float* sh; const float* scl;
        if (row < NTOK) { xr = x + (size_t)row * D; const int b = row >> 13; sh = mod + b * 6144; scl = sh + 1024; }
        else { xr = ctx + (size_t)(row - NTOK) * D; sh = modc; scl = modc + 1024; }
        f32x4 v[4]; float ss = 0.f;
#pragma unroll
        for (int i = 0; i < 4; ++i) { v[i] = *(const f32x4*)(xr + 4 * (lane + 64 * i)); ss += v[i].x * v[i].x + v[i].y * v[i].y + v[i].z * v[i].z + v[i].w * v[i].w; }
        ss = wave_sum(ss);
        const float r = rsqrtf(ss * (1.0f / D) + 1e-6f);
#pragma unroll
        for (int i = 0; i < 4; ++i) {
            const f32x4 s1 = *(const f32x4*)(sh + 4 * (lane + 64 * i)), c1 = *(const f32x4*)(scl + 4 * (lane + 64 * i));
            const f32x4 o = (v[i] * r) * gg[i] * (c1 + 1.0f) + s1;
            u32x2 w; w.x = pk2(o.x, o.y); w.y = pk2(o.z, o.w);
            *(u32x2*)(U + (size_t)row * D + 4 * (lane + 64 * i)) = w;
        }
    }
}

__device__ __forceinline__ void conv_units(LAS unsigned char* lds, const Args& a, int ubeg, int ustride, const int TID, const int BID, const int GD) {
    const int tid = TID, lane = tid & 63, wave = tid >> 6;
    const float* cw = a.in[10]; const float* cb = a.in[11]; const float* lg = a.in[12]; const float* lb = a.in[13];
    const bf16_t* xglu = (const bf16_t*)(a.ws + WS_XGLU); bf16_t* mix = (bf16_t*)(a.ws + WS_MIX);
    LAS float* wts = (LAS float*)lds;
    for (int i = tid; i < 31 * 512; i += NTHREADS) { const int k = i >> 9, ch = i & 511; wts[((k * 2 + ((ch >> 2) & 1)) * 64 + (ch >> 3)) * 4 + (ch & 3)] = cw[i]; }
    __syncthreads();
    const int ch0 = 8 * lane;
    const bool rowc = lane < 32;
    for (int unit = ubeg; unit < NB * 128; unit += ustride) {
        const int b = unit >> 7, r = unit & 127;
        const bf16_t* xb = xglu + (size_t)b * SEQ * 512;
#pragma unroll 1
        for (int p = 0; p < 4; ++p) {
            const int c = p * 16 + 2 * wave;
            float acc[2][8];
#pragma unroll
            for (int j = 0; j < 8; ++j) { const float bj_ = cb[ch0 + j]; acc[0][j] = bj_; acc[1][j] = bj_; }
            u32x4 xv[2][2][8];
#define CONV_LOADS(buf, kb) do { _Pragma("unroll") for (int kk = 0; kk < 8; ++kk) { const int k = (kb) + kk; _Pragma("unroll") for (int tt = 0; tt < 2; ++tt) { xv[buf][tt][kk] = (u32x4){0u, 0u, 0u, 0u}; \
                if (k < 31) { int tok; bool valid; \
                    if (rowc) { const int cc = c + tt + k - 15; valid = (cc >= 0) && (cc < 64); tok = r * 64 + cc; } \
                    else { const int rr = r + k - 15; valid = (rr >= 0) && (rr < 128); tok = rr * 64 + c + tt; } \
                    if (valid) xv[buf][tt][kk] = *(const u32x4*)(xb + (size_t)tok * 512 + ch0); } } } } while (0)
#define CONV_FMAS(buf, kb) do { _Pragma("unroll") for (int kk = 0; kk < 8; ++kk) { const int k = (kb) + kk; if (k < 31) { \
                const f32x4 w0 = *(const LAS f32x4*)(wts + ((k * 2 + 0) * 64 + lane) * 4), w1 = *(const LAS f32x4*)(wts + ((k * 2 + 1) * 64 + lane) * 4); \
                _Pragma("unroll") for (int tt = 0; tt < 2; ++tt) { const u32x4 x4 = xv[buf][tt][kk]; \
                    fma_mix_lo(acc[tt][0], w0.x, x4.x); fma_mix_hi(acc[tt][1], w0.y, x4.x); fma_mix_lo(acc[tt][2], w0.z, x4.y); fma_mix_hi(acc[tt][3], w0.w, x4.y); \
                    fma_mix_lo(acc[tt][4], w1.x, x4.z); fma_mix_hi(acc[tt][5], w1.y, x4.z); fma_mix_lo(acc[tt][6], w1.z, x4.w); fma_mix_hi(acc[tt][7], w1.w, x4.w); } } } } while (0)
            CONV_LOADS(0, 0);
            CONV_LOADS(1, 8);  CONV_FMAS(0, 0);
            CONV_LOADS(0, 16); CONV_FMAS(1, 8);
            CONV_LOADS(1, 24); CONV_FMAS(0, 16);
            CONV_FMAS(1, 24);
#undef CONV_LOADS
#undef CONV_FMAS
#pragma unroll
            for (int tt = 0; tt < 2; ++tt) {
                float s = 0.f;
#pragma unroll
                for (int j = 0; j < 8; ++j) s += acc[tt][j];
                const float mean = wave_sum(s) * (1.0f / 512.0f);
                float q = 0.f;
#pragma unroll
                for (int j = 0; j < 8; ++j) { acc[tt][j] -= mean; q += acc[tt][j] * acc[tt][j]; }
                const float rstd = rsqrtf(wave_sum(q) * (1.0f / 512.0f) + 1e-5f);
                float o[8];
#pragma unroll
                for (int j = 0; j < 8; ++j) { const float y = acc[tt][j] * rstd * lg[ch0 + j] + lb[ch0 + j]; o[j] = silu_f(y); }
                u32x4 w; w.x = pk2(o[0], o[1]); w.y = pk2(o[2], o[3]); w.z = pk2(o[4], o[5]); w.w = pk2(o[6], o[7]);
                *(u32x4*)(mix + (size_t)(b * SEQ + r * 64 + c + tt) * D + ch0) = w;
            }
        }
    }
    __syncthreads();
}

constexpr int L_XT = 0;
constexpr int L_XC = 9216;
constexpr int L_A = L_XC + 2 * 17408;
constexpr int L_U = L_A + 2 * 16384;
constexpr int L_SUB = L_U + 2 * 16384;
constexpr int L_PRE = L_SUB + 8192;
constexpr int L_CIN = L_PRE + 4096;
static_assert(L_CIN + 2 * 17 * 64 * 4 <= 131072, "lru lds");

__device__ __forceinline__ int lru_seq(int d, int i) { return d == 0 ? i : (i < 4 ? 3 - i : NQ - 1 - (i - 4)); }
__device__ __forceinline__ u32x4 lru_load_xt(const bf16_t* xlx, int b, int h, int q, int i) {
    int rowbase, L, chunk;
    if (q < 4) { rowbase = NTOK + b * CTXL; L = CTXL; chunk = q; } else { rowbase = b * SEQ; L = SEQ; chunk = q - 4; }
    const int rr = i >> 3, seg = i & 7, t = chunk * 64 - 3 + rr;
    u32x4 v = (u32x4){0u, 0u, 0u, 0u};
    if (t >= 0 && t < L) v = *(const u32x4*)(xlx + (size_t)(rowbase + t) * 512 + 64 * h + 8 * seg);
    return v;
}
template <int MODE>
__device__ __forceinline__ void lru_phase(LAS unsigned char* lds, const Args& a, const int TID, const int BID, const int GD) {
    const int tid = TID, lane = tid & 63, wave = tid >> 6;
    const float* wa = a.in[16]; const float* wi = a.in[18];
    const bf16_t* xlx = (const bf16_t*)(a.ws + WS_XLX); const bf16_t* glg = (const bf16_t*)(a.ws + WS_GLG); bf16_t* mix = (bf16_t*)(a.ws + WS_MIX);
    f32x2* carry = (f32x2*)(a.ws + WS_CARRY); unsigned* au = (unsigned*)(a.ws + WS_AU);
    const float* conv_w = a.in[14]; const float* conv_b = a.in[15]; const float* ba = a.in[17]; const float* bi = a.in[19]; const float* lam = a.in[20];
    LAS bf16_t* XT = (LAS bf16_t*)(lds + L_XT); LAS float* XC = (LAS float*)(lds + L_XC); LAS float* Aa = (LAS float*)(lds + L_A); LAS float* Uu = (LAS float*)(lds + L_U);
    LAS f32x2* SUB = (LAS f32x2*)(lds + L_SUB); LAS float* PRE = (LAS float*)(lds + L_PRE); LAS float* CIN = (LAS float*)(lds + L_CIN);
    const int l15 = lane & 15, l4 = lane >> 4;
    for (int vb = BID; vb < 256; vb += GD) {
        const int bh = vb >> 3, grp = vb & 7, b = bh >> 3, h = bh & 7;
        int q0, nq;
        if (MODE == 1) { q0 = grp * 17; nq = (NQ - q0) < 17 ? (NQ - q0) : 17; } else { q0 = 4 + grp * 16; nq = 16; }
        const int wd = wave >> 2, mtp = (wave >> 1) & 1, ntp = wave & 1;
        bf16x8 wf[2][2][2];
#pragma unroll
        for (int nn = 0; nn < 2; ++nn)
#pragma unroll
            for (int g = 0; g < 2; ++g)
#pragma unroll
                for (int ks = 0; ks < 2; ++ks) { const float* wp = (g ? wi : wa) + (size_t)((wd * 8 + h) * 64 + 32 * ks + 8 * l4) * 64 + 16 * (ntp * 2 + nn) + l15;
                    u32x4 w; w.x = pk2(wp[0], wp[64]); w.y = pk2(wp[128], wp[192]); w.z = pk2(wp[256], wp[320]); w.w = pk2(wp[384], wp[448]); wf[nn][g][ks] = __builtin_bit_cast(bf16x8, w); }
        float cw[2][4], cbv[2];
        { const int gc = 64 * h + (tid & 63);
#pragma unroll
            for (int d = 0; d < 2; ++d) { cbv[d] = conv_b[d * 512 + gc];
#pragma unroll
                for (int k = 0; k < 4; ++k) cw[d][k] = conv_w[(d * 4 + k) * 512 + gc]; } }
        float bav[2], biv[2], spv[2];
#pragma unroll
        for (int nn = 0; nn < 2; ++nn) { const int gc = 64 * h + 16 * (ntp * 2 + nn) + l15;
            bav[nn] = ba[wd * 512 + gc]; biv[nn] = bi[wd * 512 + gc]; spv[nn] = log1pf(__expf(-lam[wd * 512 + gc])); }
        if (MODE == 2 && tid < 128) {
            const int d = tid >> 6, ch = tid & 63;
            const f32x2* cp = carry + (size_t)((d * NB + b) * NQ) * 512 + 64 * h + ch;
            const int cnt = d == 0 ? q0 : (NQ + 4 - (q0 + nq));
            float s = 0.f;
            for (int i0 = 0; i0 < cnt; i0 += 8) {
                f32x2 c[8];
#pragma unroll
                for (int j = 0; j < 8; ++j) { const int ii = (i0 + j) < cnt ? (i0 + j) : (cnt - 1); c[j] = cp[(size_t)lru_seq(d, ii) * 512]; }
#pragma unroll
                for (int j = 0; j < 8; ++j) if (i0 + j < cnt) s = c[j].x * s + c[j].y;
            }
            f32x2 c[16];
#pragma unroll
            for (int j = 0; j < 16; ++j) c[j] = cp[(size_t)(q0 + j) * 512];
            if (d == 0) {
#pragma unroll
                for (int j = 0; j < 16; ++j) { CIN[(0 * 17 + j) * 64 + ch] = s; s = c[j].x * s + c[j].y; }
            } else {
#pragma unroll
                for (int j = 15; j >= 0; --j) { CIN[(1 * 17 + j) * 64 + ch] = s; s = c[j].x * s + c[j].y; }
            }
        }
        if (MODE == 1 && q0 < 4) {
            if (tid == 0) { unsigned* fl = (unsigned*)(a.ws + WS_CTXFLAG) + 64 * (b * 2 + (h >> 2)); unsigned sp = 0;
                while (__hip_atomic_load(fl, __ATOMIC_RELAXED, __HIP_MEMORY_SCOPE_AGENT) == 0u && ++sp < (1u << 22)) __builtin_amdgcn_s_sleep(2);
                __builtin_amdgcn_fence(__ATOMIC_ACQUIRE, "agent"); asm volatile("s_waitcnt vmcnt(0)" ::: "memory"); }
            __syncthreads();
        }
        u32x4 xr0 = lru_load_xt(xlx, b, h, q0, tid), xr1 = (u32x4){0u, 0u, 0u, 0u};
        if (tid < 48) xr1 = lru_load_xt(xlx, b, h, q0, tid + 512);
#pragma unroll 1
        for (int jc = 0; jc < nq; ++jc) {
            const int q = q0 + jc;
            const size_t rowbase0 = (q < 4) ? (size_t)(NTOK + b * CTXL + q * 64) : (size_t)(b * SEQ + (q - 4) * 64);
            *(LAS u32x4*)(XT + tid * 8) = xr0;
            if (tid < 48) *(LAS u32x4*)(XT + (tid + 512) * 8) = xr1;
            __syncthreads();
            if (jc + 1 < nq) { xr0 = lru_load_xt(xlx, b, h, q + 1, tid); if (tid < 48) xr1 = lru_load_xt(xlx, b, h, q + 1, tid + 512); }
            u32x4 gl = (u32x4){0u, 0u, 0u, 0u};
            if (MODE == 2) gl = *(const u32x4*)(glg + (rowbase0 + (tid >> 3)) * 512 + 64 * h + (tid & 7) * 8);
            { const int ch = tid & 63, tb = tid >> 6;
#pragma unroll
                for (int i = 0; i < 8; ++i) { const int t = tb + 8 * i;
                    const float x0 = bf_lo(XT[(t + 0) * 64 + ch]), x1 = bf_lo(XT[(t + 1) * 64 + ch]), x2 = bf_lo(XT[(t + 2) * 64 + ch]), x3 = bf_lo(XT[(t + 3) * 64 + ch]), x4 = bf_lo(XT[(t + 4) * 64 + ch]), x5 = bf_lo(XT[(t + 5) * 64 + ch]), x6 = bf_lo(XT[(t + 6) * 64 + ch]);
                    XC[t * 68 + ch] = cbv[0] + cw[0][0] * x0 + cw[0][1] * x1 + cw[0][2] * x2 + cw[0][3] * x3;
                    XC[64 * 68 + t * 68 + ch] = cbv[1] + cw[1][3] * x3 + cw[1][2] * x4 + cw[1][1] * x5 + cw[1][0] * x6; } }
            __syncthreads();
#pragma unroll
            for (int mm = 0; mm < 2; ++mm) {
                const int mtl = 2 * mtp + mm;
                bf16x8 af[2];
#pragma unroll
                for (int ks = 0; ks < 2; ++ks) { const LAS float* p = XC + wd * (64 * 68) + (16 * mtl + l15) * 68 + 32 * ks + 8 * l4; const f32x4 p0 = *(const LAS f32x4*)p, p1 = *(const LAS f32x4*)(p + 4);
                    u32x4 w; w.x = pk2(p0.x, p0.y); w.y = pk2(p0.z, p0.w); w.z = pk2(p1.x, p1.y); w.w = pk2(p1.z, p1.w); af[ks] = __builtin_bit_cast(bf16x8, w); }
#pragma unroll
                for (int nn = 0; nn < 2; ++nn) { const int n = 16 * (ntp * 2 + nn) + l15;
                    f32x4 accR = (f32x4){0.f, 0.f, 0.f, 0.f}, accI = (f32x4){0.f, 0.f, 0.f, 0.f};
#pragma unroll
                    for (int ks = 0; ks < 2; ++ks) {
                        accR = __builtin_amdgcn_mfma_f32_16x16x32_bf16(af[ks], wf[nn][0][ks], accR, 0, 0, 0);
                        accI = __builtin_amdgcn_mfma_f32_16x16x32_bf16(af[ks], wf[nn][1][ks], accI, 0, 0, 0);
                    }
#pragma unroll
                    for (int rg = 0; rg < 4; rg += 2) { const int t = 16 * mtl + 4 * l4 + rg;
                        const f32x2 zr = (f32x2){accR[rg], accR[rg + 1]} + bav[nn], zi = (f32x2){accI[rg], accI[rg + 1]} + biv[nn];
                        const f32x2 tr = zr * (-1.4426950408889634f), ti = zi * (-1.4426950408889634f);
                        f32x2 er, ei; er.x = __builtin_amdgcn_exp2f(tr.x); er.y = __builtin_amdgcn_exp2f(tr.y); ei.x = __builtin_amdgcn_exp2f(ti.x); ei.y = __builtin_amdgcn_exp2f(ti.y);
                        const f32x2 dr = er + 1.0f, di = ei + 1.0f;
                        f32x2 rr, ii; rr.x = __builtin_amdgcn_rcpf(dr.x); rr.y = __builtin_amdgcn_rcpf(dr.y); ii.x = __builtin_amdgcn_rcpf(di.x); ii.y = __builtin_amdgcn_rcpf(di.y);
                        const f32x2 la = rr * (-8.0f * spv[nn]);
                        f32x2 oma = -la * (1.0f + 0.5f * la * (1.0f + 0.33333334f * la * (1.0f + 0.25f * la * (1.0f + 0.2f * la))));
                        if (__any(la.x < -0.25f || la.y < -0.25f)) {
                            oma.x = la.x < -0.25f ? 1.0f - __expf(la.x) : oma.x; oma.y = la.y < -0.25f ? 1.0f - __expf(la.y) : oma.y; }
                        const f32x2 om2 = oma * (2.0f - oma);
                        f32x2 mult; mult.x = __builtin_amdgcn_sqrtf(om2.x); mult.y = __builtin_amdgcn_sqrtf(om2.y);
                        const f32x2 xc2 = (f32x2){XC[wd * (64 * 68) + t * 68 + n], XC[wd * (64 * 68) + (t + 1) * 68 + n]};
                        const f32x2 uu = mult * ii * xc2;
                        Aa[wd * 4096 + t * 64 + n] = oma.x; Aa[wd * 4096 + (t + 1) * 64 + n] = oma.y; Uu[wd * 4096 + t * 64 + n] = uu.x; Uu[wd * 4096 + (t + 1) * 64 + n] = uu.y; }
                }
            }
            __syncthreads();
            if (MODE == 1 && q >= 4) {
                const int t = tid >> 3, c8 = (tid & 7) * 8;
#pragma unroll
                for (int d = 0; d < 2; ++d) {
                    const LAS float* ap = Aa + d * 4096 + t * 64 + c8; const LAS float* up = Uu + d * 4096 + t * 64 + c8;
                    const f32x4 a0 = *(const LAS f32x4*)ap, a1 = *(const LAS f32x4*)(ap + 4), u0 = *(const LAS f32x4*)up, u1 = *(const LAS f32x4*)(up + 4);
                    u32x4 w0, w1; w0.x = pk2h(a0.x, u0.x); w0.y = pk2h(a0.y, u0.y); w0.z = pk2h(a0.z, u0.z); w0.w = pk2h(a0.w, u0.w); w1.x = pk2h(a1.x, u1.x); w1.y = pk2h(a1.y, u1.y); w1.z = pk2h(a1.z, u1.z); w1.w = pk2h(a1.w, u1.w);
                    unsigned* dst = au + ((size_t)d * NTOK + rowbase0 + t) * 512 + 64 * h + c8;
                    *(u32x4*)dst = w0; *(u32x4*)(dst + 4) = w1; }
            }
            { float A0 = 1.f, h0 = 0.f, A1 = 1.f, h1 = 0.f;
#pragma unroll
                for (int s2 = 0; s2 < 8; ++s2) { const int p = 8 * wave + s2, t0 = p, t1 = 63 - p;
                    const float a0 = 1.0f - Aa[t0 * 64 + lane], u0 = Uu[t0 * 64 + lane], a1 = 1.0f - Aa[4096 + t1 * 64 + lane], u1 = Uu[4096 + t1 * 64 + lane];
                    h0 = a0 * h0 + u0; A0 *= a0; h1 = a1 * h1 + u1; A1 *= a1; }
                SUB[wave * 64 + lane] = (f32x2){A0, h0}; SUB[512 + wave * 64 + lane] = (f32x2){A1, h1}; }
            __syncthreads();
            if (MODE == 1) {
                if (tid < 128) { const int d = tid >> 6, ch = tid & 63; float Ac = 1.f, hc = 0.f;
#pragma unroll
                    for (int s2 = 0; s2 < 8; ++s2) { const f32x2 c = SUB[d * 512 + s2 * 64 + ch]; hc = c.x * hc + c.y; Ac *= c.x; }
                    carry[(size_t)((d * NB + b) * NQ + q) * 512 + 64 * h + ch] = (f32x2){Ac, hc}; }
            } else {
                if (tid < 128) { const int d = tid >> 6, ch = tid & 63; float s2 = CIN[(d * 17 + jc) * 64 + ch];
#pragma unroll
                    for (int sb = 0; sb < 8; ++sb) { PRE[d * 512 + sb * 64 + ch] = s2; const f32x2 c = SUB[d * 512 + sb * 64 + ch]; s2 = c.x * s2 + c.y; } }
                __syncthreads();
                { float h0 = PRE[wave * 64 + lane], h1 = PRE[512 + wave * 64 + lane];
#pragma unroll
                    for (int s2 = 0; s2 < 8; ++s2) { const int p = 8 * wave + s2, t0 = p, t1 = 63 - p;
                        h0 = (1.0f - Aa[t0 * 64 + lane]) * h0 + Uu[t0 * 64 + lane]; Uu[t0 * 64 + lane] = h0;
                        h1 = (1.0f - Aa[4096 + t1 * 64 + lane]) * h1 + Uu[4096 + t1 * 64 + lane]; Uu[4096 + t1 * 64 + lane] = h1; } }
                __syncthreads();
                { const int t = tid >> 3, c8 = (tid & 7) * 8;
                    const LAS float* u1 = Uu + t * 64 + c8; const LAS float* u2 = Uu + 4096 + t * 64 + c8;
                    const f32x4 f0 = *(const LAS f32x4*)u1, f1 = *(const LAS f32x4*)(u1 + 4), b0 = *(const LAS f32x4*)u2, b1 = *(const LAS f32x4*)(u2 + 4);
                    u32x4 w;
                    w.x = pk2((f0.x + b0.x) * bf_lo(gl.x), (f0.y + b0.y) * bf_hi(gl.x)); w.y = pk2((f0.z + b0.z) * bf_lo(gl.y), (f0.w + b0.w) * bf_hi(gl.y));
                    w.z = pk2((f1.x + b1.x) * bf_lo(gl.z), (f1.y + b1.y) * bf_hi(gl.z)); w.w = pk2((f1.z + b1.z) * bf_lo(gl.w), (f1.w + b1.w) * bf_hi(gl.w));
                    *(u32x4*)(mix + (rowbase0 + t) * D + 512 + 64 * h + c8) = w; }
            }
        }
        if (MODE == 1) wg_publish((unsigned*)(a.ws + WS_BHCNT) + 64 * bh, tid);
        __syncthreads();
    }
}

__device__ __forceinline__ void lru_rescan(LAS unsigned char* lds, const Args& a, const int TID, const int BID, const int GD) {
    const int tid = TID, lane = tid & 63, wave = tid >> 6;
    const unsigned* au = (const unsigned*)(a.ws + WS_AU); const bf16_t* glg = (const bf16_t*)(a.ws + WS_GLG); bf16_t* mix = (bf16_t*)(a.ws + WS_MIX);
    const f32x2* carry = (const f32x2*)(a.ws + WS_CARRY);
    LAS f32x2* SUB = (LAS f32x2*)(lds + L_SUB); LAS float* PRE = (LAS float*)(lds + L_PRE); LAS float* CIN = (LAS float*)(lds + L_CIN);
    for (int vb = BID; vb < 256; vb += GD) {
        const int bh = vb >> 3, grp = vb & 7, b = bh >> 3, h = bh & 7;
        const int q0 = 4 + grp * 16, nq = 16;
        wg_wait((unsigned*)(a.ws + WS_BHCNT) + 64 * bh, 8u * (unsigned)(1 + ((a.dbg >> 11) & 1)), tid);
        if (tid < 128) {
            const int d = tid >> 6, ch = tid & 63;
            const f32x2* cp = carry + (size_t)((d * NB + b) * NQ) * 512 + 64 * h + ch;
            const int cnt = d == 0 ? q0 : (NQ + 4 - (q0 + nq));
            float s = 0.f;
            for (int i0 = 0; i0 < cnt; i0 += 8) {
                f32x2 c[8];
#pragma unroll
                for (int j = 0; j < 8; ++j) { const int ii = (i0 + j) < cnt ? (i0 + j) : (cnt - 1); c[j] = cp[(size_t)lru_seq(d, ii) * 512]; }
#pragma unroll
                for (int j = 0; j < 8; ++j) if (i0 + j < cnt) s = c[j].x * s + c[j].y;
            }
            f32x2 c[16];
#pragma unroll
            for (int j = 0; j < 16; ++j) c[j] = cp[(size_t)(q0 + j) * 512];
            if (d == 0) {
#pragma unroll
                for (int j = 0; j < 16; ++j) { CIN[(0 * 17 + j) * 64 + ch] = s; s = c[j].x * s + c[j].y; }
            } else {
#pragma unroll
                for (int j = 15; j >= 0; --j) { CIN[(1 * 17 + j) * 64 + ch] = s; s = c[j].x * s + c[j].y; }
            }
        }
        __syncthreads();
        const size_t cbase = (size_t)64 * h + lane;
        unsigned pfn[8], pbn[8]; bf16_t ggn[8];
        { const size_t rown = (size_t)b * SEQ + (size_t)(q0 - 4) * 64 + 8 * wave;
#pragma unroll
            for (int s2 = 0; s2 < 8; ++s2) { pfn[s2] = au[(rown + s2) * 512 + cbase]; pbn[s2] = au[((size_t)NTOK + rown + s2) * 512 + cbase]; ggn[s2] = glg[(rown + s2) * 512 + cbase]; } }
#pragma unroll 1
        for (int jc = 0; jc < nq; ++jc) {
            const size_t row0 = (size_t)b * SEQ + (size_t)(q0 - 4 + jc) * 64 + 8 * wave;
            unsigned pf[8], pb[8]; bf16_t gg[8];
#pragma unroll
            for (int s2 = 0; s2 < 8; ++s2) { pf[s2] = pfn[s2]; pb[s2] = pbn[s2]; gg[s2] = ggn[s2]; }
            if (jc + 1 < nq) { const size_t rown = row0 + 64;
#pragma unroll
                for (int s2 = 0; s2 < 8; ++s2) { pfn[s2] = au[(rown + s2) * 512 + cbase]; pbn[s2] = au[((size_t)NTOK + rown + s2) * 512 + cbase]; ggn[s2] = glg[(rown + s2) * 512 + cbase]; } }
            float af[8], uf[8], ab[8], ub[8];
#pragma unroll
            for (int s2 = 0; s2 < 8; ++s2) { const h2_t x = __builtin_bit_cast(h2_t, pf[s2]), y = __builtin_bit_cast(h2_t, pb[s2]);
                af[s2] = 1.0f - (float)x.x; uf[s2] = (float)x.y; ab[s2] = 1.0f - (float)y.x; ub[s2] = (float)y.y; }
            float A0 = 1.f, h0 = 0.f, A1 = 1.f, h1 = 0.f;
#pragma unroll
            for (int s2 = 0; s2 < 8; ++s2) { h0 = af[s2] * h0 + uf[s2]; A0 *= af[s2]; h1 = ab[7 - s2] * h1 + ub[7 - s2]; A1 *= ab[7 - s2]; }
            SUB[wave * 64 + lane] = (f32x2){A0, h0}; SUB[512 + (7 - wave) * 64 + lane] = (f32x2){A1, h1};
            __syncthreads();
            if (tid < 128) { const int d = tid >> 6, ch = tid & 63; float s2 = CIN[(d * 17 + jc) * 64 + ch];
#pragma unroll
                for (int sb = 0; sb < 8; ++sb) { PRE[d * 512 + sb * 64 + ch] = s2; const f32x2 c = SUB[d * 512 + sb * 64 + ch]; s2 = c.x * s2 + c.y; } }
            __syncthreads();
            float hf[8], hb[8];
            { float hc = PRE[wave * 64 + lane];
#pragma unroll
                for (int s2 = 0; s2 < 8; ++s2) { hc = af[s2] * hc + uf[s2]; hf[s2] = hc; }
                hc = PRE[512 + (7 - wave) * 64 + lane];
#pragma unroll
                for (int s2 = 7; s2 >= 0; --s2) { hc = ab[s2] * hc + ub[s2]; hb[s2] = hc; } }
#pragma unroll
            for (int s2 = 0; s2 < 8; ++s2) mix[(row0 + s2) * D + 512 + cbase] = (bf16_t)f2bf((hf[s2] + hb[s2]) * bf_lo(gg[s2]));
        }
        __syncthreads();
    }
}

__device__ __forceinline__ void phase6(LAS unsigned char* lds, const Args& a, const int TID, const int BID, const int GD) {
    const int tid = TID, lane = tid & 63, wave = tid >> 6, G = GD;
    const float* x = a.in[0]; const bf16_t* Mb = (const bf16_t*)(a.ws + WS_M); const float* g2 = a.in[5]; const float* rw = a.in[23];
    const float* mod = (const float*)(a.ws + WS_MOD);
    unsigned char* V = a.ws + WS_V; float* affT = (float*)(a.ws + WS_AFFT); bf16_t* X1b = (bf16_t*)(a.ws + WS_X1B);
    LAS float* rwT = (LAS float*)lds;
    for (int idx = tid; idx < 16384; idx += NTHREADS) rwT[(idx & 15) * 1024 + (idx >> 4)] = rw[idx];
    __syncthreads();
    f32x4 gg[4];
#pragma unroll
    for (int i = 0; i < 4; ++i) gg[i] = *(const f32x4*)(g2 + 4 * (lane + 64 * i));
    for (int row = BID * NWAVES + wave; row < NTOK; row += G * NWAVES) {
        const int b = row >> 13, t = row & (SEQ - 1);
        const float* sh = mod + b * 6144 + 3072; const float* scl = mod + b * 6144 + 4096;
        f32x4 v[4]; float ss = 0.f;
#pragma unroll
        for (int i = 0; i < 4; ++i) { v[i] = *(const f32x4*)(x + (size_t)row * D + 4 * (lane + 64 * i)); const u32x2 mw = *(const u32x2*)(Mb + (size_t)row * D + 4 * (lane + 64 * i));
            v[i].x += bf_lo(mw.x); v[i].y += bf_hi(mw.x); v[i].z += bf_lo(mw.y); v[i].w += bf_hi(mw.y);
            { u32x2 xw; xw.x = pk2(v[i].x, v[i].y); xw.y = pk2(v[i].z, v[i].w); *(u32x2*)(X1b + (size_t)row * D + 4 * (lane + 64 * i)) = xw; }
            ss += v[i].x * v[i].x + v[i].y * v[i].y + v[i].z * v[i].z + v[i].w * v[i].w; }
        ss = wave_sum(ss);
        const float r = rsqrtf(ss * (1.0f / D) + 1e-6f);
#pragma unroll
        for (int i = 0; i < 4; ++i) {
            const f32x4 s1 = *(const f32x4*)(sh + 4 * (lane + 64 * i)), c1 = *(const f32x4*)(scl + 4 * (lane + 64 * i));
            v[i] = (v[i] * r) * gg[i] * (c1 + 1.0f) + s1;
            *(unsigned*)(V + (size_t)row * D + 4 * (lane + 64 * i)) = pk4_fp8(v[i].x, v[i].y, v[i].z, v[i].w);
        }
        float p[16];
#pragma unroll
        for (int e = 0; e < 16; ++e) p[e] = 0.f;
#pragma unroll
        for (int i = 0; i < 4; ++i) {
#pragma unroll
            for (int e = 0; e < 16; ++e) { const f32x4 w = *(const LAS f32x4*)(rwT + e * 1024 + 4 * (lane + 64 * i)); p[e] += v[i].x * w.x + v[i].y * w.y + v[i].z * w.z + v[i].w * w.w; }
            asm volatile("" ::: "memory");
        }
        const bool b5 = (lane & 32) != 0, b4 = (lane & 16) != 0, b3 = (lane & 8) != 0, b2 = (lane & 4) != 0;
        float q8[8], q4[4], q2[2];
#pragma unroll
        for (int j = 0; j < 8; ++j) { const float send = b5 ? p[j] : p[j + 8], keep = b5 ? p[j + 8] : p[j]; q8[j] = keep + __shfl_xor(send, 32); }
#pragma unroll
        for (int j = 0; j < 4; ++j) { const float send = b4 ? q8[j] : q8[j + 4], keep = b4 ? q8[j + 4] : q8[j]; q4[j] = keep + __shfl_xor(send, 16); }
#pragma unroll
        for (int j = 0; j < 2; ++j) { const float send = b3 ? q4[j] : q4[j + 2], keep = b3 ? q4[j + 2] : q4[j]; q2[j] = keep + __shfl_xor(send, 8); }
        float lgt = (b2 ? q2[1] : q2[0]) + __shfl_xor(b2 ? q2[0] : q2[1], 4);
        lgt += __shfl_xor(lgt, 2); lgt += __shfl_xor(lgt, 1);
        float mx = lgt;
        mx = fmaxf(mx, __shfl_xor(mx, 4)); mx = fmaxf(mx, __shfl_xor(mx, 8)); mx = fmaxf(mx, __shfl_xor(mx, 16)); mx = fmaxf(mx, __shfl_xor(mx, 32));
        const float ex = __expf(lgt - mx);
        float den = ex;
        den += __shfl_xor(den, 4); den += __shfl_xor(den, 8); den += __shfl_xor(den, 16); den += __shfl_xor(den, 32);
        if ((lane & 3) == 0) affT[(size_t)(b * 16 + ((lane >> 2) & 15)) * SEQ + t] = ex / den;
    }
    __syncthreads();
}

__device__ __forceinline__ int block_excl_scan(int v, LAS int* wsum, int tid, int& total) {
    const int lane = tid & 63, wave = tid >> 6;
    int inc = v;
#pragma unroll
    for (int o = 1; o < 64; o <<= 1) { const int t = __shfl_up(inc, o); if (lane >= o) inc += t; }
    __syncthreads();
    if (lane == 63) wsum[wave] = inc;
    __syncthreads();
    int base = 0, tot = 0;
#pragma unroll
    for (int w = 0; w < 8; ++w) { const int s = wsum[w]; if (w < wave) base += s; tot += s; }
    total = tot;
    return base + inc - v;
}
__device__ __forceinline__ void phase7(LAS unsigned char* lds, const Args& a, const int TID, const int BID, const int GD) {
    const int tid = TID, lane = tid & 63, wave = tid >> 6, G = GD;
    const float* affT = (const float*)(a.ws + WS_AFFT);
    int* idxE = (int*)(a.ws + WS_IDXE); float* gateE = (float*)(a.ws + WS_GATEE); int* inv = (int*)(a.ws + WS_INV);
    LAS unsigned* hist = (LAS unsigned*)lds;
    LAS unsigned* selw = hist + 256;
    LAS int* wsum = (LAS int*)(hist + 264);
    for (int unit = BID; unit < NB * NE; unit += G) {
        const int b = unit >> 4, e = unit & 15;
        const float* src = affT + (size_t)unit * SEQ + 16 * tid;
        unsigned key[16];
#pragma unroll
        for (int i = 0; i < 4; ++i) { const f32x4 v = *(const f32x4*)(src + 4 * i); const float f0 = v[0], f1 = v[1], f2 = v[2], f3 = v[3]; key[4 * i + 0] = __float_as_uint(f0); key[4 * i + 1] = __float_as_uint(f1); key[4 * i + 2] = __float_as_uint(f2); key[4 * i + 3] = __float_as_uint(f3); }
        unsigned prefix = 0u, mask = 0u, rem = CAP;
#pragma unroll 1
        for (int pass = 0; pass < 4; ++pass) {
            const int shift = 24 - 8 * pass;
            if (tid < 256) hist[tid] = 0u;
            __syncthreads();
#pragma unroll
            for (int j = 0; j < 16; ++j) if ((key[j] & mask) == prefix) __hip_atomic_fetch_add(&hist[(key[j] >> shift) & 255u], 1u, __ATOMIC_RELAXED, __HIP_MEMORY_SCOPE_WORKGROUP);
            __syncthreads();
            if (wave == 0) {
                const unsigned c0 = hist[4 * lane], c1 = hist[4 * lane + 1], c2 = hist[4 * lane + 2], c3 = hist[4 * lane + 3];
                const unsigned s = c0 + c1 + c2 + c3; unsigned v = s;
#pragma unroll
                for (int o = 1; o < 64; o <<= 1) { const unsigned t = __shfl_down(v, o); if (lane + o < 64) v += t; }
                const unsigned above = v - s;
                if (above < rem && rem <= above + s) {
                    unsigned cum = above, bin, nr;
                    if (cum + c3 >= rem) { bin = 4 * lane + 3; nr = rem - cum; }
                    else { cum += c3; if (cum + c2 >= rem) { bin = 4 * lane + 2; nr = rem - cum; }
                        else { cum += c2; if (cum + c1 >= rem) { bin = 4 * lane + 1; nr = rem - cum; } else { cum += c1; bin = 4 * lane; nr = rem - cum; } } }
                    selw[0] = bin; selw[1] = nr;
                }
            }
            __syncthreads();
            prefix |= selw[0] << shift; mask |= 255u << shift; rem = selw[1];
            __syncthreads();
        }
        const unsigned thr = prefix;
        int ceq = 0;
#pragma unroll
        for (int j = 0; j < 16; ++j) ceq += (key[j] == thr) ? 1 : 0;
        int tot; const int eqbase = block_excl_scan(ceq, wsum, tid, tot);
        unsigned selm = 0u; int er = eqbase, cs = 0;
#pragma unroll
        for (int j = 0; j < 16; ++j) { bool s = key[j] > thr; if (key[j] == thr) { s = (unsigned)er < rem; ++er; } if (s) { selm |= 1u << j; ++cs; } }
        int slot = block_excl_scan(cs, wsum, tid, tot);
#pragma unroll
        for (int j = 0; j < 16; ++j) { const int t = 16 * tid + j; const bool s = (selm >> j) & 1u;
            inv[(size_t)(b * SEQ + t) * 16 + e] = s ? slot : -1;
            if (s) { const int ro = e * ROWS_E + b * CAP + slot; idxE[ro] = b * SEQ + t; gateE[ro] = __uint_as_float(key[j]); ++slot; } }
        __syncthreads();
    }
}


__device__ __forceinline__ void phase10(const Args& a, const int TID, const int BID, const int GD) {
    const int lane = TID & 63, wave = TID >> 6;
    float* xo = a.out; const float* fg = a.in[27];
    const float* mod = (const float*)(a.ws + WS_MOD);
    const bf16_t* X1b = (const bf16_t*)(a.ws + WS_X1B);
    const unsigned char* Y = a.ws + WS_WGUT; const int* inv = (const int*)(a.ws + WS_INV);
    f32x4 gg[4];
#pragma unroll
    for (int i = 0; i < 4; ++i) gg[i] = *(const f32x4*)(fg + 4 * (lane + 64 * i));
    const int row0 = BID * NWAVES + wave, rstride = GD * NWAVES;
    int myslot = (row0 < NTOK) ? inv[(size_t)row0 * 16 + (lane & 15)] : -1;
#pragma unroll 1
    for (int row = row0; row < NTOK; row += rstride) {
        const int b = row >> 13;
        const int slot_cur = myslot;
        if (row + rstride < NTOK) myslot = inv[(size_t)(row + rstride) * 16 + (lane & 15)];
        u32x2 xw[4];
#pragma unroll
        for (int i = 0; i < 4; ++i) xw[i] = *(const u32x2*)(X1b + (size_t)row * D + 4 * (lane + 64 * i));
        f32x4 mo[4];
#pragma unroll
        for (int i = 0; i < 4; ++i) mo[i] = (f32x4){0.f, 0.f, 0.f, 0.f};
        unsigned long long bal = __ballot(lane < 16 && slot_cur >= 0);
        while (bal) {
            int ee[4]; const unsigned char* yr[4];
#pragma unroll
            for (int q = 0; q < 4; ++q) { ee[q] = -1; if (bal) { ee[q] = (int)__builtin_ctzll(bal); bal &= bal - 1; } }
#pragma unroll
            for (int q = 0; q < 4; ++q) { const int e = ee[q] < 0 ? 0 : ee[q]; const int sl = __shfl(slot_cur, e); yr[q] = Y + (size_t)(e * ROWS_E + b * CAP + (sl < 0 ? 0 : sl)) * D; }
            unsigned yw[4][4];
#pragma unroll
            for (int q = 0; q < 4; ++q)
#pragma unroll
                for (int i = 0; i < 4; ++i) { yw[q][i] = 0u; if (ee[q] >= 0) yw[q][i] = *(const unsigned*)(yr[q] + 4 * (lane + 64 * i)); }
#pragma unroll
            for (int q = 0; q < 4; ++q)
#pragma unroll
                for (int i = 0; i < 4; ++i) { const f32x2 lo = __builtin_amdgcn_cvt_pk_f32_fp8((int)yw[q][i], false), hi = __builtin_amdgcn_cvt_pk_f32_fp8((int)yw[q][i], true);
                    mo[i].x += lo.x; mo[i].y += lo.y; mo[i].z += hi.x; mo[i].w += hi.y; }
        }
        const float* g5 = mod + b * 6144 + 5120;
        f32x4 v[4]; float ss = 0.f;
#pragma unroll
        for (int i = 0; i < 4; ++i) { const f32x4 g = *(const f32x4*)(g5 + 4 * (lane + 64 * i)) * (1.0f / 32.0f);
            v[i] = (f32x4){bf_lo(xw[i].x), bf_hi(xw[i].x), bf_lo(xw[i].y), bf_hi(xw[i].y)};
            v[i] = v[i] + g * mo[i];
            ss += v[i].x * v[i].x + v[i].y * v[i].y + v[i].z * v[i].z + v[i].w * v[i].w; }
        ss = wave_sum(ss);
        const float r = rsqrtf(ss * (1.0f / D) + 1e-6f);
#pragma unroll
        for (int i = 0; i < 4; ++i) *(f32x4*)(xo + (size_t)row * D + 4 * (lane + 64 * i)) = (v[i] * r) * gg[i];
    }
}

#define XB_TMO      128
#define XB_XCNT(j)  (256  + 64 * (j))
#define XB_XSUB(j)  (1280 + 64 * (j))
#define XB_XGEN(j)  (2304 + 64 * (j))
#define XB_TOP      3328
#define XB_TOPGEN   3392
#define XCD_BAR_WORDS 3456
#define XB_SPIN_CAP (1u << 18)
__device__ __forceinline__ unsigned xb_ld(unsigned* p)              { return __hip_atomic_load(p, __ATOMIC_RELAXED, __HIP_MEMORY_SCOPE_AGENT); }
__device__ __forceinline__ unsigned xb_add(unsigned* p, unsigned v) { return __hip_atomic_fetch_add(p, v, __ATOMIC_RELAXED, __HIP_MEMORY_SCOPE_AGENT); }
__device__ __forceinline__ unsigned xb_xcc_id() { return (unsigned)__builtin_amdgcn_s_getreg((3 << 11) | 20) & 0xFu; }
#define XB_SPIN(cond, bar) do { unsigned _sp = 0; while (cond) { __builtin_amdgcn_s_sleep(1); \
    if ((++_sp & 255u) == 0u) { if (xb_ld(&(bar)[XB_TMO])) break; if (_sp > XB_SPIN_CAP) { atomicAdd(&(bar)[XB_TMO], 1u); break; } } } } while (0)
struct XcdBarrier { unsigned* bar; unsigned x; volatile LAS unsigned* st; };

__device__ __forceinline__ int lane_id_opaque() { unsigned m = ~0u; asm volatile("" : "+s"(m)); return (int)__builtin_amdgcn_mbcnt_hi(m, __builtin_amdgcn_mbcnt_lo(m, 0u)); }
__device__ __forceinline__ XcdBarrier xcd_barrier_post(unsigned* bar, volatile LAS unsigned* st, int tid) {
    XcdBarrier b; b.bar = bar; b.x = xb_xcc_id(); b.st = st;
    if (tid == 0) (void)xb_add(&bar[XB_XCNT(b.x)], 1u);
    return b;
}
__device__ __forceinline__ void xcd_barrier_complete(unsigned* bar, unsigned x, unsigned G, unsigned& nloc, unsigned& nx) {
    unsigned sum, cnt, mine, sp = 0u;
    for (;;) {
        sum = 0u; cnt = 0u; mine = 0u;
#pragma unroll
        for (unsigned j = 0; j < 16; ++j) { const unsigned c = xb_ld(&bar[XB_XCNT(j)]); sum += c; cnt += (c > 0u) ? 1u : 0u; mine = (j == x) ? c : mine; }
        if (sum == G) break;
        __builtin_amdgcn_s_sleep(1);
        if ((++sp & 255u) == 0u) { if (xb_ld(&bar[XB_TMO])) break; if (sp > XB_SPIN_CAP) { atomicAdd(&bar[XB_TMO], 1u); break; } }
    }
    nloc = mine > 0u ? mine : 1u; nx = cnt > 0u ? cnt : 1u;
}
__device__ __forceinline__ void xcd_barrier(const XcdBarrier& b, int tid, unsigned G) {
    asm volatile("s_waitcnt vmcnt(0)" ::: "memory");
    __syncthreads();
    if (tid == 0) {
        unsigned* bar = b.bar;
        __builtin_amdgcn_s_waitcnt(0);
        unsigned nloc = b.st[0], nx = b.st[1];
        if (nloc == 0u) { xcd_barrier_complete(bar, b.x, G, nloc, nx); b.st[0] = nloc; b.st[1] = nx; }
        const unsigned old = xb_add(&bar[XB_XSUB(b.x)], 1u);
        const unsigned gen = old / nloc;
        if (old + 1u == (gen + 1u) * nloc) {
            __builtin_amdgcn_fence(__ATOMIC_RELEASE, "agent");
            asm volatile("s_waitcnt vmcnt(0)" ::: "memory");
            const unsigned og = xb_add(&bar[XB_TOP], 1u);
            const unsigned tg = og / nx;
            if (og + 1u == (tg + 1u) * nx) xb_add(&bar[XB_TOPGEN], 1u);
            else XB_SPIN(xb_ld(&bar[XB_TOPGEN]) == tg, bar);
            __builtin_amdgcn_fence(__ATOMIC_ACQUIRE, "agent");
            xb_add(&bar[XB_XGEN(b.x)], 1u);
            asm volatile("s_waitcnt vmcnt(0)" ::: "memory");
        } else {
            XB_SPIN(xb_ld(&bar[XB_XGEN(b.x)]) == gen, bar);
            __builtin_amdgcn_fence(__ATOMIC_ACQUIRE, "agent");
            asm volatile("s_waitcnt vmcnt(0)" ::: "memory");
        }
    }
    __syncthreads();
}
constexpr int BAR_LDS_OFF = LDS_BYTES - 64;
constexpr size_t WS_BAR = WS_CTL + 16384;

typedef const __attribute__((address_space(4))) Args* ArgsP;
template <int PH>
__device__ __forceinline__ void do_phase(LAS unsigned char* lds, const Args& a_in, const int wave_id_s) {
#if defined(__HIP_DEVICE_COMPILE__)
    ArgsP ap = (ArgsP)__builtin_amdgcn_kernarg_segment_ptr();
    asm volatile("" : "+s"(ap));
    const Args a = *ap;
#else
    const Args a = a_in;
#endif
    const int nrep = 1 + ((a.dbg >> (8 + PH)) & 1);
#pragma unroll 1
    for (int rep = 0; rep < nrep; ++rep) {
        int WID = wave_id_s, BID = blockIdx.x, GD = gridDim.x;
        asm volatile("" : "+s"(WID), "+s"(BID), "+s"(GD));
        const int TID = WID * 64 + lane_id_opaque();
        const int G = GD;
        unsigned char* ws = a.ws;
        if constexpr (PH == 0) { phase0(lds, a, TID, BID, GD); if (rep == nrep - 1) { wg_wait((unsigned*)(ws + WS_ADACNT), 96u * (unsigned)nrep, TID); phase1(a, TID, BID, GD); } }
        else if constexpr (PH == 1) { }
        else if constexpr (PH == 2) {
            if (BID & 1) { convert_items(lds, a, 1, TID, BID, GD); __syncthreads(); }
            pg8::SchedInProj S{G, BID};
            EpiInProj E{(bf16_t*)(ws + WS_XGLU), (bf16_t*)(ws + WS_XLX), (bf16_t*)(ws + WS_GLG), a.in[9]};
            pg8::gemm_phase<EpiInProj, pg8::SchedInProj, false>(lds, (const bf16_t*)(ws + WS_U), (const bf16_t*)(ws + WS_WINT), 1024, S, E, nullptr, TID, BID, GD, 0x7F7F7F7F, pg8::lay_rowmajor(1024));
            if (!(BID & 1)) { __syncthreads(); convert_items(lds, a, 1, TID, BID, GD); }
        } else if constexpr (PH == 3) {
            {
                pg8::SchedCtx S{BID};
                EpiInProj E{(bf16_t*)(ws + WS_XGLU), (bf16_t*)(ws + WS_XLX), (bf16_t*)(ws + WS_GLG), a.in[9]};
                pg8::gemm_phase<EpiInProj, pg8::SchedCtx, false>(lds, (const bf16_t*)(ws + WS_U), (const bf16_t*)(ws + WS_WINT), 1024, S, E, nullptr, TID, BID, GD, 0x7F7F7F7F, pg8::lay_rowmajor(1024));
                if ((BID & 7) == 7 && (BID >> 3) < 8) {
                    asm volatile("s_waitcnt vmcnt(0)" ::: "memory");
                    __syncthreads();
                    if (TID == 0) { __builtin_amdgcn_fence(__ATOMIC_RELEASE, "agent"); asm volatile("s_waitcnt vmcnt(0)" ::: "memory");
                        __hip_atomic_store((unsigned*)(ws + WS_CTXFLAG) + 64 * (BID >> 3), 1u, __ATOMIC_RELAXED, __HIP_MEMORY_SCOPE_AGENT); }
                }
            }
            conv_units(lds, a, BID, G, TID, BID, GD);
            lru_phase<1>(lds, a, TID, BID, GD);
            if (rep == nrep - 1) { __syncthreads(); lru_rescan(lds, a, TID, BID, GD); }
        } else if constexpr (PH == 4) {
        } else if constexpr (PH == 5) {
            pg8::Sched S{128, 4, 1, G, BID};
            EpiOutProj E{(bf16_t*)(ws + WS_M), (const float*)(ws + WS_MOD), a.in[22]};
            pg8::gemm_phase<EpiOutProj, pg8::Sched, false>(lds, (const bf16_t*)(ws + WS_MIX), (const bf16_t*)(ws + WS_WOUTT), 1024, S, E, nullptr, TID, BID, GD, 0x7F7F7F7F, pg8::lay_rowmajor(1024));
        } else if constexpr (PH == 6) phase6(lds, a, TID, BID, GD);
        else if constexpr (PH == 7) phase7(lds, a, TID, BID, GD);
        else if constexpr (PH == 8) {
            if (BID & 1) { convert_items(lds, a, 2, TID, BID, GD); __syncthreads(); }
            pg8::Sched S{16, 22, 16, G, BID};
            EpiExpUp E{ws + WS_R1};
            pg8::gemm_phase<EpiExpUp, pg8::Sched, true, true>(lds, (const bf16_t*)(ws + WS_V), (const bf16_t*)(ws + WS_WGUT), 512, S, E, (const int*)(ws + WS_IDXE), TID, BID, GD, 0x7A7A7A7A, pg8::lay_rowmajor(512));
            if (!(BID & 1)) { __syncthreads(); convert_items(lds, a, 2, TID, BID, GD); }
        } else if constexpr (PH == 9) {
            pg8::SchedDown S{G, BID};
            EpiExpDown E{ws + WS_WGUT, (const float*)(ws + WS_GATEE)};
            pg8::gemm_phase<EpiExpDown, pg8::SchedDown, false, true>(lds, (const bf16_t*)(ws + WS_R1), (const bf16_t*)(ws + WS_WDT), DE / 2, S, E, nullptr, TID, BID, GD, 0x79797979, pg8::lay_blocked(22));
        } else if constexpr (PH == 10) phase10(a, TID, BID, GD);
    }
}
template <int PH, int PH0, int PH1>
__device__ __forceinline__ void run_phases(LAS unsigned char* lds, const Args& a_in, const int wave_id_s) {
    if constexpr (PH < PH1) {
        if constexpr (PH > PH0 && PH != 1 && PH != 4) {
#if defined(__HIP_DEVICE_COMPILE__)
            ArgsP apb = (ArgsP)__builtin_amdgcn_kernarg_segment_ptr(); asm volatile("" : "+s"(apb));
            XcdBarrier xb2; xb2.bar = (unsigned*)(apb->ws + WS_BAR); xb2.x = xb_xcc_id(); xb2.st = (volatile LAS unsigned*)(lds + BAR_LDS_OFF);
            int wv = wave_id_s; asm volatile("" : "+s"(wv));
            xcd_barrier(xb2, wv * 64 + lane_id_opaque(), gridDim.x);
#endif
        }
        do_phase<PH>(lds, a_in, wave_id_s);
        run_phases<PH + 1, PH0, PH1>(lds, a_in, wave_id_s);
    }
}
template <int PH0, int PH1>
__global__ void __launch_bounds__(NTHREADS, 2) hybrid_fwd(Args a_in) {
    extern __shared__ __attribute__((aligned(16))) unsigned char lds_raw[];
    LAS unsigned char* lds = (LAS unsigned char*)lds_raw;
    const int wave_id_s = __builtin_amdgcn_readfirstlane((int)threadIdx.x >> 6);
    {
        volatile LAS unsigned* st = (volatile LAS unsigned*)(lds + BAR_LDS_OFF);
        if (threadIdx.x == 0) { st[0] = 0u; st[1] = 0u; }
        __syncthreads();
        (void)xcd_barrier_post((unsigned*)(a_in.ws + WS_BAR), st, (int)threadIdx.x);
    }
    run_phases<PH0, PH0, PH1>(lds, a_in, wave_id_s);
}

extern "C" void kernel_launch(void* const* d_in, const int* in_sizes, int n_in, void* d_out, int out_size, void* d_ws, size_t ws_size, hipStream_t stream) {
    if (n_in != 28 || out_size != NTOK * D || ws_size < WS_END) { fprintf(stderr, "kernel_launch: unexpected shapes (n_in %d out %d ws %zu)\n", n_in, out_size, ws_size); return; }
    Args a{};
    for (int i = 0; i < 28; ++i) a.in[i] = (const float*)d_in[i];
    a.out = (float*)d_out; a.ws = (unsigned char*)d_ws; a.dbg = PROBE_MASK; a.pad = 0;
    static int grid = 0;
    if (!grid) {
        (void)hipFuncSetAttribute((const void*)hybrid_fwd<0, 11>, hipFuncAttributeMaxDynamicSharedMemorySize, LDS_BYTES);
        int dev = 0, cus = 0, per_cu = 0;
        (void)hipGetDevice(&dev); (void)hipDeviceGetAttribute(&cus, hipDeviceAttributeMultiprocessorCount, dev);
        (void)hipOccupancyMaxActiveBlocksPerMultiprocessor(&per_cu, (const void*)hybrid_fwd<0, 11>, NTHREADS, LDS_BYTES);
        grid = (per_cu >= 1 ? 1 : 0) * cus;
        if (grid != 256) fprintf(stderr, "kernel_launch: grid %d (cus %d per_cu %d)\n", grid, cus, per_cu);
    }
    if (grid <= 0) return;
    a.ph_lo = 0; a.ph_hi = 11;
    (void)hipMemsetAsync((char*)d_ws + WS_CTL, 0, 65536, stream);
    void* kargs[] = {&a};
    hipError_t e = hipLaunchCooperativeKernel((const void*)hybrid_fwd<0, 11>, dim3(grid), dim3(NTHREADS), kargs, LDS_BYTES, stream);
    if (e != hipSuccess) fprintf(stderr, "cooperative launch failed: %s (grid %d)\n", hipGetErrorString(e), grid);
}
```

```cpp
#include <hip/hip_runtime.h>
#include <hip/hip_cooperative_groups.h>
#include <cstdio>
#include <cstdint>

#define LAS __attribute__((address_space(3)))
typedef unsigned short bf16_t;
typedef short bf16x8 __attribute__((ext_vector_type(8)));
typedef float f32x4 __attribute__((ext_vector_type(4)));
typedef float f32x2 __attribute__((ext_vector_type(2)));
typedef unsigned u32x4 __attribute__((ext_vector_type(4)));
typedef unsigned u32x2 __attribute__((ext_vector_type(2)));
typedef int v4i_t __attribute__((ext_vector_type(4)));
typedef _Float16 h2_t __attribute__((ext_vector_type(2)));
typedef int v8i_t __attribute__((ext_vector_type(8)));

constexpr int D = 1024, NB = 4, SEQ = 8192, NTOK = NB * SEQ, CTXL = 256, NCTX = NB * CTXL, NROWS = NTOK + NCTX;
constexpr int DE = 2816, NE = 16, CAP = 1024, ROWS_E = NB * CAP;
constexpr int NQ = 132;
constexpr int NWAVES = 8, NTHREADS = 512;

constexpr size_t MiB = 1u << 20;
constexpr size_t WS_CTL = 0, CTL_BYTES = 1 * MiB;
constexpr size_t WS_CTXFLAG = WS_CTL + 40960;
constexpr size_t WS_ADACNT = WS_CTL + 45056;
constexpr size_t WS_BHCNT = WS_CTL + 49152;
constexpr size_t WS_MOD = 1 * MiB;
constexpr size_t WS_CARRY = 2 * MiB;
constexpr size_t WS_AFFT = 7 * MiB;
constexpr size_t WS_IDXE = 9 * MiB;
constexpr size_t WS_GATEE = WS_IDXE + 256 * 1024;
constexpr size_t WS_INV = WS_GATEE + 256 * 1024;
constexpr size_t WS_WINT = 12 * MiB;
constexpr size_t WS_WOUTT = 16 * MiB;
constexpr size_t WS_WGUT = 18 * MiB;
constexpr size_t WS_WDT = 146 * MiB;
constexpr size_t WS_V = 190 * MiB;
constexpr size_t WS_R1 = 222 * MiB;
constexpr size_t WS_U = WS_R1;
constexpr size_t WS_XGLU = WS_R1 + 66 * MiB;
constexpr size_t WS_XLX = WS_R1 + 98 * MiB;
constexpr size_t WS_GLG = WS_R1 + 131 * MiB;
constexpr size_t WS_MIX = WS_R1 + 163 * MiB;
constexpr size_t WS_M = WS_R1 + 227 * MiB;
constexpr size_t WS_X1B = WS_R1 + 291 * MiB;
constexpr size_t WS_AU = WS_R1 + 291 * MiB;
constexpr size_t WS_END = 641 * MiB;
constexpr int LDS_BYTES = 147456;

__device__ __forceinline__ unsigned f2bf(float f) { unsigned u = __builtin_bit_cast(unsigned, f); return (u + 0x7fffu + ((u >> 16) & 1u)) >> 16; }
__device__ __forceinline__ unsigned pk2(float lo, float hi) { return f2bf(lo) | (f2bf(hi) << 16); }
__device__ __forceinline__ unsigned pk2h(float lo, float hi) { h2_t p; p.x = (_Float16)lo; p.y = (_Float16)hi; return __builtin_bit_cast(unsigned, p); }
__device__ __forceinline__ void fma_mix_lo(float& acc, float w, unsigned xh) { asm("v_fma_mix_f32 %0, %1, %2, %0 op_sel_hi:[0,1,0]" : "+v"(acc) : "v"(w), "v"(xh)); }
__device__ __forceinline__ void fma_mix_hi(float& acc, float w, unsigned xh) { asm("v_fma_mix_f32 %0, %1, %2, %0 op_sel:[0,1,0] op_sel_hi:[0,1,0]" : "+v"(acc) : "v"(w), "v"(xh)); }
__device__ __forceinline__ float bf_lo(unsigned w) { return __builtin_bit_cast(float, w << 16); }
__device__ __forceinline__ float bf_hi(unsigned w) { return __builtin_bit_cast(float, w & 0xffff0000u); }
__device__ __forceinline__ unsigned pk4_fp8(float a, float b, float c, float d) {
    a = __builtin_amdgcn_fmed3f(a, -448.f, 448.f); b = __builtin_amdgcn_fmed3f(b, -448.f, 448.f); c = __builtin_amdgcn_fmed3f(c, -448.f, 448.f); d = __builtin_amdgcn_fmed3f(d, -448.f, 448.f);
    int w = 0; w = __builtin_amdgcn_cvt_pk_fp8_f32(a, b, w, false); w = __builtin_amdgcn_cvt_pk_fp8_f32(c, d, w, true); return (unsigned)w; }
__device__ __forceinline__ float wave_sum(float v) {
#pragma unroll
    for (int o = 32; o >= 1; o >>= 1) v += __shfl_xor(v, o);
    return v;
}
__device__ __forceinline__ float wave_max(float v) {
#pragma unroll
    for (int o = 32; o >= 1; o >>= 1) v = fmaxf(v, __shfl_xor(v, o));
    return v;
}
__device__ __forceinline__ float sigm(float x) { return __builtin_amdgcn_rcpf(1.0f + __expf(-x)); }
__device__ __forceinline__ float silu_f(float x) { return x * sigm(x); }
__device__ __forceinline__ float gelu_tanh(float x) { const float z = 0.7978845608028654f * (x + 0.044715f * x * x * x); return x * sigm(2.0f * z); }

namespace pg8 {
constexpr int BM = 256, BK = 64, HALF = 128, HTB = HALF * BK * 2, STAGE_BYTES = 8 * HTB, NXCD = 8, WGM = 8;
__device__ __forceinline__ int lds_byte(int r, int c) { const int st = (r >> 4) * 2 + (c >> 5), rr = r & 15, cc = c & 31, ob = rr * 64 + cc * 2; return st * 1024 + (ob ^ (((ob >> 9) & 1) << 5)); }
__device__ __forceinline__ void stage_rc(int b, int& R, int& C) { const int st = b / 1024, sb = b % 1024, swz = sb ^ (((sb >> 9) & 1) << 5); R = (st >> 1) * 16 + swz / 64; C = (st & 1) * 32 + (swz % 64) / 2; }
__device__ __forceinline__ int perm32(int rho) { const int n = rho >> 4, i = rho & 15; return 8 * (i >> 2) + 4 * n + (i & 3); }
struct Unit { int pm, pn; };
struct Lay { unsigned rowA, rowB; size_t kstepA, kstepB, hstepB, tstepA, tstepB; };
__device__ __forceinline__ Lay lay_rowmajor(int K) { Lay l; l.rowA = l.rowB = (unsigned)K * 2u; l.kstepA = l.kstepB = 128; l.hstepB = (size_t)128 * K * 2; l.tstepA = l.tstepB = (size_t)256 * K * 2; return l; }
__device__ __forceinline__ Lay lay_blocked(int nkt) { Lay l; l.rowA = l.rowB = 128u; l.kstepA = l.kstepB = 32768; l.hstepB = 16384; l.tstepA = l.tstepB = (size_t)nkt * 32768; return l; }

__device__ __forceinline__ void tile_order(int w, int nM, int nN, int& pm, int& pn) {
    const int nwg = nM * nN;
    int wgid = w; { const int q = nwg / NXCD, r = nwg % NXCD, xcd = wgid % NXCD, off = wgid / NXCD; wgid = (xcd < r ? xcd * (q + 1) : r * (q + 1) + (xcd - r) * q) + off; }
    const int nig = WGM * nN, gid = wgid / nig, fm = gid * WGM, gsz = (nM - fm) < WGM ? (nM - fm) : WGM;
    pm = fm + ((wgid % nig) % gsz); pn = (wgid % nig) / gsz;
}
struct Sched {
    int nM, nN, ngroups, G, c;
    __device__ __forceinline__ bool next(int i, Unit& u) const {
        const int per = nM * nN; const long L = (long)i * G + c; if (L >= (long)per * ngroups) return false;
        const int e = (int)(L / per), w = (int)(L % per); int pm, pn; tile_order(w, nM, nN, pm, pn);
        u.pm = e * nM + pm; u.pn = e * nN + pn; return true;
    }
};
struct SchedInProj {
    int G, c;
    __device__ __forceinline__ bool next(int i, Unit& u) const {
        const long L = (long)i * G + c; if (L >= 1024) return false;
        int pm, pn; tile_order((int)L, 128, 8, pm, pn); u.pm = pm; u.pn = pn; return true;
    }
};
struct SchedCtx {
    int c;
    __device__ __forceinline__ bool next(int i, Unit& u) const {
        if (i != 0 || (c & 7) != 7 || (c >> 3) >= 8) return false;
        const int k = c >> 3; u.pm = 128 + (k >> 1); u.pn = 4 + (k & 1); return true;
    }
};
struct SchedDown {
    int G, c;
    __device__ __forceinline__ bool next(int i, Unit& u) const {
        if (G != 256) { const long L = (long)i * G + c; if (L >= 1024) return false; const int e = (int)(L >> 6), w = (int)(L & 63); u.pm = e * 16 + (w >> 2); u.pn = e * 4 + (w & 3); return true; }
        if (i >= 4) return false;
        const int x = c & 7, j = c >> 3, e = 4 * i + (x >> 1);
        u.pm = e * 16 + 8 * (x & 1) + (j & 7); u.pn = e * 4 + (j >> 3); return true;
    }
};
template <class Epi, class SchedT, bool GATHER, bool FP8 = false, bool SP2 = true, bool ALIGN_EPI = true>
__device__ __forceinline__ void gemm_phase(LAS unsigned char* lds, const bf16_t* Ag, const bf16_t* Btg, const int K, const SchedT& S, const Epi& E, const int* gidx, const int TID, const int BID, const int GD, const int scaleB, const Lay L) {
    const int tid = TID, wid = __builtin_amdgcn_readfirstlane(tid >> 6), lane = tid & 63, wr = wid >> 2, wc = wid & 3, fr = lane & 15, fq = lane >> 4;
    const int nt = K / BK;
    int Rr[2], Cc[2]; unsigned voffB[2];
#pragma unroll
    for (int i = 0; i < 2; ++i) { stage_rc(tid * 16 + i * 8192, Rr[i], Cc[i]); const int Rb = Epi::PERM ? ((Rr[i] & ~31) + perm32(Rr[i] & 31)) : Rr[i]; voffB[i] = (unsigned)Rb * L.rowB + (unsigned)Cc[i] * 2u; }
    const size_t kstepA = L.kstepA, kstepB = L.kstepB, hstep = L.hstepB, tstepA = L.tstepA, tstepB = L.tstepB;
    const unsigned ldsw = (unsigned)wid * 1024u;
    const int aoff = lds_byte(wr * 64 + fr, fq * 8), boff = lds_byte(wc * 32 + fr, fq * 8);
    const int aoff8_0 = aoff, aoff8_1 = aoff + 1024, boff8_0 = boff, boff8_1 = boff + 1024;
#define PG8_SA(b, h) (((b) * 2 + (h)) * HTB)
#define PG8_SB(b, h) ((4 + (b) * 2 + (h)) * HTB)
#define PG8_STAGE(bufoff, gbase, voff) do { _Pragma("unroll") for (int _i = 0; _i < 2; ++_i) \
        __builtin_amdgcn_global_load_lds((const unsigned*)((const char*)(gbase) + (voff)[_i]), (LAS unsigned*)(lds + (bufoff) + ldsw + _i * 8192), 16, 0, 0); } while (0)
#define PG8_LD8(p0, p1) __builtin_shufflevector(*(const LAS v4i_t*)(p0), *(const LAS v4i_t*)(p1), 0, 1, 2, 3, 4, 5, 6, 7)
#define PG8_LDA(dst, b, h) do { _Pragma("unroll") for (int m = 0; m < 4; ++m) { if constexpr (FP8) { \
        dst##8[m] = PG8_LD8(lds + PG8_SA(b, h) + aoff8_0 + m * 2048, lds + PG8_SA(b, h) + aoff8_1 + m * 2048); } else { \
        _Pragma("unroll") for (int k = 0; k < 2; ++k) dst[m][k] = *(const LAS bf16x8*)(lds + PG8_SA(b, h) + aoff + m * 2048 + k * 1024); } } } while (0)
#define PG8_LDB(dst, b, h) do { _Pragma("unroll") for (int n = 0; n < 2; ++n) { if constexpr (FP8) { \
        dst##8[n] = PG8_LD8(lds + PG8_SB(b, h) + boff8_0 + n * 2048, lds + PG8_SB(b, h) + boff8_1 + n * 2048); } else { \
        _Pragma("unroll") for (int k = 0; k < 2; ++k) dst[n][k] = *(const LAS bf16x8*)(lds + PG8_SB(b, h) + boff + n * 2048 + k * 1024); } } } while (0)
#define PG8_MMA(ai, bj, At, Bt) do { if constexpr (FP8) __builtin_amdgcn_sched_barrier(0); __builtin_amdgcn_s_setprio(1); _Pragma("unroll") for (int m = 0; m < 4; ++m) _Pragma("unroll") for (int n = 0; n < 2; ++n) { if constexpr (FP8) { \
        acc[ai][bj][m][n] = __builtin_amdgcn_mfma_scale_f32_16x16x128_f8f6f4(Bt##8[n], At##8[m], acc[ai][bj][m][n], 0, 0, 0, scaleB, 0, 0x7F7F7F7F); } else { \
        _Pragma("unroll") for (int k = 0; k < 2; ++k) acc[ai][bj][m][n] = __builtin_amdgcn_mfma_f32_16x16x32_bf16(Bt[n][k], At[m][k], acc[ai][bj][m][n], 0, 0, 0); } } \
        if constexpr (FP8) { _Pragma("unroll") for (int m = 0; m < 4; ++m) _Pragma("unroll") for (int n = 0; n < 2; ++n) asm volatile("" : "+v"(acc[ai][bj][m][n])); } \
        __builtin_amdgcn_s_setprio(0); if constexpr (FP8) __builtin_amdgcn_sched_barrier(0); } while (0)
#define PG8_WAIT_V(n) asm volatile("s_waitcnt vmcnt(" #n ")" ::: "memory")
#define PG8_WAIT_L(n) asm volatile("s_waitcnt lgkmcnt(" #n ")" ::: "memory")
#define PG8_BAR __builtin_amdgcn_s_barrier()
#define PG8_SCHED __builtin_amdgcn_sched_barrier(0)
#define PG8_LOADV(dst, u) do { _Pragma("unroll") for (int _h = 0; _h < 2; ++_h) _Pragma("unroll") for (int _i = 0; _i < 2; ++_i) \
        dst[_h][_i] = GATHER ? ((unsigned)gidx[(u).pm * BM + _h * HALF + Rr[_i]] * L.rowA + (unsigned)Cc[_i] * 2u) : ((unsigned)(_h * HALF + Rr[_i]) * L.rowA + (unsigned)Cc[_i] * 2u); } while (0)
    Unit cur, nxt; int ui = 0;
    if (!S.next(0, cur)) return;
    f32x4 acc[2][2][4][2];
#pragma unroll
    for (int a = 0; a < 2; ++a)
#pragma unroll
        for (int b = 0; b < 2; ++b)
#pragma unroll
            for (int m = 0; m < 4; ++m)
#pragma unroll
                for (int n = 0; n < 2; ++n) acc[a][b][m][n] = (f32x4){0.f, 0.f, 0.f, 0.f};
    bf16x8 At[4][2], B0[2][2], B1[2][2];
    v8i_t At8[4], B08[2], B18[2];
    unsigned vc[2][2], vn[2][2];
    PG8_LOADV(vc, cur);
    const char* cA = GATHER ? (const char*)Ag : (const char*)Ag + (size_t)cur.pm * tstepA;
    const char* cB = (const char*)Btg + (size_t)cur.pn * tstepB;
    if constexpr (SP2) {
        PG8_STAGE(PG8_SB(0, 0), cB, voffB); PG8_STAGE(PG8_SB(0, 1), cB + hstep, voffB); PG8_STAGE(PG8_SA(0, 0), cA, vc[0]); PG8_STAGE(PG8_SA(0, 1), cA, vc[1]);
        if (wr == 1) PG8_BAR;
        PG8_WAIT_V(2); PG8_BAR;
        PG8_STAGE(PG8_SB(1, 0), cB + kstepB, voffB); PG8_STAGE(PG8_SA(1, 0), cA + kstepA, vc[0]); PG8_STAGE(PG8_SB(1, 1), cB + hstep + kstepB, voffB);
        PG8_WAIT_V(6); PG8_BAR;
    } else {
    PG8_STAGE(PG8_SB(0, 0), cB, voffB); PG8_STAGE(PG8_SA(0, 0), cA, vc[0]); PG8_STAGE(PG8_SB(0, 1), cB + hstep, voffB); PG8_STAGE(PG8_SA(0, 1), cA, vc[1]);
    if (wr == 1) PG8_BAR;
    PG8_WAIT_V(4); PG8_BAR;
    PG8_STAGE(PG8_SB(1, 0), cB + kstepB, voffB); PG8_STAGE(PG8_SA(1, 0), cA + kstepA, vc[0]); PG8_STAGE(PG8_SB(1, 1), cB + hstep + kstepB, voffB);
    PG8_WAIT_V(6); PG8_BAR;
    }
    for (;;) {
        const bool has_next = S.next(ui + 1, nxt);
        const char* nA = cA; const char* nB = cB;
        if (has_next) { nA = GATHER ? (const char*)Ag : (const char*)Ag + (size_t)nxt.pm * tstepA; nB = (const char*)Btg + (size_t)nxt.pn * tstepB; PG8_LOADV(vn, nxt); }
        else {
#pragma unroll
            for (int h = 0; h < 2; ++h)
#pragma unroll
                for (int i = 0; i < 2; ++i) vn[h][i] = vc[h][i];
        }
        for (int t = 0; t < nt; t += 2) {
            const bool last = (t == nt - 2);
            const char* a1 = cA + (size_t)(t + 1) * kstepA;
            const char* a2 = last ? nA : cA + (size_t)(t + 2) * kstepA; const char* b2 = last ? nB : cB + (size_t)(t + 2) * kstepB;
            const char* a3 = a2 + kstepA; const char* b3 = b2 + kstepB;
#pragma unroll
            for (int i = 0; i < 2; ++i) vc[0][i] = last ? vn[0][i] : vc[0][i];
            if constexpr (SP2) {
            PG8_LDB(B0, 0, 0); PG8_LDB(B1, 0, 1); PG8_SCHED; PG8_LDA(At, 0, 0); PG8_STAGE(PG8_SA(1, 1), a1, vc[1]);
            _Pragma("unroll") for (int i = 0; i < 2; ++i) vc[1][i] = last ? vn[1][i] : vc[1][i];
            PG8_WAIT_V(8); PG8_WAIT_L(0); PG8_BAR; PG8_MMA(0, 0, At, B0); PG8_MMA(0, 1, At, B1); PG8_BAR; PG8_SCHED;
            PG8_LDA(At, 0, 1); PG8_STAGE(PG8_SB(0, 0), b2, voffB); PG8_STAGE(PG8_SB(0, 1), b2 + hstep, voffB); PG8_STAGE(PG8_SA(0, 0), a2, vc[0]);
            PG8_WAIT_V(8); PG8_WAIT_L(0); PG8_BAR; PG8_MMA(1, 0, At, B0); PG8_MMA(1, 1, At, B1); PG8_BAR; PG8_SCHED;
            PG8_LDB(B0, 1, 0); PG8_LDB(B1, 1, 1); PG8_SCHED; PG8_LDA(At, 1, 0); PG8_STAGE(PG8_SA(0, 1), a2, vc[1]);
            PG8_WAIT_V(8); PG8_WAIT_L(0); PG8_BAR; PG8_MMA(0, 0, At, B0); PG8_MMA(0, 1, At, B1); PG8_BAR; PG8_SCHED;
            PG8_LDA(At, 1, 1); PG8_STAGE(PG8_SB(1, 0), b3, voffB); PG8_STAGE(PG8_SB(1, 1), b3 + hstep, voffB); PG8_STAGE(PG8_SA(1, 0), a3, vc[0]);
            PG8_WAIT_V(8); PG8_WAIT_L(0); PG8_BAR; PG8_MMA(1, 0, At, B0); PG8_MMA(1, 1, At, B1); PG8_BAR; PG8_SCHED;
            } else {
            PG8_LDB(B0, 0, 0); PG8_SCHED; PG8_LDA(At, 0, 0); PG8_STAGE(PG8_SA(1, 1), a1, vc[1]);
            _Pragma("unroll") for (int i = 0; i < 2; ++i) vc[1][i] = last ? vn[1][i] : vc[1][i];
            PG8_WAIT_L(8); PG8_BAR; PG8_WAIT_L(0); PG8_MMA(0, 0, At, B0); PG8_BAR; PG8_SCHED;
            PG8_LDB(B1, 0, 1); PG8_STAGE(PG8_SB(0, 0), b2, voffB);
            PG8_BAR; PG8_WAIT_L(0); PG8_MMA(0, 1, At, B1); PG8_BAR;
            PG8_LDA(At, 0, 1); PG8_STAGE(PG8_SA(0, 0), a2, vc[0]);
            PG8_BAR; PG8_WAIT_L(0); PG8_MMA(1, 0, At, B0); PG8_BAR; PG8_SCHED;
            PG8_STAGE(PG8_SB(0, 1), b2 + hstep, voffB);
            PG8_WAIT_V(6); PG8_BAR; PG8_MMA(1, 1, At, B1); PG8_BAR;
            PG8_LDB(B0, 1, 0); PG8_SCHED; PG8_LDA(At, 1, 0); PG8_STAGE(PG8_SA(0, 1), a2, vc[1]);
            PG8_WAIT_L(8); PG8_BAR; PG8_WAIT_L(0); PG8_MMA(0, 0, At, B0); PG8_BAR; PG8_SCHED;
            PG8_LDB(B1, 1, 1); PG8_STAGE(PG8_SB(1, 0), b3, voffB);
            PG8_BAR; PG8_WAIT_L(0); PG8_MMA(0, 1, At, B1); PG8_BAR;
            PG8_LDA(At, 1, 1); PG8_STAGE(PG8_SA(1, 0), a3, vc[0]);
            PG8_BAR; PG8_WAIT_L(0); PG8_MMA(1, 0, At, B0); PG8_BAR; PG8_SCHED;
            PG8_STAGE(PG8_SB(1, 1), b3 + hstep, voffB);
            PG8_WAIT_V(6); PG8_BAR; PG8_MMA(1, 1, At, B1); PG8_BAR;
            }
        }
        if constexpr (ALIGN_EPI) { if (wr == 0) PG8_BAR; }
        E(acc, cur, wr, wc, fr, fq);
        if (!has_next) break;
#pragma unroll
        for (int a = 0; a < 2; ++a)
#pragma unroll
            for (int b = 0; b < 2; ++b)
#pragma unroll
                for (int m = 0; m < 4; ++m)
#pragma unroll
                    for (int n = 0; n < 2; ++n) acc[a][b][m][n] = (f32x4){0.f, 0.f, 0.f, 0.f};
        cur = nxt; cA = nA; cB = nB; ++ui;
#pragma unroll
        for (int h = 0; h < 2; ++h)
#pragma unroll
            for (int i = 0; i < 2; ++i) vc[h][i] = vn[h][i];
        if constexpr (ALIGN_EPI) { if (wr == 1) PG8_BAR; }
    }
    PG8_WAIT_V(0);
    if constexpr (!ALIGN_EPI) { if (wr == 0) PG8_BAR; }
    PG8_BAR;
#undef PG8_SA
#undef PG8_SB
#undef PG8_STAGE
#undef PG8_LDA
#undef PG8_LDB
#undef PG8_MMA
#undef PG8_LD8
#undef PG8_WAIT_V
#undef PG8_WAIT_L
#undef PG8_BAR
#undef PG8_SCHED
#undef PG8_LOADV
}
}

struct EpiInProj {
    static constexpr bool PERM = true;
    bf16_t* xglu; bf16_t* xlx; bf16_t* glg; const float* b_in;
    __device__ __forceinline__ void operator()(const f32x4 (&acc)[2][2][4][2], const pg8::Unit& u, int wr, int wc, int fr, int fq) const {
        const int row0 = u.pm * 256 + wr * 64 + fr, cl = wc * 32 + 8 * fq;
        if (u.pn < 4) {
            const int col = 128 * u.pn + cl;
            f32x4 bv[2][2];
#pragma unroll
            for (int n = 0; n < 2; ++n) { bv[0][n] = *(const f32x4*)(b_in + col + 4 * n); bv[1][n] = *(const f32x4*)(b_in + 512 + col + 4 * n); }
#pragma unroll
            for (int ai = 0; ai < 2; ++ai)
#pragma unroll
                for (int m = 0; m < 4; ++m) {
                    const size_t row = (size_t)(row0 + ai * 128 + m * 16);
                    float o[8];
#pragma unroll
                    for (int n = 0; n < 2; ++n) { const f32x4 v = acc[ai][0][m][n] + bv[0][n], g = acc[ai][1][m][n] + bv[1][n];
#pragma unroll
                        for (int j = 0; j < 4; ++j) o[4 * n + j] = v[j] * sigm(g[j]); }
                    u32x4 w; w.x = pk2h(o[0], o[1]); w.y = pk2h(o[2], o[3]); w.z = pk2h(o[4], o[5]); w.w = pk2h(o[6], o[7]);
                    *(u32x4*)(xglu + row * 512 + col) = w;
                }
        } else {
            const bool isg = u.pn >= 6;
            const int cbase = 256 * (u.pn - (isg ? 6 : 4));
            const float* bias = b_in + (isg ? 1536 : 1024) + cbase;
            bf16_t* outp = isg ? glg : xlx;
#pragma unroll
            for (int bj = 0; bj < 2; ++bj) {
                const int col = 128 * bj + cl;
                const f32x4 b0 = *(const f32x4*)(bias + col), b1 = *(const f32x4*)(bias + col + 4);
#pragma unroll
                for (int ai = 0; ai < 2; ++ai)
#pragma unroll
                    for (int m = 0; m < 4; ++m) {
                        const size_t row = (size_t)(row0 + ai * 128 + m * 16);
                        f32x4 v0 = acc[ai][bj][m][0] + b0, v1 = acc[ai][bj][m][1] + b1;
                        if (isg) {
#pragma unroll
                            for (int j = 0; j < 4; ++j) { v0[j] = gelu_tanh(v0[j]); v1[j] = gelu_tanh(v1[j]); }
                        }
                        u32x4 w; w.x = pk2(v0[0], v0[1]); w.y = pk2(v0[2], v0[3]); w.z = pk2(v1[0], v1[1]); w.w = pk2(v1[2], v1[3]);
                        *(u32x4*)(outp + row * 512 + cbase + col) = w;
                    }
            }
        }
    }
};
struct EpiOutProj {
    static constexpr bool PERM = true;
    bf16_t* M; const float* mod; const float* b_out;
    __device__ __forceinline__ void operator()(const f32x4 (&acc)[2][2][4][2], const pg8::Unit& u, int wr, int wc, int fr, int fq) const {
        const int row0 = u.pm * 256 + wr * 64 + fr, col0 = u.pn * 256 + wc * 32 + 8 * fq;
        const int b = u.pm >> 5;
        const float* g1 = mod + b * 6144 + 2048;
#pragma unroll
        for (int bj = 0; bj < 2; ++bj) {
            const int col = col0 + bj * 128;
            const f32x4 bo0 = *(const f32x4*)(b_out + col), bo1 = *(const f32x4*)(b_out + col + 4), gg0 = *(const f32x4*)(g1 + col), gg1 = *(const f32x4*)(g1 + col + 4);
#pragma unroll
            for (int ai = 0; ai < 2; ++ai)
#pragma unroll
                for (int m = 0; m < 4; ++m) {
                    const f32x4 v0 = gg0 * (acc[ai][bj][m][0] + bo0), v1 = gg1 * (acc[ai][bj][m][1] + bo1);
                    u32x4 w; w.x = pk2(v0[0], v0[1]); w.y = pk2(v0[2], v0[3]); w.z = pk2(v1[0], v1[1]); w.w = pk2(v1[2], v1[3]);
                    *(u32x4*)(M + (size_t)(row0 + ai * 128 + m * 16) * D + col) = w;
                }
        }
    }
};
struct EpiExpUp {
    static constexpr bool PERM = true;
    unsigned char* H;
    __device__ __forceinline__ void operator()(const f32x4 (&acc)[2][2][4][2], const pg8::Unit& u, int wr, int wc, int fr, int fq) const {
        const int e = u.pm >> 4, t = u.pn - e * 22;
        const int row0 = u.pm * 256 + wr * 64 + fr, col = 128 * t + wc * 32 + 8 * fq;
#pragma unroll
        for (int ai = 0; ai < 2; ++ai)
#pragma unroll
            for (int m = 0; m < 4; ++m) {
                const size_t row = (size_t)(row0 + ai * 128 + m * 16);
                float o[8];
#pragma unroll
                for (int n = 0; n < 2; ++n)
#pragma unroll
                    for (int j = 0; j < 4; j += 2) {
                        const f32x2 g2 = (f32x2){acc[ai][0][m][n][j], acc[ai][0][m][n][j + 1]}, u2 = (f32x2){acc[ai][1][m][n][j], acc[ai][1][m][n][j + 1]};
                        const f32x2 tt = g2 * (-1.4426950408889634f);
                        f32x2 ee; ee.x = __builtin_amdgcn_exp2f(tt.x); ee.y = __builtin_amdgcn_exp2f(tt.y);
                        const f32x2 dd = ee + 1.0f;
                        f32x2 rr; rr.x = __builtin_amdgcn_rcpf(dd.x); rr.y = __builtin_amdgcn_rcpf(dd.y);
                        const f32x2 hh = (g2 * u2) * rr;
                        o[4 * n + j] = hh.x; o[4 * n + j + 1] = hh.y; }
                u32x2 w; w.x = pk4_fp8(o[0], o[1], o[2], o[3]); w.y = pk4_fp8(o[4], o[5], o[6], o[7]);
                *(u32x2*)(H + ((size_t)u.pm * 22 + t) * 32768 + (size_t)(row - (size_t)u.pm * 256) * 128 + (col - 128 * t)) = w;
            }
    }
};
struct EpiExpDown {
    static constexpr bool PERM = true;
    unsigned char* Y; const float* gateE;
    __device__ __forceinline__ void operator()(const f32x4 (&acc)[2][2][4][2], const pg8::Unit& u, int wr, int wc, int fr, int fq) const {
        const int e = u.pm >> 4, c4 = u.pn - e * 4;
        const int row0 = u.pm * 256 + wr * 64 + fr, col0 = 256 * c4 + wc * 32 + 8 * fq;
#pragma unroll
        for (int ai = 0; ai < 2; ++ai)
#pragma unroll
            for (int m = 0; m < 4; ++m) {
                const size_t row = (size_t)(row0 + ai * 128 + m * 16);
                const float g = gateE[row] * 32.0f;
#pragma unroll
                for (int bj = 0; bj < 2; ++bj) {
                    const f32x4 v0 = acc[ai][bj][m][0] * g, v1 = acc[ai][bj][m][1] * g;
                    u32x2 w; w.x = pk4_fp8(v0[0], v0[1], v0[2], v0[3]); w.y = pk4_fp8(v1[0], v1[1], v1[2], v1[3]);
                    *(u32x2*)(Y + row * D + col0 + 128 * bj) = w;
                }
            }
    }
};

__device__ __forceinline__ void wg_publish(unsigned* cnt, int tid) {
    asm volatile("s_waitcnt vmcnt(0)" ::: "memory");
    __syncthreads();
    if (tid == 0) { __builtin_amdgcn_fence(__ATOMIC_RELEASE, "agent"); asm volatile("s_waitcnt vmcnt(0)" ::: "memory");
        (void)__hip_atomic_fetch_add(cnt, 1u, __ATOMIC_RELAXED, __HIP_MEMORY_SCOPE_AGENT); }
}
__device__ __forceinline__ void wg_wait(unsigned* cnt, unsigned target, int tid) {
    if (tid == 0) { unsigned sp = 0;
        while (__hip_atomic_load(cnt, __ATOMIC_RELAXED, __HIP_MEMORY_SCOPE_AGENT) < target && ++sp < (1u << 22)) __builtin_amdgcn_s_sleep(2);
        __builtin_amdgcn_fence(__ATOMIC_ACQUIRE, "agent"); asm volatile("s_waitcnt vmcnt(0)" ::: "memory"); }
    __syncthreads();
}

__device__ __forceinline__ void transpose_item(const float* W, int K, int N, bf16_t* WT, int k0, int n0, size_t drow0, LAS float* scr, int lane) {
    float tv[32];
#pragma unroll
    for (int i = 0; i < 32; ++i) { const int kk = 2 * i + (lane >> 5); tv[i] = __builtin_nontemporal_load(W + (size_t)(k0 + kk) * N + n0 + (lane & 31)); }
#pragma unroll
    for (int i = 0; i < 32; ++i) { const int kk = 2 * i + (lane >> 5); scr[kk * 33 + (lane & 31)] = tv[i]; }
    asm volatile("s_waitcnt lgkmcnt(0)" ::: "memory");
    const int c = lane & 7;
#pragma unroll
    for (int j = 0; j < 4; ++j) { const int n = (lane >> 3) + 8 * j; const LAS float* s = scr + (8 * c) * 33 + n;
        u32x4 o; o.x = pk2(s[0 * 33], s[1 * 33]); o.y = pk2(s[2 * 33], s[3 * 33]); o.z = pk2(s[4 * 33], s[5 * 33]); o.w = pk2(s[6 * 33], s[7 * 33]);
        *(u32x4*)(WT + (drow0 + n) * (size_t)K + k0 + 8 * c) = o; }
    asm volatile("s_waitcnt lgkmcnt(0)" ::: "memory");
}

__device__ __forceinline__ void transpose_item8(const float* W, int K, int N, unsigned char* WT, int k0, int n0, size_t drow0, float scale, LAS float* scr, int lane) {
    float tv[32];
#pragma unroll
    for (int i = 0; i < 32; ++i) { const int kk = 2 * i + (lane >> 5); tv[i] = __builtin_nontemporal_load(W + (size_t)(k0 + kk) * N + n0 + (lane & 31)); }
#pragma unroll
    for (int i = 0; i < 32; ++i) { const int kk = 2 * i + (lane >> 5); scr[kk * 33 + (lane & 31)] = tv[i] * scale; }
    asm volatile("s_waitcnt lgkmcnt(0)" ::: "memory");
    const int c = lane & 7;
#pragma unroll
    for (int j = 0; j < 4; ++j) { const int n = (lane >> 3) + 8 * j; const LAS float* s = scr + (8 * c) * 33 + n;
        u32x2 o; o.x = pk4_fp8(s[0 * 33], s[1 * 33], s[2 * 33], s[3 * 33]); o.y = pk4_fp8(s[4 * 33], s[5 * 33], s[6 * 33], s[7 * 33]);
        *(u32x2*)(WT + (drow0 + n) * (size_t)K + k0 + 8 * c) = o; }
    asm volatile("s_waitcnt lgkmcnt(0)" ::: "memory");
}

__device__ __forceinline__ void transpose_item8b(const float* W, int N, unsigned char* WTblk, int k0, int n0, int drow0, int kc0, float scale, LAS float* scr, int lane) {
    float tv[32];
#pragma unroll
    for (int i = 0; i < 32; ++i) { const int kk = 2 * i + (lane >> 5); tv[i] = __builtin_nontemporal_load(W + (size_t)(k0 + kk) * N + n0 + (lane & 31)); }
#pragma unroll
    for (int i = 0; i < 32; ++i) { const int kk = 2 * i + (lane >> 5); scr[kk * 33 + (lane & 31)] = tv[i] * scale; }
    asm volatile("s_waitcnt lgkmcnt(0)" ::: "memory");
    const int c = lane & 7;
#pragma unroll
    for (int j = 0; j < 4; ++j) { const int n = (lane >> 3) + 8 * j; const LAS float* s = scr + (8 * c) * 33 + n;
        u32x2 o; o.x = pk4_fp8(s[0 * 33], s[1 * 33], s[2 * 33], s[3 * 33]); o.y = pk4_fp8(s[4 * 33], s[5 * 33], s[6 * 33], s[7 * 33]);
        *(u32x2*)(WTblk + (size_t)(drow0 + n) * 128 + kc0 + 8 * c) = o; }
    asm volatile("s_waitcnt lgkmcnt(0)" ::: "memory");
}

#ifndef PROBE_MASK
#define PROBE_MASK 0
#endif
struct Args { const float* in[28]; float* out; unsigned char* ws; int ph_lo, ph_hi, dbg, pad; };

__device__ __forceinline__ void convert_items(LAS unsigned char* lds, const Args& a, const int kind, const int TID, const int BID, const int GD) {
    const int lane = TID & 63, wave = TID >> 6;
    unsigned char* ws = a.ws;
    LAS float* scr = (LAS float*)(lds + wave * 8704);
    const int gw = BID * NWAVES + wave, NGW = GD * NWAVES;
    const float* w_in = a.in[8]; const float* w_out = a.in[21]; const float* wg = a.in[24]; const float* wu = a.in[25]; const float* wd = a.in[26];
    bf16_t* WinT = (bf16_t*)(ws + WS_WINT); bf16_t* WoutT = (bf16_t*)(ws + WS_WOUTT); unsigned char* WguT = ws + WS_WGUT; unsigned char* WdT = ws + WS_WDT;
    constexpr int I_IN = 16 * 64, I_OUT = 16 * 32, I_GE = 16 * 88, I_G = 16 * I_GE, I_DE = 44 * 32, I_D = 16 * I_DE;
    const int nitems = kind == 0 ? (I_IN + I_OUT) : (kind == 1 ? 2 * I_G : I_D);
    for (int it = gw; it < nitems; it += NGW) {
        int r = it;
        if (kind == 0) {
            if (r < I_IN) { const int kb = r / 64, nb = r % 64, n0 = 32 * nb;
                int drow; if (n0 < 512) drow = (n0 >> 7) * 256 + (n0 & 127); else if (n0 < 1024) drow = ((n0 - 512) >> 7) * 256 + 128 + ((n0 - 512) & 127); else drow = n0;
                transpose_item(w_in, 1024, 2048, WinT, 64 * kb, n0, (size_t)drow, scr, lane); continue; }
            r -= I_IN;
            { const int kb = r / 32, nb = r % 32; transpose_item(w_out, 1024, 1024, WoutT, 64 * kb, 32 * nb, (size_t)(32 * nb), scr, lane); }
        } else if (kind == 1) {
            const int up = r >= I_G; if (up) r -= I_G; const int e = r / I_GE, q = r % I_GE, kb = q / 88, nb = q % 88, n0 = 32 * nb;
            const size_t drow = (size_t)e * 5632 + (size_t)(n0 >> 7) * 256 + (up ? 128 : 0) + (n0 & 127);
            transpose_item8((up ? wu : wg) + (size_t)e * 1024 * DE, 1024, DE, WguT, 64 * kb, n0, drow, 32.0f, scr, lane);
        } else {
            const int e = r / I_DE, q = r % I_DE, kb = q / 32, nb = q % 32;
            const int n0 = 32 * nb, k0 = 64 * kb;
            transpose_item8b(wd + (size_t)e * DE * 1024, 1024, WdT + ((size_t)((e * 4 + (n0 >> 8)) * 22 + (k0 >> 7))) * 32768, k0, n0, n0 & 255, k0 & 127, 64.0f, scr, lane);
        }
    }
}

__device__ __forceinline__ void phase0(LAS unsigned char* lds, const Args& a, const int TID, const int BID, const int GD) {
    const int tid = TID, lane = tid & 63, wave = tid >> 6, G = GD;
    unsigned char* ws = a.ws;
    __syncthreads();
    {
        const float* c = a.in[1]; const float* cctx = a.in[3]; const float* ada_w = a.in[6]; const float* ada_b = a.in[7];
        float* mod = (float*)(ws + WS_MOD); float* modc = mod + 4 * 6144;
        LAS float* sc = (LAS float*)lds;
        LAS float* red = (LAS float*)(lds + 20480);
        for (int grp = BID; grp < 96; grp += G) {
            for (int i = tid; i < 5 * 1024; i += NTHREADS) { const float v = (i < 4096) ? c[i] : cctx[i - 4096]; sc[i] = silu_f(v); }
            __syncthreads();
            const int col = grp * 64 + lane;
            float acc[5] = {0.f, 0.f, 0.f, 0.f, 0.f};
            const int k0 = wave * 128;
#pragma unroll 32
            for (int k = k0; k < k0 + 128; ++k) { const float w = __builtin_nontemporal_load(ada_w + (size_t)k * 6144 + col);
#pragma unroll
                for (int v = 0; v < 5; ++v) acc[v] += sc[v * 1024 + k] * w; }
#pragma unroll
            for (int v = 0; v < 5; ++v) red[(wave * 5 + v) * 64 + lane] = acc[v];
            __syncthreads();
            if (tid < 320) { const int v = tid >> 6, l = tid & 63; float s = 0.f;
#pragma unroll
                for (int w = 0; w < 8; ++w) s += red[(w * 5 + v) * 64 + l];
                const int cc = grp * 64 + l; s += ada_b[cc];
                if (v < 4) mod[v * 6144 + cc] = s; else if (cc < 2048) modc[cc] = s; }
            wg_publish((unsigned*)(ws + WS_ADACNT), tid);
            __syncthreads();
        }
    }
    convert_items(lds, a, 0, TID, BID, GD);
}

__device__ __forceinline__ void phase1(const Args& a, const int TID, const int BID, const int GD) {
    const int lane = TID & 63, wave = TID >> 6, G = GD;
    const float* x = a.in[0]; const float* ctx = a.in[2]; const float* g1 = a.in[4];
    const float* mod = (const float*)(a.ws + WS_MOD); const float* modc = mod + 4 * 6144;
    bf16_t* U = (bf16_t*)(a.ws + WS_U);
    f32x4 gg[4];
#pragma unroll
    for (int i = 0; i < 4; ++i) gg[i] = *(const f32x4*)(g1 + 4 * (lane + 64 * i));
    for (int row = BID * NWAVES + wave; row < NROWS; row += G * NWAVES) {
        const float* xr; const float* sh; const float* scl;
        if (row < NTOK) { xr = x + (size_t)row * D; const int b = row >> 13; sh = mod + b * 6144; scl = sh + 1024; }
        else { xr = ctx + (size_t)(row - NTOK) * D; sh = modc; scl = modc + 1024; }
        f32x4 v[4]; float ss = 0.f;
#pragma unroll
        for (int i = 0; i < 4; ++i) { v[i] = *(const f32x4*)(xr + 4 * (lane + 64 * i)); ss += v[i].x * v[i].x + v[i].y * v[i].y + v[i].z * v[i].z + v[i].w * v[i].w; }
        ss = wave_sum(ss);
        const float r = rsqrtf(ss * (1.0f / D) + 1e-6f);
#pragma unroll
        for (int i = 0; i < 4; ++i) {
            const f32x4 s1 = *(const f32x4*)(sh + 4 * (lane + 64 * i)), c1 = *(const f32x4*)(scl + 4 * (lane + 64 * i));
            const f32x4 o = (v[i] * r) * gg[i] * (c1 + 1.0f) + s1;
            u32x2 w; w.x = pk2(o.x, o.y); w.y = pk2(o.z, o.w);
            *(u32x2*)(U + (size_t)row * D + 4 * (lane + 64 * i)) = w;
        }
    }
}

__device__ __forceinline__ void conv_units(LAS unsigned char* lds, const Args& a, int ubeg, int ustride, const int TID, const int BID, const int GD) {
    const int tid = TID, lane = tid & 63, wave = tid >> 6;
    const float* cw = a.in[10]; const float* cb = a.in[11]; const float* lg = a.in[12]; const float* lb = a.in[13];
    const bf16_t* xglu = (const bf16_t*)(a.ws + WS_XGLU); bf16_t* mix = (bf16_t*)(a.ws + WS_MIX);
    LAS float* wts = (LAS float*)lds;
    for (int i = tid; i < 31 * 512; i += NTHREADS) { const int k = i >> 9, ch = i & 511; wts[((k * 2 + ((ch >> 2) & 1)) * 64 + (ch >> 3)) * 4 + (ch & 3)] = cw[i]; }
    __syncthreads();
    const int ch0 = 8 * lane;
    const bool rowc = lane < 32;
    for (int unit = ubeg; unit < NB * 128; unit += ustride) {
        const int b = unit >> 7, r = unit & 127;
        const bf16_t* xb = xglu + (size_t)b * SEQ * 512;
#pragma unroll 1
        for (int p = 0; p < 4; ++p) {
            const int c = p * 16 + 2 * wave;
            float acc[2][8];
#pragma unroll
            for (int j = 0; j < 8; ++j) { const float bj_ = cb[ch0 + j]; acc[0][j] = bj_; acc[1][j] = bj_; }
            u32x4 xv[2][2][8];
#define CONV_LOADS(buf, kb) do { _Pragma("unroll") for (int kk = 0; kk < 8; ++kk) { const int k = (kb) + kk; _Pragma("unroll") for (int tt = 0; tt < 2; ++tt) { xv[buf][tt][kk] = (u32x4){0u, 0u, 0u, 0u}; \
                if (k < 31) { int tok; bool valid; \
                    if (rowc) { const int cc = c + tt + k - 15; valid = (cc >= 0) && (cc < 64); tok = r * 64 + cc; } \
                    else { const int rr = r + k - 15; valid = (rr >= 0) && (rr < 128); tok = rr * 64 + c + tt; } \
                    if (valid) xv[buf][tt][kk] = *(const u32x4*)(xb + (size_t)tok * 512 + ch0); } } } } while (0)
#define CONV_FMAS(buf, kb) do { _Pragma("unroll") for (int kk = 0; kk < 8; ++kk) { const int k = (kb) + kk; if (k < 31) { \
                const f32x4 w0 = *(const LAS f32x4*)(wts + ((k * 2 + 0) * 64 + lane) * 4), w1 = *(const LAS f32x4*)(wts + ((k * 2 + 1) * 64 + lane) * 4); \
                _Pragma("unroll") for (int tt = 0; tt < 2; ++tt) { const u32x4 x4 = xv[buf][tt][kk]; \
                    fma_mix_lo(acc[tt][0], w0.x, x4.x); fma_mix_hi(acc[tt][1], w0.y, x4.x); fma_mix_lo(acc[tt][2], w0.z, x4.y); fma_mix_hi(acc[tt][3], w0.w, x4.y); \
                    fma_mix_lo(acc[tt][4], w1.x, x4.z); fma_mix_hi(acc[tt][5], w1.y, x4.z); fma_mix_lo(acc[tt][6], w1.z, x4.w); fma_mix_hi(acc[tt][7], w1.w, x4.w); } } } } while (0)
            CONV_LOADS(0, 0);
            CONV_LOADS(1, 8);  CONV_FMAS(0, 0);
            CONV_LOADS(0, 16); CONV_FMAS(1, 8);
            CONV_LOADS(1, 24); CONV_FMAS(0, 16);
            CONV_FMAS(1, 24);
#undef CONV_LOADS
#undef CONV_FMAS
#pragma unroll
            for (int tt = 0; tt < 2; ++tt) {
                float s = 0.f;
#pragma unroll
                for (int j = 0; j < 8; ++j) s += acc[tt][j];
                const float mean = wave_sum(s) * (1.0f / 512.0f);
                float q = 0.f;
#pragma unroll
                for (int j = 0; j < 8; ++j) { acc[tt][j] -= mean; q += acc[tt][j] * acc[tt][j]; }
                const float rstd = rsqrtf(wave_sum(q) * (1.0f / 512.0f) + 1e-5f);
                float o[8];
#pragma unroll
                for (int j = 0; j < 8; ++j) { const float y = acc[tt][j] * rstd * lg[ch0 + j] + lb[ch0 + j]; o[j] = silu_f(y); }
                u32x4 w; w.x = pk2(o[0], o[1]); w.y = pk2(o[2], o[3]); w.z = pk2(o[4], o[5]); w.w = pk2(o[6], o[7]);
                *(u32x4*)(mix + (size_t)(b * SEQ + r * 64 + c + tt) * D + ch0) = w;
            }
        }
    }
    __syncthreads();
}

constexpr int L_XT = 0;
constexpr int L_XC = 9216;
constexpr int L_A = L_XC + 2 * 17408;
constexpr int L_U = L_A + 2 * 16384;
constexpr int L_SUB = L_U + 2 * 16384;
constexpr int L_PRE = L_SUB + 8192;
constexpr int L_CIN = L_PRE + 4096;
static_assert(L_CIN + 2 * 17 * 64 * 4 <= 131072, "lru lds");

__device__ __forceinline__ int lru_seq(int d, int i) { return d == 0 ? i : (i < 4 ? 3 - i : NQ - 1 - (i - 4)); }
__device__ __forceinline__ u32x4 lru_load_xt(const bf16_t* xlx, int b, int h, int q, int i) {
    int rowbase, L, chunk;
    if (q < 4) { rowbase = NTOK + b * CTXL; L = CTXL; chunk = q; } else { rowbase = b * SEQ; L = SEQ; chunk = q - 4; }
    const int rr = i >> 3, seg = i & 7, t = chunk * 64 - 3 + rr;
    u32x4 v = (u32x4){0u, 0u, 0u, 0u};
    if (t >= 0 && t < L) v = *(const u32x4*)(xlx + (size_t)(rowbase + t) * 512 + 64 * h + 8 * seg);
    return v;
}
template <int MODE>
__device__ __forceinline__ void lru_phase(LAS unsigned char* lds, const Args& a, const int TID, const int BID, const int GD) {
    const int tid = TID, lane = tid & 63, wave = tid >> 6;
    const float* wa = a.in[16]; const float* wi = a.in[18];
    const bf16_t* xlx = (const bf16_t*)(a.ws + WS_XLX); const bf16_t* glg = (const bf16_t*)(a.ws + WS_GLG); bf16_t* mix = (bf16_t*)(a.ws + WS_MIX);
    f32x2* carry = (f32x2*)(a.ws + WS_CARRY); unsigned* au = (unsigned*)(a.ws + WS_AU);
    const float* conv_w = a.in[14]; const float* conv_b = a.in[15]; const float* ba = a.in[17]; const float* bi = a.in[19]; const float* lam = a.in[20];
    LAS bf16_t* XT = (LAS bf16_t*)(lds + L_XT); LAS float* XC = (LAS float*)(lds + L_XC); LAS float* Aa = (LAS float*)(lds + L_A); LAS float* Uu = (LAS float*)(lds + L_U);
    LAS f32x2* SUB = (LAS f32x2*)(lds + L_SUB); LAS float* PRE = (LAS float*)(lds + L_PRE); LAS float* CIN = (LAS float*)(lds + L_CIN);
    const int l15 = lane & 15, l4 = lane >> 4;
    for (int vb = BID; vb < 256; vb += GD) {
        const int bh = vb >> 3, grp = vb & 7, b = bh >> 3, h = bh & 7;
        int q0, nq;
        if (MODE == 1) { q0 = grp * 17; nq = (NQ - q0) < 17 ? (NQ - q0) : 17; } else { q0 = 4 + grp * 16; nq = 16; }
        const int wd = wave >> 2, mtp = (wave >> 1) & 1, ntp = wave & 1;
        bf16x8 wf[2][2][2];
#pragma unroll
        for (int nn = 0; nn < 2; ++nn)
#pragma unroll
            for (int g = 0; g < 2; ++g)
#pragma unroll
                for (int ks = 0; ks < 2; ++ks) { const float* wp = (g ? wi : wa) + (size_t)((wd * 8 + h) * 64 + 32 * ks + 8 * l4) * 64 + 16 * (ntp * 2 + nn) + l15;
                    u32x4 w; w.x = pk2(wp[0], wp[64]); w.y = pk2(wp[128], wp[192]); w.z = pk2(wp[256], wp[320]); w.w = pk2(wp[384], wp[448]); wf[nn][g][ks] = __builtin_bit_cast(bf16x8, w); }
        float cw[2][4], cbv[2];
        { const int gc = 64 * h + (tid & 63);
#pragma unroll
            for (int d = 0; d < 2; ++d) { cbv[d] = conv_b[d * 512 + gc];
#pragma unroll
                for (int k = 0; k < 4; ++k) cw[d][k] = conv_w[(d * 4 + k) * 512 + gc]; } }
        float bav[2], biv[2], spv[2];
#pragma unroll
        for (int nn = 0; nn < 2; ++nn) { const int gc = 64 * h + 16 * (ntp * 2 + nn) + l15;
            bav[nn] = ba[wd * 512 + gc]; biv[nn] = bi[wd * 512 + gc]; spv[nn] = log1pf(__expf(-lam[wd * 512 + gc])); }
        if (MODE == 2 && tid < 128) {
            const int d = tid >> 6, ch = tid & 63;
            const f32x2* cp = carry + (size_t)((d * NB + b) * NQ) * 512 + 64 * h + ch;
            const int cnt = d == 0 ? q0 : (NQ + 4 - (q0 + nq));
            float s = 0.f;
            for (int i0 = 0; i0 < cnt; i0 += 8) {
                f32x2 c[8];
#pragma unroll
                for (int j = 0; j < 8; ++j) { const int ii = (i0 + j) < cnt ? (i0 + j) : (cnt - 1); c[j] = cp[(size_t)lru_seq(d, ii) * 512]; }
#pragma unroll
                for (int j = 0; j < 8; ++j) if (i0 + j < cnt) s = c[j].x * s + c[j].y;
            }
            f32x2 c[16];
#pragma unroll
            for (int j = 0; j < 16; ++j) c[j] = cp[(size_t)(q0 + j) * 512];
            if (d == 0) {
#pragma unroll
                for (int j = 0; j < 16; ++j) { CIN[(0 * 17 + j) * 64 + ch] = s; s = c[j].x * s + c[j].y; }
            } else {
#pragma unroll
                for (int j = 15; j >= 0; --j) { CIN[(1 * 17 + j) * 64 + ch] = s; s = c[j].x * s + c[j].y; }
            }
        }
        if (MODE == 1 && q0 < 4) {
            if (tid == 0) { unsigned* fl = (unsigned*)(a.ws + WS_CTXFLAG) + 64 * (b * 2 + (h >> 2)); unsigned sp = 0;
                while (__hip_atomic_load(fl, __ATOMIC_RELAXED, __HIP_MEMORY_SCOPE_AGENT) == 0u && ++sp < (1u << 22)) __builtin_amdgcn_s_sleep(2);
                __builtin_amdgcn_fence(__ATOMIC_ACQUIRE, "agent"); asm volatile("s_waitcnt vmcnt(0)" ::: "memory"); }
            __syncthreads();
        }
        u32x4 xr0 = lru_load_xt(xlx, b, h, q0, tid), xr1 = (u32x4){0u, 0u, 0u, 0u};
        if (tid < 48) xr1 = lru_load_xt(xlx, b, h, q0, tid + 512);
#pragma unroll 1
        for (int jc = 0; jc < nq; ++jc) {
            const int q = q0 + jc;
            const size_t rowbase0 = (q < 4) ? (size_t)(NTOK + b * CTXL + q * 64) : (size_t)(b * SEQ + (q - 4) * 64);
            *(LAS u32x4*)(XT + tid * 8) = xr0;
            if (tid < 48) *(LAS u32x4*)(XT + (tid + 512) * 8) = xr1;
            __syncthreads();
            if (jc + 1 < nq) { xr0 = lru_load_xt(xlx, b, h, q + 1, tid); if (tid < 48) xr1 = lru_load_xt(xlx, b, h, q + 1, tid + 512); }
            u32x4 gl = (u32x4){0u, 0u, 0u, 0u};
            if (MODE == 2) gl = *(const u32x4*)(glg + (rowbase0 + (tid >> 3)) * 512 + 64 * h + (tid & 7) * 8);
            { const int ch = tid & 63, tb = tid >> 6;
#pragma unroll
                for (int i = 0; i < 8; ++i) { const int t = tb + 8 * i;
                    const float x0 = bf_lo(XT[(t + 0) * 64 + ch]), x1 = bf_lo(XT[(t + 1) * 64 + ch]), x2 = bf_lo(XT[(t + 2) * 64 + ch]), x3 = bf_lo(XT[(t + 3) * 64 + ch]), x4 = bf_lo(XT[(t + 4) * 64 + ch]), x5 = bf_lo(XT[(t + 5) * 64 + ch]), x6 = bf_lo(XT[(t + 6) * 64 + ch]);
                    XC[t * 68 + ch] = cbv[0] + cw[0][0] * x0 + cw[0][1] * x1 + cw[0][2] * x2 + cw[0][3] * x3;
                    XC[64 * 68 + t * 68 + ch] = cbv[1] + cw[1][3] * x3 + cw[1][2] * x4 + cw[1][1] * x5 + cw[1][0] * x6; } }
            __syncthreads();
#pragma unroll
            for (int mm = 0; mm < 2; ++mm) {
                const int mtl = 2 * mtp + mm;
                bf16x8 af[2];
#pragma unroll
                for (int ks = 0; ks < 2; ++ks) { const LAS float* p = XC + wd * (64 * 68) + (16 * mtl + l15) * 68 + 32 * ks + 8 * l4; const f32x4 p0 = *(const LAS f32x4*)p, p1 = *(const LAS f32x4*)(p + 4);
                    u32x4 w; w.x = pk2(p0.x, p0.y); w.y = pk2(p0.z, p0.w); w.z = pk2(p1.x, p1.y); w.w = pk2(p1.z, p1.w); af[ks] = __builtin_bit_cast(bf16x8, w); }
#pragma unroll
                for (int nn = 0; nn < 2; ++nn) { const int n = 16 * (ntp * 2 + nn) + l15;
                    f32x4 accR = (f32x4){0.f, 0.f, 0.f, 0.f}, accI = (f32x4){0.f, 0.f, 0.f, 0.f};
#pragma unroll
                    for (int ks = 0; ks < 2; ++ks) {
                        accR = __builtin_amdgcn_mfma_f32_16x16x32_bf16(af[ks], wf[nn][0][ks], accR, 0, 0, 0);
                        accI = __builtin_amdgcn_mfma_f32_16x16x32_bf16(af[ks], wf[nn][1][ks], accI, 0, 0, 0);
                    }
#pragma unroll
                    for (int rg = 0; rg < 4; rg += 2) { const int t = 16 * mtl + 4 * l4 + rg;
                        const f32x2 zr = (f32x2){accR[rg], accR[rg + 1]} + bav[nn], zi = (f32x2){accI[rg], accI[rg + 1]} + biv[nn];
                        const f32x2 tr = zr * (-1.4426950408889634f), ti = zi * (-1.4426950408889634f);
                        f32x2 er, ei; er.x = __builtin_amdgcn_exp2f(tr.x); er.y = __builtin_amdgcn_exp2f(tr.y); ei.x = __builtin_amdgcn_exp2f(ti.x); ei.y = __builtin_amdgcn_exp2f(ti.y);
                        const f32x2 dr = er + 1.0f, di = ei + 1.0f;
                        f32x2 rr, ii; rr.x = __builtin_amdgcn_rcpf(dr.x); rr.y = __builtin_amdgcn_rcpf(dr.y); ii.x = __builtin_amdgcn_rcpf(di.x); ii.y = __builtin_amdgcn_rcpf(di.y);
                        const f32x2 la = rr * (-8.0f * spv[nn]);
                        f32x2 oma = -la * (1.0f + 0.5f * la * (1.0f + 0.33333334f * la * (1.0f + 0.25f * la * (1.0f + 0.2f * la))));
                        if (__any(la.x < -0.25f || la.y < -0.25f)) {
                            oma.x = la.x < -0.25f ? 1.0f - __expf(la.x) : oma.x; oma.y = la.y < -0.25f ? 1.0f - __expf(la.y) : oma.y; }
                        const f32x2 om2 = oma * (2.0f - oma);
                        f32x2 mult; mult.x = __builtin_amdgcn_sqrtf(om2.x); mult.y = __builtin_amdgcn_sqrtf(om2.y);
                        const f32x2 xc2 = (f32x2){XC[wd * (64 * 68) + t * 68 + n], XC[wd * (64 * 68) + (t + 1) * 68 + n]};
                        const f32x2 uu = mult * ii * xc2;
                        Aa[wd * 4096 + t * 64 + n] = oma.x; Aa[wd * 4096 + (t + 1) * 64 + n] = oma.y; Uu[wd * 4096 + t * 64 + n] = uu.x; Uu[wd * 4096 + (t + 1) * 64 + n] = uu.y; }
                }
            }
            __syncthreads();
            if (MODE == 1 && q >= 4) {
                const int t = tid >> 3, c8 = (tid & 7) * 8;
#pragma unroll
                for (int d = 0; d < 2; ++d) {
                    const LAS float* ap = Aa + d * 4096 + t * 64 + c8; const LAS float* up = Uu + d * 4096 + t * 64 + c8;
                    const f32x4 a0 = *(const LAS f32x4*)ap, a1 = *(const LAS f32x4*)(ap + 4), u0 = *(const LAS f32x4*)up, u1 = *(const LAS f32x4*)(up + 4);
                    u32x4 w0, w1; w0.x = pk2h(a0.x, u0.x); w0.y = pk2h(a0.y, u0.y); w0.z = pk2h(a0.z, u0.z); w0.w = pk2h(a0.w, u0.w); w1.x = pk2h(a1.x, u1.x); w1.y = pk2h(a1.y, u1.y); w1.z = pk2h(a1.z, u1.z); w1.w = pk2h(a1.w, u1.w);
                    unsigned* dst = au + ((size_t)d * NTOK + rowbase0 + t) * 512 + 64 * h + c8;
                    *(u32x4*)dst = w0; *(u32x4*)(dst + 4) = w1; }
            }
            { float A0 = 1.f, h0 = 0.f, A1 = 1.f, h1 = 0.f;
#pragma unroll
                for (int s2 = 0; s2 < 8; ++s2) { const int p = 8 * wave + s2, t0 = p, t1 = 63 - p;
                    const float a0 = 1.0f - Aa[t0 * 64 + lane], u0 = Uu[t0 * 64 + lane], a1 = 1.0f - Aa[4096 + t1 * 64 + lane], u1 = Uu[4096 + t1 * 64 + lane];
                    h0 = a0 * h0 + u0; A0 *= a0; h1 = a1 * h1 + u1; A1 *= a1; }
                SUB[wave * 64 + lane] = (f32x2){A0, h0}; SUB[512 + wave * 64 + lane] = (f32x2){A1, h1}; }
            __syncthreads();
            if (MODE == 1) {
                if (tid < 128) { const int d = tid >> 6, ch = tid & 63; float Ac = 1.f, hc = 0.f;
#pragma unroll
                    for (int s2 = 0; s2 < 8; ++s2) { const f32x2 c = SUB[d * 512 + s2 * 64 + ch]; hc = c.x * hc + c.y; Ac *= c.x; }
                    carry[(size_t)((d * NB + b) * NQ + q) * 512 + 64 * h + ch] = (f32x2){Ac, hc}; }
            } else {
                if (tid < 128) { const int d = tid >> 6, ch = tid & 63; float s2 = CIN[(d * 17 + jc) * 64 + ch];
#pragma unroll
                    for (int sb = 0; sb < 8; ++sb) { PRE[d * 512 + sb * 64 + ch] = s2; const f32x2 c = SUB[d * 512 + sb * 64 + ch]; s2 = c.x * s2 + c.y; } }
                __syncthreads();
                { float h0 = PRE[wave * 64 + lane], h1 = PRE[512 + wave * 64 + lane];
#pragma unroll
                    for (int s2 = 0; s2 < 8; ++s2) { const int p = 8 * wave + s2, t0 = p, t1 = 63 - p;
                        h0 = (1.0f - Aa[t0 * 64 + lane]) * h0 + Uu[t0 * 64 + lane]; Uu[t0 * 64 + lane] = h0;
                        h1 = (1.0f - Aa[4096 + t1 * 64 + lane]) * h1 + Uu[4096 + t1 * 64 + lane]; Uu[4096 + t1 * 64 + lane] = h1; } }
                __syncthreads();
                { const int t = tid >> 3, c8 = (tid & 7) * 8;
                    const LAS float* u1 = Uu + t * 64 + c8; const LAS float* u2 = Uu + 4096 + t * 64 + c8;
                    const f32x4 f0 = *(const LAS f32x4*)u1, f1 = *(const LAS f32x4*)(u1 + 4), b0 = *(const LAS f32x4*)u2, b1 = *(const LAS f32x4*)(u2 + 4);
                    u32x4 w;
                    w.x = pk2((f0.x + b0.x) * bf_lo(gl.x), (f0.y + b0.y) * bf_hi(gl.x)); w.y = pk2((f0.z + b0.z) * bf_lo(gl.y), (f0.w + b0.w) * bf_hi(gl.y));
                    w.z = pk2((f1.x + b1.x) * bf_lo(gl.z), (f1.y + b1.y) * bf_hi(gl.z)); w.w = pk2((f1.z + b1.z) * bf_lo(gl.w), (f1.w + b1.w) * bf_hi(gl.w));
                    *(u32x4*)(mix + (rowbase0 + t) * D + 512 + 64 * h + c8) = w; }
            }
        }
        if (MODE == 1) wg_publish((unsigned*)(a.ws + WS_BHCNT) + 64 * bh, tid);
        __syncthreads();
    }
}

__device__ __forceinline__ void lru_rescan(LAS unsigned char* lds, const Args& a, const int TID, const int BID, const int GD) {
    const int tid = TID, lane = tid & 63, wave = tid >> 6;
    const unsigned* au = (const unsigned*)(a.ws + WS_AU); const bf16_t* glg = (const bf16_t*)(a.ws + WS_GLG); bf16_t* mix = (bf16_t*)(a.ws + WS_MIX);
    const f32x2* carry = (const f32x2*)(a.ws + WS_CARRY);
    LAS f32x2* SUB = (LAS f32x2*)(lds + L_SUB); LAS float* PRE = (LAS float*)(lds + L_PRE); LAS float* CIN = (LAS float*)(lds + L_CIN);
    for (int vb = BID; vb < 256; vb += GD) {
        const int bh = vb >> 3, grp = vb & 7, b = bh >> 3, h = bh & 7;
        const int q0 = 4 + grp * 16, nq = 16;
        wg_wait((unsigned*)(a.ws + WS_BHCNT) + 64 * bh, 8u * (unsigned)(1 + ((a.dbg >> 11) & 1)), tid);
        if (tid < 128) {
            const int d = tid >> 6, ch = tid & 63;
            const f32x2* cp = carry + (size_t)((d * NB + b) * NQ) * 512 + 64 * h + ch;
            const int cnt = d == 0 ? q0 : (NQ + 4 - (q0 + nq));
            float s = 0.f;
            for (int i0 = 0; i0 < cnt; i0 += 8) {
                f32x2 c[8];
#pragma unroll
                for (int j = 0; j < 8; ++j) { const int ii = (i0 + j) < cnt ? (i0 + j) : (cnt - 1); c[j] = cp[(size_t)lru_seq(d, ii) * 512]; }
#pragma unroll
                for (int j = 0; j < 8; ++j) if (i0 + j < cnt) s = c[j].x * s + c[j].y;
            }
            f32x2 c[16];
#pragma unroll
            for (int j = 0; j < 16; ++j) c[j] = cp[(size_t)(q0 + j) * 512];
            if (d == 0) {
#pragma unroll
                for (int j = 0; j < 16; ++j) { CIN[(0 * 17 + j) * 64 + ch] = s; s = c[j].x * s + c[j].y; }
            } else {
#pragma unroll
                for (int j = 15; j >= 0; --j) { CIN[(1 * 17 + j) * 64 + ch] = s; s = c[j].x * s + c[j].y; }
            }
        }
        __syncthreads();
        const size_t cbase = (size_t)64 * h + lane;
        unsigned pfn[8], pbn[8]; bf16_t ggn[8];
        { const size_t rown = (size_t)b * SEQ + (size_t)(q0 - 4) * 64 + 8 * wave;
#pragma unroll
            for (int s2 = 0; s2 < 8; ++s2) { pfn[s2] = au[(rown + s2) * 512 + cbase]; pbn[s2] = au[((size_t)NTOK + rown + s2) * 512 + cbase]; ggn[s2] = glg[(rown + s2) * 512 + cbase]; } }
#pragma unroll 1
        for (int jc = 0; jc < nq; ++jc) {
            const size_t row0 = (size_t)b * SEQ + (size_t)(q0 - 4 + jc) * 64 + 8 * wave;
            unsigned pf[8], pb[8]; bf16_t gg[8];
#pragma unroll
            for (int s2 = 0; s2 < 8; ++s2) { pf[s2] = pfn[s2]; pb[s2] = pbn[s2]; gg[s2] = ggn[s2]; }
            if (jc + 1 < nq) { const size_t rown = row0 + 64;
#pragma unroll
                for (int s2 = 0; s2 < 8; ++s2) { pfn[s2] = au[(rown + s2) * 512 + cbase]; pbn[s2] = au[((size_t)NTOK + rown + s2) * 512 + cbase]; ggn[s2] = glg[(rown + s2) * 512 + cbase]; } }
            float af[8], uf[8], ab[8], ub[8];
#pragma unroll
            for (int s2 = 0; s2 < 8; ++s2) { const h2_t x = __builtin_bit_cast(h2_t, pf[s2]), y = __builtin_bit_cast(h2_t, pb[s2]);
                af[s2] = 1.0f - (float)x.x; uf[s2] = (float)x.y; ab[s2] = 1.0f - (float)y.x; ub[s2] = (float)y.y; }
            float A0 = 1.f, h0 = 0.f, A1 = 1.f, h1 = 0.f;
#pragma unroll
            for (int s2 = 0; s2 < 8; ++s2) { h0 = af[s2] * h0 + uf[s2]; A0 *= af[s2]; h1 = ab[7 - s2] * h1 + ub[7 - s2]; A1 *= ab[7 - s2]; }
            SUB[wave * 64 + lane] = (f32x2){A0, h0}; SUB[512 + (7 - wave) * 64 + lane] = (f32x2){A1, h1};
            __syncthreads();
            if (tid < 128) { const int d = tid >> 6, ch = tid & 63; float s2 = CIN[(d * 17 + jc) * 64 + ch];
#pragma unroll
                for (int sb = 0; sb < 8; ++sb) { PRE[d * 512 + sb * 64 + ch] = s2; const f32x2 c = SUB[d * 512 + sb * 64 + ch]; s2 = c.x * s2 + c.y; } }
            __syncthreads();
            float hf[8], hb[8];
            { float hc = PRE[wave * 64 + lane];
#pragma unroll
                for (int s2 = 0; s2 < 8; ++s2) { hc = af[s2] * hc + uf[s2]; hf[s2] = hc; }
                hc = PRE[512 + (7 - wave) * 64 + lane];
#pragma unroll
                for (int s2 = 7; s2 >= 0; --s2) { hc = ab[s2] * hc + ub[s2]; hb[s2] = hc; } }
#pragma unroll
            for (int s2 = 0; s2 < 8; ++s2) mix[(row0 + s2) * D + 512 + cbase] = (bf16_t)f2bf((hf[s2] + hb[s2]) * bf_lo(gg[s2]));
        }
        __syncthreads();
    }
}

__device__ __forceinline__ void phase6(LAS unsigned char* lds, const Args& a, const int TID, const int BID, const int GD) {
    const int tid = TID, lane = tid & 63, wave = tid >> 6, G = GD;
    const float* x = a.in[0]; const bf16_t* Mb = (const bf16_t*)(a.ws + WS_M); const float* g2 = a.in[5]; const float* rw = a.in[23];
    const float* mod = (const float*)(a.ws + WS_MOD);
    unsigned char* V = a.ws + WS_V; float* affT = (float*)(a.ws + WS_AFFT); bf16_t* X1b = (bf16_t*)(a.ws + WS_X1B);
    LAS float* rwT = (LAS float*)lds;
    for (int idx = tid; idx < 16384; idx += NTHREADS) rwT[(idx & 15) * 1024 + (idx >> 4)] = rw[idx];
    __syncthreads();
    f32x4 gg[4];
#pragma unroll
    for (int i = 0; i < 4; ++i) gg[i] = *(const f32x4*)(g2 + 4 * (lane + 64 * i));
    const int stride6 = G * NWAVES, row6 = BID * NWAVES + wave;
    f32x4 xn[4]; u32x2 mn[4];
#pragma unroll
    for (int i = 0; i < 4; ++i) { const int rl = row6 < NTOK ? row6 : 0; xn[i] = *(const f32x4*)(x + (size_t)rl * D + 4 * (lane + 64 * i)); mn[i] = *(const u32x2*)(Mb + (size_t)rl * D + 4 * (lane + 64 * i)); }
#pragma unroll 1
    for (int row = row6; row < NTOK; row += stride6) {
        const int b = row >> 13, t = row & (SEQ - 1);
        const float* sh = mod + b * 6144 + 3072; const float* scl = mod + b * 6144 + 4096;
        f32x4 v[4]; float ss = 0.f;
#pragma unroll
        for (int i = 0; i < 4; ++i) { v[i] = xn[i]; const u32x2 mw = mn[i];
            v[i].x += bf_lo(mw.x); v[i].y += bf_hi(mw.x); v[i].z += bf_lo(mw.y); v[i].w += bf_hi(mw.y); }
        if (row + stride6 < NTOK) {
#pragma unroll
            for (int i = 0; i < 4; ++i) { xn[i] = *(const f32x4*)(x + (size_t)(row + stride6) * D + 4 * (lane + 64 * i)); mn[i] = *(const u32x2*)(Mb + (size_t)(row + stride6) * D + 4 * (lane + 64 * i)); } }
#pragma unroll
        for (int i = 0; i < 4; ++i) {
            { u32x2 xw; xw.x = pk2(v[i].x, v[i].y); xw.y = pk2(v[i].z, v[i].w); *(u32x2*)(X1b + (size_t)row * D + 4 * (lane + 64 * i)) = xw; }
            ss += v[i].x * v[i].x + v[i].y * v[i].y + v[i].z * v[i].z + v[i].w * v[i].w; }
        ss = wave_sum(ss);
        const float r = rsqrtf(ss * (1.0f / D) + 1e-6f);
#pragma unroll
        for (int i = 0; i < 4; ++i) {
            const f32x4 s1 = *(const f32x4*)(sh + 4 * (lane + 64 * i)), c1 = *(const f32x4*)(scl + 4 * (lane + 64 * i));
            v[i] = (v[i] * r) * gg[i] * (c1 + 1.0f) + s1;
            *(unsigned*)(V + (size_t)row * D + 4 * (lane + 64 * i)) = pk4_fp8(v[i].x, v[i].y, v[i].z, v[i].w);
        }
        float p[16];
#pragma unroll
        for (int e = 0; e < 16; ++e) p[e] = 0.f;
#pragma unroll
        for (int i = 0; i < 4; ++i) {
#pragma unroll
            for (int e = 0; e < 16; ++e) { const f32x4 w = *(const LAS f32x4*)(rwT + e * 1024 + 4 * (lane + 64 * i)); p[e] += v[i].x * w.x + v[i].y * w.y + v[i].z * w.z + v[i].w * w.w; }
            asm volatile("" ::: "memory");
        }
        const bool b5 = (lane & 32) != 0, b4 = (lane & 16) != 0, b3 = (lane & 8) != 0, b2 = (lane & 4) != 0;
        float q8[8], q4[4], q2[2];
#pragma unroll
        for (int j = 0; j < 8; ++j) { const float send = b5 ? p[j] : p[j + 8], keep = b5 ? p[j + 8] : p[j]; q8[j] = keep + __shfl_xor(send, 32); }
#pragma unroll
        for (int j = 0; j < 4; ++j) { const float send = b4 ? q8[j] : q8[j + 4], keep = b4 ? q8[j + 4] : q8[j]; q4[j] = keep + __shfl_xor(send, 16); }
#pragma unroll
        for (int j = 0; j < 2; ++j) { const float send = b3 ? q4[j] : q4[j + 2], keep = b3 ? q4[j + 2] : q4[j]; q2[j] = keep + __shfl_xor(send, 8); }
        float lgt = (b2 ? q2[1] : q2[0]) + __shfl_xor(b2 ? q2[0] : q2[1], 4);
        lgt += __shfl_xor(lgt, 2); lgt += __shfl_xor(lgt, 1);
        float mx = lgt;
        mx = fmaxf(mx, __shfl_xor(mx, 4)); mx = fmaxf(mx, __shfl_xor(mx, 8)); mx = fmaxf(mx, __shfl_xor(mx, 16)); mx = fmaxf(mx, __shfl_xor(mx, 32));
        const float ex = __expf(lgt - mx);
        float den = ex;
        den += __shfl_xor(den, 4); den += __shfl_xor(den, 8); den += __shfl_xor(den, 16); den += __shfl_xor(den, 32);
        if ((lane & 3) == 0) affT[(size_t)(b * 16 + ((lane >> 2) & 15)) * SEQ + t] = ex / den;
    }
    __syncthreads();
}

__device__ __forceinline__ int block_excl_scan(int v, LAS int* wsum, int tid, int& total) {
    const int lane = tid & 63, wave = tid >> 6;
    int inc = v;
#pragma unroll
    for (int o = 1; o < 64; o <<= 1) { const int t = __shfl_up(inc, o); if (lane >= o) inc += t; }
    __syncthreads();
    if (lane == 63) wsum[wave] = inc;
    __syncthreads();
    int base = 0, tot = 0;
#pragma unroll
    for (int w = 0; w < 8; ++w) { const int s = wsum[w]; if (w < wave) base += s; tot += s; }
    total = tot;
    return base + inc - v;
}
__device__ __forceinline__ void phase7(LAS unsigned char* lds, const Args& a, const int TID, const int BID, const int GD) {
    const int tid = TID, lane = tid & 63, wave = tid >> 6, G = GD;
    const float* affT = (const float*)(a.ws + WS_AFFT);
    int* idxE = (int*)(a.ws + WS_IDXE); float* gateE = (float*)(a.ws + WS_GATEE); int* inv = (int*)(a.ws + WS_INV);
    LAS unsigned* hist = (LAS unsigned*)lds;
    LAS unsigned* selw = hist + 256;
    LAS int* wsum = (LAS int*)(hist + 264);
    for (int unit = BID; unit < NB * NE; unit += G) {
        const int b = unit >> 4, e = unit & 15;
        const float* src = affT + (size_t)unit * SEQ + 16 * tid;
        unsigned key[16];
#pragma unroll
        for (int i = 0; i < 4; ++i) { const f32x4 v = *(const f32x4*)(src + 4 * i); const float f0 = v[0], f1 = v[1], f2 = v[2], f3 = v[3]; key[4 * i + 0] = __float_as_uint(f0); key[4 * i + 1] = __float_as_uint(f1); key[4 * i + 2] = __float_as_uint(f2); key[4 * i + 3] = __float_as_uint(f3); }
        unsigned prefix = 0u, mask = 0u, rem = CAP;
#pragma unroll 1
        for (int pass = 0; pass < 4; ++pass) {
            const int shift = 24 - 8 * pass;
            if (tid < 256) hist[tid] = 0u;
            __syncthreads();
#pragma unroll
            for (int j = 0; j < 16; ++j) if ((key[j] & mask) == prefix) __hip_atomic_fetch_add(&hist[(key[j] >> shift) & 255u], 1u, __ATOMIC_RELAXED, __HIP_MEMORY_SCOPE_WORKGROUP);
            __syncthreads();
            if (wave == 0) {
                const unsigned c0 = hist[4 * lane], c1 = hist[4 * lane + 1], c2 = hist[4 * lane + 2], c3 = hist[4 * lane + 3];
                const unsigned s = c0 + c1 + c2 + c3; unsigned v = s;
#pragma unroll
                for (int o = 1; o < 64; o <<= 1) { const unsigned t = __shfl_down(v, o); if (lane + o < 64) v += t; }
                const unsigned above = v - s;
                if (above < rem && rem <= above + s) {
                    unsigned cum = above, bin, nr;
                    if (cum + c3 >= rem) { bin = 4 * lane + 3; nr = rem - cum; }
                    else { cum += c3; if (cum + c2 >= rem) { bin = 4 * lane + 2; nr = rem - cum; }
                        else { cum += c2; if (cum + c1 >= rem) { bin = 4 * lane + 1; nr = rem - cum; } else { cum += c1; bin = 4 * lane; nr = rem - cum; } } }
                    selw[0] = bin; selw[1] = nr;
                }
            }
            __syncthreads();
            prefix |= selw[0] << shift; mask |= 255u << shift; rem = selw[1];
            __syncthreads();
        }
        const unsigned thr = prefix;
        int ceq = 0;
#pragma unroll
        for (int j = 0; j < 16; ++j) ceq += (key[j] == thr) ? 1 : 0;
        int tot; const int eqbase = block_excl_scan(ceq, wsum, tid, tot);
        unsigned selm = 0u; int er = eqbase, cs = 0;
#pragma unroll
        for (int j = 0; j < 16; ++j) { bool s = key[j] > thr; if (key[j] == thr) { s = (unsigned)er < rem; ++er; } if (s) { selm |= 1u << j; ++cs; } }
        int slot = block_excl_scan(cs, wsum, tid, tot);
#pragma unroll
        for (int j = 0; j < 16; ++j) { const int t = 16 * tid + j; const bool s = (selm >> j) & 1u;
            inv[(size_t)(b * SEQ + t) * 16 + e] = s ? slot : -1;
            if (s) { const int ro = e * ROWS_E + b * CAP + slot; idxE[ro] = b * SEQ + t; gateE[ro] = __uint_as_float(key[j]); ++slot; } }
        __syncthreads();
    }
}


__device__ __forceinline__ void phase10(const Args& a, const int TID, const int BID, const int GD) {
    const int lane = TID & 63, wave = TID >> 6;
    float* xo = a.out; const float* fg = a.in[27];
    const float* mod = (const float*)(a.ws + WS_MOD);
    const bf16_t* X1b = (const bf16_t*)(a.ws + WS_X1B);
    const unsigned char* Y = a.ws + WS_WGUT; const int* inv = (const int*)(a.ws + WS_INV);
    f32x4 gg[4];
#pragma unroll
    for (int i = 0; i < 4; ++i) gg[i] = *(const f32x4*)(fg + 4 * (lane + 64 * i));
    const int row0 = BID * NWAVES + wave, rstride = GD * NWAVES;
    int myslot = (row0 < NTOK) ? inv[(size_t)row0 * 16 + (lane & 15)] : -1;
#pragma unroll 1
    for (int row = row0; row < NTOK; row += rstride) {
        const int b = row >> 13;
        const int slot_cur = myslot;
        if (row + rstride < NTOK) myslot = inv[(size_t)(row + rstride) * 16 + (lane & 15)];
        u32x2 xw[4];
#pragma unroll
        for (int i = 0; i < 4; ++i) xw[i] = *(const u32x2*)(X1b + (size_t)row * D + 4 * (lane + 64 * i));
        f32x4 mo[4];
#pragma unroll
        for (int i = 0; i < 4; ++i) mo[i] = (f32x4){0.f, 0.f, 0.f, 0.f};
        unsigned long long bal = __ballot(lane < 16 && slot_cur >= 0);
        while (bal) {
            int ee[4]; const unsigned char* yr[4];
#pragma unroll
            for (int q = 0; q < 4; ++q) { ee[q] = -1; if (bal) { ee[q] = (int)__builtin_ctzll(bal); bal &= bal - 1; } }
#pragma unroll
            for (int q = 0; q < 4; ++q) { const int e = ee[q] < 0 ? 0 : ee[q]; const int sl = __shfl(slot_cur, e); yr[q] = Y + (size_t)(e * ROWS_E + b * CAP + (sl < 0 ? 0 : sl)) * D; }
            unsigned yw[4][4];
#pragma unroll
            for (int q = 0; q < 4; ++q)
#pragma unroll
                for (int i = 0; i < 4; ++i) { yw[q][i] = 0u; if (ee[q] >= 0) yw[q][i] = *(const unsigned*)(yr[q] + 4 * (lane + 64 * i)); }
#pragma unroll
            for (int q = 0; q < 4; ++q)
#pragma unroll
                for (int i = 0; i < 4; ++i) { const f32x2 lo = __builtin_amdgcn_cvt_pk_f32_fp8((int)yw[q][i], false), hi = __builtin_amdgcn_cvt_pk_f32_fp8((int)yw[q][i], true);
                    mo[i].x += lo.x; mo[i].y += lo.y; mo[i].z += hi.x; mo[i].w += hi.y; }
        }
        const float* g5 = mod + b * 6144 + 5120;
        f32x4 v[4]; float ss = 0.f;
#pragma unroll
        for (int i = 0; i < 4; ++i) { const f32x4 g = *(const f32x4*)(g5 + 4 * (lane + 64 * i)) * (1.0f / 32.0f);
            v[i] = (f32x4){bf_lo(xw[i].x), bf_hi(xw[i].x), bf_lo(xw[i].y), bf_hi(xw[i].y)};
            v[i] = v[i] + g * mo[i];
            ss += v[i].x * v[i].x + v[i].y * v[i].y + v[i].z * v[i].z + v[i].w * v[i].w; }
        ss = wave_sum(ss);
        const float r = rsqrtf(ss * (1.0f / D) + 1e-6f);
#pragma unroll
        for (int i = 0; i < 4; ++i) *(f32x4*)(xo + (size_t)row * D + 4 * (lane + 64 * i)) = (v[i] * r) * gg[i];
    }
}

#define XB_TMO      128
#define XB_XCNT(j)  (256  + 64 * (j))
#define XB_XSUB(j)  (1280 + 64 * (j))
#define XB_XGEN(j)  (2304 + 64 * (j))
#define XB_TOP      3328
#define XB_TOPGEN   3392
#define XCD_BAR_WORDS 3456
#define XB_SPIN_CAP (1u << 18)
__device__ __forceinline__ unsigned xb_ld(unsigned* p)              { return __hip_atomic_load(p, __ATOMIC_RELAXED, __HIP_MEMORY_SCOPE_AGENT); }
__device__ __forceinline__ unsigned xb_add(unsigned* p, unsigned v) { return __hip_atomic_fetch_add(p, v, __ATOMIC_RELAXED, __HIP_MEMORY_SCOPE_AGENT); }
__device__ __forceinline__ unsigned xb_xcc_id() { return (unsigned)__builtin_amdgcn_s_getreg((3 << 11) | 20) & 0xFu; }
#define XB_SPIN(cond, bar) do { unsigned _sp = 0; while (cond) { __builtin_amdgcn_s_sleep(1); \
    if ((++_sp & 255u) == 0u) { if (xb_ld(&(bar)[XB_TMO])) break; if (_sp > XB_SPIN_CAP) { atomicAdd(&(bar)[XB_TMO], 1u); break; } } } } while (0)
struct XcdBarrier { unsigned* bar; unsigned x; volatile LAS unsigned* st; };

__device__ __forceinline__ int lane_id_opaque() { unsigned m = ~0u; asm volatile("" : "+s"(m)); return (int)__builtin_amdgcn_mbcnt_hi(m, __builtin_amdgcn_mbcnt_lo(m, 0u)); }
__device__ __forceinline__ XcdBarrier xcd_barrier_post(unsigned* bar, volatile LAS unsigned* st, int tid) {
    XcdBarrier b; b.bar = bar; b.x = xb_xcc_id(); b.st = st;
    if (tid == 0) (void)xb_add(&bar[XB_XCNT(b.x)], 1u);
    return b;
}
__device__ __forceinline__ void xcd_barrier_complete(unsigned* bar, unsigned x, unsigned G, unsigned& nloc, unsigned& nx) {
    unsigned sum, cnt, mine, sp = 0u;
    for (;;) {
        sum = 0u; cnt = 0u; mine = 0u;
#pragma unroll
        for (unsigned j = 0; j < 16; ++j) { const unsigned c = xb_ld(&bar[XB_XCNT(j)]); sum += c; cnt += (c > 0u) ? 1u : 0u; mine = (j == x) ? c : mine; }
        if (sum == G) break;
        __builtin_amdgcn_s_sleep(1);
        if ((++sp & 255u) == 0u) { if (xb_ld(&bar[XB_TMO])) break; if (sp > XB_SPIN_CAP) { atomicAdd(&bar[XB_TMO], 1u); break; } }
    }
    nloc = mine > 0u ? mine : 1u; nx = cnt > 0u ? cnt : 1u;
}
__device__ __forceinline__ void xcd_barrier(const XcdBarrier& b, int tid, unsigned G) {
    asm volatile("s_waitcnt vmcnt(0)" ::: "memory");
    __syncthreads();
    if (tid == 0) {
        unsigned* bar = b.bar;
        __builtin_amdgcn_s_waitcnt(0);
        unsigned nloc = b.st[0], nx = b.st[1];
        if (nloc == 0u) { xcd_barrier_complete(bar, b.x, G, nloc, nx); b.st[0] = nloc; b.st[1] = nx; }
        const unsigned old = xb_add(&bar[XB_XSUB(b.x)], 1u);
        const unsigned gen = old / nloc;
        if (old + 1u == (gen + 1u) * nloc) {
            __builtin_amdgcn_fence(__ATOMIC_RELEASE, "agent");
            asm volatile("s_waitcnt vmcnt(0)" ::: "memory");
            const unsigned og = xb_add(&bar[XB_TOP], 1u);
            const unsigned tg = og / nx;
            if (og + 1u == (tg + 1u) * nx) xb_add(&bar[XB_TOPGEN], 1u);
            else XB_SPIN(xb_ld(&bar[XB_TOPGEN]) == tg, bar);
            __builtin_amdgcn_fence(__ATOMIC_ACQUIRE, "agent");
            xb_add(&bar[XB_XGEN(b.x)], 1u);
            asm volatile("s_waitcnt vmcnt(0)" ::: "memory");
        } else {
            XB_SPIN(xb_ld(&bar[XB_XGEN(b.x)]) == gen, bar);
            __builtin_amdgcn_fence(__ATOMIC_ACQUIRE, "agent");
            asm volatile("s_waitcnt vmcnt(0)" ::: "memory");
        }
    }
    __syncthreads();
}
constexpr int BAR_LDS_OFF = LDS_BYTES - 64;
constexpr size_t WS_BAR = WS_CTL + 16384;

typedef const __attribute__((address_space(4))) Args* ArgsP;
template <int PH>
__device__ __forceinline__ void do_phase(LAS unsigned char* lds, const Args& a_in, const int wave_id_s) {
#if defined(__HIP_DEVICE_COMPILE__)
    ArgsP ap = (ArgsP)__builtin_amdgcn_kernarg_segment_ptr();
    asm volatile("" : "+s"(ap));
    const Args a = *ap;
#else
    const Args a = a_in;
#endif
    const int nrep = 1 + ((a.dbg >> (8 + PH)) & 1);
#pragma unroll 1
    for (int rep = 0; rep < nrep; ++rep) {
        int WID = wave_id_s, BID = blockIdx.x, GD = gridDim.x;
        asm volatile("" : "+s"(WID), "+s"(BID), "+s"(GD));
        const int TID = WID * 64 + lane_id_opaque();
        const int G = GD;
        unsigned char* ws = a.ws;
        if constexpr (PH == 0) { phase0(lds, a, TID, BID, GD); if (rep == nrep - 1) { wg_wait((unsigned*)(ws + WS_ADACNT), 96u * (unsigned)nrep, TID); phase1(a, TID, BID, GD); } }
        else if constexpr (PH == 1) { }
        else if constexpr (PH == 2) {
            if (BID & 1) { convert_items(lds, a, 1, TID, BID, GD); __syncthreads(); }
            pg8::SchedInProj S{G, BID};
            EpiInProj E{(bf16_t*)(ws + WS_XGLU), (bf16_t*)(ws + WS_XLX), (bf16_t*)(ws + WS_GLG), a.in[9]};
            pg8::gemm_phase<EpiInProj, pg8::SchedInProj, false>(lds, (const bf16_t*)(ws + WS_U), (const bf16_t*)(ws + WS_WINT), 1024, S, E, nullptr, TID, BID, GD, 0x7F7F7F7F, pg8::lay_rowmajor(1024));
            if (!(BID & 1)) { __syncthreads(); convert_items(lds, a, 1, TID, BID, GD); }
        } else if constexpr (PH == 3) {
            {
                pg8::SchedCtx S{BID};
                EpiInProj E{(bf16_t*)(ws + WS_XGLU), (bf16_t*)(ws + WS_XLX), (bf16_t*)(ws + WS_GLG), a.in[9]};
                pg8::gemm_phase<EpiInProj, pg8::SchedCtx, false>(lds, (const bf16_t*)(ws + WS_U), (const bf16_t*)(ws + WS_WINT), 1024, S, E, nullptr, TID, BID, GD, 0x7F7F7F7F, pg8::lay_rowmajor(1024));
                if ((BID & 7) == 7 && (BID >> 3) < 8) {
                    asm volatile("s_waitcnt vmcnt(0)" ::: "memory");
                    __syncthreads();
                    if (TID == 0) { __builtin_amdgcn_fence(__ATOMIC_RELEASE, "agent"); asm volatile("s_waitcnt vmcnt(0)" ::: "memory");
                        __hip_atomic_store((unsigned*)(ws + WS_CTXFLAG) + 64 * (BID >> 3), 1u, __ATOMIC_RELAXED, __HIP_MEMORY_SCOPE_AGENT); }
                }
            }
            conv_units(lds, a, BID, G, TID, BID, GD);
            lru_phase<1>(lds, a, TID, BID, GD);
            if (rep == nrep - 1) { __syncthreads(); lru_rescan(lds, a, TID, BID, GD); }
        } else if constexpr (PH == 4) {
        } else if constexpr (PH == 5) {
            pg8::Sched S{128, 4, 1, G, BID};
            EpiOutProj E{(bf16_t*)(ws + WS_M), (const float*)(ws + WS_MOD), a.in[22]};
            pg8::gemm_phase<EpiOutProj, pg8::Sched, false>(lds, (const bf16_t*)(ws + WS_MIX), (const bf16_t*)(ws + WS_WOUTT), 1024, S, E, nullptr, TID, BID, GD, 0x7F7F7F7F, pg8::lay_rowmajor(1024));
        } else if constexpr (PH == 6) phase6(lds, a, TID, BID, GD);
        else if constexpr (PH == 7) phase7(lds, a, TID, BID, GD);
        else if constexpr (PH == 8) {
            if (BID & 1) { convert_items(lds, a, 2, TID, BID, GD); __syncthreads(); }
            pg8::Sched S{16, 22, 16, G, BID};
            EpiExpUp E{ws + WS_R1};
            pg8::gemm_phase<EpiExpUp, pg8::Sched, true, true>(lds, (const bf16_t*)(ws + WS_V), (const bf16_t*)(ws + WS_WGUT), 512, S, E, (const int*)(ws + WS_IDXE), TID, BID, GD, 0x7A7A7A7A, pg8::lay_rowmajor(512));
            if (!(BID & 1)) { __syncthreads(); convert_items(lds, a, 2, TID, BID, GD); }
        } else if constexpr (PH == 9) {
            pg8::SchedDown S{G, BID};
            EpiExpDown E{ws + WS_WGUT, (const float*)(ws + WS_GATEE)};
            pg8::gemm_phase<EpiExpDown, pg8::SchedDown, false, true>(lds, (const bf16_t*)(ws + WS_R1), (const bf16_t*)(ws + WS_WDT), DE / 2, S, E, nullptr, TID, BID, GD, 0x79797979, pg8::lay_blocked(22));
        } else if constexpr (PH == 10) phase10(a, TID, BID, GD);
    }
}
template <int PH, int PH0, int PH1>
__device__ __forceinline__ void run_phases(LAS unsigned char* lds, const Args& a_in, const int wave_id_s) {
    if constexpr (PH < PH1) {
        if constexpr (PH > PH0 && PH != 1 && PH != 4) {
#if defined(__HIP_DEVICE_COMPILE__)
            ArgsP apb = (ArgsP)__builtin_amdgcn_kernarg_segment_ptr(); asm volatile("" : "+s"(apb));
            XcdBarrier xb2; xb2.bar = (unsigned*)(apb->ws + WS_BAR); xb2.x = xb_xcc_id(); xb2.st = (volatile LAS unsigned*)(lds + BAR_LDS_OFF);
            int wv = wave_id_s; asm volatile("" : "+s"(wv));
            xcd_barrier(xb2, wv * 64 + lane_id_opaque(), gridDim.x);
#endif
        }
        do_phase<PH>(lds, a_in, wave_id_s);
        run_phases<PH + 1, PH0, PH1>(lds, a_in, wave_id_s);
    }
}
template <int PH0, int PH1>
__global__ void __launch_bounds__(NTHREADS, 2) hybrid_fwd(Args a_in) {
    extern __shared__ __attribute__((aligned(16))) unsigned char lds_raw[];
    LAS unsigned char* lds = (LAS unsigned char*)lds_raw;
    const int wave_id_s = __builtin_amdgcn_readfirstlane((int)threadIdx.x >> 6);
    {
        volatile LAS unsigned* st = (volatile LAS unsigned*)(lds + BAR_LDS_OFF);
        if (threadIdx.x == 0) { st[0] = 0u; st[1] = 0u; }
        __syncthreads();
        (void)xcd_barrier_post((unsigned*)(a_in.ws + WS_BAR), st, (int)threadIdx.x);
    }
    run_phases<PH0, PH0, PH1>(lds, a_in, wave_id_s);
}

extern "C" void kernel_launch(void* const* d_in, const int* in_sizes, int n_in, void* d_out, int out_size, void* d_ws, size_t ws_size, hipStream_t stream) {
    if (n_in != 28 || out_size != NTOK * D || ws_size < WS_END) { fprintf(stderr, "kernel_launch: unexpected shapes (n_in %d out %d ws %zu)\n", n_in, out_size, ws_size); return; }
    Args a{};
    for (int i = 0; i < 28; ++i) a.in[i] = (const float*)d_in[i];
    a.out = (float*)d_out; a.ws = (unsigned char*)d_ws; a.dbg = PROBE_MASK; a.pad = 0;
    static int grid = 0;
    if (!grid) {
        (void)hipFuncSetAttribute((const void*)hybrid_fwd<0, 11>, hipFuncAttributeMaxDynamicSharedMemorySize, LDS_BYTES);
        int dev = 0, cus = 0, per_cu = 0;
        (void)hipGetDevice(&dev); (void)hipDeviceGetAttribute(&cus, hipDeviceAttributeMultiprocessorCount, dev);
        (void)hipOccupancyMaxActiveBlocksPerMultiprocessor(&per_cu, (const void*)hybrid_fwd<0, 11>, NTHREADS, LDS_BYTES);
        grid = (per_cu >= 1 ? 1 : 0) * cus;
        if (grid != 256) fprintf(stderr, "kernel_launch: grid %d (cus %d per_cu %d)\n", grid, cus, per_cu);
    }
    if (grid <= 0) return;
    a.ph_lo = 0; a.ph_hi = 11;
    (void)hipMemsetAsync((char*)d_ws + WS_CTL, 0, 65536, stream);
    void* kargs[] = {&a};
    hipError_t e = hipLaunchCooperativeKernel((const void*)hybrid_fwd<0, 11>, dim3(grid), dim3(NTHREADS), kargs, LDS_BYTES, stream);
    if (e != hipSuccess) fprintf(stderr, "cooperative launch failed: %s (grid %d)\n", hipGetErrorString(e), grid);
}
```

```cpp
#include <hip/hip_runtime.h>
#include <hip/hip_cooperative_groups.h>
#include <cstdio>
#include <cstdint>

#define LAS __attribute__((address_space(3)))
typedef unsigned short bf16_t;
typedef short bf16x8 __attribute__((ext_vector_type(8)));
typedef float f32x4 __attribute__((ext_vector_type(4)));
typedef float f32x2 __attribute__((ext_vector_type(2)));
typedef unsigned u32x4 __attribute__((ext_vector_type(4)));
typedef unsigned u32x2 __attribute__((ext_vector_type(2)));
typedef int v4i_t __attribute__((ext_vector_type(4)));
typedef _Float16 h2_t __attribute__((ext_vector_type(2)));
typedef int v8i_t __attribute__((ext_vector_type(8)));

constexpr int D = 1024, NB = 4, SEQ = 8192, NTOK = NB * SEQ, CTXL = 256, NCTX = NB * CTXL, NROWS = NTOK + NCTX;
constexpr int DE = 2816, NE = 16, CAP = 1024, ROWS_E = NB * CAP;
constexpr int NQ = 132;
constexpr int NWAVES = 8, NTHREADS = 512;

constexpr size_t MiB = 1u << 20;
constexpr size_t WS_CTL = 0, CTL_BYTES = 1 * MiB;
constexpr size_t WS_CTXFLAG = WS_CTL + 40960;
constexpr size_t WS_ADACNT = WS_CTL + 45056;
constexpr size_t WS_CVCNT = WS_CTL + 57344;
constexpr size_t WS_BHCNT = WS_CTL + 49152;
constexpr size_t WS_MOD = 1 * MiB;
constexpr size_t WS_CARRY = 2 * MiB;
constexpr size_t WS_AFFT = 7 * MiB;
constexpr size_t WS_IDXE = 9 * MiB;
constexpr size_t WS_GATEE = WS_IDXE + 256 * 1024;
constexpr size_t WS_INV = WS_GATEE + 256 * 1024;
constexpr size_t WS_WINT = 12 * MiB;
constexpr size_t WS_WOUTT = 16 * MiB;
constexpr size_t WS_WGUT = 18 * MiB;
constexpr size_t WS_WDT = 146 * MiB;
constexpr size_t WS_V = 190 * MiB;
constexpr size_t WS_R1 = 222 * MiB;
constexpr size_t WS_U = WS_R1;
constexpr size_t WS_XGLU = WS_R1 + 66 * MiB;
constexpr size_t WS_XLX = WS_R1 + 98 * MiB;
constexpr size_t WS_GLG = WS_R1 + 131 * MiB;
constexpr size_t WS_MIX = WS_R1 + 163 * MiB;
constexpr size_t WS_M = WS_R1 + 227 * MiB;
constexpr size_t WS_X1B = WS_R1 + 291 * MiB;
constexpr size_t WS_AU = WS_R1 + 291 * MiB;
constexpr size_t WS_XGP = 641 * MiB;
constexpr int PGR = 158, PGC = 94;
constexpr size_t WS_END = 700 * MiB;
constexpr int LDS_BYTES = 147456;

__device__ __forceinline__ unsigned f2bf(float f) { unsigned u = __builtin_bit_cast(unsigned, f); return (u + 0x7fffu + ((u >> 16) & 1u)) >> 16; }
__device__ __forceinline__ unsigned pk2(float lo, float hi) { return f2bf(lo) | (f2bf(hi) << 16); }
__device__ __forceinline__ unsigned pk2h(float lo, float hi) { h2_t p; p.x = (_Float16)lo; p.y = (_Float16)hi; return __builtin_bit_cast(unsigned, p); }
__device__ __forceinline__ void fma_mix_lo(float& acc, float w, unsigned xh) { asm("v_fma_mix_f32 %0, %1, %2, %0 op_sel_hi:[0,1,0]" : "+v"(acc) : "v"(w), "v"(xh)); }
__device__ __forceinline__ void fma_mix_hi(float& acc, float w, unsigned xh) { asm("v_fma_mix_f32 %0, %1, %2, %0 op_sel:[0,1,0] op_sel_hi:[0,1,0]" : "+v"(acc) : "v"(w), "v"(xh)); }
__device__ __forceinline__ float bf_lo(unsigned w) { return __builtin_bit_cast(float, w << 16); }
__device__ __forceinline__ float bf_hi(unsigned w) { return __builtin_bit_cast(float, w & 0xffff0000u); }
__device__ __forceinline__ unsigned pk4_fp8(float a, float b, float c, float d) {
    a = __builtin_amdgcn_fmed3f(a, -448.f, 448.f); b = __builtin_amdgcn_fmed3f(b, -448.f, 448.f); c = __builtin_amdgcn_fmed3f(c, -448.f, 448.f); d = __builtin_amdgcn_fmed3f(d, -448.f, 448.f);
    int w = 0; w = __builtin_amdgcn_cvt_pk_fp8_f32(a, b, w, false); w = __builtin_amdgcn_cvt_pk_fp8_f32(c, d, w, true); return (unsigned)w; }
__device__ __forceinline__ float wave_sum(float v) {
#pragma unroll
    for (int o = 32; o >= 1; o >>= 1) v += __shfl_xor(v, o);
    return v;
}
__device__ __forceinline__ float wave_max(float v) {
#pragma unroll
    for (int o = 32; o >= 1; o >>= 1) v = fmaxf(v, __shfl_xor(v, o));
    return v;
}
__device__ __forceinline__ float sigm(float x) { return __builtin_amdgcn_rcpf(1.0f + __expf(-x)); }
__device__ __forceinline__ float silu_f(float x) { return x * sigm(x); }
__device__ __forceinline__ float gelu_tanh(float x) { const float z = 0.7978845608028654f * (x + 0.044715f * x * x * x); return x * sigm(2.0f * z); }

namespace pg8 {
constexpr int BM = 256, BK = 64, HALF = 128, HTB = HALF * BK * 2, STAGE_BYTES = 8 * HTB, NXCD = 8, WGM = 8;
__device__ __forceinline__ int lds_byte(int r, int c) { const int st = (r >> 4) * 2 + (c >> 5), rr = r & 15, cc = c & 31, ob = rr * 64 + cc * 2; return st * 1024 + (ob ^ (((ob >> 9) & 1) << 5)); }
__device__ __forceinline__ void stage_rc(int b, int& R, int& C) { const int st = b / 1024, sb = b % 1024, swz = sb ^ (((sb >> 9) & 1) << 5); R = (st >> 1) * 16 + swz / 64; C = (st & 1) * 32 + (swz % 64) / 2; }
__device__ __forceinline__ int perm32(int rho) { const int n = rho >> 4, i = rho & 15; return 8 * (i >> 2) + 4 * n + (i & 3); }
struct Unit { int pm, pn; };
struct Lay { unsigned rowA, rowB; size_t kstepA, kstepB, hstepB, tstepA, tstepB; };
__device__ __forceinline__ Lay lay_rowmajor(int K) { Lay l; l.rowA = l.rowB = (unsigned)K * 2u; l.kstepA = l.kstepB = 128; l.hstepB = (size_t)128 * K * 2; l.tstepA = l.tstepB = (size_t)256 * K * 2; return l; }
__device__ __forceinline__ Lay lay_blocked(int nkt) { Lay l; l.rowA = l.rowB = 128u; l.kstepA = l.kstepB = 32768; l.hstepB = 16384; l.tstepA = l.tstepB = (size_t)nkt * 32768; return l; }

__device__ __forceinline__ void tile_order(int w, int nM, int nN, int& pm, int& pn) {
    const int nwg = nM * nN;
    int wgid = w; { const int q = nwg / NXCD, r = nwg % NXCD, xcd = wgid % NXCD, off = wgid / NXCD; wgid = (xcd < r ? xcd * (q + 1) : r * (q + 1) + (xcd - r) * q) + off; }
    const int nig = WGM * nN, gid = wgid / nig, fm = gid * WGM, gsz = (nM - fm) < WGM ? (nM - fm) : WGM;
    pm = fm + ((wgid % nig) % gsz); pn = (wgid % nig) / gsz;
}
struct Sched {
    int nM, nN, ngroups, G, c;
    __device__ __forceinline__ bool next(int i, Unit& u) const {
        const int per = nM * nN; const long L = (long)i * G + c; if (L >= (long)per * ngroups) return false;
        const int e = (int)(L / per), w = (int)(L % per); int pm, pn; tile_order(w, nM, nN, pm, pn);
        u.pm = e * nM + pm; u.pn = e * nN + pn; return true;
    }
};
struct SchedInProj {
    int G, c;
    __device__ __forceinline__ bool next(int i, Unit& u) const {
        const long L = (long)i * G + c; if (L >= 1024) return false;
        int pm, pn; tile_order((int)L, 128, 8, pm, pn); u.pm = pm; u.pn = pn; return true;
    }
};
struct SchedCtx {
    int c;
    __device__ __forceinline__ bool next(int i, Unit& u) const {
        if (i != 0 || (c & 7) != 7 || (c >> 3) >= 8) return false;
        const int k = c >> 3; u.pm = 128 + (k >> 1); u.pn = 4 + (k & 1); return true;
    }
};
struct SchedDown {
    int G, c;
    __device__ __forceinline__ bool next(int i, Unit& u) const {
        if (G != 256) { const long L = (long)i * G + c; if (L >= 1024) return false; const int e = (int)(L >> 6), w = (int)(L & 63); u.pm = e * 16 + (w >> 2); u.pn = e * 4 + (w & 3); return true; }
        if (i >= 4) return false;
        const int x = c & 7, j = c >> 3, e = 4 * i + (x >> 1);
        u.pm = e * 16 + 8 * (x & 1) + (j & 7); u.pn = e * 4 + (j >> 3); return true;
    }
};
template <class Epi, class SchedT, bool GATHER, bool FP8 = false, bool SP2 = true, bool ALIGN_EPI = true>
__device__ __forceinline__ void gemm_phase(LAS unsigned char* lds, const bf16_t* Ag, const bf16_t* Btg, const int K, const SchedT& S, const Epi& E, const int* gidx, const int TID, const int BID, const int GD, const int scaleB, const Lay L) {
    const int tid = TID, wid = __builtin_amdgcn_readfirstlane(tid >> 6), lane = tid & 63, wr = wid >> 2, wc = wid & 3, fr = lane & 15, fq = lane >> 4;
    const int nt = K / BK;
    int Rr[2], Cc[2]; unsigned voffB[2];
#pragma unroll
    for (int i = 0; i < 2; ++i) { stage_rc(tid * 16 + i * 8192, Rr[i], Cc[i]); const int Rb = Epi::PERM ? ((Rr[i] & ~31) + perm32(Rr[i] & 31)) : Rr[i]; voffB[i] = (unsigned)Rb * L.rowB + (unsigned)Cc[i] * 2u; }
    const size_t kstepA = L.kstepA, kstepB = L.kstepB, hstep = L.hstepB, tstepA = L.tstepA, tstepB = L.tstepB;
    const unsigned ldsw = (unsigned)wid * 1024u;
    const int aoff = lds_byte(wr * 64 + fr, fq * 8), boff = lds_byte(wc * 32 + fr, fq * 8);
    const int aoff8_0 = aoff, aoff8_1 = aoff + 1024, boff8_0 = boff, boff8_1 = boff + 1024;
#define PG8_SA(b, h) (((b) * 2 + (h)) * HTB)
#define PG8_SB(b, h) ((4 + (b) * 2 + (h)) * HTB)
#define PG8_STAGE(bufoff, gbase, voff) do { _Pragma("unroll") for (int _i = 0; _i < 2; ++_i) \
        __builtin_amdgcn_global_load_lds((const unsigned*)((const char*)(gbase) + (voff)[_i]), (LAS unsigned*)(lds + (bufoff) + ldsw + _i * 8192), 16, 0, 0); } while (0)
#define PG8_LD8(p0, p1) __builtin_shufflevector(*(const LAS v4i_t*)(p0), *(const LAS v4i_t*)(p1), 0, 1, 2, 3, 4, 5, 6, 7)
#define PG8_LDA(dst, b, h) do { _Pragma("unroll") for (int m = 0; m < 4; ++m) { if constexpr (FP8) { \
        dst##8[m] = PG8_LD8(lds + PG8_SA(b, h) + aoff8_0 + m * 2048, lds + PG8_SA(b, h) + aoff8_1 + m * 2048); } else { \
        _Pragma("unroll") for (int k = 0; k < 2; ++k) dst[m][k] = *(const LAS bf16x8*)(lds + PG8_SA(b, h) + aoff + m * 2048 + k * 1024); } } } while (0)
#define PG8_LDB(dst, b, h) do { _Pragma("unroll") for (int n = 0; n < 2; ++n) { if constexpr (FP8) { \
        dst##8[n] = PG8_LD8(lds + PG8_SB(b, h) + boff8_0 + n * 2048, lds + PG8_SB(b, h) + boff8_1 + n * 2048); } else { \
        _Pragma("unroll") for (int k = 0; k < 2; ++k) dst[n][k] = *(const LAS bf16x8*)(lds + PG8_SB(b, h) + boff + n * 2048 + k * 1024); } } } while (0)
#define PG8_MMA(ai, bj, At, Bt) do { if constexpr (FP8) __builtin_amdgcn_sched_barrier(0); __builtin_amdgcn_s_setprio(1); _Pragma("unroll") for (int m = 0; m < 4; ++m) _Pragma("unroll") for (int n = 0; n < 2; ++n) { if constexpr (FP8) { \
        acc[ai][bj][m][n] = __builtin_amdgcn_mfma_scale_f32_16x16x128_f8f6f4(Bt##8[n], At##8[m], acc[ai][bj][m][n], 0, 0, 0, scaleB, 0, 0x7F7F7F7F); } else { \
        _Pragma("unroll") for (int k = 0; k < 2; ++k) acc[ai][bj][m][n] = __builtin_amdgcn_mfma_f32_16x16x32_bf16(Bt[n][k], At[m][k], acc[ai][bj][m][n], 0, 0, 0); } } \
        if constexpr (FP8) { _Pragma("unroll") for (int m = 0; m < 4; ++m) _Pragma("unroll") for (int n = 0; n < 2; ++n) asm volatile("" : "+v"(acc[ai][bj][m][n])); } \
        __builtin_amdgcn_s_setprio(0); if constexpr (FP8) __builtin_amdgcn_sched_barrier(0); } while (0)
#define PG8_WAIT_V(n) asm volatile("s_waitcnt vmcnt(" #n ")" ::: "memory")
#define PG8_WAIT_L(n) asm volatile("s_waitcnt lgkmcnt(" #n ")" ::: "memory")
#define PG8_BAR __builtin_amdgcn_s_barrier()
#define PG8_SCHED __builtin_amdgcn_sched_barrier(0)
#define PG8_LOADV(dst, u) do { _Pragma("unroll") for (int _h = 0; _h < 2; ++_h) _Pragma("unroll") for (int _i = 0; _i < 2; ++_i) \
        dst[_h][_i] = GATHER ? ((unsigned)gidx[(u).pm * BM + _h * HALF + Rr[_i]] * L.rowA + (unsigned)Cc[_i] * 2u) : ((unsigned)(_h * HALF + Rr[_i]) * L.rowA + (unsigned)Cc[_i] * 2u); } while (0)
    Unit cur, nxt; int ui = 0;
    if (!S.next(0, cur)) return;
    f32x4 acc[2][2][4][2];
#pragma unroll
    for (int a = 0; a < 2; ++a)
#pragma unroll
        for (int b = 0; b < 2; ++b)
#pragma unroll
            for (int m = 0; m < 4; ++m)
#pragma unroll
                for (int n = 0; n < 2; ++n) acc[a][b][m][n] = (f32x4){0.f, 0.f, 0.f, 0.f};
    bf16x8 At[4][2], B0[2][2], B1[2][2];
    v8i_t At8[4], B08[2], B18[2];
    unsigned vc[2][2], vn[2][2];
    PG8_LOADV(vc, cur);
    const char* cA = GATHER ? (const char*)Ag : (const char*)Ag + (size_t)cur.pm * tstepA;
    const char* cB = (const char*)Btg + (size_t)cur.pn * tstepB;
    if constexpr (SP2) {
        PG8_STAGE(PG8_SB(0, 0), cB, voffB); PG8_STAGE(PG8_SB(0, 1), cB + hstep, voffB); PG8_STAGE(PG8_SA(0, 0), cA, vc[0]); PG8_STAGE(PG8_SA(0, 1), cA, vc[1]);
        if (wr == 1) PG8_BAR;
        PG8_WAIT_V(2); PG8_BAR;
        PG8_STAGE(PG8_SB(1, 0), cB + kstepB, voffB); PG8_STAGE(PG8_SA(1, 0), cA + kstepA, vc[0]); PG8_STAGE(PG8_SB(1, 1), cB + hstep + kstepB, voffB);
        PG8_WAIT_V(6); PG8_BAR;
    } else {
    PG8_STAGE(PG8_SB(0, 0), cB, voffB); PG8_STAGE(PG8_SA(0, 0), cA, vc[0]); PG8_STAGE(PG8_SB(0, 1), cB + hstep, voffB); PG8_STAGE(PG8_SA(0, 1), cA, vc[1]);
    if (wr == 1) PG8_BAR;
    PG8_WAIT_V(4); PG8_BAR;
    PG8_STAGE(PG8_SB(1, 0), cB + kstepB, voffB); PG8_STAGE(PG8_SA(1, 0), cA + kstepA, vc[0]); PG8_STAGE(PG8_SB(1, 1), cB + hstep + kstepB, voffB);
    PG8_WAIT_V(6); PG8_BAR;
    }
    for (;;) {
        const bool has_next = S.next(ui + 1, nxt);
        const char* nA = cA; const char* nB = cB;
        if (has_next) { nA = GATHER ? (const char*)Ag : (const char*)Ag + (size_t)nxt.pm * tstepA; nB = (const char*)Btg + (size_t)nxt.pn * tstepB; PG8_LOADV(vn, nxt); }
        else {
#pragma unroll
            for (int h = 0; h < 2; ++h)
#pragma unroll
                for (int i = 0; i < 2; ++i) vn[h][i] = vc[h][i];
        }
        for (int t = 0; t < nt; t += 2) {
            const bool last = (t == nt - 2);
            const char* a1 = cA + (size_t)(t + 1) * kstepA;
            const char* a2 = last ? nA : cA + (size_t)(t + 2) * kstepA; const char* b2 = last ? nB : cB + (size_t)(t + 2) * kstepB;
            const char* a3 = a2 + kstepA; const char* b3 = b2 + kstepB;
#pragma unroll
            for (int i = 0; i < 2; ++i) vc[0][i] = last ? vn[0][i] : vc[0][i];
            if constexpr (SP2) {
            PG8_LDB(B0, 0, 0); PG8_LDB(B1, 0, 1); PG8_SCHED; PG8_LDA(At, 0, 0); PG8_STAGE(PG8_SA(1, 1), a1, vc[1]);
            _Pragma("unroll") for (int i = 0; i < 2; ++i) vc[1][i] = last ? vn[1][i] : vc[1][i];
            PG8_WAIT_V(8); PG8_WAIT_L(0); PG8_BAR; PG8_MMA(0, 0, At, B0); PG8_MMA(0, 1, At, B1); PG8_BAR; PG8_SCHED;
            PG8_LDA(At, 0, 1); PG8_STAGE(PG8_SB(0, 0), b2, voffB); PG8_STAGE(PG8_SB(0, 1), b2 + hstep, voffB); PG8_STAGE(PG8_SA(0, 0), a2, vc[0]);
            PG8_WAIT_V(8); PG8_WAIT_L(0); PG8_BAR; PG8_MMA(1, 0, At, B0); PG8_MMA(1, 1, At, B1); PG8_BAR; PG8_SCHED;
            PG8_LDB(B0, 1, 0); PG8_LDB(B1, 1, 1); PG8_SCHED; PG8_LDA(At, 1, 0); PG8_STAGE(PG8_SA(0, 1), a2, vc[1]);
            PG8_WAIT_V(8); PG8_WAIT_L(0); PG8_BAR; PG8_MMA(0, 0, At, B0); PG8_MMA(0, 1, At, B1); PG8_BAR; PG8_SCHED;
            PG8_LDA(At, 1, 1); PG8_STAGE(PG8_SB(1, 0), b3, voffB); PG8_STAGE(PG8_SB(1, 1), b3 + hstep, voffB); PG8_STAGE(PG8_SA(1, 0), a3, vc[0]);
            PG8_WAIT_V(8); PG8_WAIT_L(0); PG8_BAR; PG8_MMA(1, 0, At, B0); PG8_MMA(1, 1, At, B1); PG8_BAR; PG8_SCHED;
            } else {
            PG8_LDB(B0, 0, 0); PG8_SCHED; PG8_LDA(At, 0, 0); PG8_STAGE(PG8_SA(1, 1), a1, vc[1]);
            _Pragma("unroll") for (int i = 0; i < 2; ++i) vc[1][i] = last ? vn[1][i] : vc[1][i];
            PG8_WAIT_L(8); PG8_BAR; PG8_WAIT_L(0); PG8_MMA(0, 0, At, B0); PG8_BAR; PG8_SCHED;
            PG8_LDB(B1, 0, 1); PG8_STAGE(PG8_SB(0, 0), b2, voffB);
            PG8_BAR; PG8_WAIT_L(0); PG8_MMA(0, 1, At, B1); PG8_BAR;
            PG8_LDA(At, 0, 1); PG8_STAGE(PG8_SA(0, 0), a2, vc[0]);
            PG8_BAR; PG8_WAIT_L(0); PG8_MMA(1, 0, At, B0); PG8_BAR; PG8_SCHED;
            PG8_STAGE(PG8_SB(0, 1), b2 + hstep, voffB);
            PG8_WAIT_V(6); PG8_BAR; PG8_MMA(1, 1, At, B1); PG8_BAR;
            PG8_LDB(B0, 1, 0); PG8_SCHED; PG8_LDA(At, 1, 0); PG8_STAGE(PG8_SA(0, 1), a2, vc[1]);
            PG8_WAIT_L(8); PG8_BAR; PG8_WAIT_L(0); PG8_MMA(0, 0, At, B0); PG8_BAR; PG8_SCHED;
            PG8_LDB(B1, 1, 1); PG8_STAGE(PG8_SB(1, 0), b3, voffB);
            PG8_BAR; PG8_WAIT_L(0); PG8_MMA(0, 1, At, B1); PG8_BAR;
            PG8_LDA(At, 1, 1); PG8_STAGE(PG8_SA(1, 0), a3, vc[0]);
            PG8_BAR; PG8_WAIT_L(0); PG8_MMA(1, 0, At, B0); PG8_BAR; PG8_SCHED;
            PG8_STAGE(PG8_SB(1, 1), b3 + hstep, voffB);
            PG8_WAIT_V(6); PG8_BAR; PG8_MMA(1, 1, At, B1); PG8_BAR;
            }
        }
        if constexpr (ALIGN_EPI) { if (wr == 0) PG8_BAR; }
        E(acc, cur, wr, wc, fr, fq);
        if (!has_next) break;
#pragma unroll
        for (int a = 0; a < 2; ++a)
#pragma unroll
            for (int b = 0; b < 2; ++b)
#pragma unroll
                for (int m = 0; m < 4; ++m)
#pragma unroll
                    for (int n = 0; n < 2; ++n) acc[a][b][m][n] = (f32x4){0.f, 0.f, 0.f, 0.f};
        cur = nxt; cA = nA; cB = nB; ++ui;
#pragma unroll
        for (int h = 0; h < 2; ++h)
#pragma unroll
            for (int i = 0; i < 2; ++i) vc[h][i] = vn[h][i];
        if constexpr (ALIGN_EPI) { if (wr == 1) PG8_BAR; }
    }
    PG8_WAIT_V(0);
    if constexpr (!ALIGN_EPI) { if (wr == 0) PG8_BAR; }
    PG8_BAR;
#undef PG8_SA
#undef PG8_SB
#undef PG8_STAGE
#undef PG8_LDA
#undef PG8_LDB
#undef PG8_MMA
#undef PG8_LD8
#undef PG8_WAIT_V
#undef PG8_WAIT_L
#undef PG8_BAR
#undef PG8_SCHED
#undef PG8_LOADV
}
}

struct EpiInProj {
    static constexpr bool PERM = true;
    bf16_t* xglu; bf16_t* xlx; bf16_t* glg; const float* b_in;
    __device__ __forceinline__ void operator()(const f32x4 (&acc)[2][2][4][2], const pg8::Unit& u, int wr, int wc, int fr, int fq) const {
        const int row0 = u.pm * 256 + wr * 64 + fr, cl = wc * 32 + 8 * fq;
        if (u.pn < 4) {
            const int col = 128 * u.pn + cl;
            f32x4 bv[2][2];
#pragma unroll
            for (int n = 0; n < 2; ++n) { bv[0][n] = *(const f32x4*)(b_in + col + 4 * n); bv[1][n] = *(const f32x4*)(b_in + 512 + col + 4 * n); }
#pragma unroll
            for (int ai = 0; ai < 2; ++ai)
#pragma unroll
                for (int m = 0; m < 4; ++m) {
                    const size_t row = (size_t)(row0 + ai * 128 + m * 16);
                    float o[8];
#pragma unroll
                    for (int n = 0; n < 2; ++n) { const f32x4 v = acc[ai][0][m][n] + bv[0][n], g = acc[ai][1][m][n] + bv[1][n];
#pragma unroll
                        for (int j = 0; j < 4; ++j) o[4 * n + j] = v[j] * sigm(g[j]); }
                    u32x4 w; w.x = pk2h(o[0], o[1]); w.y = pk2h(o[2], o[3]); w.z = pk2h(o[4], o[5]); w.w = pk2h(o[6], o[7]);
                    { const int rw = (int)row, bb = rw >> 13, tk = rw & (SEQ - 1);
                      *(u32x4*)(xglu + ((size_t)((bb * PGR + (tk >> 6) + 15) * PGC + (tk & 63) + 15)) * 512 + col) = w; }
                }
        } else {
            const bool isg = u.pn >= 6;
            const int cbase = 256 * (u.pn - (isg ? 6 : 4));
            const float* bias = b_in + (isg ? 1536 : 1024) + cbase;
            bf16_t* outp = isg ? glg : xlx;
#pragma unroll
            for (int bj = 0; bj < 2; ++bj) {
                const int col = 128 * bj + cl;
                const f32x4 b0 = *(const f32x4*)(bias + col), b1 = *(const f32x4*)(bias + col + 4);
#pragma unroll
                for (int ai = 0; ai < 2; ++ai)
#pragma unroll
                    for (int m = 0; m < 4; ++m) {
                        const size_t row = (size_t)(row0 + ai * 128 + m * 16);
                        f32x4 v0 = acc[ai][bj][m][0] + b0, v1 = acc[ai][bj][m][1] + b1;
                        if (isg) {
#pragma unroll
                            for (int j = 0; j < 4; ++j) { v0[j] = gelu_tanh(v0[j]); v1[j] = gelu_tanh(v1[j]); }
                        }
                        u32x4 w; w.x = pk2(v0[0], v0[1]); w.y = pk2(v0[2], v0[3]); w.z = pk2(v1[0], v1[1]); w.w = pk2(v1[2], v1[3]);
                        *(u32x4*)(outp + row * 512 + cbase + col) = w;
                    }
            }
        }
    }
};
struct EpiOutProj {
    static constexpr bool PERM = true;
    bf16_t* X1; const float* x; const float* mod; const float* b_out;
    __device__ __forceinline__ void operator()(const f32x4 (&acc)[2][2][4][2], const pg8::Unit& u, int wr, int wc, int fr, int fq) const {
        const int row0 = u.pm * 256 + wr * 64 + fr, col0 = u.pn * 256 + wc * 32 + 8 * fq;
        const int b = u.pm >> 5;
        const float* g1 = mod + b * 6144 + 2048;
#pragma unroll
        for (int bj = 0; bj < 2; ++bj) {
            const int col = col0 + bj * 128;
            const f32x4 bo0 = *(const f32x4*)(b_out + col), bo1 = *(const f32x4*)(b_out + col + 4), gg0 = *(const f32x4*)(g1 + col), gg1 = *(const f32x4*)(g1 + col + 4);
#pragma unroll
            for (int ai = 0; ai < 2; ++ai) {
                f32x4 xa[4][2];
#pragma unroll
                for (int m = 0; m < 4; ++m) { const float* xp = x + (size_t)(row0 + ai * 128 + m * 16) * D + col;
                    xa[m][0] = __builtin_nontemporal_load((const f32x4*)xp); xa[m][1] = __builtin_nontemporal_load((const f32x4*)(xp + 4)); }
#pragma unroll
                for (int m = 0; m < 4; ++m) {
                    const f32x4 v0 = xa[m][0] + gg0 * (acc[ai][bj][m][0] + bo0), v1 = xa[m][1] + gg1 * (acc[ai][bj][m][1] + bo1);
                    u32x4 w; w.x = pk2(v0[0], v0[1]); w.y = pk2(v0[2], v0[3]); w.z = pk2(v1[0], v1[1]); w.w = pk2(v1[2], v1[3]);
                    *(u32x4*)(X1 + (size_t)(row0 + ai * 128 + m * 16) * D + col) = w;
                }
            }
        }
    }
};
struct EpiExpUp {
    static constexpr bool PERM = true;
    unsigned char* H;
    __device__ __forceinline__ void operator()(const f32x4 (&acc)[2][2][4][2], const pg8::Unit& u, int wr, int wc, int fr, int fq) const {
        const int e = u.pm >> 4, t = u.pn - e * 22;
        const int row0 = u.pm * 256 + wr * 64 + fr, col = 128 * t + wc * 32 + 8 * fq;
#pragma unroll
        for (int ai = 0; ai < 2; ++ai)
#pragma unroll
            for (int m = 0; m < 4; ++m) {
                const size_t row = (size_t)(row0 + ai * 128 + m * 16);
                float o[8];
#pragma unroll
                for (int n = 0; n < 2; ++n)
#pragma unroll
                    for (int j = 0; j < 4; j += 2) {
                        const f32x2 g2 = (f32x2){acc[ai][0][m][n][j], acc[ai][0][m][n][j + 1]}, u2 = (f32x2){acc[ai][1][m][n][j], acc[ai][1][m][n][j + 1]};
                        const f32x2 tt = g2 * (-1.4426950408889634f);
                        f32x2 ee; ee.x = __builtin_amdgcn_exp2f(tt.x); ee.y = __builtin_amdgcn_exp2f(tt.y);
                        const f32x2 dd = ee + 1.0f;
                        f32x2 rr; rr.x = __builtin_amdgcn_rcpf(dd.x); rr.y = __builtin_amdgcn_rcpf(dd.y);
                        const f32x2 hh = (g2 * u2) * rr;
                        o[4 * n + j] = hh.x; o[4 * n + j + 1] = hh.y; }
                u32x2 w; w.x = pk4_fp8(o[0], o[1], o[2], o[3]); w.y = pk4_fp8(o[4], o[5], o[6], o[7]);
                *(u32x2*)(H + ((size_t)u.pm * 22 + t) * 32768 + (size_t)(row - (size_t)u.pm * 256) * 128 + (col - 128 * t)) = w;
            }
    }
};
struct EpiExpDown {
    static constexpr bool PERM = true;
    unsigned char* Y; const float* gateE;
    __device__ __forceinline__ void operator()(const f32x4 (&acc)[2][2][4][2], const pg8::Unit& u, int wr, int wc, int fr, int fq) const {
        const int e = u.pm >> 4, c4 = u.pn - e * 4;
        const int row0 = u.pm * 256 + wr * 64 + fr, col0 = 256 * c4 + wc * 32 + 8 * fq;
#pragma unroll
        for (int ai = 0; ai < 2; ++ai)
#pragma unroll
            for (int m = 0; m < 4; ++m) {
                const size_t row = (size_t)(row0 + ai * 128 + m * 16);
                const float g = gateE[row] * 32.0f;
#pragma unroll
                for (int bj = 0; bj < 2; ++bj) {
                    const f32x4 v0 = acc[ai][bj][m][0] * g, v1 = acc[ai][bj][m][1] * g;
                    u32x2 w; w.x = pk4_fp8(v0[0], v0[1], v0[2], v0[3]); w.y = pk4_fp8(v1[0], v1[1], v1[2], v1[3]);
                    *(u32x2*)(Y + row * D + col0 + 128 * bj) = w;
                }
            }
    }
};

__device__ __forceinline__ void wg_publish(unsigned* cnt, int tid) {
    asm volatile("s_waitcnt vmcnt(0)" ::: "memory");
    __syncthreads();
    if (tid == 0) { __builtin_amdgcn_fence(__ATOMIC_RELEASE, "agent"); asm volatile("s_waitcnt vmcnt(0)" ::: "memory");
        (void)__hip_atomic_fetch_add(cnt, 1u, __ATOMIC_RELAXED, __HIP_MEMORY_SCOPE_AGENT); }
}
__device__ __forceinline__ void wg_wait(unsigned* cnt, unsigned target, int tid) {
    if (tid == 0) { unsigned sp = 0;
        while (__hip_atomic_load(cnt, __ATOMIC_RELAXED, __HIP_MEMORY_SCOPE_AGENT) < target && ++sp < (1u << 22)) __builtin_amdgcn_s_sleep(2);
        __builtin_amdgcn_fence(__ATOMIC_ACQUIRE, "agent"); asm volatile("s_waitcnt vmcnt(0)" ::: "memory"); }
    __syncthreads();
}

__device__ __forceinline__ void transpose_item(const float* W, int K, int N, bf16_t* WT, int k0, int n0, size_t drow0, LAS float* scr, int lane) {
    float tv[32];
#pragma unroll
    for (int i = 0; i < 32; ++i) { const int kk = 2 * i + (lane >> 5); tv[i] = __builtin_nontemporal_load(W + (size_t)(k0 + kk) * N + n0 + (lane & 31)); }
#pragma unroll
    for (int i = 0; i < 32; ++i) { const int kk = 2 * i + (lane >> 5); scr[kk * 33 + (lane & 31)] = tv[i]; }
    asm volatile("s_waitcnt lgkmcnt(0)" ::: "memory");
    const int c = lane & 7;
#pragma unroll
    for (int j = 0; j < 4; ++j) { const int n = (lane >> 3) + 8 * j; const LAS float* s = scr + (8 * c) * 33 + n;
        u32x4 o; o.x = pk2(s[0 * 33], s[1 * 33]); o.y = pk2(s[2 * 33], s[3 * 33]); o.z = pk2(s[4 * 33], s[5 * 33]); o.w = pk2(s[6 * 33], s[7 * 33]);
        *(u32x4*)(WT + (drow0 + n) * (size_t)K + k0 + 8 * c) = o; }
    asm volatile("s_waitcnt lgkmcnt(0)" ::: "memory");
}

__device__ __forceinline__ void transpose_item8(const float* W, int K, int N, unsigned char* WT, int k0, int n0, size_t drow0, float scale, LAS float* scr, int lane) {
    float tv[32];
#pragma unroll
    for (int i = 0; i < 32; ++i) { const int kk = 2 * i + (lane >> 5); tv[i] = __builtin_nontemporal_load(W + (size_t)(k0 + kk) * N + n0 + (lane & 31)); }
#pragma unroll
    for (int i = 0; i < 32; ++i) { const int kk = 2 * i + (lane >> 5); scr[kk * 33 + (lane & 31)] = tv[i] * scale; }
    asm volatile("s_waitcnt lgkmcnt(0)" ::: "memory");
    const int c = lane & 7;
#pragma unroll
    for (int j = 0; j < 4; ++j) { const int n = (lane >> 3) + 8 * j; const LAS float* s = scr + (8 * c) * 33 + n;
        u32x2 o; o.x = pk4_fp8(s[0 * 33], s[1 * 33], s[2 * 33], s[3 * 33]); o.y = pk4_fp8(s[4 * 33], s[5 * 33], s[6 * 33], s[7 * 33]);
        *(u32x2*)(WT + (drow0 + n) * (size_t)K + k0 + 8 * c) = o; }
    asm volatile("s_waitcnt lgkmcnt(0)" ::: "memory");
}

__device__ __forceinline__ void transpose_item8b(const float* W, int N, unsigned char* WTblk, int k0, int n0, int drow0, int kc0, float scale, LAS float* scr, int lane) {
    float tv[32];
#pragma unroll
    for (int i = 0; i < 32; ++i) { const int kk = 2 * i + (lane >> 5); tv[i] = __builtin_nontemporal_load(W + (size_t)(k0 + kk) * N + n0 + (lane & 31)); }
#pragma unroll
    for (int i = 0; i < 32; ++i) { const int kk = 2 * i + (lane >> 5); scr[kk * 33 + (lane & 31)] = tv[i] * scale; }
    asm volatile("s_waitcnt lgkmcnt(0)" ::: "memory");
    const int c = lane & 7;
#pragma unroll
    for (int j = 0; j < 4; ++j) { const int n = (lane >> 3) + 8 * j; const LAS float* s = scr + (8 * c) * 33 + n;
        u32x2 o; o.x = pk4_fp8(s[0 * 33], s[1 * 33], s[2 * 33], s[3 * 33]); o.y = pk4_fp8(s[4 * 33], s[5 * 33], s[6 * 33], s[7 * 33]);
        *(u32x2*)(WTblk + (size_t)(drow0 + n) * 128 + kc0 + 8 * c) = o; }
    asm volatile("s_waitcnt lgkmcnt(0)" ::: "memory");
}

#ifndef PROBE_MASK
#define PROBE_MASK 0
#endif
struct Args { const float* in[28]; float* out; unsigned char* ws; int ph_lo, ph_hi, dbg, pad; };

constexpr int CV_TOTAL1 = 2 * 16 * 16 * 88, CV_TOTAL2 = 16 * 44 * 32;
__device__ __forceinline__ int cv1_early(int G) { return G > 96 ? (G - 96) * NWAVES * 5 : 0; }
__device__ __forceinline__ int cv2_early(int G) { return G > 64 ? (G - 64) * NWAVES * 5 : 0; }
__device__ __forceinline__ void convert_range(LAS unsigned char* lds, const Args& a, const int kind, const int lo, const int hi, const int gw, const int NGW, const int wave, const int lane);
__device__ __forceinline__ void convert_items(LAS unsigned char* lds, const Args& a, const int kind, const int TID, const int BID, const int GD) {
    const int lo = kind == 1 ? cv1_early(GD) : (kind == 2 ? cv2_early(GD) : 0);
    const int hi = kind == 0 ? (16 * 64 + 16 * 32) : (kind == 1 ? CV_TOTAL1 : CV_TOTAL2);
    convert_range(lds, a, kind, lo < hi ? lo : hi, hi, BID * NWAVES + (TID >> 6), GD * NWAVES, TID >> 6, TID & 63);
}
constexpr int CV_CHUNK = 8;
__device__ __forceinline__ void convert_items_dyn(LAS unsigned char* lds, const Args& a, const int kind, const int maxrounds, const int TID, const int GD) {
    const int lo0 = kind == 1 ? cv1_early(GD) : cv2_early(GD), hi = kind == 1 ? CV_TOTAL1 : CV_TOTAL2, lo = lo0 < hi ? lo0 : hi;
    unsigned* ctr = (unsigned*)(a.ws + WS_CVCNT) + 64 * (kind - 1);
    volatile LAS unsigned* slot = (volatile LAS unsigned*)(lds + 8 * 8704 + 64);
    const int wave = TID >> 6, lane = TID & 63;
    unsigned nb = 0u;
    if (TID == 0) nb = __hip_atomic_fetch_add(ctr, (unsigned)CV_CHUNK, __ATOMIC_RELAXED, __HIP_MEMORY_SCOPE_AGENT);
#pragma unroll 1
    for (int round = 0; round < maxrounds; ++round) {
        if (TID == 0) slot[0] = nb;
        __syncthreads();
        const int base = lo + (int)slot[0];
        __syncthreads();
        if (base >= hi) break;
        if (TID == 0 && round + 1 < maxrounds) nb = __hip_atomic_fetch_add(ctr, (unsigned)CV_CHUNK, __ATOMIC_RELAXED, __HIP_MEMORY_SCOPE_AGENT);
        const int top = base + CV_CHUNK < hi ? base + CV_CHUNK : hi;
        convert_range(lds, a, kind, base, top, wave, NWAVES, wave, lane);
    }
}
__device__ __forceinline__ void convert_range(LAS unsigned char* lds, const Args& a, const int kind, const int lo, const int hi, const int gw, const int NGW, const int wave, const int lane) {
    unsigned char* ws = a.ws;
    LAS float* scr = (LAS float*)(lds + wave * 8704);
    const float* w_in = a.in[8]; const float* w_out = a.in[21]; const float* wg = a.in[24]; const float* wu = a.in[25]; const float* wd = a.in[26];
    bf16_t* WinT = (bf16_t*)(ws + WS_WINT); bf16_t* WoutT = (bf16_t*)(ws + WS_WOUTT); unsigned char* WguT = ws + WS_WGUT; unsigned char* WdT = ws + WS_WDT;
    constexpr int I_IN = 16 * 64, I_OUT = 16 * 32, I_GE = 16 * 88, I_G = 16 * I_GE, I_DE = 44 * 32, I_D = 16 * I_DE;
    static_assert(2 * I_G == CV_TOTAL1 && I_D == CV_TOTAL2, "item counts");
    for (int it = lo + gw; it < hi; it += NGW) {
        int r = it;
        if (kind == 0) {
            if (r < I_IN) { const int kb = r / 64, nb = r % 64, n0 = 32 * nb;
                int drow; if (n0 < 512) drow = (n0 >> 7) * 256 + (n0 & 127); else if (n0 < 1024) drow = ((n0 - 512) >> 7) * 256 + 128 + ((n0 - 512) & 127); else drow = n0;
                transpose_item(w_in, 1024, 2048, WinT, 64 * kb, n0, (size_t)drow, scr, lane); }
            else { r -= I_IN; const int kb = r / 32, nb = r % 32; transpose_item(w_out, 1024, 1024, WoutT, 64 * kb, 32 * nb, (size_t)(32 * nb), scr, lane); }
        } else if (kind == 1) {
            const int up = r >= I_G; if (up) r -= I_G; const int e = r / I_GE, q = r % I_GE, kb = q / 88, nb = q % 88, n0 = 32 * nb;
            const size_t drow = (size_t)e * 5632 + (size_t)(n0 >> 7) * 256 + (up ? 128 : 0) + (n0 & 127);
            transpose_item8((up ? wu : wg) + (size_t)e * 1024 * DE, 1024, DE, WguT, 64 * kb, n0, drow, 32.0f, scr, lane);
        } else {
            const int e = r / I_DE, q = r % I_DE, kb = q / 32, nb = q % 32;
            const int n0 = 32 * nb, k0 = 64 * kb;
            transpose_item8b(wd + (size_t)e * DE * 1024, 1024, WdT + ((size_t)((e * 4 + (n0 >> 8)) * 22 + (k0 >> 7))) * 32768, k0, n0, n0 & 255, k0 & 127, 64.0f, scr, lane);
        }
    }
}

__device__ __forceinline__ void phase0(LAS unsigned char* lds, const Args& a, const int TID, const int BID, const int GD) {
    const int tid = TID, lane = tid & 63, wave = tid >> 6, G = GD;
    unsigned char* ws = a.ws;
    __syncthreads();
    {
        const float* c = a.in[1]; const float* cctx = a.in[3]; const float* ada_w = a.in[6]; const float* ada_b = a.in[7];
        float* mod = (float*)(ws + WS_MOD); float* modc = mod + 4 * 6144;
        LAS float* sc = (LAS float*)lds;
        LAS float* red = (LAS float*)(lds + 20480);
        for (int grp = BID; grp < 96; grp += G) {
            for (int i = tid; i < 5 * 1024; i += NTHREADS) { const float v = (i < 4096) ? c[i] : cctx[i - 4096]; sc[i] = silu_f(v); }
            __syncthreads();
            const int col = grp * 64 + lane;
            float acc[5] = {0.f, 0.f, 0.f, 0.f, 0.f};
            const int k0 = wave * 128;
#pragma unroll 64
            for (int k = k0; k < k0 + 128; ++k) { const float w = __builtin_nontemporal_load(ada_w + (size_t)k * 6144 + col);
#pragma unroll
                for (int v = 0; v < 5; ++v) acc[v] += sc[v * 1024 + k] * w; }
#pragma unroll
            for (int v = 0; v < 5; ++v) red[(wave * 5 + v) * 64 + lane] = acc[v];
            __syncthreads();
            if (tid < 320) { const int v = tid >> 6, l = tid & 63; float s = 0.f;
#pragma unroll
                for (int w = 0; w < 8; ++w) s += red[(w * 5 + v) * 64 + l];
                const int cc = grp * 64 + l; s += ada_b[cc];
                if (v < 4) mod[v * 6144 + cc] = s; else if (cc < 2048) modc[cc] = s; }
            wg_publish((unsigned*)(ws + WS_ADACNT), tid);
            __syncthreads();
        }
    }
    {
        const int nz = G > 96 ? G - 96 : G, zb = G > 96 ? BID - 96 : BID;
        if (zb >= 0) for (int cell = zb * NWAVES + wave; cell < NB * PGR * PGC; cell += nz * NWAVES) {
            const int rc = cell % (PGR * PGC), pr = rc / PGC, pc = rc % PGC;
            if (pr < 15 || pr >= 143 || pc < 15 || pc >= 79) *(u32x4*)(ws + WS_XGP + (size_t)cell * 1024 + lane * 16) = (u32x4){0u, 0u, 0u, 0u};
        }
    }
    convert_items(lds, a, 0, TID, BID, GD);
    if (G > 96 && BID >= 96) { const int e1 = cv1_early(G); convert_range(lds, a, 1, 0, e1 < CV_TOTAL1 ? e1 : CV_TOTAL1, (BID - 96) * NWAVES + wave, (G - 96) * NWAVES, wave, lane); }
}

__device__ __forceinline__ void phase1(const Args& a, const int TID, const int BID, const int GD) {
    const int lane = TID & 63, wave = TID >> 6, G = GD;
    const float* x = a.in[0]; const float* ctx = a.in[2]; const float* g1 = a.in[4];
    const float* mod = (const float*)(a.ws + WS_MOD); const float* modc = mod + 4 * 6144;
    bf16_t* U = (bf16_t*)(a.ws + WS_U);
    const int stride1 = G * NWAVES, row1 = BID * NWAVES + wave;
    f32x4 q0[4], q1[4];
#pragma unroll
    for (int i = 0; i < 4; ++i) {
        const int ra = row1 < NROWS ? row1 : 0, rb = row1 + stride1 < NROWS ? row1 + stride1 : 0;
        q0[i] = __builtin_nontemporal_load((const f32x4*)((ra < NTOK ? x + (size_t)ra * D : ctx + (size_t)(ra - NTOK) * D) + 4 * (lane + 64 * i)));
        q1[i] = __builtin_nontemporal_load((const f32x4*)((rb < NTOK ? x + (size_t)rb * D : ctx + (size_t)(rb - NTOK) * D) + 4 * (lane + 64 * i))); }
    int kcur = -1; f32x4 mg[4], ms[4];
#pragma unroll 1
    for (int row = row1; row < NROWS; row += stride1) {
        const int key = row < NTOK ? (row >> 13) : NB;
        if (key != kcur) { kcur = key; const float* sh = key < NB ? mod + key * 6144 : modc; const float* scl = sh + 1024;
#pragma unroll
            for (int i = 0; i < 4; ++i) { ms[i] = *(const f32x4*)(sh + 4 * (lane + 64 * i)); mg[i] = *(const f32x4*)(g1 + 4 * (lane + 64 * i)) * (*(const f32x4*)(scl + 4 * (lane + 64 * i)) + 1.0f); } }
        f32x4 v[4]; float ss = 0.f;
        const int rn = row + 2 * stride1 < NROWS ? row + 2 * stride1 : 0;
        const float* xn = rn < NTOK ? x + (size_t)rn * D : ctx + (size_t)(rn - NTOK) * D;
#pragma unroll
        for (int i = 0; i < 4; ++i) { v[i] = q0[i]; q0[i] = q1[i]; q1[i] = __builtin_nontemporal_load((const f32x4*)(xn + 4 * (lane + 64 * i))); ss += v[i].x * v[i].x + v[i].y * v[i].y + v[i].z * v[i].z + v[i].w * v[i].w; }
        ss = wave_sum(ss);
        const float r = rsqrtf(ss * (1.0f / D) + 1e-6f);
#pragma unroll
        for (int i = 0; i < 4; ++i) {
            const f32x4 o = (v[i] * r) * mg[i] + ms[i];
            u32x2 w; w.x = pk2(o.x, o.y); w.y = pk2(o.z, o.w);
            *(u32x2*)(U + (size_t)row * D + 4 * (lane + 64 * i)) = w;
        }
    }
}

__device__ __forceinline__ void conv_units(LAS unsigned char* lds, const Args& a, int ubeg, int ustride, const int TID, const int BID, const int GD) {
    const int tid = TID, lane = tid & 63, wave = tid >> 6;
    const float* cw = a.in[10]; const float* cb = a.in[11]; const float* lg = a.in[12]; const float* lb = a.in[13];
    const bf16_t* xglu = (const bf16_t*)(a.ws + WS_XGP); bf16_t* mix = (bf16_t*)(a.ws + WS_MIX);
    LAS float* wts = (LAS float*)lds;
    for (int i = tid; i < 31 * 512; i += NTHREADS) { const int k = i >> 9, ch = i & 511; wts[((k * 2 + ((ch >> 2) & 1)) * 64 + (ch >> 3)) * 4 + (ch & 3)] = cw[i]; }
    __syncthreads();
    const int ch0 = 8 * lane;
    const bool rowc = lane < 32;
    for (int unit0 = ubeg; unit0 < NB * 128; unit0 += ustride) {
        const int unit = (GD == 256) ? ((unit0 & 7) >> 1) * 128 + (unit0 & 1) * 64 + (unit0 >> 8) * 32 + ((unit0 & 255) >> 3) : unit0;
        const int b = unit >> 7, r = unit & 127;
        const bf16_t* xb = xglu + ((size_t)((b * PGR + r + 15) * PGC + 15)) * 512 + ch0;
        const long tstride = rowc ? 512 : (long)PGC * 512;
#pragma unroll 1
        for (int p = 0; p < 4; ++p) {
            const int c = p * 16 + 2 * wave;
            float acc[2][8];
#pragma unroll
            for (int j = 0; j < 8; ++j) { const float bj_ = cb[ch0 + j]; acc[0][j] = bj_; acc[1][j] = bj_; }
            u32x4 xv[2][2][8];
            const bf16_t* tp = xb + (long)c * 512 - 15 * tstride;
#define CONV_LOADS(buf, kb) do { _Pragma("unroll") for (int kk = 0; kk < 8; ++kk) { if ((kb) + kk < 31) { \
                xv[buf][0][kk] = *(const u32x4*)tp; xv[buf][1][kk] = *(const u32x4*)(tp + 512); tp += tstride; } } } while (0)
#define CONV_FMAS(buf, kb) do { _Pragma("unroll") for (int kk = 0; kk < 8; ++kk) { const int k = (kb) + kk; if (k < 31) { \
                const f32x4 w0 = *(const LAS f32x4*)(wts + ((k * 2 + 0) * 64 + lane) * 4), w1 = *(const LAS f32x4*)(wts + ((k * 2 + 1) * 64 + lane) * 4); \
                _Pragma("unroll") for (int tt = 0; tt < 2; ++tt) { const u32x4 x4 = xv[buf][tt][kk]; \
                    fma_mix_lo(acc[tt][0], w0.x, x4.x); fma_mix_hi(acc[tt][1], w0.y, x4.x); fma_mix_lo(acc[tt][2], w0.z, x4.y); fma_mix_hi(acc[tt][3], w0.w, x4.y); \
                    fma_mix_lo(acc[tt][4], w1.x, x4.z); fma_mix_hi(acc[tt][5], w1.y, x4.z); fma_mix_lo(acc[tt][6], w1.z, x4.w); fma_mix_hi(acc[tt][7], w1.w, x4.w); } } } } while (0)
            CONV_LOADS(0, 0);
            CONV_LOADS(1, 8);  CONV_FMAS(0, 0);
            CONV_LOADS(0, 16); CONV_FMAS(1, 8);
            CONV_LOADS(1, 24); CONV_FMAS(0, 16);
            f32x4 lgv[2], lbv[2];
#pragma unroll
            for (int hh = 0; hh < 2; ++hh) { lgv[hh] = *(const f32x4*)(lg + ch0 + 4 * hh); lbv[hh] = *(const f32x4*)(lb + ch0 + 4 * hh); }
            CONV_FMAS(1, 24);
#undef CONV_LOADS
#undef CONV_FMAS
#pragma unroll
            for (int tt = 0; tt < 2; ++tt) {
                float s = 0.f;
#pragma unroll
                for (int j = 0; j < 8; ++j) s += acc[tt][j];
                const float mean = wave_sum(s) * (1.0f / 512.0f);
                float q = 0.f;
#pragma unroll
                for (int j = 0; j < 8; ++j) { acc[tt][j] -= mean; q += acc[tt][j] * acc[tt][j]; }
                const float rstd = rsqrtf(wave_sum(q) * (1.0f / 512.0f) + 1e-5f);
                float o[8];
#pragma unroll
                for (int j = 0; j < 8; ++j) { const float y = acc[tt][j] * rstd * lgv[j >> 2][j & 3] + lbv[j >> 2][j & 3]; o[j] = silu_f(y); }
                u32x4 w; w.x = pk2(o[0], o[1]); w.y = pk2(o[2], o[3]); w.z = pk2(o[4], o[5]); w.w = pk2(o[6], o[7]);
                *(u32x4*)(mix + (size_t)(b * SEQ + r * 64 + c + tt) * D + ch0) = w;
            }
        }
    }
    __syncthreads();
}

constexpr int L_XT = 0;
constexpr int L_XC = 9216;
constexpr int L_A = L_XC + 2 * 17408;
constexpr int L_U = L_A + 2 * 16384;
constexpr int L_SUB = L_U + 2 * 16384;
constexpr int L_PRE = L_SUB + 8192;
constexpr int L_CIN = L_PRE + 4096;
static_assert(L_CIN + 2 * 17 * 64 * 4 <= 131072, "lru lds");

__device__ __forceinline__ int lru_seq(int d, int i) { return d == 0 ? i : (i < 4 ? 3 - i : NQ - 1 - (i - 4)); }
__device__ __forceinline__ u32x4 lru_load_xt(const bf16_t* xlx, int b, int h, int q, int i) {
    int rowbase, L, chunk;
    if (q < 4) { rowbase = NTOK + b * CTXL; L = CTXL; chunk = q; } else { rowbase = b * SEQ; L = SEQ; chunk = q - 4; }
    const int rr = i >> 3, seg = i & 7, t = chunk * 64 - 3 + rr;
    u32x4 v = (u32x4){0u, 0u, 0u, 0u};
    if (t >= 0 && t < L) v = __builtin_nontemporal_load((const u32x4*)(xlx + (size_t)(rowbase + t) * 512 + 64 * h + 8 * seg));
    return v;
}
template <int MODE>
__device__ __forceinline__ void lru_phase(LAS unsigned char* lds, const Args& a, const int TID, const int BID, const int GD) {
    const int tid = TID, lane = tid & 63, wave = tid >> 6;
    const float* wa = a.in[16]; const float* wi = a.in[18];
    const bf16_t* xlx = (const bf16_t*)(a.ws + WS_XLX); const bf16_t* glg = (const bf16_t*)(a.ws + WS_GLG); bf16_t* mix = (bf16_t*)(a.ws + WS_MIX);
    f32x2* carry = (f32x2*)(a.ws + WS_CARRY); unsigned* au = (unsigned*)(a.ws + WS_AU);
    const float* conv_w = a.in[14]; const float* conv_b = a.in[15]; const float* ba = a.in[17]; const float* bi = a.in[19]; const float* lam = a.in[20];
    LAS bf16_t* XT = (LAS bf16_t*)(lds + L_XT); LAS float* XC = (LAS float*)(lds + L_XC); LAS float* Aa = (LAS float*)(lds + L_A); LAS float* Uu = (LAS float*)(lds + L_U);
    LAS f32x2* SUB = (LAS f32x2*)(lds + L_SUB); LAS float* PRE = (LAS float*)(lds + L_PRE); LAS float* CIN = (LAS float*)(lds + L_CIN);
    const int l15 = lane & 15, l4 = lane >> 4;
    for (int vb = BID; vb < 256; vb += GD) {
        const int bh = vb >> 3, grp = vb & 7, b = bh >> 3, h = bh & 7;
        int q0, nq;
        if (MODE == 1) { q0 = grp * 17; nq = (NQ - q0) < 17 ? (NQ - q0) : 17; } else { q0 = 4 + grp * 16; nq = 16; }
        const int wd = wave >> 2, mtp = (wave >> 1) & 1, ntp = wave & 1;
        bf16x8 wf[2][2][2];
#pragma unroll
        for (int nn = 0; nn < 2; ++nn)
#pragma unroll
            for (int g = 0; g < 2; ++g)
#pragma unroll
                for (int ks = 0; ks < 2; ++ks) { const float* wp = (g ? wi : wa) + (size_t)((wd * 8 + h) * 64 + 32 * ks + 8 * l4) * 64 + 16 * (ntp * 2 + nn) + l15;
                    u32x4 w; w.x = pk2(wp[0], wp[64]); w.y = pk2(wp[128], wp[192]); w.z = pk2(wp[256], wp[320]); w.w = pk2(wp[384], wp[448]); wf[nn][g][ks] = __builtin_bit_cast(bf16x8, w); }
        float cw[2][4], cbv[2];
        { const int gc = 64 * h + (tid & 63);
#pragma unroll
            for (int d = 0; d < 2; ++d) { cbv[d] = conv_b[d * 512 + gc];
#pragma unroll
                for (int k = 0; k < 4; ++k) cw[d][k] = conv_w[(d * 4 + k) * 512 + gc]; } }
        float bav[2], biv[2], spv[2];
#pragma unroll
        for (int nn = 0; nn < 2; ++nn) { const int gc = 64 * h + 16 * (ntp * 2 + nn) + l15;
            bav[nn] = ba[wd * 512 + gc]; biv[nn] = bi[wd * 512 + gc]; spv[nn] = log1pf(__expf(-lam[wd * 512 + gc])); }
        if (MODE == 2 && tid < 128) {
            const int d = tid >> 6, ch = tid & 63;
            const f32x2* cp = carry + (size_t)((d * NB + b) * NQ) * 512 + 64 * h + ch;
            const int cnt = d == 0 ? q0 : (NQ + 4 - (q0 + nq));
            float s = 0.f;
            for (int i0 = 0; i0 < cnt; i0 += 8) {
                f32x2 c[8];
#pragma unroll
                for (int j = 0; j < 8; ++j) { const int ii = (i0 + j) < cnt ? (i0 + j) : (cnt - 1); c[j] = cp[(size_t)lru_seq(d, ii) * 512]; }
#pragma unroll
                for (int j = 0; j < 8; ++j) if (i0 + j < cnt) s = c[j].x * s + c[j].y;
            }
            f32x2 c[16];
#pragma unroll
            for (int j = 0; j < 16; ++j) c[j] = cp[(size_t)(q0 + j) * 512];
            if (d == 0) {
#pragma unroll
                for (int j = 0; j < 16; ++j) { CIN[(0 * 17 + j) * 64 + ch] = s; s = c[j].x * s + c[j].y; }
            } else {
#pragma unroll
                for (int j = 15; j >= 0; --j) { CIN[(1 * 17 + j) * 64 + ch] = s; s = c[j].x * s + c[j].y; }
            }
        }
        if (MODE == 1 && q0 < 4) {
            if (tid == 0) { unsigned* fl = (unsigned*)(a.ws + WS_CTXFLAG) + 64 * (b * 2 + (h >> 2)); unsigned sp = 0;
                while (__hip_atomic_load(fl, __ATOMIC_RELAXED, __HIP_MEMORY_SCOPE_AGENT) == 0u && ++sp < (1u << 22)) __builtin_amdgcn_s_sleep(2);
                __builtin_amdgcn_fence(__ATOMIC_ACQUIRE, "agent"); asm volatile("s_waitcnt vmcnt(0)" ::: "memory"); }
            __syncthreads();
        }
        u32x4 xr0 = lru_load_xt(xlx, b, h, q0, tid), xr1 = (u32x4){0u, 0u, 0u, 0u};
        if (tid < 48) xr1 = lru_load_xt(xlx, b, h, q0, tid + 512);
#pragma unroll 1
        for (int jc = 0; jc < nq; ++jc) {
            const int q = q0 + jc;
            const size_t rowbase0 = (q < 4) ? (size_t)(NTOK + b * CTXL + q * 64) : (size_t)(b * SEQ + (q - 4) * 64);
            *(LAS u32x4*)(XT + tid * 8) = xr0;
            if (tid < 48) *(LAS u32x4*)(XT + (tid + 512) * 8) = xr1;
            __syncthreads();
            if (jc + 1 < nq) { xr0 = lru_load_xt(xlx, b, h, q + 1, tid); if (tid < 48) xr1 = lru_load_xt(xlx, b, h, q + 1, tid + 512); }
            u32x4 gl = (u32x4){0u, 0u, 0u, 0u};
            if (MODE == 2) gl = *(const u32x4*)(glg + (rowbase0 + (tid >> 3)) * 512 + 64 * h + (tid & 7) * 8);
            { const int ch = tid & 63, tb = tid >> 6;
#pragma unroll
                for (int i = 0; i < 8; ++i) { const int t = tb + 8 * i;
                    const float x0 = bf_lo(XT[(t + 0) * 64 + ch]), x1 = bf_lo(XT[(t + 1) * 64 + ch]), x2 = bf_lo(XT[(t + 2) * 64 + ch]), x3 = bf_lo(XT[(t + 3) * 64 + ch]), x4 = bf_lo(XT[(t + 4) * 64 + ch]), x5 = bf_lo(XT[(t + 5) * 64 + ch]), x6 = bf_lo(XT[(t + 6) * 64 + ch]);
                    XC[t * 68 + ch] = cbv[0] + cw[0][0] * x0 + cw[0][1] * x1 + cw[0][2] * x2 + cw[0][3] * x3;
                    XC[64 * 68 + t * 68 + ch] = cbv[1] + cw[1][3] * x3 + cw[1][2] * x4 + cw[1][1] * x5 + cw[1][0] * x6; } }
            __syncthreads();
#pragma unroll
            for (int mm = 0; mm < 2; ++mm) {
                const int mtl = 2 * mtp + mm;
                bf16x8 af[2];
#pragma unroll
                for (int ks = 0; ks < 2; ++ks) { const LAS float* p = XC + wd * (64 * 68) + (16 * mtl + l15) * 68 + 32 * ks + 8 * l4; const f32x4 p0 = *(const LAS f32x4*)p, p1 = *(const LAS f32x4*)(p + 4);
                    u32x4 w; w.x = pk2(p0.x, p0.y); w.y = pk2(p0.z, p0.w); w.z = pk2(p1.x, p1.y); w.w = pk2(p1.z, p1.w); af[ks] = __builtin_bit_cast(bf16x8, w); }
#pragma unroll
                for (int nn = 0; nn < 2; ++nn) { const int n = 16 * (ntp * 2 + nn) + l15;
                    f32x4 accR = (f32x4){0.f, 0.f, 0.f, 0.f}, accI = (f32x4){0.f, 0.f, 0.f, 0.f};
#pragma unroll
                    for (int ks = 0; ks < 2; ++ks) {
                        accR = __builtin_amdgcn_mfma_f32_16x16x32_bf16(af[ks], wf[nn][0][ks], accR, 0, 0, 0);
                        accI = __builtin_amdgcn_mfma_f32_16x16x32_bf16(af[ks], wf[nn][1][ks], accI, 0, 0, 0);
                    }
#pragma unroll
                    for (int rg = 0; rg < 4; rg += 2) { const int t = 16 * mtl + 4 * l4 + rg;
                        const f32x2 zr = (f32x2){accR[rg], accR[rg + 1]} + bav[nn], zi = (f32x2){accI[rg], accI[rg + 1]} + biv[nn];
                        const f32x2 tr = zr * (-1.4426950408889634f), ti = zi * (-1.4426950408889634f);
                        f32x2 er, ei; er.x = __builtin_amdgcn_exp2f(tr.x); er.y = __builtin_amdgcn_exp2f(tr.y); ei.x = __builtin_amdgcn_exp2f(ti.x); ei.y = __builtin_amdgcn_exp2f(ti.y);
                        const f32x2 dr = er + 1.0f, di = ei + 1.0f;
                        f32x2 rr, ii; rr.x = __builtin_amdgcn_rcpf(dr.x); rr.y = __builtin_amdgcn_rcpf(dr.y); ii.x = __builtin_amdgcn_rcpf(di.x); ii.y = __builtin_amdgcn_rcpf(di.y);
                        const f32x2 la = rr * (-8.0f * spv[nn]);
                        f32x2 oma = -la * (1.0f + 0.5f * la * (1.0f + 0.33333334f * la * (1.0f + 0.25f * la * (1.0f + 0.2f * la))));
                        if (__any(la.x < -0.25f || la.y < -0.25f)) {
                            oma.x = la.x < -0.25f ? 1.0f - __expf(la.x) : oma.x; oma.y = la.y < -0.25f ? 1.0f - __expf(la.y) : oma.y; }
                        const f32x2 om2 = oma * (2.0f - oma);
                        f32x2 mult; mult.x = __builtin_amdgcn_sqrtf(om2.x); mult.y = __builtin_amdgcn_sqrtf(om2.y);
                        const f32x2 xc2 = (f32x2){XC[wd * (64 * 68) + t * 68 + n], XC[wd * (64 * 68) + (t + 1) * 68 + n]};
                        const f32x2 uu = mult * ii * xc2;
                        Aa[wd * 4096 + t * 64 + n] = oma.x; Aa[wd * 4096 + (t + 1) * 64 + n] = oma.y; Uu[wd * 4096 + t * 64 + n] = uu.x; Uu[wd * 4096 + (t + 1) * 64 + n] = uu.y; }
                }
            }
            __syncthreads();
            if (MODE == 1 && q >= 4) {
                const int t = tid >> 3, c8 = (tid & 7) * 8;
#pragma unroll
                for (int d = 0; d < 2; ++d) {
                    const LAS float* ap = Aa + d * 4096 + t * 64 + c8; const LAS float* up = Uu + d * 4096 + t * 64 + c8;
                    const f32x4 a0 = *(const LAS f32x4*)ap, a1 = *(const LAS f32x4*)(ap + 4), u0 = *(const LAS f32x4*)up, u1 = *(const LAS f32x4*)(up + 4);
                    u32x4 w0, w1; w0.x = pk2h(a0.x, u0.x); w0.y = pk2h(a0.y, u0.y); w0.z = pk2h(a0.z, u0.z); w0.w = pk2h(a0.w, u0.w); w1.x = pk2h(a1.x, u1.x); w1.y = pk2h(a1.y, u1.y); w1.z = pk2h(a1.z, u1.z); w1.w = pk2h(a1.w, u1.w);
                    unsigned* dst = au + ((size_t)d * NTOK + rowbase0 + t) * 512 + 64 * h + c8;
                    *(u32x4*)dst = w0; *(u32x4*)(dst + 4) = w1; }
            }
            { float A0 = 1.f, h0 = 0.f, A1 = 1.f, h1 = 0.f;
#pragma unroll
                for (int s2 = 0; s2 < 8; ++s2) { const int p = 8 * wave + s2, t0 = p, t1 = 63 - p;
                    const float a0 = 1.0f - Aa[t0 * 64 + lane], u0 = Uu[t0 * 64 + lane], a1 = 1.0f - Aa[4096 + t1 * 64 + lane], u1 = Uu[4096 + t1 * 64 + lane];
                    h0 = a0 * h0 + u0; A0 *= a0; h1 = a1 * h1 + u1; A1 *= a1; }
                SUB[wave * 64 + lane] = (f32x2){A0, h0}; SUB[512 + wave * 64 + lane] = (f32x2){A1, h1}; }
            __syncthreads();
            if (MODE == 1) {
                if (tid < 128) { const int d = tid >> 6, ch = tid & 63; float Ac = 1.f, hc = 0.f;
#pragma unroll
                    for (int s2 = 0; s2 < 8; ++s2) { const f32x2 c = SUB[d * 512 + s2 * 64 + ch]; hc = c.x * hc + c.y; Ac *= c.x; }
                    carry[(size_t)((d * NB + b) * NQ + q) * 512 + 64 * h + ch] = (f32x2){Ac, hc}; }
            } else {
                if (tid < 128) { const int d = tid >> 6, ch = tid & 63; float s2 = CIN[(d * 17 + jc) * 64 + ch];
#pragma unroll
                    for (int sb = 0; sb < 8; ++sb) { PRE[d * 512 + sb * 64 + ch] = s2; const f32x2 c = SUB[d * 512 + sb * 64 + ch]; s2 = c.x * s2 + c.y; } }
                __syncthreads();
                { float h0 = PRE[wave * 64 + lane], h1 = PRE[512 + wave * 64 + lane];
#pragma unroll
                    for (int s2 = 0; s2 < 8; ++s2) { const int p = 8 * wave + s2, t0 = p, t1 = 63 - p;
                        h0 = (1.0f - Aa[t0 * 64 + lane]) * h0 + Uu[t0 * 64 + lane]; Uu[t0 * 64 + lane] = h0;
                        h1 = (1.0f - Aa[4096 + t1 * 64 + lane]) * h1 + Uu[4096 + t1 * 64 + lane]; Uu[4096 + t1 * 64 + lane] = h1; } }
                __syncthreads();
                { const int t = tid >> 3, c8 = (tid & 7) * 8;
                    const LAS float* u1 = Uu + t * 64 + c8; const LAS float* u2 = Uu + 4096 + t * 64 + c8;
                    const f32x4 f0 = *(const LAS f32x4*)u1, f1 = *(const LAS f32x4*)(u1 + 4), b0 = *(const LAS f32x4*)u2, b1 = *(const LAS f32x4*)(u2 + 4);
                    u32x4 w;
                    w.x = pk2((f0.x + b0.x) * bf_lo(gl.x), (f0.y + b0.y) * bf_hi(gl.x)); w.y = pk2((f0.z + b0.z) * bf_lo(gl.y), (f0.w + b0.w) * bf_hi(gl.y));
                    w.z = pk2((f1.x + b1.x) * bf_lo(gl.z), (f1.y + b1.y) * bf_hi(gl.z)); w.w = pk2((f1.z + b1.z) * bf_lo(gl.w), (f1.w + b1.w) * bf_hi(gl.w));
                    *(u32x4*)(mix + (rowbase0 + t) * D + 512 + 64 * h + c8) = w; }
            }
        }
        if (MODE == 1) wg_publish((unsigned*)(a.ws + WS_BHCNT) + 64 * bh, tid);
        __syncthreads();
    }
}

__device__ __forceinline__ void lru_rescan(LAS unsigned char* lds, const Args& a, const int TID, const int BID, const int GD) {
    const int tid = TID, lane = tid & 63, wave = tid >> 6;
    const unsigned* au = (const unsigned*)(a.ws + WS_AU); const bf16_t* glg = (const bf16_t*)(a.ws + WS_GLG); bf16_t* mix = (bf16_t*)(a.ws + WS_MIX);
    const f32x2* carry = (const f32x2*)(a.ws + WS_CARRY);
    LAS f32x2* SUB = (LAS f32x2*)(lds + L_SUB); LAS float* PRE = (LAS float*)(lds + L_PRE); LAS float* CIN = (LAS float*)(lds + L_CIN);
    for (int vb = BID; vb < 256; vb += GD) {
        const int bh = vb >> 3, grp = vb & 7, b = bh >> 3, h = bh & 7;
        const int q0 = 4 + grp * 16, nq = 16;
        wg_wait((unsigned*)(a.ws + WS_BHCNT) + 64 * bh, 8u * (unsigned)(1 + ((a.dbg >> 11) & 1)), tid);
        if (tid < 128) {
            const int d = tid >> 6, ch = tid & 63;
            const f32x2* cp = carry + (size_t)((d * NB + b) * NQ) * 512 + 64 * h + ch;
            const int cnt = d == 0 ? q0 : (NQ + 4 - (q0 + nq));
            float s = 0.f;
            for (int i0 = 0; i0 < cnt; i0 += 8) {
                f32x2 c[8];
#pragma unroll
                for (int j = 0; j < 8; ++j) { const int ii = (i0 + j) < cnt ? (i0 + j) : (cnt - 1); c[j] = cp[(size_t)lru_seq(d, ii) * 512]; }
#pragma unroll
                for (int j = 0; j < 8; ++j) if (i0 + j < cnt) s = c[j].x * s + c[j].y;
            }
            f32x2 c[16];
#pragma unroll
            for (int j = 0; j < 16; ++j) c[j] = cp[(size_t)(q0 + j) * 512];
            if (d == 0) {
#pragma unroll
                for (int j = 0; j < 16; ++j) { CIN[(0 * 17 + j) * 64 + ch] = s; s = c[j].x * s + c[j].y; }
            } else {
#pragma unroll
                for (int j = 15; j >= 0; --j) { CIN[(1 * 17 + j) * 64 + ch] = s; s = c[j].x * s + c[j].y; }
            }
        }
        __syncthreads();
        const size_t cbase = (size_t)64 * h + lane;
        unsigned pfn[8], pbn[8]; bf16_t ggn[8];
        { const size_t rown = (size_t)b * SEQ + (size_t)(q0 - 4) * 64 + 8 * wave;
#pragma unroll
            for (int s2 = 0; s2 < 8; ++s2) { pfn[s2] = __builtin_nontemporal_load(au + (rown + s2) * 512 + cbase); pbn[s2] = __builtin_nontemporal_load(au + ((size_t)NTOK + rown + s2) * 512 + cbase); ggn[s2] = __builtin_nontemporal_load(glg + (rown + s2) * 512 + cbase); } }
#pragma unroll 1
        for (int jc = 0; jc < nq; ++jc) {
            const size_t row0 = (size_t)b * SEQ + (size_t)(q0 - 4 + jc) * 64 + 8 * wave;
            unsigned pf[8], pb[8]; bf16_t gg[8];
#pragma unroll
            for (int s2 = 0; s2 < 8; ++s2) { pf[s2] = pfn[s2]; pb[s2] = pbn[s2]; gg[s2] = ggn[s2]; }
            if (jc + 1 < nq) { const size_t rown = row0 + 64;
#pragma unroll
                for (int s2 = 0; s2 < 8; ++s2) { pfn[s2] = __builtin_nontemporal_load(au + (rown + s2) * 512 + cbase); pbn[s2] = __builtin_nontemporal_load(au + ((size_t)NTOK + rown + s2) * 512 + cbase); ggn[s2] = __builtin_nontemporal_load(glg + (rown + s2) * 512 + cbase); } }
            float af[8], uf[8], ab[8], ub[8];
#pragma unroll
            for (int s2 = 0; s2 < 8; ++s2) { const h2_t x = __builtin_bit_cast(h2_t, pf[s2]), y = __builtin_bit_cast(h2_t, pb[s2]);
                af[s2] = 1.0f - (float)x.x; uf[s2] = (float)x.y; ab[s2] = 1.0f - (float)y.x; ub[s2] = (float)y.y; }
            float A0 = 1.f, h0 = 0.f, A1 = 1.f, h1 = 0.f;
#pragma unroll
            for (int s2 = 0; s2 < 8; ++s2) { h0 = af[s2] * h0 + uf[s2]; A0 *= af[s2]; h1 = ab[7 - s2] * h1 + ub[7 - s2]; A1 *= ab[7 - s2]; }
            SUB[wave * 64 + lane] = (f32x2){A0, h0}; SUB[512 + (7 - wave) * 64 + lane] = (f32x2){A1, h1};
            __syncthreads();
            if (tid < 128) { const int d = tid >> 6, ch = tid & 63; float s2 = CIN[(d * 17 + jc) * 64 + ch];
#pragma unroll
                for (int sb = 0; sb < 8; ++sb) { PRE[d * 512 + sb * 64 + ch] = s2; const f32x2 c = SUB[d * 512 + sb * 64 + ch]; s2 = c.x * s2 + c.y; } }
            __syncthreads();
            float hf[8], hb[8];
            { float hc = PRE[wave * 64 + lane];
#pragma unroll
                for (int s2 = 0; s2 < 8; ++s2) { hc = af[s2] * hc + uf[s2]; hf[s2] = hc; }
                hc = PRE[512 + (7 - wave) * 64 + lane];
#pragma unroll
                for (int s2 = 7; s2 >= 0; --s2) { hc = ab[s2] * hc + ub[s2]; hb[s2] = hc; } }
#pragma unroll
            for (int s2 = 0; s2 < 8; ++s2) mix[(row0 + s2) * D + 512 + cbase] = (bf16_t)f2bf((hf[s2] + hb[s2]) * bf_lo(gg[s2]));
        }
        __syncthreads();
    }
}

__device__ __forceinline__ void phase6(LAS unsigned char* lds, const Args& a, const int TID, const int BID, const int GD) {
    const int tid = TID, lane = tid & 63, wave = tid >> 6, G = GD;
    const float* g2 = a.in[5]; const float* rw = a.in[23];
    const float* mod = (const float*)(a.ws + WS_MOD);
    unsigned char* V = a.ws + WS_V; float* affT = (float*)(a.ws + WS_AFFT); const bf16_t* X1b = (const bf16_t*)(a.ws + WS_X1B);
    LAS float* rwT = (LAS float*)lds;
    for (int idx = tid; idx < 16384; idx += NTHREADS) rwT[(idx & 15) * 1024 + (idx >> 4)] = rw[idx];
    __syncthreads();
    const int stride6 = G * NWAVES, row6 = BID * NWAVES + wave;
    u32x2 mn[4];
#pragma unroll
    for (int i = 0; i < 4; ++i) { const int rl = row6 < NTOK ? row6 : 0; mn[i] = __builtin_nontemporal_load((const u32x2*)(X1b + (size_t)rl * D + 4 * (lane + 64 * i))); }
    int bcur = -1; f32x4 mg[4], ms[4];
#pragma unroll 1
    for (int row = row6; row < NTOK; row += stride6) {
        const int b = row >> 13, t = row & (SEQ - 1);
        if (b != bcur) { bcur = b; const float* sh = mod + b * 6144 + 3072; const float* scl = mod + b * 6144 + 4096;
#pragma unroll
            for (int i = 0; i < 4; ++i) { ms[i] = *(const f32x4*)(sh + 4 * (lane + 64 * i)); mg[i] = *(const f32x4*)(g2 + 4 * (lane + 64 * i)) * (*(const f32x4*)(scl + 4 * (lane + 64 * i)) + 1.0f); } }
        f32x4 v[4]; float ss = 0.f;
#pragma unroll
        for (int i = 0; i < 4; ++i) { const u32x2 mw = mn[i]; v[i] = (f32x4){bf_lo(mw.x), bf_hi(mw.x), bf_lo(mw.y), bf_hi(mw.y)}; }
        if (row + stride6 < NTOK) {
#pragma unroll
            for (int i = 0; i < 4; ++i) mn[i] = __builtin_nontemporal_load((const u32x2*)(X1b + (size_t)(row + stride6) * D + 4 * (lane + 64 * i))); }
#pragma unroll
        for (int i = 0; i < 4; ++i) ss += v[i].x * v[i].x + v[i].y * v[i].y + v[i].z * v[i].z + v[i].w * v[i].w;
        ss = wave_sum(ss);
        const float r = rsqrtf(ss * (1.0f / D) + 1e-6f);
#pragma unroll
        for (int i = 0; i < 4; ++i) {
            v[i] = (v[i] * r) * mg[i] + ms[i];
            *(unsigned*)(V + (size_t)row * D + 4 * (lane + 64 * i)) = pk4_fp8(v[i].x, v[i].y, v[i].z, v[i].w);
        }
        float p[16];
#pragma unroll
        for (int e = 0; e < 16; ++e) p[e] = 0.f;
        {
            f32x2 p2[16];
#pragma unroll
            for (int e = 0; e < 16; ++e) p2[e] = (f32x2){0.f, 0.f};
            f32x4 wq[2][8];
#pragma unroll
            for (int e = 0; e < 8; ++e) wq[0][e] = *(const LAS f32x4*)(rwT + e * 1024 + 4 * lane);
#pragma unroll
            for (int st = 0; st < 8; ++st) {
                if (st + 1 < 8) {
#pragma unroll
                    for (int e = 0; e < 8; ++e) wq[(st + 1) & 1][e] = *(const LAS f32x4*)(rwT + (8 * ((st + 1) & 1) + e) * 1024 + 4 * (lane + 64 * ((st + 1) >> 1)));
                }
                __builtin_amdgcn_sched_barrier(0);
                const int i = st >> 1;
                const f32x2 vlo = (f32x2){v[i].x, v[i].y}, vhi = (f32x2){v[i].z, v[i].w};
#pragma unroll
                for (int e = 0; e < 8; ++e) { const f32x4 w = wq[st & 1][e]; const int ee = 8 * (st & 1) + e; p2[ee] = p2[ee] + vlo * (f32x2){w.x, w.y}; p2[ee] = p2[ee] + vhi * (f32x2){w.z, w.w}; }
                __builtin_amdgcn_sched_barrier(0);
            }
#pragma unroll
            for (int e = 0; e < 16; ++e) p[e] = p2[e].x + p2[e].y;
        }
        const bool b5 = (lane & 32) != 0, b4 = (lane & 16) != 0, b3 = (lane & 8) != 0, b2 = (lane & 4) != 0;
        float q8[8], q4[4], q2[2];
#pragma unroll
        for (int j = 0; j < 8; ++j) { const float send = b5 ? p[j] : p[j + 8], keep = b5 ? p[j + 8] : p[j]; q8[j] = keep + __shfl_xor(send, 32); }
#pragma unroll
        for (int j = 0; j < 4; ++j) { const float send = b4 ? q8[j] : q8[j + 4], keep = b4 ? q8[j + 4] : q8[j]; q4[j] = keep + __shfl_xor(send, 16); }
#pragma unroll
        for (int j = 0; j < 2; ++j) { const float send = b3 ? q4[j] : q4[j + 2], keep = b3 ? q4[j + 2] : q4[j]; q2[j] = keep + __shfl_xor(send, 8); }
        float lgt = (b2 ? q2[1] : q2[0]) + __shfl_xor(b2 ? q2[0] : q2[1], 4);
        lgt += __shfl_xor(lgt, 2); lgt += __shfl_xor(lgt, 1);
        float mx = lgt;
        mx = fmaxf(mx, __shfl_xor(mx, 4)); mx = fmaxf(mx, __shfl_xor(mx, 8)); mx = fmaxf(mx, __shfl_xor(mx, 16)); mx = fmaxf(mx, __shfl_xor(mx, 32));
        const float ex = __expf(lgt - mx);
        float den = ex;
        den += __shfl_xor(den, 4); den += __shfl_xor(den, 8); den += __shfl_xor(den, 16); den += __shfl_xor(den, 32);
        if ((lane & 3) == 0) affT[(size_t)(b * 16 + ((lane >> 2) & 15)) * SEQ + t] = ex / den;
    }
    __syncthreads();
}

__device__ __forceinline__ int block_excl_scan(int v, LAS int* wsum, int tid, int& total) {
    const int lane = tid & 63, wave = tid >> 6;
    int inc = v;
#pragma unroll
    for (int o = 1; o < 64; o <<= 1) { const int t = __shfl_up(inc, o); if (lane >= o) inc += t; }
    __syncthreads();
    if (lane == 63) wsum[wave] = inc;
    __syncthreads();
    int base = 0, tot = 0;
#pragma unroll
    for (int w = 0; w < 8; ++w) { const int s = wsum[w]; if (w < wave) base += s; tot += s; }
    total = tot;
    return base + inc - v;
}
__device__ __forceinline__ void phase7(LAS unsigned char* lds, const Args& a, const int TID, const int BID, const int GD) {
    const int tid = TID, lane = tid & 63, wave = tid >> 6, G = GD;
    const float* affT = (const float*)(a.ws + WS_AFFT);
    int* idxE = (int*)(a.ws + WS_IDXE); float* gateE = (float*)(a.ws + WS_GATEE); int* inv = (int*)(a.ws + WS_INV);
    LAS unsigned* hist = (LAS unsigned*)lds;
    LAS unsigned* selw = hist + 256;
    LAS int* wsum = (LAS int*)(hist + 264);
    for (int unit = BID; unit < NB * NE; unit += G) {
        const int b = unit >> 4, e = unit & 15;
        const float* src = affT + (size_t)unit * SEQ + 16 * tid;
        unsigned key[16];
#pragma unroll
        for (int i = 0; i < 4; ++i) { const f32x4 v = *(const f32x4*)(src + 4 * i); const float f0 = v[0], f1 = v[1], f2 = v[2], f3 = v[3]; key[4 * i + 0] = __float_as_uint(f0); key[4 * i + 1] = __float_as_uint(f1); key[4 * i + 2] = __float_as_uint(f2); key[4 * i + 3] = __float_as_uint(f3); }
        unsigned prefix = 0u, mask = 0u, rem = CAP;
#pragma unroll 1
        for (int pass = 0; pass < 4; ++pass) {
            const int shift = 24 - 8 * pass;
            if (tid < 256) hist[tid] = 0u;
            __syncthreads();
#pragma unroll
            for (int j = 0; j < 16; ++j) if ((key[j] & mask) == prefix) __hip_atomic_fetch_add(&hist[(key[j] >> shift) & 255u], 1u, __ATOMIC_RELAXED, __HIP_MEMORY_SCOPE_WORKGROUP);
            __syncthreads();
            if (wave == 0) {
                const unsigned c0 = hist[4 * lane], c1 = hist[4 * lane + 1], c2 = hist[4 * lane + 2], c3 = hist[4 * lane + 3];
                const unsigned s = c0 + c1 + c2 + c3; unsigned v = s;
#pragma unroll
                for (int o = 1; o < 64; o <<= 1) { const unsigned t = __shfl_down(v, o); if (lane + o < 64) v += t; }
                const unsigned above = v - s;
                if (above < rem && rem <= above + s) {
                    unsigned cum = above, bin, nr;
                    if (cum + c3 >= rem) { bin = 4 * lane + 3; nr = rem - cum; }
                    else { cum += c3; if (cum + c2 >= rem) { bin = 4 * lane + 2; nr = rem - cum; }
                        else { cum += c2; if (cum + c1 >= rem) { bin = 4 * lane + 1; nr = rem - cum; } else { cum += c1; bin = 4 * lane; nr = rem - cum; } } }
                    selw[0] = bin; selw[1] = nr;
                }
            }
            __syncthreads();
            prefix |= selw[0] << shift; mask |= 255u << shift; rem = selw[1];
            __syncthreads();
        }
        const unsigned thr = prefix;
        int ceq = 0;
#pragma unroll
        for (int j = 0; j < 16; ++j) ceq += (key[j] == thr) ? 1 : 0;
        int tot; const int eqbase = block_excl_scan(ceq, wsum, tid, tot);
        unsigned selm = 0u; int er = eqbase, cs = 0;
#pragma unroll
        for (int j = 0; j < 16; ++j) { bool s = key[j] > thr; if (key[j] == thr) { s = (unsigned)er < rem; ++er; } if (s) { selm |= 1u << j; ++cs; } }
        int slot = block_excl_scan(cs, wsum, tid, tot);
#pragma unroll
        for (int j = 0; j < 16; ++j) { const int t = 16 * tid + j; const bool s = (selm >> j) & 1u;
            inv[(size_t)(b * SEQ + t) * 16 + e] = s ? slot : -1;
            if (s) { const int ro = e * ROWS_E + b * CAP + slot; idxE[ro] = b * SEQ + t; gateE[ro] = __uint_as_float(key[j]); ++slot; } }
        __syncthreads();
    }
}


__device__ __forceinline__ void phase10(const Args& a, const int TID, const int BID, const int GD) {
    const int lane = TID & 63, wave = TID >> 6;
    float* xo = a.out; const float* fg = a.in[27];
    const float* mod = (const float*)(a.ws + WS_MOD);
    const bf16_t* X1b = (const bf16_t*)(a.ws + WS_X1B);
    const unsigned char* Y = a.ws + WS_WGUT; const int* inv = (const int*)(a.ws + WS_INV);
    f32x4 gg[4];
#pragma unroll
    for (int i = 0; i < 4; ++i) gg[i] = *(const f32x4*)(fg + 4 * (lane + 64 * i));
    const int row0 = BID * NWAVES + wave, rstride = GD * NWAVES;
    auto issue_y = [&](int row, int slots, unsigned long long& bal, unsigned (&yw)[4][4]) {
        const int b = row >> 13;
        bal = __ballot(lane < 16 && slots >= 0);
        unsigned long long bb = bal;
#pragma unroll
        for (int q = 0; q < 4; ++q) {
            int e = -1; if (bb) { e = (int)__builtin_ctzll(bb); bb &= bb - 1; }
            const int es = e < 0 ? 0 : e; const int sl = __shfl(slots, es);
            const unsigned char* yr = Y + (size_t)(es * ROWS_E + b * CAP + (sl < 0 ? 0 : sl)) * D;
#pragma unroll
            for (int i = 0; i < 4; ++i) { yw[q][i] = 0u; if (e >= 0) yw[q][i] = __builtin_nontemporal_load((const unsigned*)(yr + 4 * (lane + 64 * i))); }
        }
    };
    int sl_cur = (row0 < NTOK) ? inv[(size_t)row0 * 16 + (lane & 15)] : -1;
    int sl_nxt = (row0 + rstride < NTOK) ? inv[(size_t)(row0 + rstride) * 16 + (lane & 15)] : -1;
    u32x2 xnx[4]; unsigned ywn[4][4]; unsigned long long baln = 0ull;
#pragma unroll
    for (int i = 0; i < 4; ++i) xnx[i] = __builtin_nontemporal_load((const u32x2*)(X1b + (size_t)(row0 < NTOK ? row0 : 0) * D + 4 * (lane + 64 * i)));
    issue_y(row0 < NTOK ? row0 : 0, sl_cur, baln, ywn);
    int bcur = -1; f32x4 gq[4];
#pragma unroll 1
    for (int row = row0; row < NTOK; row += rstride) {
        const int b = row >> 13;
        if (b != bcur) { bcur = b; const float* g5 = mod + b * 6144 + 5120;
#pragma unroll
            for (int i = 0; i < 4; ++i) gq[i] = *(const f32x4*)(g5 + 4 * (lane + 64 * i)) * (1.0f / 32.0f); }
        const int slot_cur = sl_cur;
        u32x2 xw[4]; unsigned yw[4][4]; unsigned long long bal = baln;
#pragma unroll
        for (int i = 0; i < 4; ++i) xw[i] = xnx[i];
#pragma unroll
        for (int q = 0; q < 4; ++q)
#pragma unroll
            for (int i = 0; i < 4; ++i) yw[q][i] = ywn[q][i];
        sl_cur = sl_nxt;
        if (row + rstride < NTOK) {
            if (row + 2 * rstride < NTOK) sl_nxt = inv[(size_t)(row + 2 * rstride) * 16 + (lane & 15)];
#pragma unroll
            for (int i = 0; i < 4; ++i) xnx[i] = __builtin_nontemporal_load((const u32x2*)(X1b + (size_t)(row + rstride) * D + 4 * (lane + 64 * i)));
            issue_y(row + rstride, sl_cur, baln, ywn);
        }
        f32x4 mo[4];
#pragma unroll
        for (int i = 0; i < 4; ++i) mo[i] = (f32x4){0.f, 0.f, 0.f, 0.f};
#pragma unroll
        for (int q = 0; q < 4; ++q)
#pragma unroll
            for (int i = 0; i < 4; ++i) { const f32x2 lo = __builtin_amdgcn_cvt_pk_f32_fp8((int)yw[q][i], false), hi = __builtin_amdgcn_cvt_pk_f32_fp8((int)yw[q][i], true);
                mo[i].x += lo.x; mo[i].y += lo.y; mo[i].z += hi.x; mo[i].w += hi.y; }
        { int k4 = 0; while (bal && k4 < 4) { bal &= bal - 1; ++k4; } }
        while (bal) {
            const int e = (int)__builtin_ctzll(bal); bal &= bal - 1;
            const int sl = __shfl(slot_cur, e);
            const unsigned char* yr = Y + (size_t)(e * ROWS_E + b * CAP + (sl < 0 ? 0 : sl)) * D;
#pragma unroll
            for (int i = 0; i < 4; ++i) { const unsigned w = __builtin_nontemporal_load((const unsigned*)(yr + 4 * (lane + 64 * i)));
                const f32x2 lo = __builtin_amdgcn_cvt_pk_f32_fp8((int)w, false), hi = __builtin_amdgcn_cvt_pk_f32_fp8((int)w, true);
                mo[i].x += lo.x; mo[i].y += lo.y; mo[i].z += hi.x; mo[i].w += hi.y; }
        }
        f32x4 v[4]; float ss = 0.f;
#pragma unroll
        for (int i = 0; i < 4; ++i) { const f32x4 g = gq[i];
            v[i] = (f32x4){bf_lo(xw[i].x), bf_hi(xw[i].x), bf_lo(xw[i].y), bf_hi(xw[i].y)};
            v[i] = v[i] + g * mo[i];
            ss += v[i].x * v[i].x + v[i].y * v[i].y + v[i].z * v[i].z + v[i].w * v[i].w; }
        ss = wave_sum(ss);
        const float r = rsqrtf(ss * (1.0f / D) + 1e-6f);
#pragma unroll
        for (int i = 0; i < 4; ++i) *(f32x4*)(xo + (size_t)row * D + 4 * (lane + 64 * i)) = (v[i] * r) * gg[i];
    }
}

#define XB_TMO      128
#define XB_XCNT(j)  (256  + 64 * (j))
#define XB_XSUB(j)  (1280 + 64 * (j))
#define XB_XGEN(j)  (2304 + 64 * (j))
#define XB_TOP      3328
#define XB_TOPGEN   3392
#define XCD_BAR_WORDS 3456
#define XB_SPIN_CAP (1u << 18)
__device__ __forceinline__ unsigned xb_ld(unsigned* p)              { return __hip_atomic_load(p, __ATOMIC_RELAXED, __HIP_MEMORY_SCOPE_AGENT); }
__device__ __forceinline__ unsigned xb_add(unsigned* p, unsigned v) { return __hip_atomic_fetch_add(p, v, __ATOMIC_RELAXED, __HIP_MEMORY_SCOPE_AGENT); }
__device__ __forceinline__ unsigned xb_xcc_id() { return (unsigned)__builtin_amdgcn_s_getreg((3 << 11) | 20) & 0xFu; }
#define XB_SPIN(cond, bar) do { unsigned _sp = 0; while (cond) { __builtin_amdgcn_s_sleep(1); \
    if ((++_sp & 255u) == 0u) { if (xb_ld(&(bar)[XB_TMO])) break; if (_sp > XB_SPIN_CAP) { atomicAdd(&(bar)[XB_TMO], 1u); break; } } } } while (0)
struct XcdBarrier { unsigned* bar; unsigned x; volatile LAS unsigned* st; };

__device__ __forceinline__ int lane_id_opaque() { unsigned m = ~0u; asm volatile("" : "+s"(m)); return (int)__builtin_amdgcn_mbcnt_hi(m, __builtin_amdgcn_mbcnt_lo(m, 0u)); }
__device__ __forceinline__ XcdBarrier xcd_barrier_post(unsigned* bar, volatile LAS unsigned* st, int tid) {
    XcdBarrier b; b.bar = bar; b.x = xb_xcc_id(); b.st = st;
    if (tid == 0) (void)xb_add(&bar[XB_XCNT(b.x)], 1u);
    return b;
}
__device__ __forceinline__ void xcd_barrier_complete(unsigned* bar, unsigned x, unsigned G, unsigned& nloc, unsigned& nx) {
    unsigned sum, cnt, mine, sp = 0u;
    for (;;) {
        sum = 0u; cnt = 0u; mine = 0u;
#pragma unroll
        for (unsigned j = 0; j < 16; ++j) { const unsigned c = xb_ld(&bar[XB_XCNT(j)]); sum += c; cnt += (c > 0u) ? 1u : 0u; mine = (j == x) ? c : mine; }
        if (sum == G) break;
        __builtin_amdgcn_s_sleep(1);
        if ((++sp & 255u) == 0u) { if (xb_ld(&bar[XB_TMO])) break; if (sp > XB_SPIN_CAP) { atomicAdd(&bar[XB_TMO], 1u); break; } }
    }
    nloc = mine > 0u ? mine : 1u; nx = cnt > 0u ? cnt : 1u;
}
__device__ __forceinline__ void xcd_barrier(const XcdBarrier& b, int tid, unsigned G) {
    asm volatile("s_waitcnt vmcnt(0)" ::: "memory");
    __syncthreads();
    if (tid == 0) {
        unsigned* bar = b.bar;
        __builtin_amdgcn_s_waitcnt(0);
        unsigned nloc = b.st[0], nx = b.st[1];
        if (nloc == 0u) { xcd_barrier_complete(bar, b.x, G, nloc, nx); b.st[0] = nloc; b.st[1] = nx; }
        const unsigned old = xb_add(&bar[XB_XSUB(b.x)], 1u);
        const unsigned gen = old / nloc;
        if (old + 1u == (gen + 1u) * nloc) {
            __builtin_amdgcn_fence(__ATOMIC_RELEASE, "agent");
            asm volatile("s_waitcnt vmcnt(0)" ::: "memory");
            const unsigned og = xb_add(&bar[XB_TOP], 1u);
            const unsigned tg = og / nx;
            if (og + 1u == (tg + 1u) * nx) xb_add(&bar[XB_TOPGEN], 1u);
            else XB_SPIN(xb_ld(&bar[XB_TOPGEN]) == tg, bar);
            __builtin_amdgcn_fence(__ATOMIC_ACQUIRE, "agent");
            xb_add(&bar[XB_XGEN(b.x)], 1u);
            asm volatile("s_waitcnt vmcnt(0)" ::: "memory");
        } else {
            XB_SPIN(xb_ld(&bar[XB_XGEN(b.x)]) == gen, bar);
            __builtin_amdgcn_fence(__ATOMIC_ACQUIRE, "agent");
            asm volatile("s_waitcnt vmcnt(0)" ::: "memory");
        }
    }
    __syncthreads();
}
constexpr int BAR_LDS_OFF = LDS_BYTES - 64;
constexpr size_t WS_BAR = WS_CTL + 16384;

typedef const __attribute__((address_space(4))) Args* ArgsP;
#ifndef TS_A
#define TS_A -2
#define TS_B -2
#endif
#if TS_A > -2
constexpr size_t WS_TS = WS_CTL + 61440;
__device__ __forceinline__ void ts_mark(unsigned char* ws, int ph, int wv) {
    __syncthreads();
    asm volatile("" : "+s"(wv));
    if (wv == 0 && lane_id_opaque() == 0) { const unsigned long long t = wall_clock64();
        atomicMax((unsigned long long*)(ws + WS_TS) + ph, t); atomicMax((unsigned long long*)(ws + WS_TS) + 16 + ph, ~t); }
}
__device__ __forceinline__ long long ts_value(unsigned char* ws, int id) {
    const unsigned long long* p = (const unsigned long long*)(ws + WS_TS);
    if (id < 0) return 0;
    const int k = id & 15;
    const unsigned long long ek = __hip_atomic_load(p + k, __ATOMIC_RELAXED, __HIP_MEMORY_SCOPE_AGENT);
    const unsigned long long st0 = ~__hip_atomic_load(p + 16 + 15, __ATOMIC_RELAXED, __HIP_MEMORY_SCOPE_AGENT);
    if (id >= 512) return (long long)(~__hip_atomic_load(p + 16 + (((id - 512) >> 4) & 15), __ATOMIC_RELAXED, __HIP_MEMORY_SCOPE_AGENT) - __hip_atomic_load(p + (id & 15), __ATOMIC_RELAXED, __HIP_MEMORY_SCOPE_AGENT));
    if (id >= 64) return (long long)(__hip_atomic_load(p + (((id - 64) >> 4) & 15), __ATOMIC_RELAXED, __HIP_MEMORY_SCOPE_AGENT) - __hip_atomic_load(p + (id & 15), __ATOMIC_RELAXED, __HIP_MEMORY_SCOPE_AGENT));
    if (id >= 48) return (long long)(~__hip_atomic_load(p + 16 + k, __ATOMIC_RELAXED, __HIP_MEMORY_SCOPE_AGENT) - st0);
    if (id >= 32) return (long long)(ek - st0);
    if (id >= 16) return (long long)(ek - ~__hip_atomic_load(p + 16 + k, __ATOMIC_RELAXED, __HIP_MEMORY_SCOPE_AGENT));
    const unsigned long long prev = k == 0 ? ~__hip_atomic_load(p + 16 + 15, __ATOMIC_RELAXED, __HIP_MEMORY_SCOPE_AGENT) : __hip_atomic_load(p + k - 1, __ATOMIC_RELAXED, __HIP_MEMORY_SCOPE_AGENT);
    return (long long)(ek - prev);
}
#endif
template <int PH>
__device__ __forceinline__ void do_phase(LAS unsigned char* lds, const Args& a_in, const int wave_id_s) {
#if defined(__HIP_DEVICE_COMPILE__)
    ArgsP ap = (ArgsP)__builtin_amdgcn_kernarg_segment_ptr();
    asm volatile("" : "+s"(ap));
    const Args a = *ap;
#else
    const Args a = a_in;
#endif
    const int nrep = 1 + ((a.dbg >> (8 + PH)) & 1);
#pragma unroll 1
    for (int rep = 0; rep < nrep; ++rep) {
        int WID = wave_id_s, BID = blockIdx.x, GD = gridDim.x;
        asm volatile("" : "+s"(WID), "+s"(BID), "+s"(GD));
        const int TID = WID * 64 + lane_id_opaque();
        const int G = GD;
        unsigned char* ws = a.ws;
        if constexpr (PH == 0) { phase0(lds, a, TID, BID, GD);
#if TS_A > -2
            ts_mark(ws, 12, WID);
#endif
            if (rep == nrep - 1) { wg_wait((unsigned*)(ws + WS_ADACNT), 96u * (unsigned)nrep, TID);
#if TS_A > -2
            ts_mark(ws, 11, WID);
#endif
            phase1(a, TID, BID, GD); } }
        else if constexpr (PH == 1) { }
        else if constexpr (PH == 2) {
            if (BID & 1) { convert_items_dyn(lds, a, 1, (CV_TOTAL1 - cv1_early(GD)) / (GD * CV_CHUNK), TID, GD); __syncthreads(); }
            pg8::SchedInProj S{G, BID};
            EpiInProj E{(bf16_t*)(ws + WS_XGP), (bf16_t*)(ws + WS_XLX), (bf16_t*)(ws + WS_GLG), a.in[9]};
            pg8::gemm_phase<EpiInProj, pg8::SchedInProj, false>(lds, (const bf16_t*)(ws + WS_U), (const bf16_t*)(ws + WS_WINT), 1024, S, E, nullptr, TID, BID, GD, 0x7F7F7F7F, pg8::lay_rowmajor(1024));
            __syncthreads(); convert_items_dyn(lds, a, 1, 1 << 30, TID, GD);
        } else if constexpr (PH == 3) {
            {
                pg8::SchedCtx S{BID};
                EpiInProj E{(bf16_t*)(ws + WS_XGP), (bf16_t*)(ws + WS_XLX), (bf16_t*)(ws + WS_GLG), a.in[9]};
                pg8::gemm_phase<EpiInProj, pg8::SchedCtx, false>(lds, (const bf16_t*)(ws + WS_U), (const bf16_t*)(ws + WS_WINT), 1024, S, E, nullptr, TID, BID, GD, 0x7F7F7F7F, pg8::lay_rowmajor(1024));
                if ((BID & 7) == 7 && (BID >> 3) < 8) {
                    asm volatile("s_waitcnt vmcnt(0)" ::: "memory");
                    __syncthreads();
                    if (TID == 0) { __builtin_amdgcn_fence(__ATOMIC_RELEASE, "agent"); asm volatile("s_waitcnt vmcnt(0)" ::: "memory");
                        __hip_atomic_store((unsigned*)(ws + WS_CTXFLAG) + 64 * (BID >> 3), 1u, __ATOMIC_RELAXED, __HIP_MEMORY_SCOPE_AGENT); }
                }
            }
            conv_units(lds, a, BID, G, TID, BID, GD);
#if TS_A > -2
            ts_mark(ws, 13, WID);
#endif
            lru_phase<1>(lds, a, TID, BID, GD);
#if TS_A > -2
            ts_mark(ws, 14, WID);
#endif
            if (rep == nrep - 1) { __syncthreads(); lru_rescan(lds, a, TID, BID, GD); }
        } else if constexpr (PH == 4) {
        } else if constexpr (PH == 5) {
            pg8::Sched S{128, 4, 1, G, BID};
            EpiOutProj E{(bf16_t*)(ws + WS_X1B), a.in[0], (const float*)(ws + WS_MOD), a.in[22]};
            pg8::gemm_phase<EpiOutProj, pg8::Sched, false>(lds, (const bf16_t*)(ws + WS_MIX), (const bf16_t*)(ws + WS_WOUTT), 1024, S, E, nullptr, TID, BID, GD, 0x7F7F7F7F, pg8::lay_rowmajor(1024));
        } else if constexpr (PH == 6) phase6(lds, a, TID, BID, GD);
        else if constexpr (PH == 7) { phase7(lds, a, TID, BID, GD);
            if (G > 64 && BID >= 64) { const int e2 = cv2_early(G); convert_range(lds, a, 2, 0, e2 < CV_TOTAL2 ? e2 : CV_TOTAL2, (BID - 64) * NWAVES + (TID >> 6), (G - 64) * NWAVES, TID >> 6, TID & 63); } }
        else if constexpr (PH == 8) {
            if (BID & 1) { convert_items_dyn(lds, a, 2, (CV_TOTAL2 - cv2_early(GD)) / (GD * CV_CHUNK), TID, GD); __syncthreads(); }
            pg8::Sched S{16, 22, 16, G, BID};
            EpiExpUp E{ws + WS_R1};
            pg8::gemm_phase<EpiExpUp, pg8::Sched, true, true>(lds, (const bf16_t*)(ws + WS_V), (const bf16_t*)(ws + WS_WGUT), 512, S, E, (const int*)(ws + WS_IDXE), TID, BID, GD, 0x7A7A7A7A, pg8::lay_rowmajor(512));
            __syncthreads(); convert_items_dyn(lds, a, 2, 1 << 30, TID, GD);
        } else if constexpr (PH == 9) {
            pg8::SchedDown S{G, BID};
            EpiExpDown E{ws + WS_WGUT, (const float*)(ws + WS_GATEE)};
            pg8::gemm_phase<EpiExpDown, pg8::SchedDown, false, true>(lds, (const bf16_t*)(ws + WS_R1), (const bf16_t*)(ws + WS_WDT), DE / 2, S, E, nullptr, TID, BID, GD, 0x79797979, pg8::lay_blocked(22));
        } else if constexpr (PH == 10) phase10(a, TID, BID, GD);
    }
}
template <int PH, int PH0, int PH1>
__device__ __forceinline__ void run_phases(LAS unsigned char* lds, const Args& a_in, const int wave_id_s) {
    if constexpr (PH < PH1) {
        if constexpr (PH > PH0 && PH != 1 && PH != 4) {
#if defined(__HIP_DEVICE_COMPILE__)
            ArgsP apb = (ArgsP)__builtin_amdgcn_kernarg_segment_ptr(); asm volatile("" : "+s"(apb));
            XcdBarrier xb2; xb2.bar = (unsigned*)(apb->ws + WS_BAR); xb2.x = xb_xcc_id(); xb2.st = (volatile LAS unsigned*)(lds + BAR_LDS_OFF);
            int wv = wave_id_s; asm volatile("" : "+s"(wv));
            xcd_barrier(xb2, wv * 64 + lane_id_opaque(), gridDim.x);
#endif
        }
        do_phase<PH>(lds, a_in, wave_id_s);
#if TS_A > -2 && defined(__HIP_DEVICE_COMPILE__)
        { ArgsP apt = (ArgsP)__builtin_amdgcn_kernarg_segment_ptr(); asm volatile("" : "+s"(apt)); ts_mark(apt->ws, PH, wave_id_s); }
#endif
        run_phases<PH + 1, PH0, PH1>(lds, a_in, wave_id_s);
    }
#if TS_A > -2 && defined(__HIP_DEVICE_COMPILE__)
    else {
        ArgsP apb = (ArgsP)__builtin_amdgcn_kernarg_segment_ptr(); asm volatile("" : "+s"(apb));
        XcdBarrier xb2; xb2.bar = (unsigned*)(apb->ws + WS_BAR); xb2.x = xb_xcc_id(); xb2.st = (volatile LAS unsigned*)(lds + BAR_LDS_OFF);
        int wv = wave_id_s; asm volatile("" : "+s"(wv));
        const int tidp = wv * 64 + lane_id_opaque();
        xcd_barrier(xb2, tidp, gridDim.x);
        if (blockIdx.x == 0 && tidp == 0) {
            const long long va = ts_value(apb->ws, TS_A) / 100, vb = ts_value(apb->ws, TS_B) / 100;
            const long long ticks = 16 * ts_value(apb->ws, TS_A) + 0 * (va + vb);
            const unsigned long long t0 = wall_clock64();
            while ((long long)(wall_clock64() - t0) < ticks) __builtin_amdgcn_s_sleep(8);
        }
    }
#endif
}
template <int PH0, int PH1>
__global__ void __launch_bounds__(NTHREADS, 2) hybrid_fwd(Args a_in) {
    extern __shared__ __attribute__((aligned(16))) unsigned char lds_raw[];
    LAS unsigned char* lds = (LAS unsigned char*)lds_raw;
    const int wave_id_s = __builtin_amdgcn_readfirstlane((int)threadIdx.x >> 6);
    {
        volatile LAS unsigned* st = (volatile LAS unsigned*)(lds + BAR_LDS_OFF);
        if (threadIdx.x == 0) { st[0] = 0u; st[1] = 0u; }
        __syncthreads();
        (void)xcd_barrier_post((unsigned*)(a_in.ws + WS_BAR), st, (int)threadIdx.x);
    }
#if TS_A > -2
    ts_mark(a_in.ws, 15, wave_id_s);
#endif
    run_phases<PH0, PH0, PH1>(lds, a_in, wave_id_s);
}

extern "C" void kernel_launch(void* const* d_in, const int* in_sizes, int n_in, void* d_out, int out_size, void* d_ws, size_t ws_size, hipStream_t stream) {
    if (n_in != 28 || out_size != NTOK * D || ws_size < WS_END) { fprintf(stderr, "kernel_launch: unexpected shapes (n_in %d out %d ws %zu)\n", n_in, out_size, ws_size); return; }
    Args a{};
    for (int i = 0; i < 28; ++i) a.in[i] = (const float*)d_in[i];
    a.out = (float*)d_out; a.ws = (unsigned char*)d_ws; a.dbg = PROBE_MASK; a.pad = 0;
    static int grid = 0;
    if (!grid) {
        (void)hipFuncSetAttribute((const void*)hybrid_fwd<0, 11>, hipFuncAttributeMaxDynamicSharedMemorySize, LDS_BYTES);
        int dev = 0, cus = 0, per_cu = 0;
        (void)hipGetDevice(&dev); (void)hipDeviceGetAttribute(&cus, hipDeviceAttributeMultiprocessorCount, dev);
        (void)hipOccupancyMaxActiveBlocksPerMultiprocessor(&per_cu, (const void*)hybrid_fwd<0, 11>, NTHREADS, LDS_BYTES);
        grid = (per_cu >= 1 ? 1 : 0) * cus;
        if (grid != 256) fprintf(stderr, "kernel_launch: grid %d (cus %d per_cu %d)\n", grid, cus, per_cu);
    }
    if (grid <= 0) return;
    a.ph_lo = 0; a.ph_hi = 11;
    (void)hipMemsetAsync((char*)d_ws + WS_CTL, 0, 65536, stream);
    void* kargs[] = {&a};
    hipError_t e = hipLaunchCooperativeKernel((const void*)hybrid_fwd<0, 11>, dim3(grid), dim3(NTHREADS), kargs, LDS_BYTES, stream);
    if (e != hipSuccess) fprintf(stderr, "cooperative launch failed: %s (grid %d)\n", hipGetErrorString(e), grid);
}
```

```cpp
#include <hip/hip_runtime.h>
#include <hip/hip_cooperative_groups.h>
#include <cstdio>
#include <cstdint>

#define LAS __attribute__((address_space(3)))
typedef unsigned short bf16_t;
typedef short bf16x8 __attribute__((ext_vector_type(8)));
typedef float f32x4 __attribute__((ext_vector_type(4)));
typedef float f32x2 __attribute__((ext_vector_type(2)));
typedef unsigned u32x4 __attribute__((ext_vector_type(4)));
typedef unsigned u32x2 __attribute__((ext_vector_type(2)));
typedef int v4i_t __attribute__((ext_vector_type(4)));
typedef _Float16 h2_t __attribute__((ext_vector_type(2)));
typedef int v8i_t __attribute__((ext_vector_type(8)));

constexpr int D = 1024, NB = 4, SEQ = 8192, NTOK = NB * SEQ, CTXL = 256, NCTX = NB * CTXL, NROWS = NTOK + NCTX;
constexpr int DE = 2816, NE = 16, CAP = 1024, ROWS_E = NB * CAP;
constexpr int NQ = 132;
constexpr int NWAVES = 8, NTHREADS = 512;

constexpr size_t MiB = 1u << 20;
constexpr size_t WS_CTL = 0, CTL_BYTES = 1 * MiB;
constexpr size_t WS_CTXFLAG = WS_CTL + 40960;
constexpr size_t WS_ADACNT = WS_CTL + 45056;
constexpr size_t WS_CVCNT = WS_CTL + 57344;
constexpr size_t WS_BHCNT = WS_CTL + 49152;
constexpr size_t WS_MOD = 1 * MiB;
constexpr size_t WS_CARRY = 2 * MiB;
constexpr size_t WS_AFFT = 7 * MiB;
constexpr size_t WS_IDXE = 9 * MiB;
constexpr size_t WS_GATEE = WS_IDXE + 256 * 1024;
constexpr size_t WS_INV = WS_GATEE + 256 * 1024;
constexpr size_t WS_WINT = 12 * MiB;
constexpr size_t WS_WOUTT = 16 * MiB;
constexpr size_t WS_WGUT = 18 * MiB;
constexpr size_t WS_WDT = 146 * MiB;
constexpr size_t WS_V = 190 * MiB;
constexpr size_t WS_R1 = 222 * MiB;
constexpr size_t WS_U = WS_R1;
constexpr size_t WS_XGLU = WS_R1 + 66 * MiB;
constexpr size_t WS_XLX = WS_R1 + 98 * MiB;
constexpr size_t WS_GLG = WS_R1 + 131 * MiB;
constexpr size_t WS_MIX = WS_R1 + 163 * MiB;
constexpr size_t WS_M = WS_R1 + 227 * MiB;
constexpr size_t WS_X1B = WS_R1 + 291 * MiB;
constexpr size_t WS_AU = WS_R1 + 291 * MiB;
constexpr size_t WS_XGP = 641 * MiB;
constexpr int PGR = 158, PGC = 94;
constexpr size_t WS_END = 700 * MiB;
constexpr int LDS_BYTES = 147456;

__device__ __forceinline__ unsigned f2bf(float f) { unsigned u = __builtin_bit_cast(unsigned, f); return (u + 0x7fffu + ((u >> 16) & 1u)) >> 16; }
typedef __bf16 bf2_t __attribute__((ext_vector_type(2)));
__device__ __forceinline__ unsigned pk2(float lo, float hi) { return __builtin_bit_cast(unsigned, __builtin_convertvector((f32x2){lo, hi}, bf2_t)); }
__device__ __forceinline__ unsigned pk2h(float lo, float hi) { h2_t p; p.x = (_Float16)lo; p.y = (_Float16)hi; return __builtin_bit_cast(unsigned, p); }
__device__ __forceinline__ void fma_mix_lo(float& acc, float w, unsigned xh) { asm("v_fma_mix_f32 %0, %1, %2, %0 op_sel_hi:[0,1,0]" : "+v"(acc) : "v"(w), "v"(xh)); }
__device__ __forceinline__ void fma_mix_hi(float& acc, float w, unsigned xh) { asm("v_fma_mix_f32 %0, %1, %2, %0 op_sel:[0,1,0] op_sel_hi:[0,1,0]" : "+v"(acc) : "v"(w), "v"(xh)); }
__device__ __forceinline__ float bf_lo(unsigned w) { return __builtin_bit_cast(float, w << 16); }
__device__ __forceinline__ float bf_hi(unsigned w) { return __builtin_bit_cast(float, w & 0xffff0000u); }
__device__ __forceinline__ unsigned pk4_fp8(float a, float b, float c, float d) {
    a = __builtin_amdgcn_fmed3f(a, -448.f, 448.f); b = __builtin_amdgcn_fmed3f(b, -448.f, 448.f); c = __builtin_amdgcn_fmed3f(c, -448.f, 448.f); d = __builtin_amdgcn_fmed3f(d, -448.f, 448.f);
    int w = 0; w = __builtin_amdgcn_cvt_pk_fp8_f32(a, b, w, false); w = __builtin_amdgcn_cvt_pk_fp8_f32(c, d, w, true); return (unsigned)w; }
template <int CTRL, int ROWMASK> __device__ __forceinline__ float dpp_add(float v) {
    return v + __int_as_float(__builtin_amdgcn_update_dpp(0, __float_as_int(v), CTRL, ROWMASK, 0xf, false)); }
__device__ __forceinline__ float wave_sum(float v) {
    v = dpp_add<0xb1, 0xf>(v);
    v = dpp_add<0x4e, 0xf>(v);
    v = dpp_add<0x124, 0xf>(v);
    v = dpp_add<0x128, 0xf>(v);
    v = dpp_add<0x142, 0xa>(v);
    v = dpp_add<0x143, 0xc>(v);
    return __int_as_float(__builtin_amdgcn_readlane(__float_as_int(v), 63));
}
__device__ __forceinline__ float wave_max(float v) {
#pragma unroll
    for (int o = 32; o >= 1; o >>= 1) v = fmaxf(v, __shfl_xor(v, o));
    return v;
}
__device__ __forceinline__ float sigm(float x) { return __builtin_amdgcn_rcpf(1.0f + __expf(-x)); }
__device__ __forceinline__ float silu_f(float x) { return x * sigm(x); }
__device__ __forceinline__ float gelu_tanh(float x) { const float z = 0.7978845608028654f * (x + 0.044715f * x * x * x); return x * sigm(2.0f * z); }

namespace pg8 {
constexpr int BM = 256, BK = 64, HALF = 128, HTB = HALF * BK * 2, STAGE_BYTES = 8 * HTB, NXCD = 8, WGM = 8;
__device__ __forceinline__ int lds_byte(int r, int c) { const int st = (r >> 4) * 2 + (c >> 5), rr = r & 15, cc = c & 31, ob = rr * 64 + cc * 2; return st * 1024 + (ob ^ (((ob >> 9) & 1) << 5)); }
__device__ __forceinline__ void stage_rc(int b, int& R, int& C) { const int st = b / 1024, sb = b % 1024, swz = sb ^ (((sb >> 9) & 1) << 5); R = (st >> 1) * 16 + swz / 64; C = (st & 1) * 32 + (swz % 64) / 2; }
__device__ __forceinline__ int perm32(int rho) { const int n = rho >> 4, i = rho & 15; return 8 * (i >> 2) + 4 * n + (i & 3); }
struct Unit { int pm, pn; };
struct Lay { unsigned rowA, rowB; size_t kstepA, kstepB, hstepB, tstepA, tstepB; };
__device__ __forceinline__ Lay lay_rowmajor(int K) { Lay l; l.rowA = l.rowB = (unsigned)K * 2u; l.kstepA = l.kstepB = 128; l.hstepB = (size_t)128 * K * 2; l.tstepA = l.tstepB = (size_t)256 * K * 2; return l; }
__device__ __forceinline__ Lay lay_blocked(int nkt) { Lay l; l.rowA = l.rowB = 128u; l.kstepA = l.kstepB = 32768; l.hstepB = 16384; l.tstepA = l.tstepB = (size_t)nkt * 32768; return l; }

__device__ __forceinline__ void tile_order(int w, int nM, int nN, int& pm, int& pn) {
    const int nwg = nM * nN;
    int wgid = w; { const int q = nwg / NXCD, r = nwg % NXCD, xcd = wgid % NXCD, off = wgid / NXCD; wgid = (xcd < r ? xcd * (q + 1) : r * (q + 1) + (xcd - r) * q) + off; }
    const int nig = WGM * nN, gid = wgid / nig, fm = gid * WGM, gsz = (nM - fm) < WGM ? (nM - fm) : WGM;
    pm = fm + ((wgid % nig) % gsz); pn = (wgid % nig) / gsz;
}
struct Sched {
    int nM, nN, ngroups, G, c;
    __device__ __forceinline__ bool next(int i, Unit& u) const {
        const int per = nM * nN; const long L = (long)i * G + c; if (L >= (long)per * ngroups) return false;
        const int e = (int)(L / per), w = (int)(L % per); int pm, pn; tile_order(w, nM, nN, pm, pn);
        u.pm = e * nM + pm; u.pn = e * nN + pn; return true;
    }
};
struct SchedInProj {
    int G, c;
    __device__ __forceinline__ bool next(int i, Unit& u) const {
        const long L = (long)i * G + c; if (L >= 1024) return false;
        int pm, pn; tile_order((int)L, 128, 8, pm, pn); u.pm = pm; u.pn = pn; return true;
    }
};
struct SchedCtx {
    int c;
    __device__ __forceinline__ bool next(int i, Unit& u) const {
        if (i != 0 || (c & 7) != 7 || (c >> 3) >= 8) return false;
        const int k = c >> 3; u.pm = 128 + (k >> 1); u.pn = 4 + (k & 1); return true;
    }
};
struct SchedDown {
    int G, c;
    __device__ __forceinline__ bool next(int i, Unit& u) const {
        if (G != 256) { const long L = (long)i * G + c; if (L >= 1024) return false; const int e = (int)(L >> 6), w = (int)(L & 63); u.pm = e * 16 + (w >> 2); u.pn = e * 4 + (w & 3); return true; }
        if (i >= 4) return false;
        const int x = c & 7, j = c >> 3, e = 15 - (4 * i + (x >> 1));
        u.pm = e * 16 + 8 * (x & 1) + (j & 7); u.pn = e * 4 + (j >> 3); return true;
    }
};
template <class Epi, class SchedT, bool GATHER, bool FP8 = false, bool SP2 = true, bool ALIGN_EPI = true>
__device__ __forceinline__ void gemm_phase(LAS unsigned char* lds, const bf16_t* Ag, const bf16_t* Btg, const int K, const SchedT& S, const Epi& E, const int* gidx, const int TID, const int BID, const int GD, const int scaleB, const Lay L) {
    const int tid = TID, wid = __builtin_amdgcn_readfirstlane(tid >> 6), lane = tid & 63, wr = wid >> 2, wc = wid & 3, fr = lane & 15, fq = lane >> 4;
    const int nt = K / BK;
    int Rr[2], Cc[2]; unsigned voffB[2];
#pragma unroll
    for (int i = 0; i < 2; ++i) { stage_rc(tid * 16 + i * 8192, Rr[i], Cc[i]); const int Rb = Epi::PERM ? ((Rr[i] & ~31) + perm32(Rr[i] & 31)) : Rr[i]; voffB[i] = (unsigned)Rb * L.rowB + (unsigned)Cc[i] * 2u; }
    const size_t kstepA = L.kstepA, kstepB = L.kstepB, hstep = L.hstepB, tstepA = L.tstepA, tstepB = L.tstepB;
    const unsigned ldsw = (unsigned)wid * 1024u;
    const int aoff = lds_byte(wr * 64 + fr, fq * 8), boff = lds_byte(wc * 32 + fr, fq * 8);
    const int aoff8_0 = aoff, aoff8_1 = aoff + 1024, boff8_0 = boff, boff8_1 = boff + 1024;
#define PG8_SA(b, h) (((b) * 2 + (h)) * HTB)
#define PG8_SB(b, h) ((4 + (b) * 2 + (h)) * HTB)
#define PG8_STAGE(bufoff, gbase, voff) do { _Pragma("unroll") for (int _i = 0; _i < 2; ++_i) \
        __builtin_amdgcn_global_load_lds((const unsigned*)((const char*)(gbase) + (voff)[_i]), (LAS unsigned*)(lds + (bufoff) + ldsw + _i * 8192), 16, 0, 0); } while (0)
#define PG8_LD8(p0, p1) __builtin_shufflevector(*(const LAS v4i_t*)(p0), *(const LAS v4i_t*)(p1), 0, 1, 2, 3, 4, 5, 6, 7)
#define PG8_LDA(dst, b, h) do { _Pragma("unroll") for (int m = 0; m < 4; ++m) { if constexpr (FP8) { \
        dst##8[m] = PG8_LD8(lds + PG8_SA(b, h) + aoff8_0 + m * 2048, lds + PG8_SA(b, h) + aoff8_1 + m * 2048); } else { \
        _Pragma("unroll") for (int k = 0; k < 2; ++k) dst[m][k] = *(const LAS bf16x8*)(lds + PG8_SA(b, h) + aoff + m * 2048 + k * 1024); } } } while (0)
#define PG8_LDB(dst, b, h) do { _Pragma("unroll") for (int n = 0; n < 2; ++n) { if constexpr (FP8) { \
        dst##8[n] = PG8_LD8(lds + PG8_SB(b, h) + boff8_0 + n * 2048, lds + PG8_SB(b, h) + boff8_1 + n * 2048); } else { \
        _Pragma("unroll") for (int k = 0; k < 2; ++k) dst[n][k] = *(const LAS bf16x8*)(lds + PG8_SB(b, h) + boff + n * 2048 + k * 1024); } } } while (0)
#define PG8_MMA(ai, bj, At, Bt) do { if constexpr (FP8) __builtin_amdgcn_sched_barrier(0); __builtin_amdgcn_s_setprio(1); _Pragma("unroll") for (int m = 0; m < 4; ++m) _Pragma("unroll") for (int n = 0; n < 2; ++n) { if constexpr (FP8) { \
        acc[ai][bj][m][n] = __builtin_amdgcn_mfma_scale_f32_16x16x128_f8f6f4(Bt##8[n], At##8[m], acc[ai][bj][m][n], 0, 0, 0, scaleB, 0, 0x7F7F7F7F); } else { \
        _Pragma("unroll") for (int k = 0; k < 2; ++k) acc[ai][bj][m][n] = __builtin_amdgcn_mfma_f32_16x16x32_bf16(Bt[n][k], At[m][k], acc[ai][bj][m][n], 0, 0, 0); } } \
        if constexpr (FP8) { _Pragma("unroll") for (int m = 0; m < 4; ++m) _Pragma("unroll") for (int n = 0; n < 2; ++n) asm volatile("" : "+v"(acc[ai][bj][m][n])); } \
        __builtin_amdgcn_s_setprio(0); if constexpr (FP8) __builtin_amdgcn_sched_barrier(0); } while (0)
#define PG8_WAIT_V(n) asm volatile("s_waitcnt vmcnt(" #n ")" ::: "memory")
#define PG8_WAIT_L(n) asm volatile("s_waitcnt lgkmcnt(" #n ")" ::: "memory")
#define PG8_BAR __builtin_amdgcn_s_barrier()
#define PG8_SCHED __builtin_amdgcn_sched_barrier(0)
#define PG8_LOADV(dst, u) do { _Pragma("unroll") for (int _h = 0; _h < 2; ++_h) _Pragma("unroll") for (int _i = 0; _i < 2; ++_i) \
        dst[_h][_i] = GATHER ? ((unsigned)gidx[(u).pm * BM + _h * HALF + Rr[_i]] * L.rowA + (unsigned)Cc[_i] * 2u) : ((unsigned)(_h * HALF + Rr[_i]) * L.rowA + (unsigned)Cc[_i] * 2u); } while (0)
    Unit cur, nxt; int ui = 0;
    if (!S.next(0, cur)) return;
    f32x4 acc[2][2][4][2];
#pragma unroll
    for (int a = 0; a < 2; ++a)
#pragma unroll
        for (int b = 0; b < 2; ++b)
#pragma unroll
            for (int m = 0; m < 4; ++m)
#pragma unroll
                for (int n = 0; n < 2; ++n) acc[a][b][m][n] = (f32x4){0.f, 0.f, 0.f, 0.f};
    bf16x8 At[4][2], B0[2][2], B1[2][2];
    v8i_t At8[4], B08[2], B18[2];
    unsigned vc[2][2], vn[2][2];
    PG8_LOADV(vc, cur);
    const char* cA = GATHER ? (const char*)Ag : (const char*)Ag + (size_t)cur.pm * tstepA;
    const char* cB = (const char*)Btg + (size_t)cur.pn * tstepB;
    if constexpr (SP2) {
        PG8_STAGE(PG8_SB(0, 0), cB, voffB); PG8_STAGE(PG8_SB(0, 1), cB + hstep, voffB); PG8_STAGE(PG8_SA(0, 0), cA, vc[0]); PG8_STAGE(PG8_SA(0, 1), cA, vc[1]);
        if (wr == 1) PG8_BAR;
        PG8_WAIT_V(2); PG8_BAR;
        PG8_STAGE(PG8_SB(1, 0), cB + kstepB, voffB); PG8_STAGE(PG8_SA(1, 0), cA + kstepA, vc[0]); PG8_STAGE(PG8_SB(1, 1), cB + hstep + kstepB, voffB);
        PG8_WAIT_V(6); PG8_BAR;
    } else {
    PG8_STAGE(PG8_SB(0, 0), cB, voffB); PG8_STAGE(PG8_SA(0, 0), cA, vc[0]); PG8_STAGE(PG8_SB(0, 1), cB + hstep, voffB); PG8_STAGE(PG8_SA(0, 1), cA, vc[1]);
    if (wr == 1) PG8_BAR;
    PG8_WAIT_V(4); PG8_BAR;
    PG8_STAGE(PG8_SB(1, 0), cB + kstepB, voffB); PG8_STAGE(PG8_SA(1, 0), cA + kstepA, vc[0]); PG8_STAGE(PG8_SB(1, 1), cB + hstep + kstepB, voffB);
    PG8_WAIT_V(6); PG8_BAR;
    }
    for (;;) {
        const bool has_next = S.next(ui + 1, nxt);
        const char* nA = cA; const char* nB = cB;
        if (has_next) { nA = GATHER ? (const char*)Ag : (const char*)Ag + (size_t)nxt.pm * tstepA; nB = (const char*)Btg + (size_t)nxt.pn * tstepB; PG8_LOADV(vn, nxt); }
        else {
#pragma unroll
            for (int h = 0; h < 2; ++h)
#pragma unroll
                for (int i = 0; i < 2; ++i) vn[h][i] = vc[h][i];
        }
        for (int t = 0; t < nt; t += 2) {
            const bool last = (t == nt - 2);
            const char* a1 = cA + (size_t)(t + 1) * kstepA;
            const char* a2 = last ? nA : cA + (size_t)(t + 2) * kstepA; const char* b2 = last ? nB : cB + (size_t)(t + 2) * kstepB;
            const char* a3 = a2 + kstepA; const char* b3 = b2 + kstepB;
#pragma unroll
            for (int i = 0; i < 2; ++i) vc[0][i] = last ? vn[0][i] : vc[0][i];
            if constexpr (SP2) {
            PG8_LDB(B0, 0, 0); PG8_LDB(B1, 0, 1); PG8_SCHED; PG8_LDA(At, 0, 0); PG8_STAGE(PG8_SA(1, 1), a1, vc[1]);
            _Pragma("unroll") for (int i = 0; i < 2; ++i) vc[1][i] = last ? vn[1][i] : vc[1][i];
            PG8_WAIT_V(8); PG8_WAIT_L(0); PG8_BAR; PG8_MMA(0, 0, At, B0); PG8_MMA(0, 1, At, B1); PG8_BAR; PG8_SCHED;
            PG8_LDA(At, 0, 1); PG8_STAGE(PG8_SB(0, 0), b2, voffB); PG8_STAGE(PG8_SB(0, 1), b2 + hstep, voffB); PG8_STAGE(PG8_SA(0, 0), a2, vc[0]);
            PG8_WAIT_V(8); PG8_WAIT_L(0); PG8_BAR; PG8_MMA(1, 0, At, B0); PG8_MMA(1, 1, At, B1); PG8_BAR; PG8_SCHED;
            PG8_LDB(B0, 1, 0); PG8_LDB(B1, 1, 1); PG8_SCHED; PG8_LDA(At, 1, 0); PG8_STAGE(PG8_SA(0, 1), a2, vc[1]);
            PG8_WAIT_V(8); PG8_WAIT_L(0); PG8_BAR; PG8_MMA(0, 0, At, B0); PG8_MMA(0, 1, At, B1); PG8_BAR; PG8_SCHED;
            PG8_LDA(At, 1, 1); PG8_STAGE(PG8_SB(1, 0), b3, voffB); PG8_STAGE(PG8_SB(1, 1), b3 + hstep, voffB); PG8_STAGE(PG8_SA(1, 0), a3, vc[0]);
            PG8_WAIT_V(8); PG8_WAIT_L(0); PG8_BAR; PG8_MMA(1, 0, At, B0); PG8_MMA(1, 1, At, B1); PG8_BAR; PG8_SCHED;
            } else {
            PG8_LDB(B0, 0, 0); PG8_SCHED; PG8_LDA(At, 0, 0); PG8_STAGE(PG8_SA(1, 1), a1, vc[1]);
            _Pragma("unroll") for (int i = 0; i < 2; ++i) vc[1][i] = last ? vn[1][i] : vc[1][i];
            PG8_WAIT_L(8); PG8_BAR; PG8_WAIT_L(0); PG8_MMA(0, 0, At, B0); PG8_BAR; PG8_SCHED;
            PG8_LDB(B1, 0, 1); PG8_STAGE(PG8_SB(0, 0), b2, voffB);
            PG8_BAR; PG8_WAIT_L(0); PG8_MMA(0, 1, At, B1); PG8_BAR;
            PG8_LDA(At, 0, 1); PG8_STAGE(PG8_SA(0, 0), a2, vc[0]);
            PG8_BAR; PG8_WAIT_L(0); PG8_MMA(1, 0, At, B0); PG8_BAR; PG8_SCHED;
            PG8_STAGE(PG8_SB(0, 1), b2 + hstep, voffB);
            PG8_WAIT_V(6); PG8_BAR; PG8_MMA(1, 1, At, B1); PG8_BAR;
            PG8_LDB(B0, 1, 0); PG8_SCHED; PG8_LDA(At, 1, 0); PG8_STAGE(PG8_SA(0, 1), a2, vc[1]);
            PG8_WAIT_L(8); PG8_BAR; PG8_WAIT_L(0); PG8_MMA(0, 0, At, B0); PG8_BAR; PG8_SCHED;
            PG8_LDB(B1, 1, 1); PG8_STAGE(PG8_SB(1, 0), b3, voffB);
            PG8_BAR; PG8_WAIT_L(0); PG8_MMA(0, 1, At, B1); PG8_BAR;
            PG8_LDA(At, 1, 1); PG8_STAGE(PG8_SA(1, 0), a3, vc[0]);
            PG8_BAR; PG8_WAIT_L(0); PG8_MMA(1, 0, At, B0); PG8_BAR; PG8_SCHED;
            PG8_STAGE(PG8_SB(1, 1), b3 + hstep, voffB);
            PG8_WAIT_V(6); PG8_BAR; PG8_MMA(1, 1, At, B1); PG8_BAR;
            }
        }
        if constexpr (ALIGN_EPI) { if (wr == 0) PG8_BAR; }
        E(acc, cur, wr, wc, fr, fq);
        if (!has_next) break;
#pragma unroll
        for (int a = 0; a < 2; ++a)
#pragma unroll
            for (int b = 0; b < 2; ++b)
#pragma unroll
                for (int m = 0; m < 4; ++m)
#pragma unroll
                    for (int n = 0; n < 2; ++n) acc[a][b][m][n] = (f32x4){0.f, 0.f, 0.f, 0.f};
        cur = nxt; cA = nA; cB = nB; ++ui;
#pragma unroll
        for (int h = 0; h < 2; ++h)
#pragma unroll
            for (int i = 0; i < 2; ++i) vc[h][i] = vn[h][i];
        if constexpr (ALIGN_EPI) { if (wr == 1) PG8_BAR; }
    }
    PG8_WAIT_V(0);
    if constexpr (!ALIGN_EPI) { if (wr == 0) PG8_BAR; }
    PG8_BAR;
#undef PG8_SA
#undef PG8_SB
#undef PG8_STAGE
#undef PG8_LDA
#undef PG8_LDB
#undef PG8_MMA
#undef PG8_LD8
#undef PG8_WAIT_V
#undef PG8_WAIT_L
#undef PG8_BAR
#undef PG8_SCHED
#undef PG8_LOADV
}
}

struct EpiInProj {
    static constexpr bool PERM = true;
    bf16_t* xglu; bf16_t* xlx; bf16_t* glg; const float* b_in;
    __device__ __forceinline__ void operator()(const f32x4 (&acc)[2][2][4][2], const pg8::Unit& u, int wr, int wc, int fr, int fq) const {
        const int row0 = u.pm * 256 + wr * 64 + fr, cl = wc * 32 + 8 * fq;
        if (u.pn < 4) {
            const int col = 128 * u.pn + cl;
            f32x4 bv[2][2];
#pragma unroll
            for (int n = 0; n < 2; ++n) { bv[0][n] = *(const f32x4*)(b_in + col + 4 * n); bv[1][n] = *(const f32x4*)(b_in + 512 + col + 4 * n); }
#pragma unroll
            for (int ai = 0; ai < 2; ++ai)
#pragma unroll
                for (int m = 0; m < 4; ++m) {
                    const size_t row = (size_t)(row0 + ai * 128 + m * 16);
                    float o[8];
#pragma unroll
                    for (int n = 0; n < 2; ++n) { const f32x4 v = acc[ai][0][m][n] + bv[0][n], g = acc[ai][1][m][n] + bv[1][n];
#pragma unroll
                        for (int j = 0; j < 4; ++j) o[4 * n + j] = v[j] * sigm(g[j]); }
                    u32x4 w; w.x = pk2h(o[0], o[1]); w.y = pk2h(o[2], o[3]); w.z = pk2h(o[4], o[5]); w.w = pk2h(o[6], o[7]);
                    { const int rw = (int)row, bb = rw >> 13, tk = rw & (SEQ - 1);
                      *(u32x4*)(xglu + ((size_t)((bb * PGR + (tk >> 6) + 15) * PGC + (tk & 63) + 15)) * 512 + col) = w; }
                }
        } else {
            const bool isg = u.pn >= 6;
            const int cbase = 256 * (u.pn - (isg ? 6 : 4));
            const float* bias = b_in + (isg ? 1536 : 1024) + cbase;
            bf16_t* outp = isg ? glg : xlx;
#pragma unroll
            for (int bj = 0; bj < 2; ++bj) {
                const int col = 128 * bj + cl;
                const f32x4 b0 = *(const f32x4*)(bias + col), b1 = *(const f32x4*)(bias + col + 4);
#pragma unroll
                for (int ai = 0; ai < 2; ++ai)
#pragma unroll
                    for (int m = 0; m < 4; ++m) {
                        const size_t row = (size_t)(row0 + ai * 128 + m * 16);
                        f32x4 v0 = acc[ai][bj][m][0] + b0, v1 = acc[ai][bj][m][1] + b1;
                        if (isg) {
#pragma unroll
                            for (int j = 0; j < 4; ++j) { v0[j] = gelu_tanh(v0[j]); v1[j] = gelu_tanh(v1[j]); }
                        }
                        u32x4 w; w.x = pk2(v0[0], v0[1]); w.y = pk2(v0[2], v0[3]); w.z = pk2(v1[0], v1[1]); w.w = pk2(v1[2], v1[3]);
                        *(u32x4*)(outp + row * 512 + cbase + col) = w;
                    }
            }
        }
    }
};
struct EpiOutProj {
    static constexpr bool PERM = true;
    bf16_t* X1; const float* x; const float* mod; const float* b_out;
    __device__ __forceinline__ void operator()(const f32x4 (&acc)[2][2][4][2], const pg8::Unit& u, int wr, int wc, int fr, int fq) const {
        const int row0 = u.pm * 256 + wr * 64 + fr, col0 = u.pn * 256 + wc * 32 + 8 * fq;
        const int b = u.pm >> 5;
        const float* g1 = mod + b * 6144 + 2048;
#pragma unroll
        for (int bj = 0; bj < 2; ++bj) {
            const int col = col0 + bj * 128;
            const f32x4 bo0 = *(const f32x4*)(b_out + col), bo1 = *(const f32x4*)(b_out + col + 4), gg0 = *(const f32x4*)(g1 + col), gg1 = *(const f32x4*)(g1 + col + 4);
#pragma unroll
            for (int ai = 0; ai < 2; ++ai) {
                f32x4 xa[4][2];
#pragma unroll
                for (int m = 0; m < 4; ++m) { const float* xp = x + (size_t)(row0 + ai * 128 + m * 16) * D + col;
                    xa[m][0] = __builtin_nontemporal_load((const f32x4*)xp); xa[m][1] = __builtin_nontemporal_load((const f32x4*)(xp + 4)); }
#pragma unroll
                for (int m = 0; m < 4; ++m) {
                    const f32x4 v0 = xa[m][0] + gg0 * (acc[ai][bj][m][0] + bo0), v1 = xa[m][1] + gg1 * (acc[ai][bj][m][1] + bo1);
                    u32x4 w; w.x = pk2(v0[0], v0[1]); w.y = pk2(v0[2], v0[3]); w.z = pk2(v1[0], v1[1]); w.w = pk2(v1[2], v1[3]);
                    *(u32x4*)(X1 + (size_t)(row0 + ai * 128 + m * 16) * D + col) = w;
                }
            }
        }
    }
};
struct EpiExpUp {
    static constexpr bool PERM = true;
    unsigned char* H;
    __device__ __forceinline__ void operator()(const f32x4 (&acc)[2][2][4][2], const pg8::Unit& u, int wr, int wc, int fr, int fq) const {
        const int e = u.pm >> 4, t = u.pn - e * 22;
        const int rloc0 = wr * 64 + fr, cloc = wc * 32 + 8 * (fq & ~1);
        unsigned char* Ht = H + ((size_t)u.pm * 22 + t) * 32768 + cloc;
#pragma unroll
        for (int ai = 0; ai < 2; ++ai)
#pragma unroll
            for (int mp = 0; mp < 4; mp += 2) {
                u32x2 w[2];
#pragma unroll
                for (int mm = 0; mm < 2; ++mm) { const int m = mp + mm;
                    float o[8];
#pragma unroll
                    for (int n = 0; n < 2; ++n)
#pragma unroll
                        for (int j = 0; j < 4; j += 2) {
                            const f32x2 g2 = (f32x2){acc[ai][0][m][n][j], acc[ai][0][m][n][j + 1]}, u2 = (f32x2){acc[ai][1][m][n][j], acc[ai][1][m][n][j + 1]};
                            const f32x2 tt = g2 * (-1.4426950408889634f);
                            f32x2 ee; ee.x = __builtin_amdgcn_exp2f(tt.x); ee.y = __builtin_amdgcn_exp2f(tt.y);
                            const f32x2 dd = ee + 1.0f;
                            f32x2 rr; rr.x = __builtin_amdgcn_rcpf(dd.x); rr.y = __builtin_amdgcn_rcpf(dd.y);
                            const f32x2 hh = (g2 * u2) * rr;
                            o[4 * n + j] = hh.x; o[4 * n + j + 1] = hh.y; }
                    w[mm].x = pk4_fp8(o[0], o[1], o[2], o[3]); w[mm].y = pk4_fp8(o[4], o[5], o[6], o[7]); }
                const auto sx = __builtin_amdgcn_permlane16_swap(w[0].x, w[1].x, false, false), sy = __builtin_amdgcn_permlane16_swap(w[0].y, w[1].y, false, false);
                const int rloc = rloc0 + ai * 128 + (mp + (fq & 1)) * 16;
                *(u32x4*)(Ht + (size_t)rloc * 128) = (u32x4){sx[0], sy[0], sx[1], sy[1]};
            }
    }
};
struct EpiExpDown {
    static constexpr bool PERM = true;
    unsigned char* Y; const float* gateE;
    __device__ __forceinline__ void operator()(const f32x4 (&acc)[2][2][4][2], const pg8::Unit& u, int wr, int wc, int fr, int fq) const {
        const int e = u.pm >> 4, c4 = u.pn - e * 4;
        const int row0 = u.pm * 256 + wr * 64 + fr, colw = 256 * c4 + wc * 32 + 8 * (fq & ~1);
#pragma unroll
        for (int ai = 0; ai < 2; ++ai)
#pragma unroll
            for (int mp = 0; mp < 4; mp += 2) {
                const size_t rowa = (size_t)(row0 + ai * 128 + mp * 16), rowb = rowa + 16;
                const float ga = gateE[rowa] * 32.0f, gb = gateE[rowb] * 32.0f;
                const size_t rowst = (fq & 1) ? rowb : rowa;
#pragma unroll
                for (int bj = 0; bj < 2; ++bj) {
                    const f32x4 a0 = acc[ai][bj][mp][0] * ga, a1 = acc[ai][bj][mp][1] * ga, b0 = acc[ai][bj][mp + 1][0] * gb, b1 = acc[ai][bj][mp + 1][1] * gb;
                    u32x2 wa, wb; wa.x = pk4_fp8(a0[0], a0[1], a0[2], a0[3]); wa.y = pk4_fp8(a1[0], a1[1], a1[2], a1[3]); wb.x = pk4_fp8(b0[0], b0[1], b0[2], b0[3]); wb.y = pk4_fp8(b1[0], b1[1], b1[2], b1[3]);
                    const auto sx = __builtin_amdgcn_permlane16_swap(wa.x, wb.x, false, false), sy = __builtin_amdgcn_permlane16_swap(wa.y, wb.y, false, false);
                    *(u32x4*)(Y + rowst * D + colw + 128 * bj) = (u32x4){sx[0], sy[0], sx[1], sy[1]};
                }
            }
    }
};

__device__ __forceinline__ void wg_publish(unsigned* cnt, int tid) {
    asm volatile("s_waitcnt vmcnt(0)" ::: "memory");
    __syncthreads();
    if (tid == 0) { __builtin_amdgcn_fence(__ATOMIC_RELEASE, "agent"); asm volatile("s_waitcnt vmcnt(0)" ::: "memory");
        (void)__hip_atomic_fetch_add(cnt, 1u, __ATOMIC_RELAXED, __HIP_MEMORY_SCOPE_AGENT); }
}
__device__ __forceinline__ void wg_wait(unsigned* cnt, unsigned target, int tid) {
    if (tid == 0) { unsigned sp = 0;
        while (__hip_atomic_load(cnt, __ATOMIC_RELAXED, __HIP_MEMORY_SCOPE_AGENT) < target && ++sp < (1u << 22)) __builtin_amdgcn_s_sleep(2);
        __builtin_amdgcn_fence(__ATOMIC_ACQUIRE, "agent"); asm volatile("s_waitcnt vmcnt(0)" ::: "memory"); }
    __syncthreads();
}

__device__ __forceinline__ void transpose_item(const float* W, int K, int N, bf16_t* WT, int k0, int n0, size_t drow0, LAS float* scr, int lane) {
    float tv[32];
#pragma unroll
    for (int i = 0; i < 32; ++i) { const int kk = 2 * i + (lane >> 5); tv[i] = __builtin_nontemporal_load(W + (size_t)(k0 + kk) * N + n0 + (lane & 31)); }
#pragma unroll
    for (int i = 0; i < 32; ++i) { const int kk = 2 * i + (lane >> 5); scr[kk * 33 + (lane & 31)] = tv[i]; }
    asm volatile("s_waitcnt lgkmcnt(0)" ::: "memory");
    const int c = lane & 7;
#pragma unroll
    for (int j = 0; j < 4; ++j) { const int n = (lane >> 3) + 8 * j; const LAS float* s = scr + (8 * c) * 33 + n;
        u32x4 o; o.x = pk2(s[0 * 33], s[1 * 33]); o.y = pk2(s[2 * 33], s[3 * 33]); o.z = pk2(s[4 * 33], s[5 * 33]); o.w = pk2(s[6 * 33], s[7 * 33]);
        *(u32x4*)(WT + (drow0 + n) * (size_t)K + k0 + 8 * c) = o; }
    asm volatile("s_waitcnt lgkmcnt(0)" ::: "memory");
}

__device__ __forceinline__ void transpose_item8(const float* W, int K, int N, unsigned char* WT, int k0, int n0, size_t drow0, float scale, LAS float* scr, int lane) {
    float tv[32];
#pragma unroll
    for (int i = 0; i < 32; ++i) { const int kk = 2 * i + (lane >> 5); tv[i] = __builtin_nontemporal_load(W + (size_t)(k0 + kk) * N + n0 + (lane & 31)); }
#pragma unroll
    for (int i = 0; i < 32; ++i) { const int kk = 2 * i + (lane >> 5); scr[kk * 33 + (lane & 31)] = tv[i] * scale; }
    asm volatile("s_waitcnt lgkmcnt(0)" ::: "memory");
    const int c = lane & 7;
#pragma unroll
    for (int j = 0; j < 4; ++j) { const int n = (lane >> 3) + 8 * j; const LAS float* s = scr + (8 * c) * 33 + n;
        u32x2 o; o.x = pk4_fp8(s[0 * 33], s[1 * 33], s[2 * 33], s[3 * 33]); o.y = pk4_fp8(s[4 * 33], s[5 * 33], s[6 * 33], s[7 * 33]);
        *(u32x2*)(WT + (drow0 + n) * (size_t)K + k0 + 8 * c) = o; }
    asm volatile("s_waitcnt lgkmcnt(0)" ::: "memory");
}

__device__ __forceinline__ void transpose_item8w(const float* Wb, int N, unsigned char* dst, int dpitch, float scale, LAS float* scr, int lane) {
    f32x4 tv[8];
    const int ks = lane >> 3, n4 = (lane & 7) * 4;
#pragma unroll
    for (int i = 0; i < 8; ++i) tv[i] = __builtin_nontemporal_load((const f32x4*)(Wb + (size_t)(8 * i + ks) * N + n4));
#pragma unroll
    for (int i = 0; i < 8; ++i) { LAS float* p = scr + (8 * i + ks) * 33 + n4; p[0] = tv[i].x; p[1] = tv[i].y; p[2] = tv[i].z; p[3] = tv[i].w; }
    asm volatile("s_waitcnt lgkmcnt(0)" ::: "memory");
    const int c = lane & 3;
#pragma unroll
    for (int j = 0; j < 2; ++j) { const int n = (lane >> 2) + 16 * j; const LAS float* s = scr + (16 * c) * 33 + n;
        u32x4 o;
#pragma unroll
        for (int q = 0; q < 4; ++q) { const f32x2 a0 = (f32x2){s[(4 * q + 0) * 33], s[(4 * q + 1) * 33]} * scale, a1 = (f32x2){s[(4 * q + 2) * 33], s[(4 * q + 3) * 33]} * scale; o[q] = pk4_fp8(a0.x, a0.y, a1.x, a1.y); }
        *(u32x4*)(dst + (size_t)n * dpitch + 16 * c) = o; }
    asm volatile("s_waitcnt lgkmcnt(0)" ::: "memory");
}

__device__ __forceinline__ void transpose_item8b(const float* W, int N, unsigned char* WTblk, int k0, int n0, int drow0, int kc0, float scale, LAS float* scr, int lane) {
    float tv[32];
#pragma unroll
    for (int i = 0; i < 32; ++i) { const int kk = 2 * i + (lane >> 5); tv[i] = __builtin_nontemporal_load(W + (size_t)(k0 + kk) * N + n0 + (lane & 31)); }
#pragma unroll
    for (int i = 0; i < 32; ++i) { const int kk = 2 * i + (lane >> 5); scr[kk * 33 + (lane & 31)] = tv[i] * scale; }
    asm volatile("s_waitcnt lgkmcnt(0)" ::: "memory");
    const int c = lane & 7;
#pragma unroll
    for (int j = 0; j < 4; ++j) { const int n = (lane >> 3) + 8 * j; const LAS float* s = scr + (8 * c) * 33 + n;
        u32x2 o; o.x = pk4_fp8(s[0 * 33], s[1 * 33], s[2 * 33], s[3 * 33]); o.y = pk4_fp8(s[4 * 33], s[5 * 33], s[6 * 33], s[7 * 33]);
        *(u32x2*)(WTblk + (size_t)(drow0 + n) * 128 + kc0 + 8 * c) = o; }
    asm volatile("s_waitcnt lgkmcnt(0)" ::: "memory");
}

#ifndef PROBE_MASK
#define PROBE_MASK 0
#endif
struct Args { const float* in[28]; float* out; unsigned char* ws; int ph_lo, ph_hi, dbg, pad; };

constexpr int CV_TOTAL1 = 2 * 16 * 16 * 88, CV_TOTAL2 = 16 * 44 * 32;
__device__ __forceinline__ int cv1_early(int G) { (void)G; return 0; }
__device__ __forceinline__ int cv2_early(int G) { (void)G; return 0; }
__device__ __forceinline__ void convert_range(LAS unsigned char* lds, const Args& a, const int kind, const int lo, const int hi, const int gw, const int NGW, const int wave, const int lane);
__device__ __forceinline__ void convert_items(LAS unsigned char* lds, const Args& a, const int kind, const int TID, const int BID, const int GD) {
    const int lo = kind == 1 ? cv1_early(GD) : (kind == 2 ? cv2_early(GD) : 0);
    const int hi = kind == 0 ? (16 * 64 + 16 * 32) : (kind == 1 ? CV_TOTAL1 : CV_TOTAL2);
    convert_range(lds, a, kind, lo < hi ? lo : hi, hi, BID * NWAVES + (TID >> 6), GD * NWAVES, TID >> 6, TID & 63);
}
constexpr int CV_CHUNK = 8;
__device__ __forceinline__ void convert_items_dyn(LAS unsigned char* lds, const Args& a, const int kind, const int maxrounds_in, const int TID, const int GD) {
    const int lo0 = kind == 1 ? cv1_early(GD) : cv2_early(GD), hi = kind == 1 ? CV_TOTAL1 : CV_TOTAL2, lo = lo0 < hi ? lo0 : hi;
    unsigned* ctr = (unsigned*)(a.ws + WS_CVCNT) + 64 * (kind - 1);
    volatile LAS unsigned* slot = (volatile LAS unsigned*)(lds + 8 * 8704 + 64);
    const int wave = TID >> 6, lane = TID & 63;
    int maxrounds = maxrounds_in;
    if (maxrounds < 0) {
        if (TID == 0) { const int cur = (int)__hip_atomic_load(ctr, __ATOMIC_RELAXED, __HIP_MEMORY_SCOPE_AGENT); const int remaining = hi - lo - cur; slot[1] = (unsigned)(remaining > 0 ? remaining / (GD * CV_CHUNK) : 0); }
        __syncthreads();
        maxrounds = (int)slot[1];
        __syncthreads();
    }
    if (maxrounds <= 0) return;
    unsigned nb = 0u;
    if (TID == 0) nb = __hip_atomic_fetch_add(ctr, (unsigned)CV_CHUNK, __ATOMIC_RELAXED, __HIP_MEMORY_SCOPE_AGENT);
#pragma unroll 1
    for (int round = 0; round < maxrounds; ++round) {
        if (TID == 0) slot[0] = nb;
        __syncthreads();
        const int base = lo + (int)slot[0];
        __syncthreads();
        if (base >= hi) break;
        if (TID == 0 && round + 1 < maxrounds) nb = __hip_atomic_fetch_add(ctr, (unsigned)CV_CHUNK, __ATOMIC_RELAXED, __HIP_MEMORY_SCOPE_AGENT);
        const int top = base + CV_CHUNK < hi ? base + CV_CHUNK : hi;
        convert_range(lds, a, kind, base, top, wave, NWAVES, wave, lane);
    }
}
__device__ __forceinline__ void convert_range(LAS unsigned char* lds, const Args& a, const int kind, const int lo, const int hi, const int gw, const int NGW, const int wave, const int lane) {
    unsigned char* ws = a.ws;
    LAS float* scr = (LAS float*)(lds + wave * 8704);
    const float* w_in = a.in[8]; const float* w_out = a.in[21]; const float* wg = a.in[24]; const float* wu = a.in[25]; const float* wd = a.in[26];
    bf16_t* WinT = (bf16_t*)(ws + WS_WINT); bf16_t* WoutT = (bf16_t*)(ws + WS_WOUTT); unsigned char* WguT = ws + WS_WGUT; unsigned char* WdT = ws + WS_WDT;
    constexpr int I_IN = 16 * 64, I_OUT = 16 * 32, I_GE = 16 * 88, I_G = 16 * I_GE, I_DE = 44 * 32, I_D = 16 * I_DE;
    static_assert(2 * I_G == CV_TOTAL1 && I_D == CV_TOTAL2, "item counts");
    for (int it = lo + gw; it < hi; it += NGW) {
        int r = it;
        if (kind == 0) {
            if (r < I_IN) { const int kb = r / 64, nb = r % 64, n0 = 32 * nb;
                int drow; if (n0 < 512) drow = (n0 >> 7) * 256 + (n0 & 127); else if (n0 < 1024) drow = ((n0 - 512) >> 7) * 256 + 128 + ((n0 - 512) & 127); else drow = n0;
                transpose_item(w_in, 1024, 2048, WinT, 64 * kb, n0, (size_t)drow, scr, lane); }
            else { r -= I_IN; const int kb = r / 32, nb = r % 32; transpose_item(w_out, 1024, 1024, WoutT, 64 * kb, 32 * nb, (size_t)(32 * nb), scr, lane); }
        } else if (kind == 1) {
            const int up = r >= I_G; if (up) r -= I_G; const int e = r / I_GE, q = r % I_GE, kb = q / 88, nb = q % 88, n0 = 32 * nb;
            const size_t drow = (size_t)e * 5632 + (size_t)(n0 >> 7) * 256 + (up ? 128 : 0) + (n0 & 127);
            transpose_item8w((up ? wu : wg) + (size_t)e * 1024 * DE + (size_t)(64 * kb) * DE + n0, DE, WguT + drow * 1024 + 64 * kb, 1024, 32.0f, scr, lane);
        } else {
            const int e = r / I_DE, q = r % I_DE, kb = q / 32, nb = q % 32;
            const int n0 = 32 * nb, k0 = 64 * kb;
            transpose_item8w(wd + (size_t)e * DE * 1024 + (size_t)k0 * 1024 + n0, 1024, WdT + ((size_t)((e * 4 + (n0 >> 8)) * 22 + (k0 >> 7))) * 32768 + (size_t)(n0 & 255) * 128 + (k0 & 127), 128, 64.0f, scr, lane);
        }
    }
}

__device__ __forceinline__ void phase0(LAS unsigned char* lds, const Args& a, const int TID, const int BID, const int GD) {
    const int tid = TID, lane = tid & 63, wave = tid >> 6, G = GD;
    unsigned char* ws = a.ws;
    __syncthreads();
    {
        const float* c = a.in[1]; const float* cctx = a.in[3]; const float* ada_w = a.in[6]; const float* ada_b = a.in[7];
        float* mod = (float*)(ws + WS_MOD); float* modc = mod + 4 * 6144;
        LAS float* sc = (LAS float*)lds;
        LAS float* red = (LAS float*)(lds + 20480);
        for (int grp = BID; grp < 96; grp += G) {
            for (int i = tid; i < 5 * 1024; i += NTHREADS) { const float v = (i < 4096) ? c[i] : cctx[i - 4096]; sc[i] = silu_f(v); }
            __syncthreads();
            const int kk = lane >> 4, c4 = (lane & 15) * 4;
            f32x4 acc[5];
#pragma unroll
            for (int v = 0; v < 5; ++v) acc[v] = (f32x4){0.f, 0.f, 0.f, 0.f};
            const float* wp = ada_w + (size_t)(wave * 128 + kk) * 6144 + grp * 64 + c4;
#pragma unroll 16
            for (int it = 0; it < 32; ++it) { const f32x4 w = __builtin_nontemporal_load((const f32x4*)(wp + (size_t)(4 * it) * 6144)); const int k = wave * 128 + 4 * it + kk;
#pragma unroll
                for (int v = 0; v < 5; ++v) acc[v] = acc[v] + w * sc[v * 1024 + k]; }
#pragma unroll
            for (int v = 0; v < 5; ++v) *(LAS f32x4*)(red + ((wave * 4 + kk) * 5 + v) * 64 + c4) = acc[v];
            __syncthreads();
            if (tid < 320) { const int v = tid >> 6, l = tid & 63; float s = 0.f;
#pragma unroll
                for (int w = 0; w < 32; ++w) s += red[(w * 5 + v) * 64 + l];
                const int cc = grp * 64 + l; s += ada_b[cc];
                if (v < 4) mod[v * 6144 + cc] = s; else if (cc < 2048) modc[cc] = s; }
            wg_publish((unsigned*)(ws + WS_ADACNT), tid);
            __syncthreads();
        }
    }
    {
        const int nz = G > 96 ? G - 96 : G, zb = G > 96 ? BID - 96 : BID;
        if (zb >= 0) for (int cell = zb * NWAVES + wave; cell < NB * PGR * PGC; cell += nz * NWAVES) {
            const int rc = cell % (PGR * PGC), pr = rc / PGC, pc = rc % PGC;
            if (pr < 15 || pr >= 143 || pc < 15 || pc >= 79) *(u32x4*)(ws + WS_XGP + (size_t)cell * 1024 + lane * 16) = (u32x4){0u, 0u, 0u, 0u};
        }
    }
    convert_items(lds, a, 0, TID, BID, GD);
}

__device__ __forceinline__ void phase1(const Args& a, const int TID, const int BID, const int GD) {
    const int lane = TID & 63, wave = TID >> 6, G = GD;
    const float* x = a.in[0]; const float* ctx = a.in[2]; const float* g1 = a.in[4];
    const float* mod = (const float*)(a.ws + WS_MOD); const float* modc = mod + 4 * 6144;
    bf16_t* U = (bf16_t*)(a.ws + WS_U);
    const int stride1 = G * NWAVES, row1 = BID * NWAVES + wave;
    f32x4 q0[4], q1[4];
#pragma unroll
    for (int i = 0; i < 4; ++i) {
        const int ra = row1 < NROWS ? row1 : 0, rb = row1 + stride1 < NROWS ? row1 + stride1 : 0;
        q0[i] = __builtin_nontemporal_load((const f32x4*)((ra < NTOK ? x + (size_t)ra * D : ctx + (size_t)(ra - NTOK) * D) + 4 * (lane + 64 * i)));
        q1[i] = __builtin_nontemporal_load((const f32x4*)((rb < NTOK ? x + (size_t)rb * D : ctx + (size_t)(rb - NTOK) * D) + 4 * (lane + 64 * i))); }
    int kcur = -1; f32x4 mg[4], ms[4];
#pragma unroll 1
    for (int row = row1; row < NROWS; row += stride1) {
        const int key = row < NTOK ? (row >> 13) : NB;
        if (key != kcur) { kcur = key; const float* sh = key < NB ? mod + key * 6144 : modc; const float* scl = sh + 1024;
#pragma unroll
            for (int i = 0; i < 4; ++i) { ms[i] = *(const f32x4*)(sh + 4 * (lane + 64 * i)); mg[i] = *(const f32x4*)(g1 + 4 * (lane + 64 * i)) * (*(const f32x4*)(scl + 4 * (lane + 64 * i)) + 1.0f); } }
        f32x4 v[4]; float ss = 0.f;
        const int rn = row + 2 * stride1 < NROWS ? row + 2 * stride1 : 0;
        const float* xn = rn < NTOK ? x + (size_t)rn * D : ctx + (size_t)(rn - NTOK) * D;
#pragma unroll
        for (int i = 0; i < 4; ++i) { v[i] = q0[i]; q0[i] = q1[i]; q1[i] = __builtin_nontemporal_load((const f32x4*)(xn + 4 * (lane + 64 * i))); ss += v[i].x * v[i].x + v[i].y * v[i].y + v[i].z * v[i].z + v[i].w * v[i].w; }
        ss = wave_sum(ss);
        const float r = rsqrtf(ss * (1.0f / D) + 1e-6f);
#pragma unroll
        for (int i = 0; i < 4; ++i) {
            const f32x4 o = (v[i] * r) * mg[i] + ms[i];
            u32x2 w; w.x = pk2(o.x, o.y); w.y = pk2(o.z, o.w);
            *(u32x2*)(U + (size_t)row * D + 4 * (lane + 64 * i)) = w;
        }
    }
}

__device__ __forceinline__ void conv_units(LAS unsigned char* lds, const Args& a, int ubeg, int ustride, const int TID, const int BID, const int GD) {
    const int tid = TID, lane = tid & 63, wave = tid >> 6;
    const float* cw = a.in[10]; const float* cb = a.in[11]; const float* lg = a.in[12]; const float* lb = a.in[13];
    const bf16_t* xglu = (const bf16_t*)(a.ws + WS_XGP); bf16_t* mix = (bf16_t*)(a.ws + WS_MIX);
    LAS float* wts = (LAS float*)lds;
    for (int i = tid; i < 31 * 512; i += NTHREADS) { const int k = i >> 9, ch = i & 511; wts[((k * 2 + ((ch >> 2) & 1)) * 64 + (ch >> 3)) * 4 + (ch & 3)] = cw[i]; }
    __syncthreads();
    const int ch0 = 8 * lane;
    const bool rowc = lane < 32;
    const long sj = rowc ? 512 : (long)PGC * 512;
    const long sl = rowc ? (long)PGC * 512 : 512;
    const int nitems = ubeg < NB * 64 ? ((NB * 64 - ubeg + ustride - 1) / ustride) * 4 : 0;
    auto item_of = [&](int idx, int& b, int& r, int& c) -> const bf16_t* {
        const int unit0 = ubeg + (idx >> 2) * ustride;
        const int unit = (GD == 256) ? ((unit0 & 7) >> 1) * 64 + (unit0 & 1) * 32 + (unit0 >> 3) : unit0;
        b = unit >> 6; r = (unit & 63) * 2; c = ((idx & 3) * 8 + wave) * 2;
        return xglu + ((size_t)((b * PGR + r + 15) * PGC + 15 + c)) * 512 + ch0 - 15 * sj;
    };
    u32x4 xv[2][2][8];
    const bf16_t* tp = nullptr;
    f32x4 wq0 = *(const LAS f32x4*)(wts + lane * 4), wq1 = *(const LAS f32x4*)(wts + (64 + lane) * 4);
    f32x4 wc0 = wq0, wc1 = wq1, wp0 = wq0, wp1 = wq1;
#define CONV_LOADS(buf) do { _Pragma("unroll") for (int jj = 0; jj < 8; ++jj) { xv[buf][0][jj] = *(const u32x4*)tp; xv[buf][1][jj] = *(const u32x4*)(tp + sl); tp += sj; } } while (0)
#define CONV_ACC(s, W0, W1, x4) do { fma_mix_lo(acc[s][0], W0.x, x4.x); fma_mix_hi(acc[s][1], W0.y, x4.x); fma_mix_lo(acc[s][2], W0.z, x4.y); fma_mix_hi(acc[s][3], W0.w, x4.y); \
                                     fma_mix_lo(acc[s][4], W1.x, x4.z); fma_mix_hi(acc[s][5], W1.y, x4.z); fma_mix_lo(acc[s][6], W1.z, x4.w); fma_mix_hi(acc[s][7], W1.w, x4.w); } while (0)
#define CONV_FMAS(buf, jb) do { _Pragma("unroll") for (int jj = 0; jj < 8; ++jj) { const int j = (jb) + jj; \
            if (j <= 30) { wc0 = wq0; wc1 = wq1; const int j1 = (j + 1 <= 30) ? j + 1 : 0; \
                wq0 = *(const LAS f32x4*)(wts + ((j1 * 2 + 0) * 64 + lane) * 4); wq1 = *(const LAS f32x4*)(wts + ((j1 * 2 + 1) * 64 + lane) * 4); } \
            const u32x4 xa = xv[buf][0][jj], xb_ = xv[buf][1][jj]; \
            if (j <= 30) { CONV_ACC(0, wc0, wc1, xa); CONV_ACC(2, wc0, wc1, xb_); } \
            if (j >= 1)  { CONV_ACC(1, wp0, wp1, xa); CONV_ACC(3, wp0, wp1, xb_); } \
            wp0 = wc0; wp1 = wc1; } } while (0)
    int b = 0, r = 0, c = 0;
    if (nitems > 0) { tp = item_of(0, b, r, c); CONV_LOADS(0); }
#pragma unroll 1
    for (int idx = 0; idx < nitems; ++idx) {
        float acc[4][8];
#pragma unroll
        for (int j = 0; j < 8; ++j) { const float bj_ = cb[ch0 + j]; acc[0][j] = bj_; acc[1][j] = bj_; acc[2][j] = bj_; acc[3][j] = bj_; }
        CONV_LOADS(1); CONV_FMAS(0, 0);
        CONV_LOADS(0); CONV_FMAS(1, 8);
        CONV_LOADS(1); CONV_FMAS(0, 16);
        int bn = b, rn = r, cn = c;
        if (idx + 1 < nitems) { tp = item_of(idx + 1, bn, rn, cn); CONV_LOADS(0); }
        __builtin_amdgcn_sched_barrier(0);
        CONV_FMAS(1, 24);
#pragma unroll
        for (int tk = 0; tk < 4; ++tk) {
            float y[8];
#pragma unroll
            for (int j = 0; j < 8; ++j) y[j] = tk == 0 ? acc[0][j] : tk == 3 ? acc[3][j] : tk == 1 ? (rowc ? acc[1][j] : acc[2][j]) : (rowc ? acc[2][j] : acc[1][j]);
            float sm = 0.f;
#pragma unroll
            for (int j = 0; j < 8; ++j) sm += y[j];
            const float mean = wave_sum(sm) * (1.0f / 512.0f);
            float q = 0.f;
#pragma unroll
            for (int j = 0; j < 8; ++j) { y[j] -= mean; q += y[j] * y[j]; }
            const float rstd = rsqrtf(wave_sum(q) * (1.0f / 512.0f) + 1e-5f);
            float o[8];
#pragma unroll
            for (int j = 0; j < 8; ++j) { const float z = y[j] * rstd * lg[ch0 + j] + lb[ch0 + j]; o[j] = silu_f(z); }
            u32x4 w; w.x = pk2(o[0], o[1]); w.y = pk2(o[2], o[3]); w.z = pk2(o[4], o[5]); w.w = pk2(o[6], o[7]);
            *(u32x4*)(mix + (size_t)(b * SEQ + (r + (tk >> 1)) * 64 + c + (tk & 1)) * D + ch0) = w;
        }
        b = bn; r = rn; c = cn;
    }
#undef CONV_LOADS
#undef CONV_ACC
#undef CONV_FMAS
    __syncthreads();
}

constexpr int L_XT = 0;
constexpr int L_XC = 9216;
constexpr int L_A = L_XC + 2 * 17408;
constexpr int L_U = L_A + 2 * 16384;
constexpr int L_SUB = L_U + 2 * 16384;
constexpr int L_PRE = L_SUB + 8192;
constexpr int L_CIN = L_PRE + 4096;
static_assert(L_CIN + 2 * 17 * 64 * 4 <= 131072, "lru lds");

__device__ __forceinline__ int lru_seq(int d, int i) { return d == 0 ? i : (i < 4 ? 3 - i : NQ - 1 - (i - 4)); }
__device__ __forceinline__ u32x4 lru_load_xt(const bf16_t* xlx, int b, int h, int q, int i) {
    int rowbase, L, chunk;
    if (q < 4) { rowbase = NTOK + b * CTXL; L = CTXL; chunk = q; } else { rowbase = b * SEQ; L = SEQ; chunk = q - 4; }
    const int rr = i >> 3, seg = i & 7, t = chunk * 64 - 3 + rr;
    u32x4 v = (u32x4){0u, 0u, 0u, 0u};
    if (t >= 0 && t < L) v = __builtin_nontemporal_load((const u32x4*)(xlx + (size_t)(rowbase + t) * 512 + 64 * h + 8 * seg));
    return v;
}
template <int MODE>
__device__ __forceinline__ void lru_phase(LAS unsigned char* lds, const Args& a, const int TID, const int BID, const int GD) {
    const int tid = TID, lane = tid & 63, wave = tid >> 6;
    const float* wa = a.in[16]; const float* wi = a.in[18];
    const bf16_t* xlx = (const bf16_t*)(a.ws + WS_XLX); const bf16_t* glg = (const bf16_t*)(a.ws + WS_GLG); bf16_t* mix = (bf16_t*)(a.ws + WS_MIX);
    f32x2* carry = (f32x2*)(a.ws + WS_CARRY); unsigned* au = (unsigned*)(a.ws + WS_AU);
    const float* conv_w = a.in[14]; const float* conv_b = a.in[15]; const float* ba = a.in[17]; const float* bi = a.in[19]; const float* lam = a.in[20];
    LAS bf16_t* XT = (LAS bf16_t*)(lds + L_XT); LAS float* XC = (LAS float*)(lds + L_XC); LAS float* Aa = (LAS float*)(lds + L_A); LAS float* Uu = (LAS float*)(lds + L_U);
    LAS f32x2* SUB = (LAS f32x2*)(lds + L_SUB); LAS float* PRE = (LAS float*)(lds + L_PRE); LAS float* CIN = (LAS float*)(lds + L_CIN);
    const int l15 = lane & 15, l4 = lane >> 4;
    for (int vb = BID; vb < 256; vb += GD) {
        const int bh = vb >> 3, grp = vb & 7, b = bh >> 3, h = bh & 7;
        int q0, nq;
        if (MODE == 1) { q0 = grp * 17; nq = (NQ - q0) < 17 ? (NQ - q0) : 17; } else { q0 = 4 + grp * 16; nq = 16; }
        const int wd = wave >> 2, mtp = (wave >> 1) & 1, ntp = wave & 1;
        bf16x8 wf[2][2][2];
#pragma unroll
        for (int nn = 0; nn < 2; ++nn)
#pragma unroll
            for (int g = 0; g < 2; ++g)
#pragma unroll
                for (int ks = 0; ks < 2; ++ks) { const float* wp = (g ? wi : wa) + (size_t)((wd * 8 + h) * 64 + 32 * ks + 8 * l4) * 64 + 16 * (ntp * 2 + nn) + l15;
                    u32x4 w; w.x = pk2(wp[0], wp[64]); w.y = pk2(wp[128], wp[192]); w.z = pk2(wp[256], wp[320]); w.w = pk2(wp[384], wp[448]); wf[nn][g][ks] = __builtin_bit_cast(bf16x8, w); }
        float cw[2][4], cbv[2];
        { const int gc = 64 * h + (tid & 63);
#pragma unroll
            for (int d = 0; d < 2; ++d) { cbv[d] = conv_b[d * 512 + gc];
#pragma unroll
                for (int k = 0; k < 4; ++k) cw[d][k] = conv_w[(d * 4 + k) * 512 + gc]; } }
        float bav[2], biv[2], spv[2];
#pragma unroll
        for (int nn = 0; nn < 2; ++nn) { const int gc = 64 * h + 16 * (ntp * 2 + nn) + l15;
            bav[nn] = ba[wd * 512 + gc]; biv[nn] = bi[wd * 512 + gc]; spv[nn] = log1pf(__expf(-lam[wd * 512 + gc])); }
        if (MODE == 2 && tid < 128) {
            const int d = tid >> 6, ch = tid & 63;
            const f32x2* cp = carry + (size_t)((d * NB + b) * NQ) * 512 + 64 * h + ch;
            const int cnt = d == 0 ? q0 : (NQ + 4 - (q0 + nq));
            float s = 0.f;
            for (int i0 = 0; i0 < cnt; i0 += 8) {
                f32x2 c[8];
#pragma unroll
                for (int j = 0; j < 8; ++j) { const int ii = (i0 + j) < cnt ? (i0 + j) : (cnt - 1); c[j] = cp[(size_t)lru_seq(d, ii) * 512]; }
#pragma unroll
                for (int j = 0; j < 8; ++j) if (i0 + j < cnt) s = c[j].x * s + c[j].y;
            }
            f32x2 c[16];
#pragma unroll
            for (int j = 0; j < 16; ++j) c[j] = cp[(size_t)(q0 + j) * 512];
            if (d == 0) {
#pragma unroll
                for (int j = 0; j < 16; ++j) { CIN[(0 * 17 + j) * 64 + ch] = s; s = c[j].x * s + c[j].y; }
            } else {
#pragma unroll
                for (int j = 15; j >= 0; --j) { CIN[(1 * 17 + j) * 64 + ch] = s; s = c[j].x * s + c[j].y; }
            }
        }
        if (MODE == 1 && q0 < 4) {
            if (tid == 0) { unsigned* fl = (unsigned*)(a.ws + WS_CTXFLAG) + 64 * (b * 2 + (h >> 2)); unsigned sp = 0;
                while (__hip_atomic_load(fl, __ATOMIC_RELAXED, __HIP_MEMORY_SCOPE_AGENT) == 0u && ++sp < (1u << 22)) __builtin_amdgcn_s_sleep(2);
                __builtin_amdgcn_fence(__ATOMIC_ACQUIRE, "agent"); asm volatile("s_waitcnt vmcnt(0)" ::: "memory"); }
            __syncthreads();
        }
        u32x4 xr0 = lru_load_xt(xlx, b, h, q0, tid), xr1 = (u32x4){0u, 0u, 0u, 0u};
        if (tid < 48) xr1 = lru_load_xt(xlx, b, h, q0, tid + 512);
#pragma unroll 1
        for (int jc = 0; jc < nq; ++jc) {
            const int q = q0 + jc;
            const size_t rowbase0 = (q < 4) ? (size_t)(NTOK + b * CTXL + q * 64) : (size_t)(b * SEQ + (q - 4) * 64);
            *(LAS u32x4*)(XT + tid * 8) = xr0;
            if (tid < 48) *(LAS u32x4*)(XT + (tid + 512) * 8) = xr1;
            __syncthreads();
            if (jc + 1 < nq) { xr0 = lru_load_xt(xlx, b, h, q + 1, tid); if (tid < 48) xr1 = lru_load_xt(xlx, b, h, q + 1, tid + 512); }
            u32x4 gl = (u32x4){0u, 0u, 0u, 0u};
            if (MODE == 2) gl = *(const u32x4*)(glg + (rowbase0 + (tid >> 3)) * 512 + 64 * h + (tid & 7) * 8);
            { const int ch = tid & 63, tb = tid >> 6;
                float xr[14];
#pragma unroll
                for (int r = 0; r < 14; ++r) xr[r] = bf_lo(XT[(8 * tb + r) * 64 + ch]);
#pragma unroll
                for (int i = 0; i < 8; ++i) { const int t = 8 * tb + i;
                    XC[t * 68 + ch] = cbv[0] + cw[0][0] * xr[i] + cw[0][1] * xr[i + 1] + cw[0][2] * xr[i + 2] + cw[0][3] * xr[i + 3];
                    XC[64 * 68 + t * 68 + ch] = cbv[1] + cw[1][3] * xr[i + 3] + cw[1][2] * xr[i + 4] + cw[1][1] * xr[i + 5] + cw[1][0] * xr[i + 6]; } }
            __syncthreads();
#pragma unroll
            for (int mm = 0; mm < 2; ++mm) {
                const int mtl = 2 * mtp + mm;
                bf16x8 af[2];
#pragma unroll
                for (int ks = 0; ks < 2; ++ks) { const LAS float* p = XC + wd * (64 * 68) + (16 * mtl + l15) * 68 + 32 * ks + 8 * l4; const f32x4 p0 = *(const LAS f32x4*)p, p1 = *(const LAS f32x4*)(p + 4);
                    u32x4 w; w.x = pk2(p0.x, p0.y); w.y = pk2(p0.z, p0.w); w.z = pk2(p1.x, p1.y); w.w = pk2(p1.z, p1.w); af[ks] = __builtin_bit_cast(bf16x8, w); }
#pragma unroll
                for (int nn = 0; nn < 2; ++nn) { const int n = 16 * (ntp * 2 + nn) + l15;
                    f32x4 accR = (f32x4){0.f, 0.f, 0.f, 0.f}, accI = (f32x4){0.f, 0.f, 0.f, 0.f};
#pragma unroll
                    for (int ks = 0; ks < 2; ++ks) {
                        accR = __builtin_amdgcn_mfma_f32_16x16x32_bf16(af[ks], wf[nn][0][ks], accR, 0, 0, 0);
                        accI = __builtin_amdgcn_mfma_f32_16x16x32_bf16(af[ks], wf[nn][1][ks], accI, 0, 0, 0);
                    }
#pragma unroll
                    for (int rg = 0; rg < 4; rg += 2) { const int t = 16 * mtl + 4 * l4 + rg;
                        const f32x2 zr = (f32x2){accR[rg], accR[rg + 1]} + bav[nn], zi = (f32x2){accI[rg], accI[rg + 1]} + biv[nn];
                        const f32x2 tr = zr * (-1.4426950408889634f), ti = zi * (-1.4426950408889634f);
                        f32x2 er, ei; er.x = __builtin_amdgcn_exp2f(tr.x); er.y = __builtin_amdgcn_exp2f(tr.y); ei.x = __builtin_amdgcn_exp2f(ti.x); ei.y = __builtin_amdgcn_exp2f(ti.y);
                        const f32x2 dr = er + 1.0f, di = ei + 1.0f;
                        f32x2 rr, ii; rr.x = __builtin_amdgcn_rcpf(dr.x); rr.y = __builtin_amdgcn_rcpf(dr.y); ii.x = __builtin_amdgcn_rcpf(di.x); ii.y = __builtin_amdgcn_rcpf(di.y);
                        const f32x2 la = rr * (-8.0f * spv[nn]);
                        f32x2 oma = -la * (1.0f + 0.5f * la * (1.0f + 0.33333334f * la * (1.0f + 0.25f * la * (1.0f + 0.2f * la))));
                        if (__any(la.x < -0.25f || la.y < -0.25f)) {
                            oma.x = la.x < -0.25f ? 1.0f - __expf(la.x) : oma.x; oma.y = la.y < -0.25f ? 1.0f - __expf(la.y) : oma.y; }
                        const f32x2 om2 = oma * (2.0f - oma);
                        f32x2 mult; mult.x = __builtin_amdgcn_sqrtf(om2.x); mult.y = __builtin_amdgcn_sqrtf(om2.y);
                        const f32x2 xc2 = (f32x2){XC[wd * (64 * 68) + t * 68 + n], XC[wd * (64 * 68) + (t + 1) * 68 + n]};
                        const f32x2 uu = mult * ii * xc2;
                        Aa[wd * 4096 + t * 64 + n] = oma.x; Aa[wd * 4096 + (t + 1) * 64 + n] = oma.y; Uu[wd * 4096 + t * 64 + n] = uu.x; Uu[wd * 4096 + (t + 1) * 64 + n] = uu.y; }
                }
            }
            __syncthreads();
            { float A0 = 1.f, h0 = 0.f, A1 = 1.f, h1 = 0.f; unsigned pkf[8], pkb[8];
#pragma unroll
                for (int s2 = 0; s2 < 8; ++s2) { const int p = 8 * wave + s2, t0 = p, t1 = 63 - p;
                    const float om0 = Aa[t0 * 64 + lane], u0 = Uu[t0 * 64 + lane], om1 = Aa[4096 + t1 * 64 + lane], u1 = Uu[4096 + t1 * 64 + lane];
                    const float a0 = 1.0f - om0, a1 = 1.0f - om1;
                    pkf[s2] = pk2h(om0, u0); pkb[7 - s2] = pk2h(om1, u1);
                    h0 = a0 * h0 + u0; A0 *= a0; h1 = a1 * h1 + u1; A1 *= a1; }
                SUB[wave * 64 + lane] = (f32x2){A0, h0}; SUB[512 + wave * 64 + lane] = (f32x2){A1, h1};
                if (MODE == 1 && q >= 4) {
                    const size_t gA = (size_t)(rowbase0 + 8 * wave) >> 3, gB = (size_t)(rowbase0 + 8 * (7 - wave)) >> 3;
                    unsigned* pa = au + ((gA * 2) * 512 + 64 * h + lane) * 4; unsigned* pb = au + ((((size_t)(NTOK / 8) + gB) * 2) * 512 + 64 * h + lane) * 4;
                    *(u32x4*)pa = (u32x4){pkf[0], pkf[1], pkf[2], pkf[3]}; *(u32x4*)(pa + 2048) = (u32x4){pkf[4], pkf[5], pkf[6], pkf[7]};
                    *(u32x4*)pb = (u32x4){pkb[0], pkb[1], pkb[2], pkb[3]}; *(u32x4*)(pb + 2048) = (u32x4){pkb[4], pkb[5], pkb[6], pkb[7]}; } }
            __syncthreads();
            if (MODE == 1) {
                if (tid < 128) { const int d = tid >> 6, ch = tid & 63; float Ac = 1.f, hc = 0.f;
#pragma unroll
                    for (int s2 = 0; s2 < 8; ++s2) { const f32x2 c = SUB[d * 512 + s2 * 64 + ch]; hc = c.x * hc + c.y; Ac *= c.x; }
                    carry[(size_t)((d * NB + b) * NQ + q) * 512 + 64 * h + ch] = (f32x2){Ac, hc}; }
            } else {
                if (tid < 128) { const int d = tid >> 6, ch = tid & 63; float s2 = CIN[(d * 17 + jc) * 64 + ch];
#pragma unroll
                    for (int sb = 0; sb < 8; ++sb) { PRE[d * 512 + sb * 64 + ch] = s2; const f32x2 c = SUB[d * 512 + sb * 64 + ch]; s2 = c.x * s2 + c.y; } }
                __syncthreads();
                { float h0 = PRE[wave * 64 + lane], h1 = PRE[512 + wave * 64 + lane];
#pragma unroll
                    for (int s2 = 0; s2 < 8; ++s2) { const int p = 8 * wave + s2, t0 = p, t1 = 63 - p;
                        h0 = (1.0f - Aa[t0 * 64 + lane]) * h0 + Uu[t0 * 64 + lane]; Uu[t0 * 64 + lane] = h0;
                        h1 = (1.0f - Aa[4096 + t1 * 64 + lane]) * h1 + Uu[4096 + t1 * 64 + lane]; Uu[4096 + t1 * 64 + lane] = h1; } }
                __syncthreads();
                { const int t = tid >> 3, c8 = (tid & 7) * 8;
                    const LAS float* u1 = Uu + t * 64 + c8; const LAS float* u2 = Uu + 4096 + t * 64 + c8;
                    const f32x4 f0 = *(const LAS f32x4*)u1, f1 = *(const LAS f32x4*)(u1 + 4), b0 = *(const LAS f32x4*)u2, b1 = *(const LAS f32x4*)(u2 + 4);
                    u32x4 w;
                    w.x = pk2((f0.x + b0.x) * bf_lo(gl.x), (f0.y + b0.y) * bf_hi(gl.x)); w.y = pk2((f0.z + b0.z) * bf_lo(gl.y), (f0.w + b0.w) * bf_hi(gl.y));
                    w.z = pk2((f1.x + b1.x) * bf_lo(gl.z), (f1.y + b1.y) * bf_hi(gl.z)); w.w = pk2((f1.z + b1.z) * bf_lo(gl.w), (f1.w + b1.w) * bf_hi(gl.w));
                    *(u32x4*)(mix + (rowbase0 + t) * D + 512 + 64 * h + c8) = w; }
            }
        }
        if (MODE == 1) wg_publish((unsigned*)(a.ws + WS_BHCNT) + 64 * bh, tid);
        __syncthreads();
    }
}

__device__ __forceinline__ void lru_rescan(LAS unsigned char* lds, const Args& a, const int TID, const int BID, const int GD) {
    const int tid = TID, lane = tid & 63, wave = tid >> 6;
    const unsigned* au = (const unsigned*)(a.ws + WS_AU); const bf16_t* glg = (const bf16_t*)(a.ws + WS_GLG); bf16_t* mix = (bf16_t*)(a.ws + WS_MIX);
    const f32x2* carry = (const f32x2*)(a.ws + WS_CARRY);
    LAS f32x2* SUB = (LAS f32x2*)(lds + L_SUB); LAS float* PRE = (LAS float*)(lds + L_PRE); LAS float* CIN = (LAS float*)(lds + L_CIN);
    for (int vb = BID; vb < 256; vb += GD) {
        const int bh = vb >> 3, grp = vb & 7, b = bh >> 3, h = bh & 7;
        const int q0 = 4 + grp * 16, nq = 16;
        wg_wait((unsigned*)(a.ws + WS_BHCNT) + 64 * bh, 8u * (unsigned)(1 + ((a.dbg >> 11) & 1)), tid);
        if (tid < 128) {
            const int d = tid >> 6, ch = tid & 63;
            const f32x2* cp = carry + (size_t)((d * NB + b) * NQ) * 512 + 64 * h + ch;
            const int cnt = d == 0 ? q0 : (NQ + 4 - (q0 + nq));
            float s = 0.f;
            for (int i0 = 0; i0 < cnt; i0 += 32) {
                f32x2 c[32];
#pragma unroll
                for (int j = 0; j < 32; ++j) { const int ii = (i0 + j) < cnt ? (i0 + j) : (cnt - 1); c[j] = cp[(size_t)lru_seq(d, ii) * 512]; }
#pragma unroll
                for (int j = 0; j < 32; ++j) if (i0 + j < cnt) s = c[j].x * s + c[j].y;
            }
            f32x2 c[16];
#pragma unroll
            for (int j = 0; j < 16; ++j) c[j] = cp[(size_t)(q0 + j) * 512];
            if (d == 0) {
#pragma unroll
                for (int j = 0; j < 16; ++j) { CIN[(0 * 17 + j) * 64 + ch] = s; s = c[j].x * s + c[j].y; }
            } else {
#pragma unroll
                for (int j = 15; j >= 0; --j) { CIN[(1 * 17 + j) * 64 + ch] = s; s = c[j].x * s + c[j].y; }
            }
        }
        __syncthreads();
        const size_t cbase = (size_t)64 * h + lane;
        unsigned pfn[8], pbn[8]; bf16_t ggn[8];
        { const size_t rown = (size_t)b * SEQ + (size_t)(q0 - 4) * 64 + 8 * wave;
            { const u32x4* pa = (const u32x4*)(au + (((rown >> 3) * 2) * 512 + cbase) * 4); const u32x4* pb2 = (const u32x4*)(au + ((((size_t)(NTOK / 8) + (rown >> 3)) * 2) * 512 + cbase) * 4);
                const u32x4 f0 = __builtin_nontemporal_load(pa), f1 = __builtin_nontemporal_load(pa + 512), g0 = __builtin_nontemporal_load(pb2), g1 = __builtin_nontemporal_load(pb2 + 512);
                pfn[0] = f0.x; pfn[1] = f0.y; pfn[2] = f0.z; pfn[3] = f0.w; pfn[4] = f1.x; pfn[5] = f1.y; pfn[6] = f1.z; pfn[7] = f1.w;
                pbn[0] = g0.x; pbn[1] = g0.y; pbn[2] = g0.z; pbn[3] = g0.w; pbn[4] = g1.x; pbn[5] = g1.y; pbn[6] = g1.z; pbn[7] = g1.w; }
_Pragma("unroll")
            for (int s2 = 0; s2 < 8; ++s2) ggn[s2] = __builtin_nontemporal_load(glg + (rown + s2) * 512 + cbase); }
#pragma unroll 1
        for (int jc = 0; jc < nq; ++jc) {
            const size_t row0 = (size_t)b * SEQ + (size_t)(q0 - 4 + jc) * 64 + 8 * wave;
            unsigned pf[8], pb[8]; bf16_t gg[8];
#pragma unroll
            for (int s2 = 0; s2 < 8; ++s2) { pf[s2] = pfn[s2]; pb[s2] = pbn[s2]; gg[s2] = ggn[s2]; }
            if (jc + 1 < nq) { const size_t rown = row0 + 64;
                { const u32x4* pa = (const u32x4*)(au + (((rown >> 3) * 2) * 512 + cbase) * 4); const u32x4* pb2 = (const u32x4*)(au + ((((size_t)(NTOK / 8) + (rown >> 3)) * 2) * 512 + cbase) * 4);
                const u32x4 f0 = __builtin_nontemporal_load(pa), f1 = __builtin_nontemporal_load(pa + 512), g0 = __builtin_nontemporal_load(pb2), g1 = __builtin_nontemporal_load(pb2 + 512);
                pfn[0] = f0.x; pfn[1] = f0.y; pfn[2] = f0.z; pfn[3] = f0.w; pfn[4] = f1.x; pfn[5] = f1.y; pfn[6] = f1.z; pfn[7] = f1.w;
                pbn[0] = g0.x; pbn[1] = g0.y; pbn[2] = g0.z; pbn[3] = g0.w; pbn[4] = g1.x; pbn[5] = g1.y; pbn[6] = g1.z; pbn[7] = g1.w; }
_Pragma("unroll")
            for (int s2 = 0; s2 < 8; ++s2) ggn[s2] = __builtin_nontemporal_load(glg + (rown + s2) * 512 + cbase); }
            float af[8], uf[8], ab[8], ub[8];
#pragma unroll
            for (int s2 = 0; s2 < 8; ++s2) { const h2_t x = __builtin_bit_cast(h2_t, pf[s2]), y = __builtin_bit_cast(h2_t, pb[s2]);
                af[s2] = 1.0f - (float)x.x; uf[s2] = (float)x.y; ab[s2] = 1.0f - (float)y.x; ub[s2] = (float)y.y; }
            float A0 = 1.f, h0 = 0.f, A1 = 1.f, h1 = 0.f;
#pragma unroll
            for (int s2 = 0; s2 < 8; ++s2) { h0 = af[s2] * h0 + uf[s2]; A0 *= af[s2]; h1 = ab[7 - s2] * h1 + ub[7 - s2]; A1 *= ab[7 - s2]; }
            SUB[wave * 64 + lane] = (f32x2){A0, h0}; SUB[512 + (7 - wave) * 64 + lane] = (f32x2){A1, h1};
            __syncthreads();
            if (tid < 128) { const int d = tid >> 6, ch = tid & 63; float s2 = CIN[(d * 17 + jc) * 64 + ch];
#pragma unroll
                for (int sb = 0; sb < 8; ++sb) { PRE[d * 512 + sb * 64 + ch] = s2; const f32x2 c = SUB[d * 512 + sb * 64 + ch]; s2 = c.x * s2 + c.y; } }
            __syncthreads();
            float hf[8], hb[8];
            { float hc = PRE[wave * 64 + lane];
#pragma unroll
                for (int s2 = 0; s2 < 8; ++s2) { hc = af[s2] * hc + uf[s2]; hf[s2] = hc; }
                hc = PRE[512 + (7 - wave) * 64 + lane];
#pragma unroll
                for (int s2 = 7; s2 >= 0; --s2) { hc = ab[s2] * hc + ub[s2]; hb[s2] = hc; } }
#pragma unroll
            for (int s2 = 0; s2 < 8; ++s2) mix[(row0 + s2) * D + 512 + cbase] = (bf16_t)f2bf((hf[s2] + hb[s2]) * bf_lo(gg[s2]));
        }
        __syncthreads();
    }
}

__device__ __forceinline__ void phase6(LAS unsigned char* lds, const Args& a, const int TID, const int BID, const int GD) {
    const int tid = TID, lane = tid & 63, wave = tid >> 6, G = GD;
    const float* g2 = a.in[5]; const float* rw = a.in[23];
    const float* mod = (const float*)(a.ws + WS_MOD);
    unsigned char* V = a.ws + WS_V; float* affT = (float*)(a.ws + WS_AFFT); const bf16_t* X1b = (const bf16_t*)(a.ws + WS_X1B);
    constexpr int PITCH = 2048 + 16;
    LAS unsigned char* tHi = lds; LAS unsigned char* tLo = lds + 16 * PITCH; LAS float* part = (LAS float*)(lds + 32 * PITCH);
    const int l15 = lane & 15, l4 = lane >> 4;
    bf16x8 rh[4], rl[4];
#pragma unroll
    for (int s4 = 0; s4 < 4; ++s4) { float wv[8];
#pragma unroll
        for (int jj = 0; jj < 8; ++jj) wv[jj] = rw[(size_t)(128 * wave + 32 * s4 + 8 * l4 + jj) * 16 + l15];
        u32x4 h; h.x = pk2(wv[0], wv[1]); h.y = pk2(wv[2], wv[3]); h.z = pk2(wv[4], wv[5]); h.w = pk2(wv[6], wv[7]);
        u32x4 l; l.x = pk2(wv[0] - bf_lo(h.x), wv[1] - bf_hi(h.x)); l.y = pk2(wv[2] - bf_lo(h.y), wv[3] - bf_hi(h.y)); l.z = pk2(wv[4] - bf_lo(h.z), wv[5] - bf_hi(h.z)); l.w = pk2(wv[6] - bf_lo(h.w), wv[7] - bf_hi(h.w));
        rh[s4] = __builtin_bit_cast(bf16x8, h); rl[s4] = __builtin_bit_cast(bf16x8, l); }
    const int stride6 = G * NWAVES, row6 = BID * NWAVES + wave;
    u32x2 mn[4], mn2[4];
#pragma unroll
    for (int i = 0; i < 4; ++i) { const int rl0 = row6 < NTOK ? row6 : 0, rl1 = row6 + stride6 < NTOK ? row6 + stride6 : 0;
        mn[i] = __builtin_nontemporal_load((const u32x2*)(X1b + (size_t)rl0 * D + 4 * (lane + 64 * i))); mn2[i] = __builtin_nontemporal_load((const u32x2*)(X1b + (size_t)rl1 * D + 4 * (lane + 64 * i))); }
    int bcur = -1; f32x4 mg[4], ms[4];
#pragma unroll 1
    for (int it0 = 0; BID * NWAVES + it0 * stride6 < NTOK; it0 += 2) {
#pragma unroll 1
        for (int s2 = 0; s2 < 2; ++s2) {
            const int row = row6 + (it0 + s2) * stride6;
            LAS unsigned char* th = tHi + (s2 * 8 + wave) * PITCH; LAS unsigned char* tl = tLo + (s2 * 8 + wave) * PITCH;
            if (row < NTOK) {
                const int b = row >> 13;
                if (b != bcur) { bcur = b; const float* sh = mod + b * 6144 + 3072; const float* scl = mod + b * 6144 + 4096;
#pragma unroll
                    for (int i = 0; i < 4; ++i) { ms[i] = *(const f32x4*)(sh + 4 * (lane + 64 * i)); mg[i] = *(const f32x4*)(g2 + 4 * (lane + 64 * i)) * (*(const f32x4*)(scl + 4 * (lane + 64 * i)) + 1.0f); } }
                f32x4 v[4]; float ss = 0.f;
#pragma unroll
                for (int i = 0; i < 4; ++i) { const u32x2 mw = mn[i]; v[i] = (f32x4){bf_lo(mw.x), bf_hi(mw.x), bf_lo(mw.y), bf_hi(mw.y)}; mn[i] = mn2[i]; }
                { const int rn = row + 2 * stride6 < NTOK ? row + 2 * stride6 : 0;
#pragma unroll
                    for (int i = 0; i < 4; ++i) mn2[i] = __builtin_nontemporal_load((const u32x2*)(X1b + (size_t)rn * D + 4 * (lane + 64 * i))); }
#pragma unroll
                for (int i = 0; i < 4; ++i) ss += v[i].x * v[i].x + v[i].y * v[i].y + v[i].z * v[i].z + v[i].w * v[i].w;
                ss = wave_sum(ss);
                const float r = rsqrtf(ss * (1.0f / D) + 1e-6f);
#pragma unroll
                for (int i = 0; i < 4; ++i) {
                    v[i] = (v[i] * r) * mg[i] + ms[i];
                    *(unsigned*)(V + (size_t)row * D + 4 * (lane + 64 * i)) = pk4_fp8(v[i].x, v[i].y, v[i].z, v[i].w);
                    u32x2 h; h.x = pk2(v[i].x, v[i].y); h.y = pk2(v[i].z, v[i].w);
                    u32x2 l; l.x = pk2(v[i].x - bf_lo(h.x), v[i].y - bf_hi(h.x)); l.y = pk2(v[i].z - bf_lo(h.y), v[i].w - bf_hi(h.y));
                    *(LAS u32x2*)(th + 8 * (lane + 64 * i)) = h; *(LAS u32x2*)(tl + 8 * (lane + 64 * i)) = l;
                }
            } else {
#pragma unroll
                for (int i = 0; i < 4; ++i) { *(LAS u32x2*)(th + 8 * (lane + 64 * i)) = (u32x2){0u, 0u}; *(LAS u32x2*)(tl + 8 * (lane + 64 * i)) = (u32x2){0u, 0u}; }
            }
        }
        __syncthreads();
        {
            f32x4 acc = (f32x4){0.f, 0.f, 0.f, 0.f};
#pragma unroll
            for (int s4 = 0; s4 < 4; ++s4) {
                const int off = l15 * PITCH + (128 * wave + 32 * s4 + 8 * l4) * 2;
                const bf16x8 vh = *(const LAS bf16x8*)(tHi + off), vl = *(const LAS bf16x8*)(tLo + off);
                acc = __builtin_amdgcn_mfma_f32_16x16x32_bf16(rh[s4], vh, acc, 0, 0, 0);
                acc = __builtin_amdgcn_mfma_f32_16x16x32_bf16(rh[s4], vl, acc, 0, 0, 0);
                acc = __builtin_amdgcn_mfma_f32_16x16x32_bf16(rl[s4], vh, acc, 0, 0, 0);
            }
            *(LAS f32x4*)(part + (wave * 64 + lane) * 4) = acc;
        }
        __syncthreads();
        if (wave == 0) {
            f32x4 lg = *(const LAS f32x4*)(part + lane * 4);
#pragma unroll
            for (int w = 1; w < 8; ++w) lg = lg + *(const LAS f32x4*)(part + (w * 64 + lane) * 4);
            float mx = fmaxf(fmaxf(lg.x, lg.y), fmaxf(lg.z, lg.w));
            mx = fmaxf(mx, __shfl_xor(mx, 16)); mx = fmaxf(mx, __shfl_xor(mx, 32));
            f32x4 ex; ex.x = __expf(lg.x - mx); ex.y = __expf(lg.y - mx); ex.z = __expf(lg.z - mx); ex.w = __expf(lg.w - mx);
            float den = (ex.x + ex.y) + (ex.z + ex.w);
            den += __shfl_xor(den, 16); den += __shfl_xor(den, 32);
            const float inv = 1.0f / den;
            const int rowo = BID * NWAVES + (l15 & 7) + (it0 + (l15 >> 3)) * stride6;
            if (rowo < NTOK) { const int b = rowo >> 13, t = rowo & (SEQ - 1);
                float* dst = affT + (size_t)(b * 16 + 4 * l4) * SEQ + t;
                dst[0] = ex.x * inv; dst[SEQ] = ex.y * inv; dst[2 * SEQ] = ex.z * inv; dst[3 * SEQ] = ex.w * inv; }
        }
    }
    __syncthreads();
}

__device__ __forceinline__ int block_excl_scan(int v, LAS int* wsum, int tid, int& total) {
    const int lane = tid & 63, wave = tid >> 6;
    int inc = v;
#pragma unroll
    for (int o = 1; o < 64; o <<= 1) { const int t = __shfl_up(inc, o); if (lane >= o) inc += t; }
    __syncthreads();
    if (lane == 63) wsum[wave] = inc;
    __syncthreads();
    int base = 0, tot = 0;
#pragma unroll
    for (int w = 0; w < 8; ++w) { const int s = wsum[w]; if (w < wave) base += s; tot += s; }
    total = tot;
    return base + inc - v;
}
__device__ __forceinline__ void phase7(LAS unsigned char* lds, const Args& a, const int TID, const int BID, const int GD) {
    const int tid = TID, lane = tid & 63, wave = tid >> 6, G = GD;
    const float* affT = (const float*)(a.ws + WS_AFFT);
    int* idxE = (int*)(a.ws + WS_IDXE); float* gateE = (float*)(a.ws + WS_GATEE); int* inv = (int*)(a.ws + WS_INV);
    LAS unsigned* hist = (LAS unsigned*)lds;
    LAS unsigned* selw = hist + 256;
    LAS int* wsum = (LAS int*)(hist + 264);
    for (int unit = BID; unit < NB * NE; unit += G) {
        const int b = unit >> 4, e = unit & 15;
        const float* src = affT + (size_t)unit * SEQ + 16 * tid;
        unsigned key[16];
#pragma unroll
        for (int i = 0; i < 4; ++i) { const f32x4 v = *(const f32x4*)(src + 4 * i); const float f0 = v[0], f1 = v[1], f2 = v[2], f3 = v[3]; key[4 * i + 0] = __float_as_uint(f0); key[4 * i + 1] = __float_as_uint(f1); key[4 * i + 2] = __float_as_uint(f2); key[4 * i + 3] = __float_as_uint(f3); }
        unsigned prefix = 0u, mask = 0u, rem = CAP;
#pragma unroll 1
        for (int pass = 0; pass < 4; ++pass) {
            const int shift = 24 - 8 * pass;
            if (tid < 256) hist[tid] = 0u;
            __syncthreads();
#pragma unroll
            for (int j = 0; j < 16; ++j) if ((key[j] & mask) == prefix) __hip_atomic_fetch_add(&hist[(key[j] >> shift) & 255u], 1u, __ATOMIC_RELAXED, __HIP_MEMORY_SCOPE_WORKGROUP);
            __syncthreads();
            if (wave == 0) {
                const unsigned c0 = hist[4 * lane], c1 = hist[4 * lane + 1], c2 = hist[4 * lane + 2], c3 = hist[4 * lane + 3];
                const unsigned s = c0 + c1 + c2 + c3; unsigned v = s;
#pragma unroll
                for (int o = 1; o < 64; o <<= 1) { const unsigned t = __shfl_down(v, o); if (lane + o < 64) v += t; }
                const unsigned above = v - s;
                if (above < rem && rem <= above + s) {
                    unsigned cum = above, bin, nr;
                    if (cum + c3 >= rem) { bin = 4 * lane + 3; nr = rem - cum; }
                    else { cum += c3; if (cum + c2 >= rem) { bin = 4 * lane + 2; nr = rem - cum; }
                        else { cum += c2; if (cum + c1 >= rem) { bin = 4 * lane + 1; nr = rem - cum; } else { cum += c1; bin = 4 * lane; nr = rem - cum; } } }
                    selw[0] = bin; selw[1] = nr;
                }
            }
            __syncthreads();
            prefix |= selw[0] << shift; mask |= 255u << shift; rem = selw[1];
            __syncthreads();
        }
        const unsigned thr = prefix;
        int ceq = 0;
#pragma unroll
        for (int j = 0; j < 16; ++j) ceq += (key[j] == thr) ? 1 : 0;
        int tot; const int eqbase = block_excl_scan(ceq, wsum, tid, tot);
        unsigned selm = 0u; int er = eqbase, cs = 0;
#pragma unroll
        for (int j = 0; j < 16; ++j) { bool s = key[j] > thr; if (key[j] == thr) { s = (unsigned)er < rem; ++er; } if (s) { selm |= 1u << j; ++cs; } }
        int slot = block_excl_scan(cs, wsum, tid, tot);
#pragma unroll
        for (int j = 0; j < 16; ++j) { const int t = 16 * tid + j; const bool s = (selm >> j) & 1u;
            inv[(size_t)(b * SEQ + t) * 16 + e] = s ? slot : -1;
            if (s) { const int ro = e * ROWS_E + b * CAP + slot; idxE[ro] = b * SEQ + t; gateE[ro] = __uint_as_float(key[j]); ++slot; } }
        __syncthreads();
    }
}


__device__ __forceinline__ void phase10(const Args& a, const int TID, const int BID, const int GD) {
    const int lane = TID & 63, wave = TID >> 6;
    float* xo = a.out; const float* fg = a.in[27];
    const float* mod = (const float*)(a.ws + WS_MOD);
    const bf16_t* X1b = (const bf16_t*)(a.ws + WS_X1B);
    const unsigned char* Y = a.ws + WS_WGUT; const int* inv = (const int*)(a.ws + WS_INV);
    f32x4 gg[4];
#pragma unroll
    for (int i = 0; i < 4; ++i) gg[i] = *(const f32x4*)(fg + 4 * (lane + 64 * i));
    const int row0 = BID * NWAVES + wave, rstride = GD * NWAVES;
    auto issue_y = [&](int row, int slots, unsigned long long& bal, unsigned (&yw)[4][4]) {
        const int b = row >> 13;
        bal = __ballot(lane < 16 && slots >= 0);
        unsigned long long bb = bal;
#pragma unroll
        for (int q = 0; q < 4; ++q) {
            int e = -1; if (bb) { e = (int)__builtin_ctzll(bb); bb &= bb - 1; }
            const int es = e < 0 ? 0 : e; const int sl = __shfl(slots, es);
            const unsigned char* yr = Y + (size_t)(es * ROWS_E + b * CAP + (sl < 0 ? 0 : sl)) * D;
#pragma unroll
            for (int i = 0; i < 4; ++i) { yw[q][i] = 0u; if (e >= 0) yw[q][i] = __builtin_nontemporal_load((const unsigned*)(yr + 4 * (lane + 64 * i))); }
        }
    };
    int sl_cur = (row0 < NTOK) ? inv[(size_t)row0 * 16 + (lane & 15)] : -1;
    int sl_nxt = (row0 + rstride < NTOK) ? inv[(size_t)(row0 + rstride) * 16 + (lane & 15)] : -1;
    u32x2 xnx[4]; unsigned ywn[4][4]; unsigned long long baln = 0ull;
#pragma unroll
    for (int i = 0; i < 4; ++i) xnx[i] = __builtin_nontemporal_load((const u32x2*)(X1b + (size_t)(row0 < NTOK ? row0 : 0) * D + 4 * (lane + 64 * i)));
    issue_y(row0 < NTOK ? row0 : 0, sl_cur, baln, ywn);
    int bcur = -1; f32x4 gq[4];
#pragma unroll 1
    for (int row = row0; row < NTOK; row += rstride) {
        const int b = row >> 13;
        if (b != bcur) { bcur = b; const float* g5 = mod + b * 6144 + 5120;
#pragma unroll
            for (int i = 0; i < 4; ++i) gq[i] = *(const f32x4*)(g5 + 4 * (lane + 64 * i)) * (1.0f / 32.0f); }
        const int slot_cur = sl_cur;
        u32x2 xw[4]; unsigned yw[4][4]; unsigned long long bal = baln;
#pragma unroll
        for (int i = 0; i < 4; ++i) xw[i] = xnx[i];
#pragma unroll
        for (int q = 0; q < 4; ++q)
#pragma unroll
            for (int i = 0; i < 4; ++i) yw[q][i] = ywn[q][i];
        sl_cur = sl_nxt;
        if (row + rstride < NTOK) {
            if (row + 2 * rstride < NTOK) sl_nxt = inv[(size_t)(row + 2 * rstride) * 16 + (lane & 15)];
#pragma unroll
            for (int i = 0; i < 4; ++i) xnx[i] = __builtin_nontemporal_load((const u32x2*)(X1b + (size_t)(row + rstride) * D + 4 * (lane + 64 * i)));
            issue_y(row + rstride, sl_cur, baln, ywn);
        }
        f32x4 mo[4];
#pragma unroll
        for (int i = 0; i < 4; ++i) mo[i] = (f32x4){0.f, 0.f, 0.f, 0.f};
#pragma unroll
        for (int q = 0; q < 4; ++q)
#pragma unroll
            for (int i = 0; i < 4; ++i) { const f32x2 lo = __builtin_amdgcn_cvt_pk_f32_fp8((int)yw[q][i], false), hi = __builtin_amdgcn_cvt_pk_f32_fp8((int)yw[q][i], true);
                mo[i].x += lo.x; mo[i].y += lo.y; mo[i].z += hi.x; mo[i].w += hi.y; }
        { int k4 = 0; while (bal && k4 < 4) { bal &= bal - 1; ++k4; } }
        while (bal) {
            const int e = (int)__builtin_ctzll(bal); bal &= bal - 1;
            const int sl = __shfl(slot_cur, e);
            const unsigned char* yr = Y + (size_t)(e * ROWS_E + b * CAP + (sl < 0 ? 0 : sl)) * D;
#pragma unroll
            for (int i = 0; i < 4; ++i) { const unsigned w = __builtin_nontemporal_load((const unsigned*)(yr + 4 * (lane + 64 * i)));
                const f32x2 lo = __builtin_amdgcn_cvt_pk_f32_fp8((int)w, false), hi = __builtin_amdgcn_cvt_pk_f32_fp8((int)w, true);
                mo[i].x += lo.x; mo[i].y += lo.y; mo[i].z += hi.x; mo[i].w += hi.y; }
        }
        f32x4 v[4]; float ss = 0.f;
#pragma unroll
        for (int i = 0; i < 4; ++i) { const f32x4 g = gq[i];
            v[i] = (f32x4){bf_lo(xw[i].x), bf_hi(xw[i].x), bf_lo(xw[i].y), bf_hi(xw[i].y)};
            v[i] = v[i] + g * mo[i];
            ss += v[i].x * v[i].x + v[i].y * v[i].y + v[i].z * v[i].z + v[i].w * v[i].w; }
        ss = wave_sum(ss);
        const float r = rsqrtf(ss * (1.0f / D) + 1e-6f);
#pragma unroll
        for (int i = 0; i < 4; ++i) *(f32x4*)(xo + (size_t)row * D + 4 * (lane + 64 * i)) = (v[i] * r) * gg[i];
    }
}

#define XB_TMO      128
#define XB_XCNT(j)  (256  + 64 * (j))
#define XB_XSUB(j)  (1280 + 64 * (j))
#define XB_XGEN(j)  (2304 + 64 * (j))
#define XB_TOP      3328
#define XB_TOPGEN   3392
#define XCD_BAR_WORDS 3456
#define XB_SPIN_CAP (1u << 18)
__device__ __forceinline__ unsigned xb_ld(unsigned* p)              { return __hip_atomic_load(p, __ATOMIC_RELAXED, __HIP_MEMORY_SCOPE_AGENT); }
__device__ __forceinline__ unsigned xb_add(unsigned* p, unsigned v) { return __hip_atomic_fetch_add(p, v, __ATOMIC_RELAXED, __HIP_MEMORY_SCOPE_AGENT); }
__device__ __forceinline__ unsigned xb_xcc_id() { return (unsigned)__builtin_amdgcn_s_getreg((3 << 11) | 20) & 0xFu; }
#define XB_SPIN(cond, bar) do { unsigned _sp = 0; while (cond) { __builtin_amdgcn_s_sleep(1); \
    if ((++_sp & 255u) == 0u) { if (xb_ld(&(bar)[XB_TMO])) break; if (_sp > XB_SPIN_CAP) { atomicAdd(&(bar)[XB_TMO], 1u); break; } } } } while (0)
struct XcdBarrier { unsigned* bar; unsigned x; volatile LAS unsigned* st; };

__device__ __forceinline__ int lane_id_opaque() { unsigned m = ~0u; asm volatile("" : "+s"(m)); return (int)__builtin_amdgcn_mbcnt_hi(m, __builtin_amdgcn_mbcnt_lo(m, 0u)); }
__device__ __forceinline__ XcdBarrier xcd_barrier_post(unsigned* bar, volatile LAS unsigned* st, int tid) {
    XcdBarrier b; b.bar = bar; b.x = xb_xcc_id(); b.st = st;
    if (tid == 0) (void)xb_add(&bar[XB_XCNT(b.x)], 1u);
    return b;
}
__device__ __forceinline__ void xcd_barrier_complete(unsigned* bar, unsigned x, unsigned G, unsigned& nloc, unsigned& nx) {
    unsigned sum, cnt, mine, sp = 0u;
    for (;;) {
        sum = 0u; cnt = 0u; mine = 0u;
#pragma unroll
        for (unsigned j = 0; j < 16; ++j) { const unsigned c = xb_ld(&bar[XB_XCNT(j)]); sum += c; cnt += (c > 0u) ? 1u : 0u; mine = (j == x) ? c : mine; }
        if (sum == G) break;
        __builtin_amdgcn_s_sleep(1);
        if ((++sp & 255u) == 0u) { if (xb_ld(&bar[XB_TMO])) break; if (sp > XB_SPIN_CAP) { atomicAdd(&bar[XB_TMO], 1u); break; } }
    }
    nloc = mine > 0u ? mine : 1u; nx = cnt > 0u ? cnt : 1u;
}
__device__ __forceinline__ void xcd_barrier(const XcdBarrier& b, int tid, unsigned G) {
    asm volatile("s_waitcnt vmcnt(0)" ::: "memory");
    __syncthreads();
    if (tid == 0) {
        unsigned* bar = b.bar;
        __builtin_amdgcn_s_waitcnt(0);
        unsigned nloc = b.st[0], nx = b.st[1];
        if (nloc == 0u) { xcd_barrier_complete(bar, b.x, G, nloc, nx); b.st[0] = nloc; b.st[1] = nx; }
        const unsigned old = xb_add(&bar[XB_XSUB(b.x)], 1u);
        const unsigned gen = old / nloc;
        if (old + 1u == (gen + 1u) * nloc) {
            __builtin_amdgcn_fence(__ATOMIC_RELEASE, "agent");
            asm volatile("s_waitcnt vmcnt(0)" ::: "memory");
            const unsigned og = xb_add(&bar[XB_TOP], 1u);
            const unsigned tg = og / nx;
            if (og + 1u == (tg + 1u) * nx) xb_add(&bar[XB_TOPGEN], 1u);
            else XB_SPIN(xb_ld(&bar[XB_TOPGEN]) == tg, bar);
            __builtin_amdgcn_fence(__ATOMIC_ACQUIRE, "agent");
            xb_add(&bar[XB_XGEN(b.x)], 1u);
            asm volatile("s_waitcnt vmcnt(0)" ::: "memory");
        } else {
            XB_SPIN(xb_ld(&bar[XB_XGEN(b.x)]) == gen, bar);
            __builtin_amdgcn_fence(__ATOMIC_ACQUIRE, "agent");
            asm volatile("s_waitcnt vmcnt(0)" ::: "memory");
        }
    }
    __syncthreads();
}
template <int KIND>
__device__ __forceinline__ void xcd_barrier_work(const XcdBarrier& b, LAS unsigned char* lds, const Args& a, const int tid, const unsigned G) {
    asm volatile("s_waitcnt vmcnt(0)" ::: "memory");
    __syncthreads();
    volatile LAS unsigned* fl = (volatile LAS unsigned*)(lds + 8 * 8704 + 128);
    const int lo0 = KIND == 1 ? cv1_early((int)G) : cv2_early((int)G), hi = KIND == 1 ? CV_TOTAL1 : CV_TOTAL2, lo = lo0 < hi ? lo0 : hi;
    unsigned* ctr = (unsigned*)(a.ws + WS_CVCNT) + 64 * (KIND - 1);
    unsigned* bar = b.bar;
    unsigned gen = 0u; bool pending = false;
    if (tid == 0) {
        __builtin_amdgcn_s_waitcnt(0);
        unsigned nloc = b.st[0], nx = b.st[1];
        if (nloc == 0u) { xcd_barrier_complete(bar, b.x, G, nloc, nx); b.st[0] = nloc; b.st[1] = nx; }
        const unsigned old = xb_add(&bar[XB_XSUB(b.x)], 1u);
        gen = old / nloc;
        if (old + 1u == (gen + 1u) * nloc) {
            __builtin_amdgcn_fence(__ATOMIC_RELEASE, "agent");
            asm volatile("s_waitcnt vmcnt(0)" ::: "memory");
            const unsigned og = xb_add(&bar[XB_TOP], 1u);
            const unsigned tg = og / nx;
            if (og + 1u == (tg + 1u) * nx) xb_add(&bar[XB_TOPGEN], 1u);
            else XB_SPIN(xb_ld(&bar[XB_TOPGEN]) == tg, bar);
            __builtin_amdgcn_fence(__ATOMIC_ACQUIRE, "agent");
            xb_add(&bar[XB_XGEN(b.x)], 1u);
            asm volatile("s_waitcnt vmcnt(0)" ::: "memory");
        } else pending = true;
    }
#pragma unroll 1
    for (;;) {
        if (tid == 0) {
            unsigned state = 0u;
            if (pending) {
                if (xb_ld(&bar[XB_XGEN(b.x)]) != gen || xb_ld(&bar[XB_TMO]) != 0u) pending = false;
                else {
                    const unsigned base = __hip_atomic_fetch_add(ctr, (unsigned)CV_CHUNK, __ATOMIC_RELAXED, __HIP_MEMORY_SCOPE_AGENT);
                    if (lo + (int)base >= hi) { XB_SPIN(xb_ld(&bar[XB_XGEN(b.x)]) == gen, bar); pending = false; }
                    else { state = 1u; fl[1] = base; }
                }
                if (!pending) { __builtin_amdgcn_fence(__ATOMIC_ACQUIRE, "agent"); asm volatile("s_waitcnt vmcnt(0)" ::: "memory"); }
            }
            fl[0] = state;
        }
        __syncthreads();
        const unsigned st = fl[0]; const int base = lo + (int)fl[1];
        __syncthreads();
        if (st == 0u) break;
        convert_range(lds, a, KIND, base, base + CV_CHUNK < hi ? base + CV_CHUNK : hi, tid >> 6, NWAVES, tid >> 6, tid & 63);
    }
}
template <int KIND>
__device__ __forceinline__ void wg_wait_work(unsigned* cnt, const unsigned target, LAS unsigned char* lds, const Args& a, const int tid, const int GD) {
    volatile LAS unsigned* fl = (volatile LAS unsigned*)(lds + 8 * 8704 + 128);
    const int hi = KIND == 1 ? CV_TOTAL1 : CV_TOTAL2, lo = 0;
    unsigned* ctr = (unsigned*)(a.ws + WS_CVCNT) + 64 * (KIND - 1);
    __syncthreads();
#pragma unroll 1
    for (;;) {
        if (tid == 0) {
            unsigned state = 0u;
            if (__hip_atomic_load(cnt, __ATOMIC_RELAXED, __HIP_MEMORY_SCOPE_AGENT) < target) {
                const unsigned base = __hip_atomic_fetch_add(ctr, (unsigned)CV_CHUNK, __ATOMIC_RELAXED, __HIP_MEMORY_SCOPE_AGENT);
                if (lo + (int)base >= hi) { unsigned sp = 0; while (__hip_atomic_load(cnt, __ATOMIC_RELAXED, __HIP_MEMORY_SCOPE_AGENT) < target && ++sp < (1u << 22)) __builtin_amdgcn_s_sleep(2); }
                else { state = 1u; fl[1] = base; }
            }
            if (state == 0u) { __builtin_amdgcn_fence(__ATOMIC_ACQUIRE, "agent"); asm volatile("s_waitcnt vmcnt(0)" ::: "memory"); }
            fl[0] = state;
        }
        __syncthreads();
        const unsigned st = fl[0]; const int base = lo + (int)fl[1];
        __syncthreads();
        if (st == 0u) break;
        convert_range(lds, a, KIND, base, base + CV_CHUNK < hi ? base + CV_CHUNK : hi, tid >> 6, NWAVES, tid >> 6, tid & 63);
    }
    (void)GD;
}
constexpr int BAR_LDS_OFF = LDS_BYTES - 64;
constexpr size_t WS_BAR = WS_CTL + 16384;

typedef const __attribute__((address_space(4))) Args* ArgsP;
#ifndef TS_A
#define TS_A -2
#define TS_B -2
#endif
#if TS_A > -2
constexpr size_t WS_TS = WS_CTL + 61440;
__device__ __forceinline__ void ts_mark(unsigned char* ws, int ph, int wv) {
    __syncthreads();
    asm volatile("" : "+s"(wv));
    if (wv == 0 && lane_id_opaque() == 0) { const unsigned long long t = wall_clock64();
        atomicMax((unsigned long long*)(ws + WS_TS) + ph, t); atomicMax((unsigned long long*)(ws + WS_TS) + 16 + ph, ~t); }
}
__device__ __forceinline__ long long ts_value(unsigned char* ws, int id) {
    const unsigned long long* p = (const unsigned long long*)(ws + WS_TS);
    if (id < 0) return 0;
    const int k = id & 15;
    const unsigned long long ek = __hip_atomic_load(p + k, __ATOMIC_RELAXED, __HIP_MEMORY_SCOPE_AGENT);
    const unsigned long long st0 = ~__hip_atomic_load(p + 16 + 15, __ATOMIC_RELAXED, __HIP_MEMORY_SCOPE_AGENT);
    if (id >= 512) return (long long)(~__hip_atomic_load(p + 16 + (((id - 512) >> 4) & 15), __ATOMIC_RELAXED, __HIP_MEMORY_SCOPE_AGENT) - __hip_atomic_load(p + (id & 15), __ATOMIC_RELAXED, __HIP_MEMORY_SCOPE_AGENT));
    if (id >= 64) return (long long)(__hip_atomic_load(p + (((id - 64) >> 4) & 15), __ATOMIC_RELAXED, __HIP_MEMORY_SCOPE_AGENT) - __hip_atomic_load(p + (id & 15), __ATOMIC_RELAXED, __HIP_MEMORY_SCOPE_AGENT));
    if (id >= 48) return (long long)(~__hip_atomic_load(p + 16 + k, __ATOMIC_RELAXED, __HIP_MEMORY_SCOPE_AGENT) - st0);
    if (id >= 32) return (long long)(ek - st0);
    if (id >= 16) return (long long)(ek - ~__hip_atomic_load(p + 16 + k, __ATOMIC_RELAXED, __HIP_MEMORY_SCOPE_AGENT));
    const unsigned long long prev = k == 0 ? ~__hip_atomic_load(p + 16 + 15, __ATOMIC_RELAXED, __HIP_MEMORY_SCOPE_AGENT) : __hip_atomic_load(p + k - 1, __ATOMIC_RELAXED, __HIP_MEMORY_SCOPE_AGENT);
    return (long long)(ek - prev);
}
#endif
template <int PH>
__device__ __forceinline__ void do_phase(LAS unsigned char* lds, const Args& a_in, const int wave_id_s) {
#if defined(__HIP_DEVICE_COMPILE__)
    ArgsP ap = (ArgsP)__builtin_amdgcn_kernarg_segment_ptr();
    asm volatile("" : "+s"(ap));
    const Args a = *ap;
#else
    const Args a = a_in;
#endif
    const int nrep = 1 + ((a.dbg >> (8 + PH)) & 1);
#pragma unroll 1
    for (int rep = 0; rep < nrep; ++rep) {
        int WID = wave_id_s, BID = blockIdx.x, GD = gridDim.x;
        asm volatile("" : "+s"(WID), "+s"(BID), "+s"(GD));
        const int TID = WID * 64 + lane_id_opaque();
        const int G = GD;
        unsigned char* ws = a.ws;
        if constexpr (PH == 0) { phase0(lds, a, TID, BID, GD);
#if TS_A > -2
            ts_mark(ws, 12, WID);
#endif
            if (rep == nrep - 1) { wg_wait_work<1>((unsigned*)(ws + WS_ADACNT), 96u * (unsigned)nrep, lds, a, TID, GD);
#if TS_A > -2
            ts_mark(ws, 11, WID);
#endif
            phase1(a, TID, BID, GD); } }
        else if constexpr (PH == 1) { }
        else if constexpr (PH == 2) {
            if (BID & 1) { convert_items_dyn(lds, a, 1, -1, TID, GD); __syncthreads(); }
            pg8::SchedInProj S{G, BID};
            EpiInProj E{(bf16_t*)(ws + WS_XGP), (bf16_t*)(ws + WS_XLX), (bf16_t*)(ws + WS_GLG), a.in[9]};
            pg8::gemm_phase<EpiInProj, pg8::SchedInProj, false>(lds, (const bf16_t*)(ws + WS_U), (const bf16_t*)(ws + WS_WINT), 1024, S, E, nullptr, TID, BID, GD, 0x7F7F7F7F, pg8::lay_rowmajor(1024));
            __syncthreads(); convert_items_dyn(lds, a, 1, 1 << 30, TID, GD);
        } else if constexpr (PH == 3) {
            {
                pg8::SchedCtx S{BID};
                EpiInProj E{(bf16_t*)(ws + WS_XGP), (bf16_t*)(ws + WS_XLX), (bf16_t*)(ws + WS_GLG), a.in[9]};
                pg8::gemm_phase<EpiInProj, pg8::SchedCtx, false>(lds, (const bf16_t*)(ws + WS_U), (const bf16_t*)(ws + WS_WINT), 1024, S, E, nullptr, TID, BID, GD, 0x7F7F7F7F, pg8::lay_rowmajor(1024));
                if ((BID & 7) == 7 && (BID >> 3) < 8) {
                    asm volatile("s_waitcnt vmcnt(0)" ::: "memory");
                    __syncthreads();
                    if (TID == 0) { __builtin_amdgcn_fence(__ATOMIC_RELEASE, "agent"); asm volatile("s_waitcnt vmcnt(0)" ::: "memory");
                        __hip_atomic_store((unsigned*)(ws + WS_CTXFLAG) + 64 * (BID >> 3), 1u, __ATOMIC_RELAXED, __HIP_MEMORY_SCOPE_AGENT); }
                }
            }
            conv_units(lds, a, BID, G, TID, BID, GD);
#if TS_A > -2
            ts_mark(ws, 13, WID);
#endif
            lru_phase<1>(lds, a, TID, BID, GD);
#if TS_A > -2
            ts_mark(ws, 14, WID);
#endif
            if (rep == nrep - 1) { __syncthreads(); lru_rescan(lds, a, TID, BID, GD); }
        } else if constexpr (PH == 4) {
        } else if constexpr (PH == 5) {
            pg8::Sched S{128, 4, 1, G, BID};
            EpiOutProj E{(bf16_t*)(ws + WS_X1B), a.in[0], (const float*)(ws + WS_MOD), a.in[22]};
            pg8::gemm_phase<EpiOutProj, pg8::Sched, false>(lds, (const bf16_t*)(ws + WS_MIX), (const bf16_t*)(ws + WS_WOUTT), 1024, S, E, nullptr, TID, BID, GD, 0x7F7F7F7F, pg8::lay_rowmajor(1024));
        } else if constexpr (PH == 6) phase6(lds, a, TID, BID, GD);
        else if constexpr (PH == 7) phase7(lds, a, TID, BID, GD);
        else if constexpr (PH == 8) {
            if (BID & 1) { convert_items_dyn(lds, a, 2, -1, TID, GD); __syncthreads(); }
            pg8::Sched S{16, 22, 16, G, BID};
            EpiExpUp E{ws + WS_R1};
            pg8::gemm_phase<EpiExpUp, pg8::Sched, true, true>(lds, (const bf16_t*)(ws + WS_V), (const bf16_t*)(ws + WS_WGUT), 512, S, E, (const int*)(ws + WS_IDXE), TID, BID, GD, 0x7A7A7A7A, pg8::lay_rowmajor(512));
            __syncthreads(); convert_items_dyn(lds, a, 2, 1 << 30, TID, GD);
        } else if constexpr (PH == 9) {
            pg8::SchedDown S{G, BID};
            EpiExpDown E{ws + WS_WGUT, (const float*)(ws + WS_GATEE)};
            pg8::gemm_phase<EpiExpDown, pg8::SchedDown, false, true>(lds, (const bf16_t*)(ws + WS_R1), (const bf16_t*)(ws + WS_WDT), DE / 2, S, E, nullptr, TID, BID, GD, 0x79797979, pg8::lay_blocked(22));
        } else if constexpr (PH == 10) phase10(a, TID, BID, GD);
    }
}
template <int PH, int PH0, int PH1>
__device__ __forceinline__ void run_phases(LAS unsigned char* lds, const Args& a_in, const int wave_id_s) {
    if constexpr (PH < PH1) {
        if constexpr (PH > PH0 && PH != 1 && PH != 4) {
#if defined(__HIP_DEVICE_COMPILE__)
            ArgsP apb = (ArgsP)__builtin_amdgcn_kernarg_segment_ptr(); asm volatile("" : "+s"(apb));
            XcdBarrier xb2; xb2.bar = (unsigned*)(apb->ws + WS_BAR); xb2.x = xb_xcc_id(); xb2.st = (volatile LAS unsigned*)(lds + BAR_LDS_OFF);
            int wv = wave_id_s; asm volatile("" : "+s"(wv));
            if constexpr (PH == 2) { const Args ab = *apb; xcd_barrier_work<1>(xb2, lds, ab, wv * 64 + lane_id_opaque(), gridDim.x); }
            else if constexpr (PH == 3 || PH == 5 || PH == 6 || PH == 7 || PH == 8) { const Args ab = *apb; xcd_barrier_work<2>(xb2, lds, ab, wv * 64 + lane_id_opaque(), gridDim.x); }
            else xcd_barrier(xb2, wv * 64 + lane_id_opaque(), gridDim.x);
#endif
        }
        do_phase<PH>(lds, a_in, wave_id_s);
#if TS_A > -2 && defined(__HIP_DEVICE_COMPILE__)
        { ArgsP apt = (ArgsP)__builtin_amdgcn_kernarg_segment_ptr(); asm volatile("" : "+s"(apt)); ts_mark(apt->ws, PH, wave_id_s); }
#endif
        run_phases<PH + 1, PH0, PH1>(lds, a_in, wave_id_s);
    }
#if TS_A > -2 && defined(__HIP_DEVICE_COMPILE__)
    else {
        ArgsP apb = (ArgsP)__builtin_amdgcn_kernarg_segment_ptr(); asm volatile("" : "+s"(apb));
        XcdBarrier xb2; xb2.bar = (unsigned*)(apb->ws + WS_BAR); xb2.x = xb_xcc_id(); xb2.st = (volatile LAS unsigned*)(lds + BAR_LDS_OFF);
        int wv = wave_id_s; asm volatile("" : "+s"(wv));
        const int tidp = wv * 64 + lane_id_opaque();
        xcd_barrier(xb2, tidp, gridDim.x);
        if (blockIdx.x == 0 && tidp == 0) {
            const long long va = ts_value(apb->ws, TS_A) / 100, vb = ts_value(apb->ws, TS_B) / 100;
            const long long ticks = 16 * ts_value(apb->ws, TS_A) + 0 * (va + vb);
            const unsigned long long t0 = wall_clock64();
            while ((long long)(wall_clock64() - t0) < ticks) __builtin_amdgcn_s_sleep(8);
        }
    }
#endif
}
template <int PH0, int PH1>
__global__ void __launch_bounds__(NTHREADS, 2) hybrid_fwd(Args a_in) {
    extern __shared__ __attribute__((aligned(16))) unsigned char lds_raw[];
    LAS unsigned char* lds = (LAS unsigned char*)lds_raw;
    const int wave_id_s = __builtin_amdgcn_readfirstlane((int)threadIdx.x >> 6);
    {
        volatile LAS unsigned* st = (volatile LAS unsigned*)(lds + BAR_LDS_OFF);
        if (threadIdx.x == 0) { st[0] = 0u; st[1] = 0u; }
        __syncthreads();
        (void)xcd_barrier_post((unsigned*)(a_in.ws + WS_BAR), st, (int)threadIdx.x);
    }
#if TS_A > -2
    ts_mark(a_in.ws, 15, wave_id_s);
#endif
    run_phases<PH0, PH0, PH1>(lds, a_in, wave_id_s);
}

extern "C" void kernel_launch(void* const* d_in, const int* in_sizes, int n_in, void* d_out, int out_size, void* d_ws, size_t ws_size, hipStream_t stream) {
    if (n_in != 28 || out_size != NTOK * D || ws_size < WS_END) { fprintf(stderr, "kernel_launch: unexpected shapes (n_in %d out %d ws %zu)\n", n_in, out_size, ws_size); return; }
    Args a{};
    for (int i = 0; i < 28; ++i) a.in[i] = (const float*)d_in[i];
    a.out = (float*)d_out; a.ws = (unsigned char*)d_ws; a.dbg = PROBE_MASK; a.pad = 0;
    static int grid = 0;
    if (!grid) {
        (void)hipFuncSetAttribute((const void*)hybrid_fwd<0, 11>, hipFuncAttributeMaxDynamicSharedMemorySize, LDS_BYTES);
        int dev = 0, cus = 0, per_cu = 0;
        (void)hipGetDevice(&dev); (void)hipDeviceGetAttribute(&cus, hipDeviceAttributeMultiprocessorCount, dev);
        (void)hipOccupancyMaxActiveBlocksPerMultiprocessor(&per_cu, (const void*)hybrid_fwd<0, 11>, NTHREADS, LDS_BYTES);
        grid = (per_cu >= 1 ? 1 : 0) * cus;
        if (grid != 256) fprintf(stderr, "kernel_launch: grid %d (cus %d per_cu %d)\n", grid, cus, per_cu);
    }
    if (grid <= 0) return;
    a.ph_lo = 0; a.ph_hi = 11;
    (void)hipMemsetAsync((char*)d_ws + WS_CTL, 0, 65536, stream);
    void* kargs[] = {&a};
    hipError_t e = hipLaunchCooperativeKernel((const void*)hybrid_fwd<0, 11>, dim3(grid), dim3(NTHREADS), kargs, LDS_BYTES, stream);
    if (e != hipSuccess) fprintf(stderr, "cooperative launch failed: %s (grid %d)\n", hipGetErrorString(e), grid);
}
```
